# Optimizing an MI355X kernel written in HIP

```python
import math
import jax, jax.numpy as jnp
from jax import lax
import numpy as np

D_MODEL = 2048
BATCH = 4
SEQ = 2048
DEPTH = 1
DEC_BATCH = 128
DEC_SEQ = 8
PAST_LEN = 16384
PAGE_SIZE = 128

POOL_WINDOWS = (2, 4, 8, 16)
POOL_MAX = 16
D_POOL = D_MODEL // 2
POOL_GROUP = D_POOL // 4
POOL_OUT_GROUP = D_MODEL // 4
N_HEADS = 8
DK = 128
DV = 256
D_QK = N_HEADS * DK
D_V = N_HEADS * DV
RET_CHUNK = 128
ROPE_BASE = 10000.0
D_FF = 5632
CONV_K = 3
EPS = 1e-6

IN_SPLITS = (D_POOL, D_QK, D_QK, D_V, D_V, D_MODEL, D_MODEL)
N_IN = sum(IN_SPLITS)

kernel_name = "hybrid_pool_retention_convffn_step"


def _split_points(sizes):
    pts, acc = [], 0
    for s in sizes[:-1]:
        acc += s
        pts.append(acc)
    return pts


def rmsnorm(x, g):
    x32 = x.astype(jnp.float32)
    y = x32 * lax.rsqrt(jnp.mean(x32 * x32, axis=-1, keepdims=True) + EPS)
    return (y * g.astype(jnp.float32)).astype(x.dtype)


def rotary(x, pos):
    half = DK // 2
    theta = ROPE_BASE ** (-jnp.arange(half, dtype=jnp.float32) / half)
    ang = pos.astype(jnp.float32)[:, None] * theta[None, :]
    cos = jnp.cos(ang)[None, :, None, :]
    sin = jnp.sin(ang)[None, :, None, :]
    x32 = x.astype(jnp.float32)
    x1, x2 = x32[..., :half], x32[..., half:]
    return jnp.concatenate([x1 * cos - x2 * sin, x2 * cos + x1 * sin], axis=-1)


def pool_mix(u_ext, pos, w_pool, pool_scale):
    P = POOL_MAX
    L = u_ext.shape[1] - (P - 1)
    u32 = u_ext.astype(jnp.float32)
    cz = jnp.concatenate([jnp.zeros_like(u32[:, :1]), jnp.cumsum(u32, axis=1)], axis=1)
    u = u32[:, P - 1:]
    outs = []
    for g, w in enumerate(POOL_WINDOWS):
        sl = slice(g * POOL_GROUP, (g + 1) * POOL_GROUP)
        wsum = cz[:, P:P + L, sl] - cz[:, P - w:P - w + L, sl]
        cnt = jnp.minimum(w, pos + 1).astype(jnp.float32)[None, :, None]
        z = wsum / cnt - u[:, :, sl]
        outs.append(jnp.einsum('bld,de->ble', z, w_pool[g].astype(jnp.float32)))
    a = jnp.concatenate(outs, axis=-1) * pool_scale.astype(jnp.float32)
    return a.astype(u_ext.dtype)


def retention(q, k, v, state0):
    B, L = q.shape[0], q.shape[1]
    C = RET_CHUNK if L % RET_CHUNK == 0 else L
    n = L // C
    log_g = jnp.log(1.0 - 2.0 ** (-5.0 - jnp.arange(N_HEADS, dtype=jnp.float32)))
    idx = jnp.arange(C, dtype=jnp.float32)
    rel = idx[:, None] - idx[None, :]
    dmask = jnp.where(rel >= 0, jnp.exp(jnp.maximum(rel, 0.0)[None] * log_g[:, None, None]), 0.0)
    xi = jnp.exp((idx + 1.0)[None, :] * log_g[:, None])
    zeta = jnp.exp((C - 1.0 - idx)[None, :] * log_g[:, None])
    g_c = jnp.exp(C * log_g)

    def to_chunks(t):
        d = t.shape[-1]
        return t.reshape(B, n, C, N_HEADS, d).transpose(1, 0, 3, 2, 4)

    def step(R, inp):
        qc, kc, vc = inp
        s = jnp.einsum('bhid,bhjd->bhij', qc, kc) * dmask[None]
        o = jnp.einsum('bhij,bhjv->bhiv', s, vc) + \
            jnp.einsum('bhid,bhdv->bhiv', qc, R) * xi[None, :, :, None]
        R = R * g_c[None, :, None, None] + \
            jnp.einsum('bhjd,bhjv->bhdv', kc * zeta[None, :, :, None], vc)
        return R, o

    R, o = lax.scan(step, state0.astype(jnp.float32), (to_chunks(q), to_chunks(k), to_chunks(v)))
    o = o.transpose(1, 0, 3, 2, 4).reshape(B, L, N_HEADS, DV)
    return o, R


def causal_dwconv(u_ext, conv_w, conv_b):
    L = u_ext.shape[1] - (CONV_K - 1)
    y = conv_b[None, None, :]
    for j in range(CONV_K):
        y = y + u_ext[:, j:j + L] * conv_w[j][None, None, :]
    return y


def layer(x, pos, pool_buf, ret_state, conv_buf,
          g_pre_mix, w_in, w_pool, pool_scale, gn_gain, w_out, g_post_mix,
          g_pre_ffn, w_up, conv_w, conv_b, w_down, g_post_ffn):
    B, L, _ = x.shape
    h = rmsnorm(x, g_pre_mix)
    proj = jnp.einsum('bld,dn->bln', h, w_in)
    u_pool, q, k, v, g_ret, g_a, g_r = jnp.split(proj, _split_points(IN_SPLITS), axis=-1)

    pool_ext = jnp.concatenate([pool_buf.astype(u_pool.dtype), u_pool], axis=1)
    a = pool_mix(pool_ext, pos, w_pool, pool_scale)

    q = rotary(q.reshape(B, L, N_HEADS, DK), pos)
    k = rotary(k.reshape(B, L, N_HEADS, DK), pos) * (DK ** -0.5)
    v = v.reshape(B, L, N_HEADS, DV).astype(jnp.float32)
    o, R = retention(q, k, v, ret_state)
    mu = jnp.mean(o, axis=-1, keepdims=True)
    var = jnp.mean(jnp.square(o - mu), axis=-1, keepdims=True)
    o = ((o - mu) * lax.rsqrt(var + EPS)).reshape(B, L, D_V) * gn_gain.astype(jnp.float32)
    r = (jax.nn.silu(g_ret.astype(jnp.float32)) * o).astype(x.dtype)

    m = jax.nn.sigmoid(g_a) * a + jax.nn.sigmoid(g_r) * r
    x1 = x + rmsnorm(jnp.einsum('bld,de->ble', m, w_out), g_post_mix)

    h2 = rmsnorm(x1, g_pre_ffn)
    up = jnp.einsum('bld,df->blf', h2, w_up)
    up_ext = jnp.concatenate([conv_buf.astype(up.dtype), up], axis=1)
    c = causal_dwconv(up_ext, conv_w, conv_b)
    val, gate = c[..., :D_FF], c[..., D_FF:]
    f = jnp.einsum('blf,fd->bld', jax.nn.gelu(gate, approximate=True) * val, w_down)
    y = x1 + rmsnorm(f, g_post_ffn)

    new_pool = pool_ext[:, -(POOL_MAX - 1):]
    new_conv = up_ext[:, -(CONV_K - 1):]
    return y, new_pool, R.astype(x.dtype), new_conv


def setup_inputs(seed: int = 0) -> dict:
    key = jax.random.key(seed)
    ks = jax.random.split(key, 20)
    f32 = jnp.float32
    nrm = lambda k, s: jax.random.normal(k, s, f32)
    return {
        "x_prompt": nrm(ks[0], (BATCH, SEQ, D_MODEL)),
        "x_sample": nrm(ks[1], (DEC_BATCH, DEC_SEQ, D_MODEL)),
        "state_pool": nrm(ks[2], (DEC_BATCH, POOL_MAX - 1, D_POOL)),
        "state_ret": 0.1 * nrm(ks[3], (DEC_BATCH, N_HEADS, DK, DV)),
        "state_conv": nrm(ks[4], (DEC_BATCH, CONV_K - 1, 2 * D_FF)),
        "g_pre_mix": 1.0 + 0.02 * nrm(ks[5], (D_MODEL,)),
        "w_in": nrm(ks[6], (D_MODEL, N_IN)) * D_MODEL ** -0.5,
        "w_pool": nrm(ks[7], (4, POOL_GROUP, POOL_OUT_GROUP)) * POOL_GROUP ** -0.5,
        "pool_scale": 1.0 + 0.1 * nrm(ks[8], (D_MODEL,)),
        "gn_gain": 1.0 + 0.02 * nrm(ks[9], (D_V,)),
        "w_out": nrm(ks[10], (D_MODEL, D_MODEL)) * D_MODEL ** -0.5,
        "g_post_mix": 1.0 + 0.02 * nrm(ks[11], (D_MODEL,)),
        "g_pre_ffn": 1.0 + 0.02 * nrm(ks[12], (D_MODEL,)),
        "w_up": nrm(ks[13], (D_MODEL, 2 * D_FF)) * D_MODEL ** -0.5,
        "conv_w": nrm(ks[14], (CONV_K, 2 * D_FF)) * CONV_K ** -0.5,
        "conv_b": 0.01 * nrm(ks[15], (2 * D_FF,)),
        "w_down": nrm(ks[16], (D_FF, D_MODEL)) * D_FF ** -0.5,
        "g_post_ffn": 1.0 + 0.02 * nrm(ks[17], (D_MODEL,)),
    }


def reference(x_prompt, x_sample, state_pool, state_ret, state_conv,
              g_pre_mix, w_in, w_pool, pool_scale, gn_gain, w_out, g_post_mix,
              g_pre_ffn, w_up, conv_w, conv_b, w_down, g_post_ffn):
    weights = (g_pre_mix, w_in, w_pool, pool_scale, gn_gain, w_out, g_post_mix,
               g_pre_ffn, w_up, conv_w, conv_b, w_down, g_post_ffn)
    Bp, Lp = x_prompt.shape[0], x_prompt.shape[1]
    Ls = x_sample.shape[1]
    pos_p = jnp.arange(Lp, dtype=jnp.int32)
    pos_s = PAST_LEN + jnp.arange(Ls, dtype=jnp.int32)

    yp, sp_pool, sp_ret, sp_conv = x_prompt, None, None, None
    ys, ss_pool, ss_ret, ss_conv = x_sample, None, None, None
    for _ in range(DEPTH):
        yp, sp_pool, sp_ret, sp_conv = layer(
            yp, pos_p,
            jnp.zeros((Bp, POOL_MAX - 1, D_POOL), x_prompt.dtype),
            jnp.zeros((Bp, N_HEADS, DK, DV), x_prompt.dtype),
            jnp.zeros((Bp, CONV_K - 1, 2 * D_FF), x_prompt.dtype),
            *weights)
        ys, ss_pool, ss_ret, ss_conv = layer(
            ys, pos_s, state_pool, state_ret, state_conv, *weights)
    return (yp, ys, sp_pool, sp_ret, sp_conv, ss_pool, ss_ret, ss_conv)
```

```cpp
#include <hip/hip_runtime.h>
#include <cstdio>
#include <cstdint>
namespace pg8 {
#define PG8_LAS __attribute__((address_space(3)))
typedef unsigned short bf16_t;
typedef short bf16x8 __attribute__((ext_vector_type(8)));
typedef float f32x4 __attribute__((ext_vector_type(4)));
typedef unsigned u32x4 __attribute__((ext_vector_type(4)));
constexpr int BM = 256, BK = 64, HALF = 128, HTB = HALF * BK * 2  , STAGE_BYTES = 8 * HTB, NXCD = 8, WGM = 2;

__host__ __device__ __forceinline__ int lds_byte(int r, int c) { const int st = (r >> 4) * 2 + (c >> 5), rr = r & 15, cc = c & 31, ob = rr * 64 + cc * 2; return st * 1024 + (ob ^ (((ob >> 9) & 1) << 5)); }
__host__ __device__ __forceinline__ void stage_rc(int b, int& R, int& C) { const int st = b / 1024, sb = b % 1024, swz = sb ^ (((sb >> 9) & 1) << 5); R = (st >> 1) * 16 + swz / 64; C = (st & 1) * 32 + (swz % 64) / 2; }
__host__ __device__ __forceinline__ int perm32(int rho) { const int n = rho >> 4, i = rho & 15; return 8 * (i >> 2) + 4 * n + (i & 3); }

struct Unit { int pm, pn, k0, nt, np, piece, slot; };
struct Gemm { const bf16_t* A; const bf16_t* Bt; int M, N, K; };

struct StaticOrder {
    int nM, nN, nwg, G, c;
    __host__ __device__ void init(int M, int N, int G_, int c_) { nM = M / BM; nN = N / BM; nwg = nM * nN; G = G_; c = c_; }
    __host__ __device__ bool next(int i, Unit& u) const {
        const long L = (long)i * G + c; if (L >= nwg) return false;
        int wgid = (int)L;
#ifndef ORDER_NOREMAP
        { const int q = nwg / NXCD, r = nwg % NXCD, xcd = wgid % NXCD, off = wgid / NXCD; wgid = (xcd < r ? xcd * (q + 1) : r * (q + 1) + (xcd - r) * q) + off; }
#endif
        const int nig = WGM * nN, gid = wgid / nig, fm = gid * WGM, gsz = (nM - fm) < WGM ? (nM - fm) : WGM;
        u.pm = fm + ((wgid % nig) % gsz); u.pn = (wgid % nig) / gsz; return true;
    }
    __device__ __forceinline__ void a_ready(const Unit&) const {}
    __device__ __forceinline__ void done(const Unit&) const {}
};


struct HybridOrder {
    int nM, nN, nwg, G, c, ntk, nfull, nrem, np;
    __host__ __device__ void init(int M, int N, int K, int G_, int c_, bool allow_split = true) {
        nM = M / BM; nN = N / BM; nwg = nM * nN; G = G_; c = c_; ntk = K / BK; nfull = nwg / G; nrem = nwg - nfull * G; np = 0;
        if (allow_split && nrem > 0 && (G % NXCD) == 0) { const int grp = (nrem + NXCD - 1) / NXCD; int p = (G / NXCD) / grp; const int maxp = ntk / 4; if (p > maxp) p = maxp; if (p > 8) p = 8; if (p >= 2) np = p; }
    }
    __host__ __device__ void map(long L, Unit& u) const {
        int wgid = (int)L;
#ifndef ORDER_NOREMAP
        { const int q = nwg / NXCD, r = nwg % NXCD, xcd = wgid % NXCD, off = wgid / NXCD; wgid = (xcd < r ? xcd * (q + 1) : r * (q + 1) + (xcd - r) * q) + off; }
#endif
        const int nig = WGM * nN, gid = wgid / nig, fm = gid * WGM, gsz = (nM - fm) < WGM ? (nM - fm) : WGM;
        u.pm = fm + ((wgid % nig) % gsz); u.pn = (wgid % nig) / gsz; u.k0 = 0; u.nt = ntk; u.np = 0; u.piece = 0; u.slot = 0;
    }
    __host__ __device__ bool next(int i, Unit& u) const {
        if (i < nfull) { map((long)i * G + c, u); return true; }
        if (i > nfull || nrem == 0) return false;
        if (np == 0) { if (c >= nrem) return false; map((long)nfull * G + c, u); return true; }
        const int x = c % NXCD, j = c / NXCD, grp = j / np, p = j - grp * np, r = grp * NXCD + x;
        if (r >= nrem) return false;
        map((long)nfull * G + r, u);
        const int pairs = ntk / 2, base = pairs / np, extra = pairs - base * np, first_big = np - extra;
        const int start = p * base + (p > first_big ? p - first_big : 0), len = base + (p >= first_big ? 1 : 0);
        u.k0 = 2 * start; u.nt = 2 * len; u.np = np; u.piece = p; u.slot = r; return true;
    }
    __device__ __forceinline__ void a_ready(const Unit&) const {}
    __device__ __forceinline__ void done(const Unit&) const {}
};
struct SplitCtx { float* slabs; unsigned* cnt; };

__device__ __forceinline__ unsigned cvt_pk_bf16(float lo, float hi) { unsigned r; asm volatile("v_cvt_pk_bf16_f32 %0, %1, %2" : "=v"(r) : "v"(lo), "v"(hi)); return r; }
typedef float f32x2 __attribute__((ext_vector_type(2)));
__device__ __forceinline__ f32x2 gelu_pk(f32x2 v) {
    const f32x2 av = __builtin_elementwise_abs(v), d = av * 0.2316418882f + 1.0f;
    f32x2 t; t.x = __builtin_amdgcn_rcpf(d.x); t.y = __builtin_amdgcn_rcpf(d.y);
    f32x2 q = t * 0.5307027145f + (-0.7265760135f); q = q * t + 0.7107068705f; q = q * t + (-0.142248368f); q = q * t + 0.127414796f; q = q * t;
    const f32x2 s = (v * v) * (-0.72134752044f);
    f32x2 e; e.x = __builtin_amdgcn_exp2f(s.x); e.y = __builtin_amdgcn_exp2f(s.y);
    const f32x2 m = v * (q * e), r = v - m;
    f32x2 o; o.x = v.x < 0.f ? m.x : r.x; o.y = v.y < 0.f ? m.y : r.y; return o;
}

template <int ACT> struct EpiBf16 {
    static constexpr bool PERM = true, AFTER_DRAIN = false;
    bf16_t* O; int ldc;
    __device__ __forceinline__ void tri(const f32x4 v0, const f32x4 v1, const Unit& u, int ai, int bj, int m, int wr, int wc, int fr, int fq) const {
        bf16_t* p = O + (size_t)(u.pm * BM + ai * HALF + wr * 64 + m * 16 + fr) * ldc + u.pn * BM + bj * HALF + wc * 32 + 8 * fq;
        u32x4 w; w.x = cvt_pk_bf16(v0[0], v0[1]); w.y = cvt_pk_bf16(v0[2], v0[3]); w.z = cvt_pk_bf16(v1[0], v1[1]); w.w = cvt_pk_bf16(v1[2], v1[3]);
        *(u32x4*)p = w;
    }
    __device__ __forceinline__ void operator()(const f32x4 (&acc)[2][2][4][2], const Unit& u, int wr, int wc, int fr, int fq) const {
#pragma unroll
        for (int ai = 0; ai < 2; ++ai)
#pragma unroll
            for (int m = 0; m < 4; ++m)
#pragma unroll
                for (int bj = 0; bj < 2; ++bj) tri(acc[ai][bj][m][0], acc[ai][bj][m][1], u, ai, bj, m, wr, wc, fr, fq);
    }
};
struct EpiF32 {
    static constexpr bool PERM = false, AFTER_DRAIN = false;
    float* C; int ldc;
    __device__ __forceinline__ void tri(const f32x4 v0, const f32x4 v1, const Unit& u, int ai, int bj, int m, int wr, int wc, int fr, int fq) const {
        float* p = C + (size_t)(u.pm * BM + ai * HALF + wr * 64 + m * 16 + fr) * ldc + u.pn * BM + bj * HALF + wc * 32 + 4 * fq;
        *(f32x4*)p = v0; *(f32x4*)(p + 16) = v1;
    }
    __device__ __forceinline__ void operator()(const f32x4 (&acc)[2][2][4][2], const Unit& u, int wr, int wc, int fr, int fq) const {
#pragma unroll
        for (int ai = 0; ai < 2; ++ai)
#pragma unroll
            for (int m = 0; m < 4; ++m)
#pragma unroll
                for (int bj = 0; bj < 2; ++bj) tri(acc[ai][bj][m][0], acc[ai][bj][m][1], u, ai, bj, m, wr, wc, fr, fq);
    }
};
typedef unsigned u32x2 __attribute__((ext_vector_type(2)));
__device__ __forceinline__ f32x4 bf4_to_f32(u32x2 x) { f32x4 o; o[0] = __builtin_bit_cast(float, x.x << 16); o[1] = __builtin_bit_cast(float, x.x & 0xffff0000u); o[2] = __builtin_bit_cast(float, x.y << 16); o[3] = __builtin_bit_cast(float, x.y & 0xffff0000u); return o; }
template <int NP, class Epi> __device__ __forceinline__ void split_epilogue(const f32x4 (&acc)[2][2][4][2], const Unit& u, const Epi& E, const SplitCtx& X, int tid, int wr, int wc, int fr, int fq) {
    constexpr int SLAB = 32 * 512 * 8;
    const __amdgpu_buffer_rsrc_t rs = __builtin_amdgcn_make_buffer_rsrc((void*)((char*)X.slabs + (size_t)(u.slot * u.np) * SLAB), 0, u.np * SLAB, 0x00020000);
    {
        const int so = u.piece * SLAB;
#pragma unroll
        for (int r = 0; r < 32; ++r) { const f32x4 v = acc[r >> 4][(r >> 3) & 1][(r >> 1) & 3][r & 1]; u32x2 w; w.x = cvt_pk_bf16(v[0], v[1]); w.y = cvt_pk_bf16(v[2], v[3]);
            __builtin_amdgcn_raw_buffer_store_b64(w, rs, (unsigned)(tid * 8), so + r * 4096, 16); }
    }
    asm volatile("s_waitcnt vmcnt(0)" ::: "memory");
    asm volatile("" ::: "memory"); __builtin_amdgcn_s_barrier(); asm volatile("" ::: "memory");
    if (tid == 0) {
        unsigned* cw = X.cnt + 64 * u.slot;
        (void)__hip_atomic_fetch_add(cw, 1u, __ATOMIC_RELAXED, __HIP_MEMORY_SCOPE_AGENT);
        unsigned sp = 0;
        while (__hip_atomic_load(cw, __ATOMIC_RELAXED, __HIP_MEMORY_SCOPE_AGENT) < (unsigned)u.np) { __builtin_amdgcn_s_sleep(1); if (++sp > (1u << 24)) break; }
        __builtin_amdgcn_fence(__ATOMIC_ACQUIRE, "agent");
        asm volatile("s_waitcnt vmcnt(0)" ::: "memory");
    }
    asm volatile("" ::: "memory"); __builtin_amdgcn_s_barrier(); asm volatile("" ::: "memory");
    const int q0 = (16 * u.piece) / u.np, q1 = (16 * (u.piece + 1)) / u.np;
#pragma unroll 1
    for (int q = q0; q < q1; ++q) {
        const unsigned vo = (unsigned)(tid * 8 + q * 8192);
        f32x4 v0 = (f32x4){0.f, 0.f, 0.f, 0.f}, v1 = v0;
        if (u.np == NP) {
            u32x2 t0[NP], t1[NP];
#pragma unroll
            for (int pp = 0; pp < NP; ++pp) { t0[pp] = __builtin_amdgcn_raw_buffer_load_b64(rs, vo, pp * SLAB, 0); t1[pp] = __builtin_amdgcn_raw_buffer_load_b64(rs, vo, pp * SLAB + 4096, 0); }
#pragma unroll
            for (int pp = 0; pp < NP; ++pp) { v0 += bf4_to_f32(t0[pp]); v1 += bf4_to_f32(t1[pp]); }
        } else {
            for (int pp = 0; pp < u.np; ++pp) { v0 += bf4_to_f32(__builtin_amdgcn_raw_buffer_load_b64(rs, vo, pp * SLAB, 0)); v1 += bf4_to_f32(__builtin_amdgcn_raw_buffer_load_b64(rs, vo, pp * SLAB + 4096, 0)); }
        }
        E.tri(v0, v1, u, q >> 3, (q >> 2) & 1, q & 3, wr, wc, fr, fq);
    }
}
template <class Epi, class Sched, bool ALIGN_EPI = false, bool SP2 = false, int NP = 8>
__device__ __forceinline__ void gemm_phase(PG8_LAS unsigned char* lds, const Gemm g, const Sched& S, const Epi& E, const SplitCtx& X) {
    int tid_ = threadIdx.x; asm volatile("" : "+v"(tid_));
    const int tid = tid_, wid = __builtin_amdgcn_readfirstlane(tid >> 6), lane = tid & 63, wr = wid >> 2, wc = wid & 3, fr = lane & 15, fq = lane >> 4;
    const int K = g.K;
    unsigned voffA[2], voffB[2];
#pragma unroll
    for (int i = 0; i < 2; ++i) { int R, C; stage_rc(tid * 16 + i * 8192, R, C); const int Rb = Epi::PERM ? ((R & ~31) + perm32(R & 31)) : R;
        voffA[i] = (unsigned)(R * K + C) * 2u; voffB[i] = (unsigned)(Rb * K + C) * 2u; }
    const size_t kstep = (size_t)(BK * 2);
    const size_t hstep = (size_t)HALF * K * 2;
    const size_t tstep = 2 * hstep;
    const unsigned ldsw = (unsigned)wid * 1024u;
    const int aoff = lds_byte(wr * 64 + fr, fq * 8), boff = lds_byte(wc * 32 + fr, fq * 8);
#define PG8_SA(b, h) (((b) * 2 + (h)) * HTB)
#define PG8_SB(b, h) ((4 + (b) * 2 + (h)) * HTB)
#define PG8_STAGE(bufoff, gbase, voff) do { _Pragma("unroll") for (int _i = 0; _i < 2; ++_i) \
        __builtin_amdgcn_global_load_lds((const unsigned*)((const char*)(gbase) + (voff)[_i]), (PG8_LAS unsigned*)(lds + (bufoff) + ldsw + _i * 8192), 16, 0, 0); } while (0)
#define PG8_LDA(dst, b, h) do { _Pragma("unroll") for (int m = 0; m < 4; ++m) _Pragma("unroll") for (int k = 0; k < 2; ++k) dst[m][k] = *(const PG8_LAS bf16x8*)(lds + PG8_SA(b, h) + aoff + m * 2048 + k * 1024); } while (0)
#define PG8_LDB(dst, b, h) do { _Pragma("unroll") for (int n = 0; n < 2; ++n) _Pragma("unroll") for (int k = 0; k < 2; ++k) dst[n][k] = *(const PG8_LAS bf16x8*)(lds + PG8_SB(b, h) + boff + n * 2048 + k * 1024); } while (0)
#define PG8_MMA(ai, bj, At, Bt) do { __builtin_amdgcn_s_setprio(1); _Pragma("unroll") for (int m = 0; m < 4; ++m) _Pragma("unroll") for (int n = 0; n < 2; ++n) _Pragma("unroll") for (int k = 0; k < 2; ++k) \
        acc[ai][bj][m][n] = __builtin_amdgcn_mfma_f32_16x16x32_bf16(Bt[n][k], At[m][k], acc[ai][bj][m][n], 0, 0, 0); __builtin_amdgcn_s_setprio(0); } while (0)
#define PG8_WAIT_V(n) asm volatile("s_waitcnt vmcnt(" #n ")" ::: "memory")
#define PG8_WAIT_L(n) asm volatile("s_waitcnt lgkmcnt(" #n ")" ::: "memory")
#define PG8_BAR __builtin_amdgcn_s_barrier()
#define PG8_SCHED __builtin_amdgcn_sched_barrier(0)
    Unit cur, nxt; int ui = 0;
    if (!S.next(0, cur)) return;
    f32x4 acc[2][2][4][2];
#pragma unroll
    for (int a = 0; a < 2; ++a)
#pragma unroll
        for (int b = 0; b < 2; ++b)
#pragma unroll
            for (int m = 0; m < 4; ++m)
#pragma unroll
                for (int n = 0; n < 2; ++n) acc[a][b][m][n] = (f32x4){0.f, 0.f, 0.f, 0.f};
    bf16x8 At[4][2], B0[2][2], B1[2][2];
    const char* cA = (const char*)g.A + (size_t)cur.pm * tstep + (size_t)cur.k0 * kstep; const char* cB = (const char*)g.Bt + (size_t)cur.pn * tstep + (size_t)cur.k0 * kstep;
    S.a_ready(cur);
    if constexpr (SP2) {
        PG8_STAGE(PG8_SB(0, 0), cB, voffB); PG8_STAGE(PG8_SB(0, 1), cB + hstep, voffB); PG8_STAGE(PG8_SA(0, 0), cA, voffA); PG8_STAGE(PG8_SA(0, 1), cA + hstep, voffA);
        if (wr == 1) PG8_BAR;
        PG8_WAIT_V(2); PG8_BAR;
        PG8_STAGE(PG8_SB(1, 0), cB + kstep, voffB); PG8_STAGE(PG8_SA(1, 0), cA + kstep, voffA); PG8_STAGE(PG8_SB(1, 1), cB + hstep + kstep, voffB);
        PG8_WAIT_V(6); PG8_BAR;
    } else {
        PG8_STAGE(PG8_SB(0, 0), cB, voffB); PG8_STAGE(PG8_SA(0, 0), cA, voffA); PG8_STAGE(PG8_SB(0, 1), cB + hstep, voffB); PG8_STAGE(PG8_SA(0, 1), cA + hstep, voffA);
        if (wr == 1) PG8_BAR;
        PG8_WAIT_V(4); PG8_BAR;
        PG8_STAGE(PG8_SB(1, 0), cB + kstep, voffB); PG8_STAGE(PG8_SA(1, 0), cA + kstep, voffA); PG8_STAGE(PG8_SB(1, 1), cB + hstep + kstep, voffB);
        PG8_WAIT_V(6); PG8_BAR;
    }
    for (;;) {
        const bool has_next = S.next(ui + 1, nxt);
        const char* nA = has_next ? (const char*)g.A + (size_t)nxt.pm * tstep + (size_t)nxt.k0 * kstep : cA; const char* nB = has_next ? (const char*)g.Bt + (size_t)nxt.pn * tstep + (size_t)nxt.k0 * kstep : cB;
        const int nt = cur.nt;
        for (int t = 0; t < nt; t += 2) {
            const bool last = (t == nt - 2);
            const char* a1 = cA + (size_t)(t + 1) * kstep;
            const char* a2 = last ? nA : cA + (size_t)(t + 2) * kstep; const char* b2 = last ? nB : cB + (size_t)(t + 2) * kstep;
            const char* a3 = a2 + kstep; const char* b3 = b2 + kstep;
            if (last && has_next) S.a_ready(nxt);
            if constexpr (SP2) {
            PG8_LDB(B0, 0, 0); PG8_LDB(B1, 0, 1); PG8_SCHED; PG8_LDA(At, 0, 0); PG8_STAGE(PG8_SA(1, 1), a1 + hstep, voffA);
            PG8_WAIT_V(8); PG8_WAIT_L(0); PG8_BAR; PG8_MMA(0, 0, At, B0); PG8_MMA(0, 1, At, B1); PG8_BAR; PG8_SCHED;
            PG8_LDA(At, 0, 1); PG8_STAGE(PG8_SB(0, 0), b2, voffB); PG8_STAGE(PG8_SB(0, 1), b2 + hstep, voffB); PG8_STAGE(PG8_SA(0, 0), a2, voffA);
            PG8_WAIT_V(8); PG8_WAIT_L(0); PG8_BAR; PG8_MMA(1, 0, At, B0); PG8_MMA(1, 1, At, B1); PG8_BAR; PG8_SCHED;
            PG8_LDB(B0, 1, 0); PG8_LDB(B1, 1, 1); PG8_SCHED; PG8_LDA(At, 1, 0); PG8_STAGE(PG8_SA(0, 1), a2 + hstep, voffA);
            PG8_WAIT_V(8); PG8_WAIT_L(0); PG8_BAR; PG8_MMA(0, 0, At, B0); PG8_MMA(0, 1, At, B1); PG8_BAR; PG8_SCHED;
            PG8_LDA(At, 1, 1); PG8_STAGE(PG8_SB(1, 0), b3, voffB); PG8_STAGE(PG8_SB(1, 1), b3 + hstep, voffB); PG8_STAGE(PG8_SA(1, 0), a3, voffA);
            PG8_WAIT_V(8); PG8_WAIT_L(0); PG8_BAR; PG8_MMA(1, 0, At, B0); PG8_MMA(1, 1, At, B1); PG8_BAR; PG8_SCHED;
            } else {
            PG8_LDB(B0, 0, 0); PG8_SCHED; PG8_LDA(At, 0, 0); PG8_STAGE(PG8_SA(1, 1), a1 + hstep, voffA);
            PG8_WAIT_L(8); PG8_BAR; PG8_WAIT_L(0); PG8_MMA(0, 0, At, B0); PG8_BAR; PG8_SCHED;
            PG8_LDB(B1, 0, 1); PG8_STAGE(PG8_SB(0, 0), b2, voffB);
            PG8_BAR; PG8_WAIT_L(0); PG8_MMA(0, 1, At, B1); PG8_BAR;
            PG8_LDA(At, 0, 1); PG8_STAGE(PG8_SA(0, 0), a2, voffA);
            PG8_BAR; PG8_WAIT_L(0); PG8_MMA(1, 0, At, B0); PG8_BAR; PG8_SCHED;
            PG8_STAGE(PG8_SB(0, 1), b2 + hstep, voffB);
            PG8_WAIT_V(6); PG8_BAR; PG8_MMA(1, 1, At, B1); PG8_BAR;
            PG8_LDB(B0, 1, 0); PG8_SCHED; PG8_LDA(At, 1, 0); PG8_STAGE(PG8_SA(0, 1), a2 + hstep, voffA);
            PG8_WAIT_L(8); PG8_BAR; PG8_WAIT_L(0); PG8_MMA(0, 0, At, B0); PG8_BAR; PG8_SCHED;
            PG8_LDB(B1, 1, 1); PG8_STAGE(PG8_SB(1, 0), b3, voffB);
            PG8_BAR; PG8_WAIT_L(0); PG8_MMA(0, 1, At, B1); PG8_BAR;
            PG8_LDA(At, 1, 1); PG8_STAGE(PG8_SA(1, 0), a3, voffA);
            PG8_BAR; PG8_WAIT_L(0); PG8_MMA(1, 0, At, B0); PG8_BAR; PG8_SCHED;
            PG8_STAGE(PG8_SB(1, 1), b3 + hstep, voffB);
            PG8_WAIT_V(6); PG8_BAR; PG8_MMA(1, 1, At, B1); PG8_BAR;
            }
        }
        if constexpr (ALIGN_EPI) { if (wr == 0) PG8_BAR; }
        if constexpr (!Epi::AFTER_DRAIN) { if (cur.np > 0) split_epilogue<NP>(acc, cur, E, X, tid, wr, wc, fr, fq); else E(acc, cur, wr, wc, fr, fq); S.done(cur); }
        if (!has_next) break;
#pragma unroll
        for (int a = 0; a < 2; ++a)
#pragma unroll
            for (int b = 0; b < 2; ++b)
#pragma unroll
                for (int m = 0; m < 4; ++m)
#pragma unroll
                    for (int n = 0; n < 2; ++n) acc[a][b][m][n] = (f32x4){0.f, 0.f, 0.f, 0.f};
        cur = nxt; cA = nA; cB = nB; ++ui;
        if constexpr (ALIGN_EPI) { if (wr == 1) PG8_BAR; }
    }
    PG8_WAIT_V(0);
    if constexpr (!ALIGN_EPI) { if (wr == 0) PG8_BAR; }
    PG8_BAR;
    if constexpr (Epi::AFTER_DRAIN) { E.fused(acc, cur, wr, wc, fr, fq, lds, wid, lane); S.done(cur); }
#undef PG8_SA
#undef PG8_SB
#undef PG8_STAGE
#undef PG8_LDA
#undef PG8_LDB
#undef PG8_MMA
#undef PG8_WAIT_V
#undef PG8_WAIT_L
#undef PG8_BAR
#undef PG8_SCHED
}
}

#ifndef PG8_SP2
#define PG8_SP2 true
#endif
#ifndef PG8_ALIGN
#define PG8_ALIGN true
#endif
#ifndef DUP_PHASE
#define DUP_PHASE -1
#endif
#ifndef MK_N_LAUNCHES
#define MK_N_LAUNCHES 1
#endif
constexpr int NWAVES = 8;
constexpr int N_PHASES = 10;
constexpr int N_LAUNCHES = MK_N_LAUNCHES;

constexpr int MP = 8192, MS = 1024, M = MP + MS;
constexpr int D = 2048, NIN = 11264, FF = 5632, FF2 = 11264;
constexpr int NH = 8, DK = 128, DVH = 256;
constexpr int C_POOL = 0, C_Q = 1024, C_K = 2048, C_V = 3072, C_GRET = 5120, C_GA = 7168, C_GR = 9216;
constexpr float EPS = 1e-6f;
constexpr int NS = 4, DVS = DVH / NS;
constexpr size_t O_Y = 0, O_POOLP = 18874368, O_RETP = 18935808, O_CONVP = 19984384, O_POOLS = 20074496, O_RETS = 22040576, O_CONVS = 55595008, O_END = 58478592;

constexpr size_t MiB = 1u << 20;
constexpr size_t WS_CTL = 0, CTL_ZERO_BYTES = 128 * 1024;
constexpr size_t WS_WIN = 1 * MiB, WS_WUP = 45 * MiB, WS_WDN = 89 * MiB, WS_WOUT = 111 * MiB, WS_WPOOL = 119 * MiB;
constexpr size_t WS_ROPE = 120 * MiB;
constexpr size_t WS_XN = 122 * MiB;
constexpr size_t WS_PROJ = 158 * MiB;
constexpr size_t WS_O = 356 * MiB, WS_AP = 392 * MiB, WS_MM = 428 * MiB;
constexpr size_t WS_SP16 = 464 * MiB;
constexpr size_t WS_END = 468 * MiB;
constexpr int CW_TMO = 0, CW_CODE = 1, CW_Q2 = 64, CW_QW = 192, CW_BAR = 4096, CW_SPLIT = 8192;
static_assert((CW_SPLIT + 4 * 4096) * 4 <= (int)CTL_ZERO_BYTES && CW_BAR + 3456 <= CW_SPLIT, "control words inside the per-call memset");
constexpr size_t WS_SLAB_A = 356 * MiB, WS_SLAB_B = 230 * MiB;

constexpr int LDS_BYTES = 147456, LDSCTL_OFF = 143360;

#define GAS __attribute__((address_space(1)))
#define LAS __attribute__((address_space(3)))
typedef unsigned short bf16;
typedef unsigned v4u __attribute__((ext_vector_type(4)));
typedef unsigned v2u __attribute__((ext_vector_type(2)));
typedef float f32x4 __attribute__((ext_vector_type(4)));
typedef short bf16x8 __attribute__((ext_vector_type(8)));
#define RLX_AGENT __ATOMIC_RELAXED, __HIP_MEMORY_SCOPE_AGENT
#define LDS_WAIT() asm volatile("s_waitcnt lgkmcnt(0)" ::: "memory")
#define VM_WAIT() asm volatile("s_waitcnt vmcnt(0)" ::: "memory")
__device__ __forceinline__ unsigned pk2(float lo, float hi) { return pg8::cvt_pk_bf16(lo, hi); }
__device__ __forceinline__ float bflo(unsigned u) { return __uint_as_float(u << 16); }
__device__ __forceinline__ float bfhi(unsigned u) { return __uint_as_float(u & 0xffff0000u); }
__device__ __forceinline__ void unpack8(v4u x, float (&f)[8]) { f[0] = bflo(x.x); f[1] = bfhi(x.x); f[2] = bflo(x.y); f[3] = bfhi(x.y); f[4] = bflo(x.z); f[5] = bfhi(x.z); f[6] = bflo(x.w); f[7] = bfhi(x.w); }
__device__ __forceinline__ v4u pack8(const float (&f)[8]) { v4u o; o.x = pk2(f[0], f[1]); o.y = pk2(f[2], f[3]); o.z = pk2(f[4], f[5]); o.w = pk2(f[6], f[7]); return o; }
__device__ __forceinline__ v2u pack4(f32x4 a) { v2u o; o.x = pk2(a[0], a[1]); o.y = pk2(a[2], a[3]); return o; }
__device__ __forceinline__ float sigmoidf_(float x) { return __builtin_amdgcn_rcpf(1.0f + __expf(-x)); }
__device__ __forceinline__ float wave_sum(float v) {
#pragma unroll
    for (int o = 1; o < 64; o <<= 1) v += __shfl_xor(v, o);
    return v;
}
__device__ __forceinline__ bf16x8 as_bf16x8(v4u x) { return __builtin_bit_cast(bf16x8, x); }
#define MFMA16(a, b, c) __builtin_amdgcn_mfma_f32_16x16x32_bf16((a), (b), (c), 0, 0, 0)

#define XB_TMO      128
#define XB_XCNT(j)  (256  + 64 * (j))
#define XB_XSUB(j)  (1280 + 64 * (j))
#define XB_XGEN(j)  (2304 + 64 * (j))
#define XB_TOP      3328
#define XB_TOPGEN   3392
#define XCD_BAR_WORDS 3456
#define XB_SPIN_CAP (1u << 22)
__device__ __forceinline__ unsigned xb_ld(unsigned* p)              { return __hip_atomic_load(p, __ATOMIC_RELAXED, __HIP_MEMORY_SCOPE_AGENT); }
__device__ __forceinline__ unsigned xb_add(unsigned* p, unsigned v) { return __hip_atomic_fetch_add(p, v, __ATOMIC_RELAXED, __HIP_MEMORY_SCOPE_AGENT); }
__device__ __forceinline__ unsigned xb_xcc_id() { return (unsigned)__builtin_amdgcn_s_getreg((3 << 11) | 20) & 0xFu; }
#define XB_SPIN(cond, bar) do { unsigned _sp = 0; while (cond) { __builtin_amdgcn_s_sleep(1); \
    if ((++_sp & 255u) == 0u) { if (xb_ld(&(bar)[XB_TMO])) break; if (_sp > XB_SPIN_CAP) { atomicAdd(&(bar)[XB_TMO], 1u); break; } } } } while (0)
struct XcdBarrier { unsigned* bar; unsigned x; volatile LAS unsigned* st; };
__device__ __forceinline__ XcdBarrier xcd_barrier_post(unsigned* bar, volatile LAS unsigned* st) {
    XcdBarrier b; b.bar = bar; b.x = xb_xcc_id(); b.st = st;
    if (threadIdx.x == 0) (void)xb_add(&bar[XB_XCNT(b.x)], 1u);
    return b;
}
__device__ __forceinline__ void xcd_barrier_complete(unsigned* bar, unsigned x, unsigned& nloc, unsigned& nx) {
    const unsigned G = gridDim.x * gridDim.y * gridDim.z;
    unsigned sum, cnt, mine, sp = 0u;
    for (;;) {
        sum = 0u; cnt = 0u; mine = 0u;
#pragma unroll
        for (unsigned j = 0; j < 16; ++j) { const unsigned c = xb_ld(&bar[XB_XCNT(j)]); sum += c; cnt += (c > 0u) ? 1u : 0u; mine = (j == x) ? c : mine; }
        if (sum == G) break;
        __builtin_amdgcn_s_sleep(1);
        if ((++sp & 255u) == 0u) { if (xb_ld(&bar[XB_TMO])) break; if (sp > XB_SPIN_CAP) { atomicAdd(&bar[XB_TMO], 1u); break; } }
    }
    nloc = mine > 0u ? mine : 1u; nx = cnt > 0u ? cnt : 1u;
}
__device__ __forceinline__ void xcd_barrier(const XcdBarrier& b) {
    asm volatile("s_waitcnt vmcnt(0)" ::: "memory");
    __syncthreads();
    if (threadIdx.x == 0) {
        unsigned* bar = b.bar;
        __builtin_amdgcn_s_waitcnt(0);
        unsigned nloc = b.st[0], nx = b.st[1];
        if (nloc == 0u) { xcd_barrier_complete(bar, b.x, nloc, nx); b.st[0] = nloc; b.st[1] = nx; }
        const unsigned old = xb_add(&bar[XB_XSUB(b.x)], 1u);
        const unsigned gen = old / nloc;
        if (old + 1u == (gen + 1u) * nloc) {
            __builtin_amdgcn_fence(__ATOMIC_RELEASE, "agent");
            asm volatile("s_waitcnt vmcnt(0)" ::: "memory");
            const unsigned og = xb_add(&bar[XB_TOP], 1u);
            const unsigned tg = og / nx;
            if (og + 1u == (tg + 1u) * nx) xb_add(&bar[XB_TOPGEN], 1u);
            else XB_SPIN(xb_ld(&bar[XB_TOPGEN]) == tg, bar);
            __builtin_amdgcn_fence(__ATOMIC_ACQUIRE, "agent");
            xb_add(&bar[XB_XGEN(b.x)], 1u);
            asm volatile("s_waitcnt vmcnt(0)" ::: "memory");
        } else {
            XB_SPIN(xb_ld(&bar[XB_XGEN(b.x)]) == gen, bar);
            __builtin_amdgcn_fence(__ATOMIC_ACQUIRE, "agent");
            asm volatile("s_waitcnt vmcnt(0)" ::: "memory");
        }
    }
    __syncthreads();
}

struct Frame {
    LAS unsigned char* lds;
    volatile LAS unsigned* MISC;
    unsigned* ctl;
    int tid, lane, wave, G, gw, NGW;
    const float *xp, *xs, *state_pool, *state_ret, *state_conv, *g_pre_mix, *w_in, *w_pool, *pool_scale, *gn_gain, *w_out, *g_post_mix, *g_pre_ffn, *w_up, *conv_w, *conv_b, *w_down, *g_post_ffn;
    float* out;
    bf16 *WIN, *WUP, *WDN, *WOUT, *WPOOL, *XN, *PROJ, *UP, *OB, *AP, *MM, *ACT;
    float *ROPE_C, *ROPE_S;
    bf16 *SP16, *MOB;
};
__device__ __forceinline__ const float* xrow(const Frame& F, int m) { return m < MP ? F.xp + (size_t)m * D : F.xs + (size_t)(m - MP) * D; }

__host__ __device__ __forceinline__ int unperm_d(int p) { const int g8 = p >> 3, e = p & 7; return e < 4 ? 4 * g8 + e : 64 + 4 * g8 + (e - 4); }
__device__ __forceinline__ void p0_transpose_item(const float* W, int K, int N, bf16* WT, LAS float* scr, int item, int lane, bool permqk = false) {
    const int nblk = N / 32, kb = item / nblk, nb = item % nblk, k0 = 64 * kb, n0 = 32 * nb;
    int src = n0 + (lane & 31); if (permqk && src >= C_Q && src < C_V) src = (src & ~127) + unperm_d(src & 127);
#pragma unroll 8
    for (int i = 0; i < 32; ++i) { const int kk = 2 * i + (lane >> 5); scr[kk * 33 + (lane & 31)] = __builtin_nontemporal_load(W + (size_t)(k0 + kk) * N + src); }
    LDS_WAIT(); asm volatile("" ::: "memory");
    const int c = lane & 7;
#pragma unroll
    for (int j = 0; j < 4; ++j) { const int n = (lane >> 3) + 8 * j; const LAS float* s = scr + (8 * c) * 33 + n;
        v4u o; o.x = pk2(s[0 * 33], s[1 * 33]); o.y = pk2(s[2 * 33], s[3 * 33]); o.z = pk2(s[4 * 33], s[5 * 33]); o.w = pk2(s[6 * 33], s[7 * 33]);
        *(v4u*)(WT + (size_t)(n0 + n) * K + k0 + 8 * c) = o; }
    LDS_WAIT(); asm volatile("" ::: "memory");
}
__device__ __forceinline__ void rms_row_to_bf16(const float* xr_, const float* g, bf16* orow, int lane) {
    const f32x4* xr = (const f32x4*)xr_ + lane; const f32x4* gr = (const f32x4*)g + lane;
    f32x4 v[8]; float s = 0.f;
#pragma unroll
    for (int j = 0; j < 8; ++j) { v[j] = __builtin_nontemporal_load(xr + 64 * j); s += (v[j].x * v[j].x + v[j].y * v[j].y) + (v[j].z * v[j].z + v[j].w * v[j].w); }
    const float rs = 1.0f / sqrtf(wave_sum(s) * (1.f / D) + EPS);
    v2u* o8 = (v2u*)orow + lane;
#pragma unroll
    for (int j = 0; j < 8; ++j) { const f32x4 gg = gr[64 * j]; v2u o; o.x = pk2(v[j].x * rs * gg.x, v[j].y * rs * gg.y); o.y = pk2(v[j].z * rs * gg.z, v[j].w * rs * gg.w); o8[64 * j] = o; }
}
__device__ __forceinline__ void p0_deferred_weights(Frame& F, LAS float* scr) {
    constexpr int I_UP = (D / 64) * (FF2 / 32), I_DN = (FF / 64) * (D / 32), I_OUT = (D / 64) * (D / 32), I_PL = (256 / 64) * (512 / 32);
    constexpr int NITEMS = I_UP + I_DN + I_OUT + 4 * I_PL, CHUNK = 4;
    for (;;) {
        int base = 0;
        if (F.lane == 0) base = (int)__hip_atomic_fetch_add(F.ctl + CW_QW, (unsigned)CHUNK, RLX_AGENT);
        base = __builtin_amdgcn_readfirstlane(base);
        if (base >= NITEMS) break;
        for (int it = base; it < base + CHUNK && it < NITEMS; ++it) {
            int r = it;
            if (r < I_UP) { p0_transpose_item(F.w_up, D, FF2, F.WUP, scr, r, F.lane); continue; } r -= I_UP;
            if (r < I_DN) { p0_transpose_item(F.w_down, FF, D, F.WDN, scr, r, F.lane); continue; } r -= I_DN;
            if (r < I_OUT) { p0_transpose_item(F.w_out, D, D, F.WOUT, scr, r, F.lane); continue; } r -= I_OUT;
            const int g = r / I_PL; r -= g * I_PL;
            p0_transpose_item(F.w_pool + (size_t)g * 256 * 512, 256, 512, F.WPOOL + (size_t)g * 512 * 256, scr, r, F.lane);
        }
    }
}
__device__ __forceinline__ void p0_prologue(Frame& F) {
    LAS float* scr = (LAS float*)(F.lds + F.wave * 16384);
    constexpr int I_IN = (D / 64) * (NIN / 32);
    for (int it = F.gw; it < I_IN; it += F.NGW) p0_transpose_item(F.w_in, D, NIN, F.WIN, scr, it, F.lane, true);
    for (int m = F.gw; m < M; m += F.NGW) rms_row_to_bf16(xrow(F, m), F.g_pre_mix, F.XN + (size_t)m * D, F.lane);
    for (int idx = blockIdx.x * 512 + F.tid; idx < 128 * 15 * 1024 / 4; idx += F.G * 512) { const f32x4 v = ((const f32x4*)F.state_pool)[idx]; ((v2u*)F.SP16)[idx] = pack4(v); }
    for (int idx = blockIdx.x * 512 + F.tid; idx < 2056 * 64; idx += F.G * 512) {
        const int row = idx >> 6, i = idx & 63; const int pos = row < 2048 ? row : 16384 + (row - 2048);
        double th = 1.0; for (int k = 0; k < i; ++k) th *= 0.8659643233600653;
        const double a = (double)pos * th;
        const double kd = rint(a * 0.6366197723675814);
        double y = fma(-kd, 1.57079632679489655800e+00, a); y = fma(-kd, 6.12323399573676603587e-17, y);
        const int k4 = ((int)kd) & 3; const double y2 = y * y;
        const double sp = y * (1.0 + y2 * (-1.0 / 6 + y2 * (1.0 / 120 + y2 * (-1.0 / 5040 + y2 * (1.0 / 362880 + y2 * (-1.0 / 39916800 + y2 * (1.0 / 6227020800.0)))))));
        const double cp = 1.0 + y2 * (-0.5 + y2 * (1.0 / 24 + y2 * (-1.0 / 720 + y2 * (1.0 / 40320 + y2 * (-1.0 / 3628800 + y2 * (1.0 / 479001600 + y2 * (-1.0 / 87178291200.0)))))));
        double sn, cs;
        if (k4 == 0) { sn = sp; cs = cp; } else if (k4 == 1) { sn = cp; cs = -sp; } else if (k4 == 2) { sn = -sp; cs = -cp; } else { sn = -cp; cs = sp; }
        F.ROPE_C[idx] = (float)cs; F.ROPE_S[idx] = (float)sn;
    }
}

constexpr float KSCALE = 0.08838834764831845f;
struct EpiProj {
    static constexpr bool PERM = true, AFTER_DRAIN = false;
    bf16* O; const float* rc; const float* rs;
    __device__ __forceinline__ void tri(f32x4 v0, f32x4 v1, const pg8::Unit& u, int ai, int bj, int m, int wr, int wc, int fr, int fq) const {
        const int row = u.pm * 256 + ai * 128 + wr * 64 + m * 16 + fr, col = u.pn * 256 + bj * 128 + wc * 32 + 8 * fq;
        if (u.pn >= 4 && u.pn < 12) {
            const int h = ((u.pn & 3) << 1) + bj;
            int prow, tl; if (row < MP) { const int t = row & 2047; prow = t; tl = t & 127; } else { tl = row & 7; prow = 2048 + tl; }
            const int g8 = 4 * wc + fq;
            const f32x4 c = *(const f32x4*)(rc + prow * 64 + 4 * g8), sn = *(const f32x4*)(rs + prow * 64 + 4 * g8);
            const float lg2 = __log2f(1.0f - __builtin_amdgcn_exp2f(-5.0f - (float)h));
            const float sc = u.pn >= 8 ? KSCALE * __builtin_amdgcn_exp2f(-lg2 * (float)tl) : __builtin_amdgcn_exp2f(lg2 * (float)tl);
            const f32x4 y1 = (v0 * c - v1 * sn) * sc, y2 = (v1 * c + v0 * sn) * sc;
            v0 = y1; v1 = y2;
        }
        v4u w4; w4.x = pk2(v0[0], v0[1]); w4.y = pk2(v0[2], v0[3]); w4.z = pk2(v1[0], v1[1]); w4.w = pk2(v1[2], v1[3]);
        *(v4u*)(O + (size_t)row * NIN + col) = w4;
    }
    __device__ __forceinline__ void operator()(const f32x4 (&acc)[2][2][4][2], const pg8::Unit& u, int wr, int wc, int fr, int fq) const {
#pragma unroll
        for (int ai = 0; ai < 2; ++ai)
#pragma unroll
            for (int m = 0; m < 4; ++m)
#pragma unroll
                for (int bj = 0; bj < 2; ++bj) tri(acc[ai][bj][m][0], acc[ai][bj][m][1], u, ai, bj, m, wr, wc, fr, fq);
    }
};

typedef short s16x4 __attribute__((ext_vector_type(4)));
__device__ __forceinline__ bf16x8 tr16x2(const LAS unsigned char* p0, const LAS unsigned char* p1) {
    const s16x4 a = __builtin_amdgcn_ds_read_tr16_b64_v4i16((LAS s16x4*)p0), b = __builtin_amdgcn_ds_read_tr16_b64_v4i16((LAS s16x4*)p1);
    return __builtin_shufflevector(a, b, 0, 1, 2, 3, 4, 5, 6, 7);
}
static_assert(DVS == 64, "chain staging below assumes 64-wide value slices");
constexpr int QI_LD = 136, VI_LD = DVS + 8;
constexpr int QI_OFF = 0, KI_OFF = 34816, VI_OFF = 69632, RT_OFF = VI_OFF + 128 * VI_LD * 2, CH_END = RT_OFF + DVS * QI_LD * 2;
static_assert(CH_END <= LDSCTL_OFF, "chain LDS");
__device__ __forceinline__ void chain_unit(Frame& F, int unit) {
    const int s = unit % NS, h = (unit / NS) & 7, b = unit / (NS * 8);
    int tid_ = F.tid; asm volatile("" : "+v"(tid_));
    const int tid = tid_, lane = tid & 63, w = F.wave, fr = lane & 15, fq = lane >> 4, tq = (lane & 15) >> 2, tp = lane & 3;
    LAS unsigned char* L = F.lds;
    const float lg2 = __log2f(1.0f - __builtin_amdgcn_exp2f(-5.0f - (float)h));
    const float gam = __builtin_amdgcn_exp2f(lg2), g127 = __builtin_amdgcn_exp2f(127.f * lg2);
    for (int i = tid; i < DVS * QI_LD * 2 / 16; i += 512) *(LAS v4u*)(L + RT_OFF + i * 16) = (v4u){0u, 0u, 0u, 0u};
    f32x4 Racc[4];
#pragma unroll
    for (int i = 0; i < 4; ++i) Racc[i] = (f32x4){0.f, 0.f, 0.f, 0.f};
    const int vt_r = w & 3, dg = w >> 2;
    const bf16* pbase = F.PROJ + ((size_t)b * 2048) * NIN;
    v4u sq[4], sk[4], sv[2];
#define CH_ISSUE(c) do { const bf16* pr_ = pbase + (size_t)((c) * 128) * NIN; \
        _Pragma("unroll") for (int i_ = 0; i_ < 4; ++i_) { const int ci = tid + 512 * i_, j = ci >> 4, ch = ci & 15; sq[i_] = *(const v4u*)(pr_ + (size_t)j * NIN + C_Q + h * 128 + 8 * ch); sk[i_] = *(const v4u*)(pr_ + (size_t)j * NIN + C_K + h * 128 + 8 * ch); } \
        _Pragma("unroll") for (int i_ = 0; i_ < 2; ++i_) { const int ci = tid + 512 * i_, j = ci >> 3, ch = ci & 7; sv[i_] = *(const v4u*)(pr_ + (size_t)j * NIN + C_V + h * DVH + s * DVS + 8 * ch); } } while (0)
#define CH_WRITE() do { \
        _Pragma("unroll") for (int i_ = 0; i_ < 4; ++i_) { const int ci = tid + 512 * i_, j = ci >> 4, ch = ci & 15; *(LAS v4u*)(L + QI_OFF + (j * QI_LD + 8 * ch) * 2) = sq[i_]; *(LAS v4u*)(L + KI_OFF + (j * QI_LD + 8 * ch) * 2) = sk[i_]; } \
        _Pragma("unroll") for (int i_ = 0; i_ < 2; ++i_) { const int ci = tid + 512 * i_, j = ci >> 3, ch = ci & 7; *(LAS v4u*)(L + VI_OFF + (j * VI_LD + 8 * ch) * 2) = sv[i_]; } } while (0)
    CH_ISSUE(0);
#pragma unroll 1
    for (int c = 0; c < 16; ++c) {
        const size_t mrow0 = (size_t)b * 2048 + c * 128;
        CH_WRITE();
        __syncthreads();
        if (c + 1 < 16) CH_ISSUE(c + 1);
        {
            bf16x8 afr[4];
#pragma unroll
            for (int kk = 0; kk < 4; ++kk) afr[kk] = *(const LAS bf16x8*)(L + QI_OFF + ((16 * w + fr) * QI_LD + 32 * kk + 8 * fq) * 2);
            f32x4 oacc[4];
#pragma unroll
            for (int vt = 0; vt < 4; ++vt) {
                f32x4 acc = (f32x4){0.f, 0.f, 0.f, 0.f};
#pragma unroll
                for (int kk = 0; kk < 4; ++kk) { const bf16x8 rf = *(const LAS bf16x8*)(L + RT_OFF + ((16 * vt + fr) * QI_LD + 32 * kk + 8 * fq) * 2); acc = MFMA16(rf, afr[kk], acc); }
                oacc[vt] = acc * gam;
            }
            const int i_ = 16 * w + fr, nkk = (w >> 1) + 1;
#pragma unroll 1
            for (int kk = 0; kk < nkk; ++kk) {
                f32x4 s0 = (f32x4){0.f, 0.f, 0.f, 0.f}, s1 = s0;
                const LAS unsigned char* kb = L + KI_OFF + ((32 * kk + fr) * QI_LD + 8 * fq) * 2;
#pragma unroll
                for (int k2 = 0; k2 < 4; ++k2) {
                    const bf16x8 kf0 = *(const LAS bf16x8*)(kb + 64 * k2), kf1 = *(const LAS bf16x8*)(kb + 16 * QI_LD * 2 + 64 * k2);
                    s0 = MFMA16(kf0, afr[k2], s0); s1 = MFMA16(kf1, afr[k2], s1);
                }
                float pv[8];
#pragma unroll
                for (int e = 0; e < 4; ++e) { const int dd0 = i_ - (32 * kk + 4 * fq + e); pv[e] = dd0 >= 0 ? s0[e] : 0.f; pv[4 + e] = dd0 >= 16 ? s1[e] : 0.f; }
                const bf16x8 pf = as_bf16x8(pack8(pv));
                const LAS unsigned char* vb = L + VI_OFF + ((32 * kk + 4 * fq + tq) * VI_LD + 4 * tp) * 2;
#pragma unroll
                for (int vt = 0; vt < 4; ++vt) oacc[vt] = MFMA16(tr16x2(vb + 32 * vt, vb + 16 * VI_LD * 2 + 32 * vt), pf, oacc[vt]);
            }
            bf16* orow = F.OB + (mrow0 + 16 * w + fr) * D + h * DVH + s * DVS + 4 * fq;
#pragma unroll
            for (int vt = 0; vt < 4; ++vt) *(v2u*)(orow + 16 * vt) = pack4(oacc[vt]);
        }
#pragma unroll
        for (int di = 0; di < 4; ++di) {
            const int dt = dg * 4 + di;
            f32x4 acc = Racc[di] * gam;
#pragma unroll
            for (int kk = 0; kk < 4; ++kk) {
                const LAS unsigned char* ka = L + KI_OFF + ((32 * kk + 8 * fq + tq) * QI_LD + 16 * dt + 4 * tp) * 2;
                const LAS unsigned char* va = L + VI_OFF + ((32 * kk + 8 * fq + tq) * VI_LD + 16 * vt_r + 4 * tp) * 2;
                acc = MFMA16(tr16x2(ka, ka + 4 * QI_LD * 2), tr16x2(va, va + 4 * VI_LD * 2), acc);
            }
            Racc[di] = acc * g127;
        }
        __syncthreads();
#pragma unroll
        for (int di = 0; di < 4; ++di) { const int dt = dg * 4 + di; *(LAS v2u*)(L + RT_OFF + ((16 * vt_r + fr) * QI_LD + 16 * dt + 4 * fq) * 2) = pack4(Racc[di]); }
    }
#undef CH_ISSUE
#undef CH_WRITE
    float* ro = F.out + O_RETP + ((size_t)(b * 8 + h) * 128) * DVH + s * DVS + 16 * vt_r + fr;
#pragma unroll
    for (int di = 0; di < 4; ++di) { const int dt = dg * 4 + di;
#pragma unroll
        for (int r = 0; r < 4; ++r) ro[(size_t)unperm_d(16 * dt + 4 * fq + r) * DVH] = Racc[di][r]; }
}

constexpr int SQ_OFF = 0, SKZ_OFF = 4096, SK_OFF = 8192, SV_OFF = 12288, SS_OFF = 20480, SRED_OFF = 24576;
__device__ __forceinline__ void sample_unit(Frame& F, int unit) {
    const int h = unit & 7, b = unit >> 3;
    int tid_ = F.tid; asm volatile("" : "+v"(tid_));
    const int tid = tid_, lane = tid & 63, w = F.wave;
    LAS unsigned char* L = F.lds;
    LAS float* qT = (LAS float*)(L + SQ_OFF); LAS float* kzT = (LAS float*)(L + SKZ_OFF); LAS float* kS = (LAS float*)(L + SK_OFF);
    LAS float* vs = (LAS float*)(L + SV_OFF); LAS float* ss = (LAS float*)(L + SS_OFF); LAS float* red = (LAS float*)(L + SRED_OFF);
    const float lg2 = __log2f(1.0f - __builtin_amdgcn_exp2f(-5.0f - (float)h));
    const float gam = __builtin_amdgcn_exp2f(lg2), g7 = __builtin_amdgcn_exp2f(7.f * lg2), g8c = __builtin_amdgcn_exp2f(8.f * lg2);
    const size_t mrow0 = (size_t)MP + (size_t)b * 8;
    const float* Rin = F.state_ret + ((size_t)(b * 8 + h) * 128) * DVH + 4 * lane;
    float* Rout = F.out + O_RETS + ((size_t)(b * 8 + h) * 128) * DVH + 4 * lane;
    f32x4 r0[16];
#pragma unroll
    for (int dd = 0; dd < 16; ++dd) r0[dd] = __builtin_nontemporal_load((const f32x4*)(Rin + (size_t)(16 * w + dd) * DVH));
    if (tid < 256) {
        const int qk = tid >> 7, it = tid & 127, i = it >> 4, ch = it & 15;
        float f[8]; unpack8(*(const v4u*)(F.PROJ + (mrow0 + i) * NIN + (qk ? C_K : C_Q) + h * 128 + 8 * ch), f);
#pragma unroll
        for (int e = 0; e < 8; ++e) { const int d = e < 4 ? 4 * ch + e : 64 + 4 * ch + (e - 4);
            if (qk == 0) qT[d * 8 + i] = f[e]; else { kS[i * 128 + d] = f[e]; kzT[d * 8 + i] = f[e] * g7; } }
    } else {
        const int it = tid - 256, j = it >> 5, g = it & 31;
        float f[8]; unpack8(*(const v4u*)(F.PROJ + (mrow0 + j) * NIN + C_V + h * DVH + 8 * g), f);
#pragma unroll
        for (int e = 0; e < 8; ++e) vs[j * 256 + 8 * g + e] = f[e];
    }
    __syncthreads();
    {
        const int pr = tid >> 3, part = tid & 7, i = pr >> 3, j = pr & 7; float dot = 0.f;
#pragma unroll
        for (int dd = 0; dd < 16; ++dd) { const int d = 16 * part + dd; dot += qT[d * 8 + i] * kS[j * 128 + d]; }
        dot += __shfl_xor(dot, 1); dot += __shfl_xor(dot, 2); dot += __shfl_xor(dot, 4);
        if (part == 0) ss[i * 8 + j] = (i >= j) ? dot : 0.f;
    }
    {
        f32x4 vreg[8], oacc[8];
#pragma unroll
        for (int j = 0; j < 8; ++j) { vreg[j] = *(const LAS f32x4*)(vs + j * 256 + 4 * lane); oacc[j] = (f32x4){0.f, 0.f, 0.f, 0.f}; }
#pragma unroll
        for (int dd = 0; dd < 16; ++dd) {
            const int d = 16 * w + dd;
            const f32x4 qa = *(const LAS f32x4*)(qT + d * 8), qb = *(const LAS f32x4*)(qT + d * 8 + 4), ka = *(const LAS f32x4*)(kzT + d * 8), kb = *(const LAS f32x4*)(kzT + d * 8 + 4);
            f32x4 rn = r0[dd] * g8c;
            rn += ka.x * vreg[0]; rn += ka.y * vreg[1]; rn += ka.z * vreg[2]; rn += ka.w * vreg[3]; rn += kb.x * vreg[4]; rn += kb.y * vreg[5]; rn += kb.z * vreg[6]; rn += kb.w * vreg[7];
            __builtin_nontemporal_store(rn, (f32x4*)(Rout + (size_t)d * DVH));
            oacc[0] += qa.x * r0[dd]; oacc[1] += qa.y * r0[dd]; oacc[2] += qa.z * r0[dd]; oacc[3] += qa.w * r0[dd];
            oacc[4] += qb.x * r0[dd]; oacc[5] += qb.y * r0[dd]; oacc[6] += qb.z * r0[dd]; oacc[7] += qb.w * r0[dd];
        }
#pragma unroll
        for (int i = 0; i < 8; ++i) *(LAS f32x4*)(red + (w * 8 + i) * 256 + 4 * lane) = oacc[i];
    }
    __syncthreads();
    {
        const int i = tid >> 6, l = tid & 63;
        f32x4 tot = (f32x4){0.f, 0.f, 0.f, 0.f};
#pragma unroll
        for (int ww = 0; ww < 8; ++ww) tot += *(const LAS f32x4*)(red + (ww * 8 + i) * 256 + 4 * l);
        tot = tot * gam;
#pragma unroll
        for (int j = 0; j < 8; ++j) tot += ss[i * 8 + j] * *(const LAS f32x4*)(vs + j * 256 + 4 * l);
        *(v2u*)(F.OB + (mrow0 + i) * D + h * DVH + 4 * l) = pack4(tot);
    }
}

constexpr int Z_LD = 264;
template <int W, int IB> __device__ __forceinline__ void pool_z(Frame& F, int g, int m0, int tid) {
    LAS unsigned char* L = F.lds;
#pragma unroll 1
    for (int it0 = tid; it0 < 4096; it0 += 512 * IB) {
        v4u raw[IB][W]; bool ok[IB][W];
#pragma unroll
        for (int ib = 0; ib < IB; ++ib) {
            const int it = it0 + 512 * ib, j = it >> 5, c8 = it & 31, m = m0 + j, col = C_POOL + 256 * g + 8 * c8;
#pragma unroll
            for (int k = 0; k < W; ++k) {
                const bf16* p;
                if (m < MP) { const int t = m & 2047; ok[ib][k] = t - k >= 0; p = F.PROJ + (size_t)(ok[ib][k] ? m - k : m) * NIN + col; }
                else { const int ms = m - MP, bb = ms >> 3, i = ms & 7, ee = 15 + i - k; ok[ib][k] = true;
                    const bf16* p1 = F.PROJ + (size_t)(MP + bb * 8 + (ee >= 15 ? ee - 15 : 0)) * NIN + col; const bf16* p2 = F.SP16 + ((size_t)bb * 15 + (ee < 15 ? ee : 0)) * 1024 + 256 * g + 8 * c8;
                    p = ee >= 15 ? p1 : p2; }
                raw[ib][k] = *(const v4u*)p;
            }
        }
#pragma unroll
        for (int ib = 0; ib < IB; ++ib) {
            const int it = it0 + 512 * ib, j = it >> 5, c8 = it & 31, m = m0 + j;
            float sum[8], cur[8], f[8];
            unpack8(raw[ib][0], cur);
#pragma unroll
            for (int e = 0; e < 8; ++e) sum[e] = cur[e];
#pragma unroll
            for (int k = 1; k < W; ++k) { unpack8(raw[ib][k], f);
#pragma unroll
                for (int e = 0; e < 8; ++e) sum[e] += ok[ib][k] ? f[e] : 0.f; }
            int cn = W; if (m < MP) { const int t = m & 2047; cn = W < t + 1 ? W : t + 1; }
            const float ic = 1.0f / (float)cn;
#pragma unroll
            for (int e = 0; e < 8; ++e) f[e] = sum[e] * ic - cur[e];
            *(LAS v4u*)(L + (j * Z_LD + 8 * c8) * 2) = pack8(f);
        }
    }
}
__device__ __forceinline__ void pool_unit(Frame& F, int unit) {
    const int g = unit & 3, tile = unit >> 2, m0 = tile * 128;
    int tid_ = F.tid; asm volatile("" : "+v"(tid_));
    const int tid = tid_, lane = tid & 63, w = F.wave, fr = lane & 15, fq = lane >> 4;
    LAS unsigned char* L = F.lds;
    bf16x8 bfr[4][8];
    {
        const bf16* wt = F.WPOOL + ((size_t)g * 512 + 64 * w + fr) * 256 + 8 * fq;
#pragma unroll
        for (int et = 0; et < 4; ++et)
#pragma unroll
            for (int kk = 0; kk < 8; ++kk) bfr[et][kk] = *(const bf16x8*)(wt + (size_t)(16 * et) * 256 + 32 * kk);
    }
    if (m0 >= MP) {
        if (g == 0) pool_z<2, 4>(F, g, m0, tid); else if (g == 1) pool_z<4, 4>(F, g, m0, tid); else if (g == 2) pool_z<8, 2>(F, g, m0, tid); else pool_z<16, 1>(F, g, m0, tid);
    } else {
        constexpr int UT_OFF = 128 * Z_LD * 2;
        static_assert(UT_OFF + 143 * Z_LD * 2 <= LDSCTL_OFF, "pool LDS");
        const bool seq0 = (m0 & 2047) == 0;
        const bf16* src = F.PROJ + (size_t)(m0 - 15) * NIN + C_POOL + 256 * g;
#pragma unroll
        for (int i = 0; i < 9; ++i) { const int ci = tid + 512 * i;
            if (ci < 143 * 32) { const int rw = ci >> 5, c8 = ci & 31; v4u v = (v4u){0u, 0u, 0u, 0u}; if (!(seq0 && rw < 15)) v = *(const v4u*)(src + (size_t)rw * NIN + 8 * c8);
                *(LAS v4u*)(L + UT_OFF + (rw * Z_LD + 8 * c8) * 2) = v; } }
        __syncthreads();
        const int W = 2 << g, c8 = tid & 31, j0 = (tid >> 5) * 8;
        const LAS unsigned char* up = L + UT_OFF + ((15 + j0) * Z_LD + 8 * c8) * 2;
        float sum[8], f[8], cur[8];
#pragma unroll
        for (int e = 0; e < 8; ++e) sum[e] = 0.f;
        for (int k = 1; k < W; ++k) { unpack8(*(const LAS v4u*)(up - k * Z_LD * 2), f);
#pragma unroll
            for (int e = 0; e < 8; ++e) sum[e] += f[e]; }
        const int t0 = (m0 & 2047) + j0;
#pragma unroll
        for (int j = 0; j < 8; ++j) {
            unpack8(*(const LAS v4u*)(up + j * Z_LD * 2), cur);
#pragma unroll
            for (int e = 0; e < 8; ++e) sum[e] += cur[e];
            const int t = t0 + j; const float ic = 1.0f / (float)(W < t + 1 ? W : t + 1);
#pragma unroll
            for (int e = 0; e < 8; ++e) f[e] = sum[e] * ic - cur[e];
            *(LAS v4u*)(L + ((j0 + j) * Z_LD + 8 * c8) * 2) = pack8(f);
            unpack8(*(const LAS v4u*)(up + (j + 1 - W) * Z_LD * 2), f);
#pragma unroll
            for (int e = 0; e < 8; ++e) sum[e] -= f[e];
        }
    }
    __syncthreads();
    f32x4 sc[4];
#pragma unroll
    for (int et = 0; et < 4; ++et) sc[et] = *(const f32x4*)(F.pool_scale + 512 * g + 64 * w + 16 * et + 4 * fq);
#pragma unroll 1
    for (int rt = 0; rt < 8; ++rt) {
        bf16x8 afr[8];
#pragma unroll
        for (int kk = 0; kk < 8; ++kk) afr[kk] = *(const LAS bf16x8*)(L + ((16 * rt + fr) * Z_LD + 32 * kk + 8 * fq) * 2);
        bf16* orow = F.AP + (size_t)(m0 + 16 * rt + fr) * D + 512 * g + 64 * w + 4 * fq;
#pragma unroll
        for (int et = 0; et < 4; ++et) {
            f32x4 acc = (f32x4){0.f, 0.f, 0.f, 0.f};
#pragma unroll
            for (int kk = 0; kk < 8; ++kk) acc = MFMA16(bfr[et][kk], afr[kk], acc);
            *(v2u*)(orow + 16 * et) = pack4(acc * sc[et]);
        }
    }
}
constexpr int N_CHAIN = 4 * 8 * NS, N_POOLU = (M / 128) * 4, N_SAMP = 128 * 8, N_P2 = N_CHAIN + N_POOLU + N_SAMP;
__device__ __forceinline__ void p2_mixers(Frame& F, int rep) {
    const int mode = rep >> 4, lo = mode == 2 ? N_CHAIN : (mode == 3 ? N_CHAIN + N_POOLU : 0), hi = mode == 1 ? N_CHAIN : (mode == 2 ? N_CHAIN + N_POOLU : N_P2);
    for (;;) {
        __syncthreads();
        if (F.tid == 0) F.MISC[0] = __hip_atomic_fetch_add(F.ctl + CW_Q2 + 64 * (rep & 15), 1u, RLX_AGENT);
        __syncthreads();
        const int u = (int)F.MISC[0] + lo;
        if (u >= hi) break;
        if (u < N_CHAIN) chain_unit(F, u);
        else if (u < N_CHAIN + N_POOLU) pool_unit(F, u - N_CHAIN);
        else sample_unit(F, u - N_CHAIN - N_POOLU);
    }
}

__device__ __forceinline__ float half_sum(float v) {
#pragma unroll
    for (int o = 1; o < 32; o <<= 1) v += __shfl_xor(v, o);
    return v;
}
__device__ __forceinline__ void p3_merge(Frame& F) {
    const int lane = F.lane, hl = lane >> 5, l32 = lane & 31;
    constexpr int NIT = M * 4;
    for (int it0 = 2 * F.gw; it0 < NIT; it0 += 2 * F.NGW) {
        v4u ov[2], gv[2], av[2], rv[2], pv[2]; int cc[2]; size_t mm[2];
#pragma unroll
        for (int u = 0; u < 2; ++u) {
            const int it = it0 + u, m = it >> 2, hp = it & 3, c = (2 * hp + hl) * DVH + 8 * l32; cc[u] = c; mm[u] = (size_t)m;
            const bf16* prow = F.PROJ + (size_t)m * NIN + c;
            ov[u] = __builtin_nontemporal_load((const v4u*)(F.OB + (size_t)m * D + c)); gv[u] = __builtin_nontemporal_load((const v4u*)(prow + C_GRET)); av[u] = __builtin_nontemporal_load((const v4u*)(prow + C_GA)); rv[u] = __builtin_nontemporal_load((const v4u*)(prow + C_GR)); pv[u] = __builtin_nontemporal_load((const v4u*)(F.AP + (size_t)m * D + c));
        }
#pragma unroll
        for (int u = 0; u < 2; ++u) {
            float o[8], g[8], ga[8], gr[8], ap[8], res[8];
            unpack8(ov[u], o); unpack8(gv[u], g); unpack8(av[u], ga); unpack8(rv[u], gr); unpack8(pv[u], ap);
            const f32x4 gn0 = *(const f32x4*)(F.gn_gain + cc[u]), gn1 = *(const f32x4*)(F.gn_gain + cc[u] + 4);
            const float gn[8] = {gn0.x, gn0.y, gn0.z, gn0.w, gn1.x, gn1.y, gn1.z, gn1.w};
            float sm = 0.f;
#pragma unroll
            for (int e = 0; e < 8; ++e) sm += o[e];
            const float mean = half_sum(sm) * (1.f / 256.f);
            float sq = 0.f;
#pragma unroll
            for (int e = 0; e < 8; ++e) { o[e] -= mean; sq += o[e] * o[e]; }
            const float rstd = 1.0f / sqrtf(half_sum(sq) * (1.f / 256.f) + EPS);
#pragma unroll
            for (int e = 0; e < 8; ++e) { const float r = g[e] * sigmoidf_(g[e]) * (o[e] * rstd * gn[e]); res[e] = sigmoidf_(ga[e]) * ap[e] + sigmoidf_(gr[e]) * r; }
            *(v4u*)(F.MM + mm[u] * D + cc[u]) = pack8(res);
        }
    }
    const int gt = blockIdx.x * 512 + F.tid, NT = F.G * 512;
    for (int idx = gt; idx < 4 * 15 * 1024; idx += NT) { const int c = idx & 1023, r = (idx >> 10) % 15, b = idx / (15 * 1024);
        F.out[O_POOLP + idx] = __uint_as_float((unsigned)F.PROJ[(size_t)(b * 2048 + 2033 + r) * NIN + C_POOL + c] << 16); }
    for (int idx = gt; idx < 128 * 15 * 1024; idx += NT) { const int c = idx & 1023, r = (idx >> 10) % 15, b = idx / (15 * 1024); const int e = 8 + r;
        F.out[O_POOLS + idx] = e < 15 ? F.state_pool[((size_t)b * 15 + e) * 1024 + c] : __uint_as_float((unsigned)F.PROJ[(size_t)(MP + b * 8 + e - 15) * NIN + C_POOL + c] << 16); }
}

__device__ __forceinline__ void p5_rows(Frame& F) {
    const int lane = F.lane;
    for (int m = F.gw; m < M; m += F.NGW) {
        const v4u* mo = (const v4u*)(F.MOB + (size_t)m * D) + lane; const f32x4* xr = (const f32x4*)xrow(F, m) + 2 * lane;
        const f32x4* g1 = (const f32x4*)F.g_post_mix + 2 * lane; const f32x4* g2 = (const f32x4*)F.g_pre_ffn + 2 * lane;
        v4u mv[4]; f32x4 x[4][2]; float v[4][8]; float s = 0.f;
#pragma unroll
        for (int j = 0; j < 4; ++j) { mv[j] = __builtin_nontemporal_load(mo + 64 * j); x[j][0] = __builtin_nontemporal_load(xr + 128 * j); x[j][1] = __builtin_nontemporal_load(xr + 128 * j + 1); }
#pragma unroll
        for (int j = 0; j < 4; ++j) { unpack8(mv[j], v[j]);
#pragma unroll
            for (int e = 0; e < 8; ++e) s += v[j][e] * v[j][e]; }
        const float rs = 1.0f / sqrtf(wave_sum(s) * (1.f / D) + EPS);
        float s2 = 0.f; f32x4* yo = (f32x4*)(F.out + O_Y + (size_t)m * D) + 2 * lane;
#pragma unroll
        for (int j = 0; j < 4; ++j) {
            const f32x4 ga = g1[128 * j], gb = g1[128 * j + 1];
            x[j][0] = x[j][0] + (f32x4){v[j][0], v[j][1], v[j][2], v[j][3]} * rs * ga; x[j][1] = x[j][1] + (f32x4){v[j][4], v[j][5], v[j][6], v[j][7]} * rs * gb;
            __builtin_nontemporal_store(x[j][0], yo + 128 * j); __builtin_nontemporal_store(x[j][1], yo + 128 * j + 1);
            s2 += (x[j][0].x * x[j][0].x + x[j][0].y * x[j][0].y) + (x[j][0].z * x[j][0].z + x[j][0].w * x[j][0].w) + (x[j][1].x * x[j][1].x + x[j][1].y * x[j][1].y) + (x[j][1].z * x[j][1].z + x[j][1].w * x[j][1].w);
        }
        const float rs2 = 1.0f / sqrtf(wave_sum(s2) * (1.f / D) + EPS);
        v4u* o8 = (v4u*)(F.XN + (size_t)m * D) + lane;
#pragma unroll
        for (int j = 0; j < 4; ++j) { const f32x4 ga = g2[128 * j], gb = g2[128 * j + 1]; const f32x4 a = x[j][0] * rs2 * ga, b2 = x[j][1] * rs2 * gb;
            v4u o; o.x = pk2(a.x, a.y); o.y = pk2(a.z, a.w); o.z = pk2(b2.x, b2.y); o.w = pk2(b2.z, b2.w); o8[64 * j] = o; }
    }
}
__device__ __forceinline__ void p9_rows(Frame& F, float* dst) {
    const int lane = F.lane;
    for (int m = F.gw; m < M; m += F.NGW) {
        const v4u* fo = (const v4u*)(F.MOB + (size_t)m * D) + lane; const f32x4* yi = (const f32x4*)(F.out + O_Y + (size_t)m * D) + 2 * lane; f32x4* yo = (f32x4*)(dst + (size_t)m * D) + 2 * lane;
        const f32x4* g1 = (const f32x4*)F.g_post_ffn + 2 * lane;
        v4u mv[4]; f32x4 x[4][2]; float v[4][8]; float s = 0.f;
#pragma unroll
        for (int j = 0; j < 4; ++j) { mv[j] = __builtin_nontemporal_load(fo + 64 * j); x[j][0] = __builtin_nontemporal_load(yi + 128 * j); x[j][1] = __builtin_nontemporal_load(yi + 128 * j + 1); }
#pragma unroll
        for (int j = 0; j < 4; ++j) { unpack8(mv[j], v[j]);
#pragma unroll
            for (int e = 0; e < 8; ++e) s += v[j][e] * v[j][e]; }
        const float rs = 1.0f / sqrtf(wave_sum(s) * (1.f / D) + EPS);
#pragma unroll
        for (int j = 0; j < 4; ++j) { const f32x4 ga = g1[128 * j], gb = g1[128 * j + 1];
            __builtin_nontemporal_store(x[j][0] + (f32x4){v[j][0], v[j][1], v[j][2], v[j][3]} * rs * ga, yo + 128 * j); __builtin_nontemporal_store(x[j][1] + (f32x4){v[j][4], v[j][5], v[j][6], v[j][7]} * rs * gb, yo + 128 * j + 1); }
    }
}

__device__ __forceinline__ float gelu_tanh(float g) { const float y2 = 1.5957691216057308f * (g + 0.044715f * g * g * g); return g * __builtin_amdgcn_rcpf(1.0f + __expf(-y2)); }
__device__ __forceinline__ void ld8f(const float* p, float (&o)[8]) { const f32x4 a = *(const f32x4*)p, b = *(const f32x4*)(p + 4); o[0] = a.x; o[1] = a.y; o[2] = a.z; o[3] = a.w; o[4] = b.x; o[5] = b.y; o[6] = b.z; o[7] = b.w; }
__device__ __forceinline__ void p7_conv(Frame& F) {
    constexpr int NCG = FF / 8, NRB = M / 8, NIT = NRB * NCG;
    const int gt = blockIdx.x * 512 + F.tid, NT = F.G * 512;
    v4u rawv[10], rawg[10];
#define P7_LOAD(dv, dg, it_) do { const int rb_ = (it_) / NCG, f0_ = 8 * ((it_) - rb_ * NCG), m0_ = rb_ * 8; const bool z_ = (m0_ >= MP) || ((m0_ & 2047) == 0); \
        _Pragma("unroll") for (int r = 0; r < 10; ++r) { const int rr = (r < 2 && z_) ? 2 : r; const bf16* ur = F.UP + (size_t)(m0_ + rr - 2) * FF2; dv[r] = *(const v4u*)(ur + f0_); dg[r] = *(const v4u*)(ur + FF + f0_); } } while (0)
#pragma unroll 1
    for (int it = gt; it < NIT; it += NT) {
        const int rb = it / NCG, cg = it - rb * NCG, f0 = 8 * cg, m0 = rb * 8;
        const bool is_p = m0 < MP; const int t0 = is_p ? (m0 & 2047) : 0; const int sb = is_p ? 0 : (m0 - MP) >> 3;
        P7_LOAD(rawv, rawg, it);
        float hv[3][8], hg[3][8];
#pragma unroll
        for (int r = 0; r < 2; ++r) {
            if (t0 == 0) {
                if (is_p) {
#pragma unroll
                    for (int e = 0; e < 8; ++e) { hv[r + 1][e] = 0.f; hg[r + 1][e] = 0.f; }
                } else { const float* sc = F.state_conv + ((size_t)sb * 2 + r) * FF2; ld8f(sc + f0, hv[r + 1]); ld8f(sc + FF + f0, hg[r + 1]); }
            } else { unpack8(rawv[r], hv[r + 1]); unpack8(rawg[r], hg[r + 1]); }
        }
        float wv[3][8], wg[3][8], bv[8], bg[8];
#pragma unroll
        for (int j = 0; j < 3; ++j) { ld8f(F.conv_w + (size_t)j * FF2 + f0, wv[j]); ld8f(F.conv_w + (size_t)j * FF2 + FF + f0, wg[j]); }
        ld8f(F.conv_b + f0, bv); ld8f(F.conv_b + FF + f0, bg);
#pragma unroll
        for (int r = 0; r < 8; ++r) {
#pragma unroll
            for (int e = 0; e < 8; ++e) { hv[0][e] = hv[1][e]; hv[1][e] = hv[2][e]; hg[0][e] = hg[1][e]; hg[1][e] = hg[2][e]; }
            unpack8(rawv[r + 2], hv[2]); unpack8(rawg[r + 2], hg[2]);
            float a[8];
#pragma unroll
            for (int e = 0; e < 8; ++e) { const float val = bv[e] + wv[0][e] * hv[0][e] + wv[1][e] * hv[1][e] + wv[2][e] * hv[2][e], gate = bg[e] + wg[0][e] * hg[0][e] + wg[1][e] * hg[1][e] + wg[2][e] * hg[2][e]; a[e] = gelu_tanh(gate) * val; }
            *(v4u*)(F.ACT + (size_t)(m0 + r) * FF + f0) = pack8(a);
            if (r >= 6) {
                float* o = nullptr;
                if (is_p) { if (t0 == 2040) o = F.out + O_CONVP + ((size_t)(m0 >> 11) * 2 + (r - 6)) * FF2; } else o = F.out + O_CONVS + ((size_t)sb * 2 + (r - 6)) * FF2;
                if (o) { *(f32x4*)(o + f0) = (f32x4){hv[2][0], hv[2][1], hv[2][2], hv[2][3]}; *(f32x4*)(o + f0 + 4) = (f32x4){hv[2][4], hv[2][5], hv[2][6], hv[2][7]};
                    *(f32x4*)(o + FF + f0) = (f32x4){hg[2][0], hg[2][1], hg[2][2], hg[2][3]}; *(f32x4*)(o + FF + f0 + 4) = (f32x4){hg[2][4], hg[2][5], hg[2][6], hg[2][7]}; }
            }
        }
    }
#undef P7_LOAD
}

struct Args { const float* in[18]; float* out; unsigned char* ws; int ph_lo, ph_hi, li, pad; };
template <int LO, int HI> __global__ void __launch_bounds__(NWAVES * 64, 2) skel_fwd(Args args) {
    extern __shared__ __attribute__((aligned(16))) unsigned char lds[];
    Frame F;
    F.lds = (LAS unsigned char*)lds;
    F.MISC = (volatile LAS unsigned*)(F.lds + LDSCTL_OFF);
    F.tid = threadIdx.x; F.lane = F.tid & 63; F.wave = __builtin_amdgcn_readfirstlane(F.tid >> 6);
    F.G = gridDim.x; F.gw = blockIdx.x * NWAVES + F.wave; F.NGW = F.G * NWAVES;
    unsigned char* ws = args.ws;
    F.ctl = (unsigned*)(ws + WS_CTL);
    F.xp = args.in[0]; F.xs = args.in[1]; F.state_pool = args.in[2]; F.state_ret = args.in[3]; F.state_conv = args.in[4]; F.g_pre_mix = args.in[5]; F.w_in = args.in[6]; F.w_pool = args.in[7];
    F.pool_scale = args.in[8]; F.gn_gain = args.in[9]; F.w_out = args.in[10]; F.g_post_mix = args.in[11]; F.g_pre_ffn = args.in[12]; F.w_up = args.in[13]; F.conv_w = args.in[14]; F.conv_b = args.in[15];
    F.w_down = args.in[16]; F.g_post_ffn = args.in[17]; F.out = args.out;
    F.WIN = (bf16*)(ws + WS_WIN); F.WUP = (bf16*)(ws + WS_WUP); F.WDN = (bf16*)(ws + WS_WDN); F.WOUT = (bf16*)(ws + WS_WOUT); F.WPOOL = (bf16*)(ws + WS_WPOOL);
    F.ROPE_C = (float*)(ws + WS_ROPE); F.ROPE_S = F.ROPE_C + 2056 * 64;
    F.XN = (bf16*)(ws + WS_XN); F.PROJ = (bf16*)(ws + WS_PROJ); F.UP = (bf16*)(ws + WS_PROJ); F.MOB = (bf16*)(ws + WS_PROJ);
    F.SP16 = (bf16*)(ws + WS_SP16);
    F.OB = (bf16*)(ws + WS_O); F.AP = (bf16*)(ws + WS_AP); F.MM = (bf16*)(ws + WS_MM); F.ACT = (bf16*)(ws + WS_O);
    for (int u = F.tid; u < (LDS_BYTES - LDSCTL_OFF) / 4; u += NWAVES * 64) ((LAS unsigned*)(F.lds + LDSCTL_OFF))[u] = 0u;
    __syncthreads();
    XcdBarrier bar; bar.bar = F.ctl + CW_BAR; bar.x = 0; bar.st = nullptr;
    if (N_LAUNCHES == 1) bar = xcd_barrier_post(F.ctl + CW_BAR, F.MISC + 8);
#define GRID_BAR() do { if (N_LAUNCHES == 1) xcd_barrier(bar); } while (0)
#define IN(k) (LO <= (k) && (k) < HI)
#define FRESH() do { int t_ = threadIdx.x; asm volatile("" : "+v"(t_)); F.tid = t_; F.lane = t_ & 63; } while (0)
#define SEAM(k) do { if constexpr (IN(k) && IN((k) + 1)) GRID_BAR(); } while (0)

#define REPS(k)
#define DUPBAR(k)
    const int rep = args.li;
    if constexpr (IN(0)) { FRESH(); REPS(0) { p0_prologue(F); DUPBAR(0); } SEAM(0); }
    if constexpr (IN(1)) {
      REPS(1) {
        pg8::Gemm g{F.XN, F.WIN, M, NIN, D}; pg8::HybridOrder S; S.init(M, NIN, D, F.G, (int)blockIdx.x, false);
        EpiProj E{F.PROJ, F.ROPE_C, F.ROPE_S}; pg8::SplitCtx X{(float*)(ws + WS_SLAB_A), F.ctl + CW_SPLIT};
        pg8::gemm_phase<EpiProj, pg8::HybridOrder, true, PG8_SP2, 5>(F.lds, g, S, E, X);
        if (rep == 0) { FRESH(); p0_deferred_weights(F, (LAS float*)(F.lds + F.wave * 16384)); }
        DUPBAR(1);
      }
        SEAM(1);
    }
    if constexpr (IN(2)) { FRESH(); REPS(2) { p2_mixers(F, rep); DUPBAR(2); } SEAM(2); }
    if constexpr (IN(3)) { FRESH(); REPS(3) { p3_merge(F); DUPBAR(3); } SEAM(3); }
    if constexpr (IN(4)) {
      REPS(4) {
        pg8::Gemm g{F.MM, F.WOUT, M, D, D}; pg8::HybridOrder S; S.init(M, D, D, F.G, (int)blockIdx.x);
        pg8::EpiBf16<0> E{F.MOB, D}; pg8::SplitCtx X{(float*)(ws + WS_SLAB_A), F.ctl + CW_SPLIT + 4096};
        pg8::gemm_phase<pg8::EpiBf16<0>, pg8::HybridOrder, true, PG8_SP2, 8>(F.lds, g, S, E, X);
        DUPBAR(4);
      }
        SEAM(4);
    }
    if constexpr (IN(5)) { FRESH(); REPS(5) { p5_rows(F); DUPBAR(5); } SEAM(5); }
    if constexpr (IN(6)) {
      REPS(6) {
        pg8::Gemm g{F.XN, F.WUP, M, FF2, D}; pg8::HybridOrder S; S.init(M, FF2, D, F.G, (int)blockIdx.x);
        pg8::EpiBf16<0> E{F.UP, FF2}; pg8::SplitCtx X{(float*)(ws + WS_SLAB_A), F.ctl + CW_SPLIT + 2 * 4096};
        pg8::gemm_phase<pg8::EpiBf16<0>, pg8::HybridOrder, true, PG8_SP2, 5>(F.lds, g, S, E, X);
        DUPBAR(6);
      }
        SEAM(6);
    }
    if constexpr (IN(7)) { FRESH(); REPS(7) { p7_conv(F); DUPBAR(7); } SEAM(7); }
    if constexpr (IN(8)) {
      REPS(8) {
        pg8::Gemm g{F.ACT, F.WDN, M, D, FF}; pg8::HybridOrder S; S.init(M, D, FF, F.G, (int)blockIdx.x);
        pg8::EpiBf16<0> E{F.MOB, D}; pg8::SplitCtx X{(float*)(ws + WS_SLAB_B), F.ctl + CW_SPLIT + 3 * 4096};
        pg8::gemm_phase<pg8::EpiBf16<0>, pg8::HybridOrder, true, PG8_SP2, 8>(F.lds, g, S, E, X);
        DUPBAR(8);
      }
        SEAM(8);
    }
    if constexpr (IN(9)) { FRESH(); p9_rows(F, (DUP_PHASE == 9 && rep == 1) ? (float*)(ws + WS_O) : F.out + O_Y); }
#undef IN
#undef SEAM
}


#if MK_N_LAUNCHES != 1
template <int P> static void launch_one(int grid, const Args& a, hipStream_t stream) { hipLaunchKernelGGL((skel_fwd<P, P + 1>), dim3(grid), dim3(NWAVES * 64), LDS_BYTES, stream, a); }
static void launch_phase(int li, int grid, const Args& a, hipStream_t stream) {
    switch (li) { case 0: launch_one<0>(grid, a, stream); break; case 1: launch_one<1>(grid, a, stream); break; case 2: launch_one<2>(grid, a, stream); break; case 3: launch_one<3>(grid, a, stream); break;
        case 4: launch_one<4>(grid, a, stream); break; case 5: launch_one<5>(grid, a, stream); break; case 6: launch_one<6>(grid, a, stream); break; case 7: launch_one<7>(grid, a, stream); break;
        case 8: launch_one<8>(grid, a, stream); break; default: launch_one<9>(grid, a, stream); break; }
}
#endif
static hipError_t set_lds_attr() {
    hipError_t e = hipSuccess;
#if MK_N_LAUNCHES == 1
    e = hipFuncSetAttribute((const void*)skel_fwd<0, N_PHASES>, hipFuncAttributeMaxDynamicSharedMemorySize, LDS_BYTES);
#else
#define SET1(P) if (e == hipSuccess) e = hipFuncSetAttribute((const void*)skel_fwd<P, P + 1>, hipFuncAttributeMaxDynamicSharedMemorySize, LDS_BYTES)
    SET1(0); SET1(1); SET1(2); SET1(3); SET1(4); SET1(5); SET1(6); SET1(7); SET1(8); SET1(9);
#undef SET1
#endif
    return e;
}
static hipError_t occ_query(int* per_cu) {
#if MK_N_LAUNCHES == 1
    return hipOccupancyMaxActiveBlocksPerMultiprocessor(per_cu, (const void*)skel_fwd<0, N_PHASES>, NWAVES * 64, LDS_BYTES);
#else
    return hipOccupancyMaxActiveBlocksPerMultiprocessor(per_cu, (const void*)skel_fwd<1, 2>, NWAVES * 64, LDS_BYTES);
#endif
}
extern "C" void kernel_launch(void* const* d_in, const int* in_sizes, int n_in, void* d_out, int out_size, void* d_ws, size_t ws_size, hipStream_t stream) {
    static int grid = 0;
    if (grid == 0) {
        if (n_in != 18 || (size_t)out_size != O_END || ws_size < WS_END) { fprintf(stderr, "kernel_launch: unexpected shapes: n_in %d out %d ws %zu (need %zu)\n", n_in, out_size, ws_size, (size_t)WS_END); grid = -1; return; }
        int dev = 0, cus = 0, per_cu = 0;
        if (hipGetDevice(&dev) != hipSuccess || hipDeviceGetAttribute(&cus, hipDeviceAttributeMultiprocessorCount, dev) != hipSuccess) { grid = -1; return; }
        if (set_lds_attr() != hipSuccess) { fprintf(stderr, "kernel_launch: hipFuncSetAttribute failed\n"); grid = -1; return; }
        if (occ_query(&per_cu) != hipSuccess || per_cu < 1) { fprintf(stderr, "kernel_launch: occupancy query says %d blocks per CU\n", per_cu); (void)hipGetLastError(); per_cu = 1; }
        grid = cus;
        fprintf(stderr, "kernel_launch: cus %d per_cu %d grid %d ws %zu\n", cus, per_cu, grid, ws_size);
    }
    if (grid < 0) return;
    (void)hipMemsetAsync((char*)d_ws + WS_CTL, 0, CTL_ZERO_BYTES, stream);
    Args a{};
    for (int i = 0; i < 18; ++i) a.in[i] = (const float*)d_in[i];
    a.out = (float*)d_out; a.ws = (unsigned char*)d_ws;
#if MK_N_LAUNCHES == 1
    {
        a.ph_lo = 0; a.ph_hi = N_PHASES; a.li = 0;
        void* kargs[] = {&a};
        hipError_t e = hipLaunchCooperativeKernel((const void*)skel_fwd<0, N_PHASES>, dim3(grid), dim3(NWAVES * 64), kargs, LDS_BYTES, stream);
        if (e != hipSuccess) fprintf(stderr, "kernel_launch: cooperative launch failed: %s (grid %d)\n", hipGetErrorString(e), grid);
    }
#else
    for (int li = 0; li < N_PHASES; ++li) { a.ph_lo = li; a.ph_hi = li + 1; a.li = 0; launch_phase(li, grid, a, stream); if (li == DUP_PHASE) { a.li = 1; launch_phase(li, grid, a, stream); if (li == 9) { a.li = 0; } } if (li == 2 && DUP_PHASE >= 20) { a.li = 1 + 16 * (DUP_PHASE - 20); launch_phase(li, grid, a, stream); } }
#endif
}
```

```cpp
#include <hip/hip_runtime.h>
#include <cstdio>
#include <cstdint>
namespace pg8 {
#define PG8_LAS __attribute__((address_space(3)))
typedef unsigned short bf16_t;
typedef short bf16x8 __attribute__((ext_vector_type(8)));
typedef float f32x4 __attribute__((ext_vector_type(4)));
typedef unsigned u32x4 __attribute__((ext_vector_type(4)));
constexpr int BM = 256, BK = 64, HALF = 128, HTB = HALF * BK * 2  , STAGE_BYTES = 8 * HTB, NXCD = 8, WGM = 2;

__host__ __device__ __forceinline__ int lds_byte(int r, int c) { const int st = (r >> 4) * 2 + (c >> 5), rr = r & 15, cc = c & 31, ob = rr * 64 + cc * 2; return st * 1024 + (ob ^ (((ob >> 9) & 1) << 5)); }
__host__ __device__ __forceinline__ void stage_rc(int b, int& R, int& C) { const int st = b / 1024, sb = b % 1024, swz = sb ^ (((sb >> 9) & 1) << 5); R = (st >> 1) * 16 + swz / 64; C = (st & 1) * 32 + (swz % 64) / 2; }
__host__ __device__ __forceinline__ int perm32(int rho) { const int n = rho >> 4, i = rho & 15; return 8 * (i >> 2) + 4 * n + (i & 3); }

struct Unit { int pm, pn, k0, nt, np, piece, slot; };
struct Gemm { const bf16_t* A; const bf16_t* Bt; int M, N, K; };

struct StaticOrder {
    int nM, nN, nwg, G, c;
    __host__ __device__ void init(int M, int N, int G_, int c_) { nM = M / BM; nN = N / BM; nwg = nM * nN; G = G_; c = c_; }
    __host__ __device__ bool next(int i, Unit& u) const {
        const long L = (long)i * G + c; if (L >= nwg) return false;
        int wgid = (int)L;
#ifndef ORDER_NOREMAP
        { const int q = nwg / NXCD, r = nwg % NXCD, xcd = wgid % NXCD, off = wgid / NXCD; wgid = (xcd < r ? xcd * (q + 1) : r * (q + 1) + (xcd - r) * q) + off; }
#endif
        const int nig = WGM * nN, gid = wgid / nig, fm = gid * WGM, gsz = (nM - fm) < WGM ? (nM - fm) : WGM;
        u.pm = fm + ((wgid % nig) % gsz); u.pn = (wgid % nig) / gsz; return true;
    }
    __device__ __forceinline__ void a_ready(const Unit&) const {}
    __device__ __forceinline__ void done(const Unit&) const {}
};


struct HybridOrder {
    int nM, nN, nwg, G, c, ntk, nfull, nrem, np;
    __host__ __device__ void init(int M, int N, int K, int G_, int c_, bool allow_split = true) {
        nM = M / BM; nN = N / BM; nwg = nM * nN; G = G_; c = c_; ntk = K / BK; nfull = nwg / G; nrem = nwg - nfull * G; np = 0;
        if (allow_split && nrem > 0 && (G % NXCD) == 0) { const int grp = (nrem + NXCD - 1) / NXCD; int p = (G / NXCD) / grp; const int maxp = ntk / 4; if (p > maxp) p = maxp; if (p > 8) p = 8; if (p >= 2) np = p; }
    }
    __host__ __device__ void map(long L, Unit& u) const {
        int wgid = (int)L;
#ifndef ORDER_NOREMAP
        { const int q = nwg / NXCD, r = nwg % NXCD, xcd = wgid % NXCD, off = wgid / NXCD; wgid = (xcd < r ? xcd * (q + 1) : r * (q + 1) + (xcd - r) * q) + off; }
#endif
        const int nig = WGM * nN, gid = wgid / nig, fm = gid * WGM, gsz = (nM - fm) < WGM ? (nM - fm) : WGM;
        u.pm = fm + ((wgid % nig) % gsz); u.pn = (wgid % nig) / gsz; u.k0 = 0; u.nt = ntk; u.np = 0; u.piece = 0; u.slot = 0;
    }
    __host__ __device__ bool next(int i, Unit& u) const {
        if (i < nfull) { map((long)i * G + c, u); return true; }
        if (i > nfull || nrem == 0) return false;
        if (np == 0) { if (c >= nrem) return false; map((long)nfull * G + c, u); return true; }
        const int x = c % NXCD, j = c / NXCD, grp = j / np, p = j - grp * np, r = grp * NXCD + x;
        if (r >= nrem) return false;
        map((long)nfull * G + r, u);
        const int pairs = ntk / 2, base = pairs / np, extra = pairs - base * np, first_big = np - extra;
        const int start = p * base + (p > first_big ? p - first_big : 0), len = base + (p >= first_big ? 1 : 0);
        u.k0 = 2 * start; u.nt = 2 * len; u.np = np; u.piece = p; u.slot = r; return true;
    }
    __device__ __forceinline__ void a_ready(const Unit&) const {}
    __device__ __forceinline__ void done(const Unit&) const {}
};
struct SplitCtx { float* slabs; unsigned* cnt; };

__device__ __forceinline__ unsigned cvt_pk_bf16(float lo, float hi) { unsigned r; asm volatile("v_cvt_pk_bf16_f32 %0, %1, %2" : "=v"(r) : "v"(lo), "v"(hi)); return r; }
typedef float f32x2 __attribute__((ext_vector_type(2)));
__device__ __forceinline__ f32x2 gelu_pk(f32x2 v) {
    const f32x2 av = __builtin_elementwise_abs(v), d = av * 0.2316418882f + 1.0f;
    f32x2 t; t.x = __builtin_amdgcn_rcpf(d.x); t.y = __builtin_amdgcn_rcpf(d.y);
    f32x2 q = t * 0.5307027145f + (-0.7265760135f); q = q * t + 0.7107068705f; q = q * t + (-0.142248368f); q = q * t + 0.127414796f; q = q * t;
    const f32x2 s = (v * v) * (-0.72134752044f);
    f32x2 e; e.x = __builtin_amdgcn_exp2f(s.x); e.y = __builtin_amdgcn_exp2f(s.y);
    const f32x2 m = v * (q * e), r = v - m;
    f32x2 o; o.x = v.x < 0.f ? m.x : r.x; o.y = v.y < 0.f ? m.y : r.y; return o;
}

template <int ACT> struct EpiBf16 {
    static constexpr bool PERM = true, AFTER_DRAIN = false;
    bf16_t* O; int ldc;
    __device__ __forceinline__ void tri(const f32x4 v0, const f32x4 v1, const Unit& u, int ai, int bj, int m, int wr, int wc, int fr, int fq) const {
        bf16_t* p = O + (size_t)(u.pm * BM + ai * HALF + wr * 64 + m * 16 + fr) * ldc + u.pn * BM + bj * HALF + wc * 32 + 8 * fq;
        u32x4 w; w.x = cvt_pk_bf16(v0[0], v0[1]); w.y = cvt_pk_bf16(v0[2], v0[3]); w.z = cvt_pk_bf16(v1[0], v1[1]); w.w = cvt_pk_bf16(v1[2], v1[3]);
        *(u32x4*)p = w;
    }
    __device__ __forceinline__ void operator()(const f32x4 (&acc)[2][2][4][2], const Unit& u, int wr, int wc, int fr, int fq) const {
#pragma unroll
        for (int ai = 0; ai < 2; ++ai)
#pragma unroll
            for (int m = 0; m < 4; ++m)
#pragma unroll
                for (int bj = 0; bj < 2; ++bj) tri(acc[ai][bj][m][0], acc[ai][bj][m][1], u, ai, bj, m, wr, wc, fr, fq);
    }
};
struct EpiF32 {
    static constexpr bool PERM = false, AFTER_DRAIN = false;
    float* C; int ldc;
    __device__ __forceinline__ void tri(const f32x4 v0, const f32x4 v1, const Unit& u, int ai, int bj, int m, int wr, int wc, int fr, int fq) const {
        float* p = C + (size_t)(u.pm * BM + ai * HALF + wr * 64 + m * 16 + fr) * ldc + u.pn * BM + bj * HALF + wc * 32 + 4 * fq;
        *(f32x4*)p = v0; *(f32x4*)(p + 16) = v1;
    }
    __device__ __forceinline__ void operator()(const f32x4 (&acc)[2][2][4][2], const Unit& u, int wr, int wc, int fr, int fq) const {
#pragma unroll
        for (int ai = 0; ai < 2; ++ai)
#pragma unroll
            for (int m = 0; m < 4; ++m)
#pragma unroll
                for (int bj = 0; bj < 2; ++bj) tri(acc[ai][bj][m][0], acc[ai][bj][m][1], u, ai, bj, m, wr, wc, fr, fq);
    }
};
typedef unsigned u32x2 __attribute__((ext_vector_type(2)));
__device__ __forceinline__ f32x4 bf4_to_f32(u32x2 x) { f32x4 o; o[0] = __builtin_bit_cast(float, x.x << 16); o[1] = __builtin_bit_cast(float, x.x & 0xffff0000u); o[2] = __builtin_bit_cast(float, x.y << 16); o[3] = __builtin_bit_cast(float, x.y & 0xffff0000u); return o; }
template <int NP, class Epi> __device__ __forceinline__ void split_epilogue(const f32x4 (&acc)[2][2][4][2], const Unit& u, const Epi& E, const SplitCtx& X, int tid, int wr, int wc, int fr, int fq) {
    constexpr int SLAB = 32 * 512 * 8;
    const __amdgpu_buffer_rsrc_t rs = __builtin_amdgcn_make_buffer_rsrc((void*)((char*)X.slabs + (size_t)(u.slot * u.np) * SLAB), 0, u.np * SLAB, 0x00020000);
    {
        const int so = u.piece * SLAB;
#pragma unroll
        for (int r = 0; r < 32; ++r) { const f32x4 v = acc[r >> 4][(r >> 3) & 1][(r >> 1) & 3][r & 1]; u32x2 w; w.x = cvt_pk_bf16(v[0], v[1]); w.y = cvt_pk_bf16(v[2], v[3]);
            __builtin_amdgcn_raw_buffer_store_b64(w, rs, (unsigned)(tid * 8), so + r * 4096, 16); }
    }
    asm volatile("s_waitcnt vmcnt(0)" ::: "memory");
    asm volatile("" ::: "memory"); __builtin_amdgcn_s_barrier(); asm volatile("" ::: "memory");
    if (tid == 0) {
        unsigned* cw = X.cnt + 64 * u.slot;
        (void)__hip_atomic_fetch_add(cw, 1u, __ATOMIC_RELAXED, __HIP_MEMORY_SCOPE_AGENT);
        unsigned sp = 0;
        while (__hip_atomic_load(cw, __ATOMIC_RELAXED, __HIP_MEMORY_SCOPE_AGENT) < (unsigned)u.np) { __builtin_amdgcn_s_sleep(1); if (++sp > (1u << 24)) break; }
        __builtin_amdgcn_fence(__ATOMIC_ACQUIRE, "agent");
        asm volatile("s_waitcnt vmcnt(0)" ::: "memory");
    }
    asm volatile("" ::: "memory"); __builtin_amdgcn_s_barrier(); asm volatile("" ::: "memory");
    const int q0 = (16 * u.piece) / u.np, q1 = (16 * (u.piece + 1)) / u.np;
#pragma unroll 1
    for (int q = q0; q < q1; ++q) {
        const unsigned vo = (unsigned)(tid * 8 + q * 8192);
        f32x4 v0 = (f32x4){0.f, 0.f, 0.f, 0.f}, v1 = v0;
        if (u.np == NP) {
            u32x2 t0[NP], t1[NP];
#pragma unroll
            for (int pp = 0; pp < NP; ++pp) { t0[pp] = __builtin_amdgcn_raw_buffer_load_b64(rs, vo, pp * SLAB, 0); t1[pp] = __builtin_amdgcn_raw_buffer_load_b64(rs, vo, pp * SLAB + 4096, 0); }
#pragma unroll
            for (int pp = 0; pp < NP; ++pp) { v0 += bf4_to_f32(t0[pp]); v1 += bf4_to_f32(t1[pp]); }
        } else {
            for (int pp = 0; pp < u.np; ++pp) { v0 += bf4_to_f32(__builtin_amdgcn_raw_buffer_load_b64(rs, vo, pp * SLAB, 0)); v1 += bf4_to_f32(__builtin_amdgcn_raw_buffer_load_b64(rs, vo, pp * SLAB + 4096, 0)); }
        }
        E.tri(v0, v1, u, q >> 3, (q >> 2) & 1, q & 3, wr, wc, fr, fq);
    }
}
template <class Epi, class Sched, bool ALIGN_EPI = false, bool SP2 = false, int NP = 8>
__device__ __forceinline__ void gemm_phase(PG8_LAS unsigned char* lds, const Gemm g, const Sched& S, const Epi& E, const SplitCtx& X) {
    int tid_ = threadIdx.x; asm volatile("" : "+v"(tid_));
    const int tid = tid_, wid = __builtin_amdgcn_readfirstlane(tid >> 6), lane = tid & 63, wr = wid >> 2, wc = wid & 3, fr = lane & 15, fq = lane >> 4;
    const int K = g.K;
    unsigned voffA[2], voffB[2];
#pragma unroll
    for (int i = 0; i < 2; ++i) { int R, C; stage_rc(tid * 16 + i * 8192, R, C); const int Rb = Epi::PERM ? ((R & ~31) + perm32(R & 31)) : R;
        voffA[i] = (unsigned)(R * K + C) * 2u; voffB[i] = (unsigned)(Rb * K + C) * 2u; }
    const size_t kstep = (size_t)(BK * 2);
    const size_t hstep = (size_t)HALF * K * 2;
    const size_t tstep = 2 * hstep;
    const unsigned ldsw = (unsigned)wid * 1024u;
    const int aoff = lds_byte(wr * 64 + fr, fq * 8), boff = lds_byte(wc * 32 + fr, fq * 8);
#define PG8_SA(b, h) (((b) * 2 + (h)) * HTB)
#define PG8_SB(b, h) ((4 + (b) * 2 + (h)) * HTB)
#define PG8_STAGE(bufoff, gbase, voff) do { _Pragma("unroll") for (int _i = 0; _i < 2; ++_i) \
        __builtin_amdgcn_global_load_lds((const unsigned*)((const char*)(gbase) + (voff)[_i]), (PG8_LAS unsigned*)(lds + (bufoff) + ldsw + _i * 8192), 16, 0, 0); } while (0)
#define PG8_LDA(dst, b, h) do { _Pragma("unroll") for (int m = 0; m < 4; ++m) _Pragma("unroll") for (int k = 0; k < 2; ++k) dst[m][k] = *(const PG8_LAS bf16x8*)(lds + PG8_SA(b, h) + aoff + m * 2048 + k * 1024); } while (0)
#define PG8_LDB(dst, b, h) do { _Pragma("unroll") for (int n = 0; n < 2; ++n) _Pragma("unroll") for (int k = 0; k < 2; ++k) dst[n][k] = *(const PG8_LAS bf16x8*)(lds + PG8_SB(b, h) + boff + n * 2048 + k * 1024); } while (0)
#define PG8_MMA(ai, bj, At, Bt) do { __builtin_amdgcn_s_setprio(1); _Pragma("unroll") for (int m = 0; m < 4; ++m) _Pragma("unroll") for (int n = 0; n < 2; ++n) _Pragma("unroll") for (int k = 0; k < 2; ++k) \
        acc[ai][bj][m][n] = __builtin_amdgcn_mfma_f32_16x16x32_bf16(Bt[n][k], At[m][k], acc[ai][bj][m][n], 0, 0, 0); __builtin_amdgcn_s_setprio(0); } while (0)
#define PG8_WAIT_V(n) asm volatile("s_waitcnt vmcnt(" #n ")" ::: "memory")
#define PG8_WAIT_L(n) asm volatile("s_waitcnt lgkmcnt(" #n ")" ::: "memory")
#define PG8_BAR __builtin_amdgcn_s_barrier()
#define PG8_SCHED __builtin_amdgcn_sched_barrier(0)
    Unit cur, nxt; int ui = 0;
    if (!S.next(0, cur)) return;
    f32x4 acc[2][2][4][2];
#pragma unroll
    for (int a = 0; a < 2; ++a)
#pragma unroll
        for (int b = 0; b < 2; ++b)
#pragma unroll
            for (int m = 0; m < 4; ++m)
#pragma unroll
                for (int n = 0; n < 2; ++n) acc[a][b][m][n] = (f32x4){0.f, 0.f, 0.f, 0.f};
    bf16x8 At[4][2], B0[2][2], B1[2][2];
    const char* cA = (const char*)g.A + (size_t)cur.pm * tstep + (size_t)cur.k0 * kstep; const char* cB = (const char*)g.Bt + (size_t)cur.pn * tstep + (size_t)cur.k0 * kstep;
    S.a_ready(cur);
    if constexpr (SP2) {
        PG8_STAGE(PG8_SB(0, 0), cB, voffB); PG8_STAGE(PG8_SB(0, 1), cB + hstep, voffB); PG8_STAGE(PG8_SA(0, 0), cA, voffA); PG8_STAGE(PG8_SA(0, 1), cA + hstep, voffA);
        if (wr == 1) PG8_BAR;
        PG8_WAIT_V(2); PG8_BAR;
        PG8_STAGE(PG8_SB(1, 0), cB + kstep, voffB); PG8_STAGE(PG8_SA(1, 0), cA + kstep, voffA); PG8_STAGE(PG8_SB(1, 1), cB + hstep + kstep, voffB);
        PG8_WAIT_V(6); PG8_BAR;
    } else {
        PG8_STAGE(PG8_SB(0, 0), cB, voffB); PG8_STAGE(PG8_SA(0, 0), cA, voffA); PG8_STAGE(PG8_SB(0, 1), cB + hstep, voffB); PG8_STAGE(PG8_SA(0, 1), cA + hstep, voffA);
        if (wr == 1) PG8_BAR;
        PG8_WAIT_V(4); PG8_BAR;
        PG8_STAGE(PG8_SB(1, 0), cB + kstep, voffB); PG8_STAGE(PG8_SA(1, 0), cA + kstep, voffA); PG8_STAGE(PG8_SB(1, 1), cB + hstep + kstep, voffB);
        PG8_WAIT_V(6); PG8_BAR;
    }
    for (;;) {
        const bool has_next = S.next(ui + 1, nxt);
        const char* nA = has_next ? (const char*)g.A + (size_t)nxt.pm * tstep + (size_t)nxt.k0 * kstep : cA; const char* nB = has_next ? (const char*)g.Bt + (size_t)nxt.pn * tstep + (size_t)nxt.k0 * kstep : cB;
        const int nt = cur.nt;
        for (int t = 0; t < nt; t += 2) {
            const bool last = (t == nt - 2);
            const char* a1 = cA + (size_t)(t + 1) * kstep;
            const char* a2 = last ? nA : cA + (size_t)(t + 2) * kstep; const char* b2 = last ? nB : cB + (size_t)(t + 2) * kstep;
            const char* a3 = a2 + kstep; const char* b3 = b2 + kstep;
            if (last && has_next) S.a_ready(nxt);
            if constexpr (SP2) {
            PG8_LDB(B0, 0, 0); PG8_LDB(B1, 0, 1); PG8_SCHED; PG8_LDA(At, 0, 0); PG8_STAGE(PG8_SA(1, 1), a1 + hstep, voffA);
            PG8_WAIT_V(8); PG8_WAIT_L(0); PG8_BAR; PG8_MMA(0, 0, At, B0); PG8_MMA(0, 1, At, B1); PG8_BAR; PG8_SCHED;
            PG8_LDA(At, 0, 1); PG8_STAGE(PG8_SB(0, 0), b2, voffB); PG8_STAGE(PG8_SB(0, 1), b2 + hstep, voffB); PG8_STAGE(PG8_SA(0, 0), a2, voffA);
            PG8_WAIT_V(8); PG8_WAIT_L(0); PG8_BAR; PG8_MMA(1, 0, At, B0); PG8_MMA(1, 1, At, B1); PG8_BAR; PG8_SCHED;
            PG8_LDB(B0, 1, 0); PG8_LDB(B1, 1, 1); PG8_SCHED; PG8_LDA(At, 1, 0); PG8_STAGE(PG8_SA(0, 1), a2 + hstep, voffA);
            PG8_WAIT_V(8); PG8_WAIT_L(0); PG8_BAR; PG8_MMA(0, 0, At, B0); PG8_MMA(0, 1, At, B1); PG8_BAR; PG8_SCHED;
            PG8_LDA(At, 1, 1); PG8_STAGE(PG8_SB(1, 0), b3, voffB); PG8_STAGE(PG8_SB(1, 1), b3 + hstep, voffB); PG8_STAGE(PG8_SA(1, 0), a3, voffA);
            PG8_WAIT_V(8); PG8_WAIT_L(0); PG8_BAR; PG8_MMA(1, 0, At, B0); PG8_MMA(1, 1, At, B1); PG8_BAR; PG8_SCHED;
            } else {
            PG8_LDB(B0, 0, 0); PG8_SCHED; PG8_LDA(At, 0, 0); PG8_STAGE(PG8_SA(1, 1), a1 + hstep, voffA);
            PG8_WAIT_L(8); PG8_BAR; PG8_WAIT_L(0); PG8_MMA(0, 0, At, B0); PG8_BAR; PG8_SCHED;
            PG8_LDB(B1, 0, 1); PG8_STAGE(PG8_SB(0, 0), b2, voffB);
            PG8_BAR; PG8_WAIT_L(0); PG8_MMA(0, 1, At, B1); PG8_BAR;
            PG8_LDA(At, 0, 1); PG8_STAGE(PG8_SA(0, 0), a2, voffA);
            PG8_BAR; PG8_WAIT_L(0); PG8_MMA(1, 0, At, B0); PG8_BAR; PG8_SCHED;
            PG8_STAGE(PG8_SB(0, 1), b2 + hstep, voffB);
            PG8_WAIT_V(6); PG8_BAR; PG8_MMA(1, 1, At, B1); PG8_BAR;
            PG8_LDB(B0, 1, 0); PG8_SCHED; PG8_LDA(At, 1, 0); PG8_STAGE(PG8_SA(0, 1), a2 + hstep, voffA);
            PG8_WAIT_L(8); PG8_BAR; PG8_WAIT_L(0); PG8_MMA(0, 0, At, B0); PG8_BAR; PG8_SCHED;
            PG8_LDB(B1, 1, 1); PG8_STAGE(PG8_SB(1, 0), b3, voffB);
            PG8_BAR; PG8_WAIT_L(0); PG8_MMA(0, 1, At, B1); PG8_BAR;
            PG8_LDA(At, 1, 1); PG8_STAGE(PG8_SA(1, 0), a3, voffA);
            PG8_BAR; PG8_WAIT_L(0); PG8_MMA(1, 0, At, B0); PG8_BAR; PG8_SCHED;
            PG8_STAGE(PG8_SB(1, 1), b3 + hstep, voffB);
            PG8_WAIT_V(6); PG8_BAR; PG8_MMA(1, 1, At, B1); PG8_BAR;
            }
        }
        if constexpr (ALIGN_EPI) { if (wr == 0) PG8_BAR; }
        if constexpr (!Epi::AFTER_DRAIN) { if (cur.np > 0) split_epilogue<NP>(acc, cur, E, X, tid, wr, wc, fr, fq); else E(acc, cur, wr, wc, fr, fq); S.done(cur); }
        if (!has_next) break;
#pragma unroll
        for (int a = 0; a < 2; ++a)
#pragma unroll
            for (int b = 0; b < 2; ++b)
#pragma unroll
                for (int m = 0; m < 4; ++m)
#pragma unroll
                    for (int n = 0; n < 2; ++n) acc[a][b][m][n] = (f32x4){0.f, 0.f, 0.f, 0.f};
        cur = nxt; cA = nA; cB = nB; ++ui;
        if constexpr (ALIGN_EPI) { if (wr == 1) PG8_BAR; }
    }
    PG8_WAIT_V(0);
    if constexpr (!ALIGN_EPI) { if (wr == 0) PG8_BAR; }
    PG8_BAR;
    if constexpr (Epi::AFTER_DRAIN) { E.fused(acc, cur, wr, wc, fr, fq, lds, wid, lane); S.done(cur); }
#undef PG8_SA
#undef PG8_SB
#undef PG8_STAGE
#undef PG8_LDA
#undef PG8_LDB
#undef PG8_MMA
#undef PG8_WAIT_V
#undef PG8_WAIT_L
#undef PG8_BAR
#undef PG8_SCHED
}
}

#ifndef PG8_SP2
#define PG8_SP2 true
#endif
#ifndef PG8_ALIGN
#define PG8_ALIGN true
#endif
#ifndef DUP_PHASE
#define DUP_PHASE -1
#endif
#ifndef MK_N_LAUNCHES
#define MK_N_LAUNCHES 1
#endif
constexpr int NWAVES = 8;
constexpr int N_PHASES = 10;
constexpr int N_LAUNCHES = MK_N_LAUNCHES;

constexpr int MP = 8192, MS = 1024, M = MP + MS;
constexpr int D = 2048, NIN = 11264, FF = 5632, FF2 = 11264;
constexpr int NH = 8, DK = 128, DVH = 256;
constexpr int C_POOL = 0, C_Q = 1024, C_K = 2048, C_V = 3072, C_GRET = 5120, C_GA = 7168, C_GR = 9216;
constexpr float EPS = 1e-6f;
constexpr int NS = 4, DVS = DVH / NS;
constexpr size_t O_Y = 0, O_POOLP = 18874368, O_RETP = 18935808, O_CONVP = 19984384, O_POOLS = 20074496, O_RETS = 22040576, O_CONVS = 55595008, O_END = 58478592;

constexpr size_t MiB = 1u << 20;
constexpr size_t WS_CTL = 0, CTL_ZERO_BYTES = 128 * 1024;
constexpr size_t WS_WIN = 1 * MiB, WS_WUP = 45 * MiB, WS_WDN = 89 * MiB, WS_WOUT = 111 * MiB, WS_WPOOL = 119 * MiB;
constexpr size_t WS_ROPE = 120 * MiB;
constexpr size_t WS_XN = 122 * MiB;
constexpr size_t WS_PROJ = 158 * MiB;
constexpr size_t WS_O = 356 * MiB, WS_AP = 392 * MiB, WS_MM = 428 * MiB;
constexpr size_t WS_SP16 = 464 * MiB;
constexpr size_t WS_X1 = 468 * MiB;
constexpr size_t WS_END = 504 * MiB;
constexpr int CW_TMO = 0, CW_CODE = 1, CW_Q2 = 64, CW_QW = 192, CW_BAR = 4096, CW_SPLIT = 8192;
static_assert((CW_SPLIT + 4 * 4096) * 4 <= (int)CTL_ZERO_BYTES && CW_BAR + 3456 <= CW_SPLIT, "control words inside the per-call memset");
constexpr size_t WS_SLAB_A = 356 * MiB, WS_SLAB_B = 230 * MiB;

constexpr int LDS_BYTES = 147456, LDSCTL_OFF = 143360;

#define GAS __attribute__((address_space(1)))
#define LAS __attribute__((address_space(3)))
typedef unsigned short bf16;
typedef unsigned v4u __attribute__((ext_vector_type(4)));
typedef unsigned v2u __attribute__((ext_vector_type(2)));
typedef float f32x4 __attribute__((ext_vector_type(4)));
typedef short bf16x8 __attribute__((ext_vector_type(8)));
#define RLX_AGENT __ATOMIC_RELAXED, __HIP_MEMORY_SCOPE_AGENT
#define LDS_WAIT() asm volatile("s_waitcnt lgkmcnt(0)" ::: "memory")
#define VM_WAIT() asm volatile("s_waitcnt vmcnt(0)" ::: "memory")
__device__ __forceinline__ unsigned pk2(float lo, float hi) { return pg8::cvt_pk_bf16(lo, hi); }
__device__ __forceinline__ float bflo(unsigned u) { return __uint_as_float(u << 16); }
__device__ __forceinline__ float bfhi(unsigned u) { return __uint_as_float(u & 0xffff0000u); }
__device__ __forceinline__ void unpack8(v4u x, float (&f)[8]) { f[0] = bflo(x.x); f[1] = bfhi(x.x); f[2] = bflo(x.y); f[3] = bfhi(x.y); f[4] = bflo(x.z); f[5] = bfhi(x.z); f[6] = bflo(x.w); f[7] = bfhi(x.w); }
__device__ __forceinline__ v4u pack8(const float (&f)[8]) { v4u o; o.x = pk2(f[0], f[1]); o.y = pk2(f[2], f[3]); o.z = pk2(f[4], f[5]); o.w = pk2(f[6], f[7]); return o; }
__device__ __forceinline__ v2u pack4(f32x4 a) { v2u o; o.x = pk2(a[0], a[1]); o.y = pk2(a[2], a[3]); return o; }
__device__ __forceinline__ float sigmoidf_(float x) { return __builtin_amdgcn_rcpf(1.0f + __expf(-x)); }
__device__ __forceinline__ float wave_sum(float v) {
#pragma unroll
    for (int o = 1; o < 64; o <<= 1) v += __shfl_xor(v, o);
    return v;
}
__device__ __forceinline__ bf16x8 as_bf16x8(v4u x) { return __builtin_bit_cast(bf16x8, x); }
#define MFMA16(a, b, c) __builtin_amdgcn_mfma_f32_16x16x32_bf16((a), (b), (c), 0, 0, 0)

#define XB_TMO      128
#define XB_XCNT(j)  (256  + 64 * (j))
#define XB_XSUB(j)  (1280 + 64 * (j))
#define XB_XGEN(j)  (2304 + 64 * (j))
#define XB_TOP      3328
#define XB_TOPGEN   3392
#define XCD_BAR_WORDS 3456
#define XB_SPIN_CAP (1u << 22)
__device__ __forceinline__ unsigned xb_ld(unsigned* p)              { return __hip_atomic_load(p, __ATOMIC_RELAXED, __HIP_MEMORY_SCOPE_AGENT); }
__device__ __forceinline__ unsigned xb_add(unsigned* p, unsigned v) { return __hip_atomic_fetch_add(p, v, __ATOMIC_RELAXED, __HIP_MEMORY_SCOPE_AGENT); }
__device__ __forceinline__ unsigned xb_xcc_id() { return (unsigned)__builtin_amdgcn_s_getreg((3 << 11) | 20) & 0xFu; }
#define XB_SPIN(cond, bar) do { unsigned _sp = 0; while (cond) { __builtin_amdgcn_s_sleep(1); \
    if ((++_sp & 255u) == 0u) { if (xb_ld(&(bar)[XB_TMO])) break; if (_sp > XB_SPIN_CAP) { atomicAdd(&(bar)[XB_TMO], 1u); break; } } } } while (0)
struct XcdBarrier { unsigned* bar; unsigned x; volatile LAS unsigned* st; };
__device__ __forceinline__ XcdBarrier xcd_barrier_post(unsigned* bar, volatile LAS unsigned* st) {
    XcdBarrier b; b.bar = bar; b.x = xb_xcc_id(); b.st = st;
    if (threadIdx.x == 0) (void)xb_add(&bar[XB_XCNT(b.x)], 1u);
    return b;
}
__device__ __forceinline__ void xcd_barrier_complete(unsigned* bar, unsigned x, unsigned& nloc, unsigned& nx) {
    const unsigned G = gridDim.x * gridDim.y * gridDim.z;
    unsigned sum, cnt, mine, sp = 0u;
    for (;;) {
        sum = 0u; cnt = 0u; mine = 0u;
#pragma unroll
        for (unsigned j = 0; j < 16; ++j) { const unsigned c = xb_ld(&bar[XB_XCNT(j)]); sum += c; cnt += (c > 0u) ? 1u : 0u; mine = (j == x) ? c : mine; }
        if (sum == G) break;
        __builtin_amdgcn_s_sleep(1);
        if ((++sp & 255u) == 0u) { if (xb_ld(&bar[XB_TMO])) break; if (sp > XB_SPIN_CAP) { atomicAdd(&bar[XB_TMO], 1u); break; } }
    }
    nloc = mine > 0u ? mine : 1u; nx = cnt > 0u ? cnt : 1u;
}
__device__ __forceinline__ void xcd_barrier(const XcdBarrier& b) {
    asm volatile("s_waitcnt vmcnt(0)" ::: "memory");
    __syncthreads();
    if (threadIdx.x == 0) {
        unsigned* bar = b.bar;
        __builtin_amdgcn_s_waitcnt(0);
        unsigned nloc = b.st[0], nx = b.st[1];
        if (nloc == 0u) { xcd_barrier_complete(bar, b.x, nloc, nx); b.st[0] = nloc; b.st[1] = nx; }
        const unsigned old = xb_add(&bar[XB_XSUB(b.x)], 1u);
        const unsigned gen = old / nloc;
        if (old + 1u == (gen + 1u) * nloc) {
            __builtin_amdgcn_fence(__ATOMIC_RELEASE, "agent");
            asm volatile("s_waitcnt vmcnt(0)" ::: "memory");
            const unsigned og = xb_add(&bar[XB_TOP], 1u);
            const unsigned tg = og / nx;
            if (og + 1u == (tg + 1u) * nx) xb_add(&bar[XB_TOPGEN], 1u);
            else XB_SPIN(xb_ld(&bar[XB_TOPGEN]) == tg, bar);
            __builtin_amdgcn_fence(__ATOMIC_ACQUIRE, "agent");
            xb_add(&bar[XB_XGEN(b.x)], 1u);
            asm volatile("s_waitcnt vmcnt(0)" ::: "memory");
        } else {
            XB_SPIN(xb_ld(&bar[XB_XGEN(b.x)]) == gen, bar);
            __builtin_amdgcn_fence(__ATOMIC_ACQUIRE, "agent");
            asm volatile("s_waitcnt vmcnt(0)" ::: "memory");
        }
    }
    __syncthreads();
}

struct Frame {
    LAS unsigned char* lds;
    volatile LAS unsigned* MISC;
    unsigned* ctl;
    int tid, lane, wave, G, gw, NGW;
    const float *xp, *xs, *state_pool, *state_ret, *state_conv, *g_pre_mix, *w_in, *w_pool, *pool_scale, *gn_gain, *w_out, *g_post_mix, *g_pre_ffn, *w_up, *conv_w, *conv_b, *w_down, *g_post_ffn;
    float* out;
    bf16 *WIN, *WUP, *WDN, *WOUT, *WPOOL, *XN, *PROJ, *UP, *OB, *AP, *MM, *ACT;
    float *ROPE_C, *ROPE_S;
    bf16 *SP16, *MOB, *X1B;
};
__device__ __forceinline__ const float* xrow(const Frame& F, int m) { return m < MP ? F.xp + (size_t)m * D : F.xs + (size_t)(m - MP) * D; }

__host__ __device__ __forceinline__ int unperm_d(int p) { const int g8 = p >> 3, e = p & 7; return e < 4 ? 4 * g8 + e : 64 + 4 * g8 + (e - 4); }
__device__ __forceinline__ void p0_transpose_item(const float* W, int K, int N, bf16* WT, LAS float* scr, int item, int lane, bool permqk = false) {
    const int nblk = N / 32, kb = item / nblk, nb = item % nblk, k0 = 64 * kb, n0 = 32 * nb;
    int src = n0 + (lane & 31); if (permqk && src >= C_Q && src < C_V) src = (src & ~127) + unperm_d(src & 127);
#pragma unroll 8
    for (int i = 0; i < 32; ++i) { const int kk = 2 * i + (lane >> 5); scr[kk * 33 + (lane & 31)] = __builtin_nontemporal_load(W + (size_t)(k0 + kk) * N + src); }
    LDS_WAIT(); asm volatile("" ::: "memory");
    const int c = lane & 7;
#pragma unroll
    for (int j = 0; j < 4; ++j) { const int n = (lane >> 3) + 8 * j; const LAS float* s = scr + (8 * c) * 33 + n;
        v4u o; o.x = pk2(s[0 * 33], s[1 * 33]); o.y = pk2(s[2 * 33], s[3 * 33]); o.z = pk2(s[4 * 33], s[5 * 33]); o.w = pk2(s[6 * 33], s[7 * 33]);
        *(v4u*)(WT + (size_t)(n0 + n) * K + k0 + 8 * c) = o; }
    LDS_WAIT(); asm volatile("" ::: "memory");
}
__device__ __forceinline__ void rms_row_to_bf16(const float* xr_, const float* g, bf16* orow, int lane) {
    const f32x4* xr = (const f32x4*)xr_ + lane; const f32x4* gr = (const f32x4*)g + lane;
    f32x4 v[8]; float s = 0.f;
#pragma unroll
    for (int j = 0; j < 8; ++j) { v[j] = __builtin_nontemporal_load(xr + 64 * j); s += (v[j].x * v[j].x + v[j].y * v[j].y) + (v[j].z * v[j].z + v[j].w * v[j].w); }
    const float rs = 1.0f / sqrtf(wave_sum(s) * (1.f / D) + EPS);
    v2u* o8 = (v2u*)orow + lane;
#pragma unroll
    for (int j = 0; j < 8; ++j) { const f32x4 gg = gr[64 * j]; v2u o; o.x = pk2(v[j].x * rs * gg.x, v[j].y * rs * gg.y); o.y = pk2(v[j].z * rs * gg.z, v[j].w * rs * gg.w); o8[64 * j] = o; }
}
__device__ __forceinline__ void p0_deferred_weights(Frame& F, LAS float* scr) {
    constexpr int I_UP = (D / 64) * (FF2 / 32), I_DN = (FF / 64) * (D / 32), I_OUT = (D / 64) * (D / 32), I_PL = (256 / 64) * (512 / 32);
    constexpr int NITEMS = I_UP + I_DN + I_OUT + 4 * I_PL, CHUNK = 4;
    for (;;) {
        int base = 0;
        if (F.lane == 0) base = (int)__hip_atomic_fetch_add(F.ctl + CW_QW, (unsigned)CHUNK, RLX_AGENT);
        base = __builtin_amdgcn_readfirstlane(base);
        if (base >= NITEMS) break;
        for (int it = base; it < base + CHUNK && it < NITEMS; ++it) {
            int r = it;
            if (r < I_UP) { p0_transpose_item(F.w_up, D, FF2, F.WUP, scr, r, F.lane); continue; } r -= I_UP;
            if (r < I_DN) { p0_transpose_item(F.w_down, FF, D, F.WDN, scr, r, F.lane); continue; } r -= I_DN;
            if (r < I_OUT) { p0_transpose_item(F.w_out, D, D, F.WOUT, scr, r, F.lane); continue; } r -= I_OUT;
            const int g = r / I_PL; r -= g * I_PL;
            p0_transpose_item(F.w_pool + (size_t)g * 256 * 512, 256, 512, F.WPOOL + (size_t)g * 512 * 256, scr, r, F.lane);
        }
    }
}
__device__ __forceinline__ void p0_prologue(Frame& F) {
    LAS float* scr = (LAS float*)(F.lds + F.wave * 16384);
    constexpr int I_IN = (D / 64) * (NIN / 32);
    for (int it = F.gw; it < I_IN; it += F.NGW) p0_transpose_item(F.w_in, D, NIN, F.WIN, scr, it, F.lane, true);
    for (int m = F.gw; m < M; m += F.NGW) rms_row_to_bf16(xrow(F, m), F.g_pre_mix, F.XN + (size_t)m * D, F.lane);
    for (int idx = blockIdx.x * 512 + F.tid; idx < 128 * 15 * 1024 / 4; idx += F.G * 512) { const f32x4 v = ((const f32x4*)F.state_pool)[idx]; ((v2u*)F.SP16)[idx] = pack4(v); }
    for (int idx = blockIdx.x * 512 + F.tid; idx < 2056 * 64; idx += F.G * 512) {
        const int row = idx >> 6, i = idx & 63; const int pos = row < 2048 ? row : 16384 + (row - 2048);
        double th = 1.0; for (int k = 0; k < i; ++k) th *= 0.8659643233600653;
        const double a = (double)pos * th;
        const double kd = rint(a * 0.6366197723675814);
        double y = fma(-kd, 1.57079632679489655800e+00, a); y = fma(-kd, 6.12323399573676603587e-17, y);
        const int k4 = ((int)kd) & 3; const double y2 = y * y;
        const double sp = y * (1.0 + y2 * (-1.0 / 6 + y2 * (1.0 / 120 + y2 * (-1.0 / 5040 + y2 * (1.0 / 362880 + y2 * (-1.0 / 39916800 + y2 * (1.0 / 6227020800.0)))))));
        const double cp = 1.0 + y2 * (-0.5 + y2 * (1.0 / 24 + y2 * (-1.0 / 720 + y2 * (1.0 / 40320 + y2 * (-1.0 / 3628800 + y2 * (1.0 / 479001600 + y2 * (-1.0 / 87178291200.0)))))));
        double sn, cs;
        if (k4 == 0) { sn = sp; cs = cp; } else if (k4 == 1) { sn = cp; cs = -sp; } else if (k4 == 2) { sn = -sp; cs = -cp; } else { sn = -cp; cs = sp; }
        F.ROPE_C[idx] = (float)cs; F.ROPE_S[idx] = (float)sn;
    }
}

constexpr float KSCALE = 0.08838834764831845f;
struct EpiProj {
    static constexpr bool PERM = true, AFTER_DRAIN = false;
    bf16* O; const float* rc; const float* rs;
    __device__ __forceinline__ void tri(f32x4 v0, f32x4 v1, const pg8::Unit& u, int ai, int bj, int m, int wr, int wc, int fr, int fq) const {
        const int row = u.pm * 256 + ai * 128 + wr * 64 + m * 16 + fr, col = u.pn * 256 + bj * 128 + wc * 32 + 8 * fq;
        if (u.pn >= 4 && u.pn < 12) {
            const int h = ((u.pn & 3) << 1) + bj;
            int prow, tl; if (row < MP) { const int t = row & 2047; prow = t; tl = t & 127; } else { tl = row & 7; prow = 2048 + tl; }
            const int g8 = 4 * wc + fq;
            const f32x4 c = *(const f32x4*)(rc + prow * 64 + 4 * g8), sn = *(const f32x4*)(rs + prow * 64 + 4 * g8);
            const float lg2 = __log2f(1.0f - __builtin_amdgcn_exp2f(-5.0f - (float)h));
            const float sc = u.pn >= 8 ? KSCALE * __builtin_amdgcn_exp2f(-lg2 * (float)tl) : __builtin_amdgcn_exp2f(lg2 * (float)tl);
            const f32x4 y1 = (v0 * c - v1 * sn) * sc, y2 = (v1 * c + v0 * sn) * sc;
            v0 = y1; v1 = y2;
        }
        v4u w4; w4.x = pk2(v0[0], v0[1]); w4.y = pk2(v0[2], v0[3]); w4.z = pk2(v1[0], v1[1]); w4.w = pk2(v1[2], v1[3]);
        *(v4u*)(O + (size_t)row * NIN + col) = w4;
    }
    __device__ __forceinline__ void operator()(const f32x4 (&acc)[2][2][4][2], const pg8::Unit& u, int wr, int wc, int fr, int fq) const {
#pragma unroll
        for (int ai = 0; ai < 2; ++ai)
#pragma unroll
            for (int m = 0; m < 4; ++m)
#pragma unroll
                for (int bj = 0; bj < 2; ++bj) tri(acc[ai][bj][m][0], acc[ai][bj][m][1], u, ai, bj, m, wr, wc, fr, fq);
    }
};

typedef short s16x4 __attribute__((ext_vector_type(4)));
__device__ __forceinline__ bf16x8 tr16x2(const LAS unsigned char* p0, const LAS unsigned char* p1) {
    const s16x4 a = __builtin_amdgcn_ds_read_tr16_b64_v4i16((LAS s16x4*)p0), b = __builtin_amdgcn_ds_read_tr16_b64_v4i16((LAS s16x4*)p1);
    return __builtin_shufflevector(a, b, 0, 1, 2, 3, 4, 5, 6, 7);
}
static_assert(DVS == 64, "chain staging below assumes 64-wide value slices");
constexpr int QI_LD = 136, VI_LD = DVS + 8;
constexpr int QI_OFF = 0, KI_OFF = 34816, VI_OFF = 69632, RT_OFF = VI_OFF + 128 * VI_LD * 2, CH_END = RT_OFF + DVS * QI_LD * 2;
static_assert(CH_END <= LDSCTL_OFF, "chain LDS");
__device__ __forceinline__ void chain_unit(Frame& F, int unit) {
    const int s = unit % NS, h = (unit / NS) & 7, b = unit / (NS * 8);
    int tid_ = F.tid; asm volatile("" : "+v"(tid_));
    const int tid = tid_, lane = tid & 63, w = F.wave, fr = lane & 15, fq = lane >> 4, tq = (lane & 15) >> 2, tp = lane & 3;
    LAS unsigned char* L = F.lds;
    const float lg2 = __log2f(1.0f - __builtin_amdgcn_exp2f(-5.0f - (float)h));
    const float gam = __builtin_amdgcn_exp2f(lg2), g127 = __builtin_amdgcn_exp2f(127.f * lg2);
    for (int i = tid; i < DVS * QI_LD * 2 / 16; i += 512) *(LAS v4u*)(L + RT_OFF + i * 16) = (v4u){0u, 0u, 0u, 0u};
    f32x4 Racc[4];
#pragma unroll
    for (int i = 0; i < 4; ++i) Racc[i] = (f32x4){0.f, 0.f, 0.f, 0.f};
    const int vt_r = w & 3, dg = w >> 2;
    const bf16* pbase = F.PROJ + ((size_t)b * 2048) * NIN;
    v4u sq[4], sk[4], sv[2];
#define CH_ISSUE(c) do { const bf16* pr_ = pbase + (size_t)((c) * 128) * NIN; \
        _Pragma("unroll") for (int i_ = 0; i_ < 4; ++i_) { const int ci = tid + 512 * i_, j = ci >> 4, ch = ci & 15; sq[i_] = *(const v4u*)(pr_ + (size_t)j * NIN + C_Q + h * 128 + 8 * ch); sk[i_] = *(const v4u*)(pr_ + (size_t)j * NIN + C_K + h * 128 + 8 * ch); } \
        _Pragma("unroll") for (int i_ = 0; i_ < 2; ++i_) { const int ci = tid + 512 * i_, j = ci >> 3, ch = ci & 7; sv[i_] = *(const v4u*)(pr_ + (size_t)j * NIN + C_V + h * DVH + s * DVS + 8 * ch); } } while (0)
#define CH_WRITE() do { \
        _Pragma("unroll") for (int i_ = 0; i_ < 4; ++i_) { const int ci = tid + 512 * i_, j = ci >> 4, ch = ci & 15; *(LAS v4u*)(L + QI_OFF + (j * QI_LD + 8 * ch) * 2) = sq[i_]; *(LAS v4u*)(L + KI_OFF + (j * QI_LD + 8 * ch) * 2) = sk[i_]; } \
        _Pragma("unroll") for (int i_ = 0; i_ < 2; ++i_) { const int ci = tid + 512 * i_, j = ci >> 3, ch = ci & 7; *(LAS v4u*)(L + VI_OFF + (j * VI_LD + 8 * ch) * 2) = sv[i_]; } } while (0)
    CH_ISSUE(0);
#pragma unroll 1
    for (int c = 0; c < 16; ++c) {
        const size_t mrow0 = (size_t)b * 2048 + c * 128;
        CH_WRITE();
        __syncthreads();
        if (c + 1 < 16) CH_ISSUE(c + 1);
        {
            bf16x8 afr[4];
#pragma unroll
            for (int kk = 0; kk < 4; ++kk) afr[kk] = *(const LAS bf16x8*)(L + QI_OFF + ((16 * w + fr) * QI_LD + 32 * kk + 8 * fq) * 2);
            f32x4 oacc[4];
#pragma unroll
            for (int vt = 0; vt < 4; ++vt) {
                f32x4 acc = (f32x4){0.f, 0.f, 0.f, 0.f};
#pragma unroll
                for (int kk = 0; kk < 4; ++kk) { const bf16x8 rf = *(const LAS bf16x8*)(L + RT_OFF + ((16 * vt + fr) * QI_LD + 32 * kk + 8 * fq) * 2); acc = MFMA16(rf, afr[kk], acc); }
                oacc[vt] = acc * gam;
            }
            const int i_ = 16 * w + fr, nkk = (w >> 1) + 1;
#pragma unroll 1
            for (int kk = 0; kk < nkk; ++kk) {
                f32x4 s0 = (f32x4){0.f, 0.f, 0.f, 0.f}, s1 = s0;
                const LAS unsigned char* kb = L + KI_OFF + ((32 * kk + fr) * QI_LD + 8 * fq) * 2;
#pragma unroll
                for (int k2 = 0; k2 < 4; ++k2) {
                    const bf16x8 kf0 = *(const LAS bf16x8*)(kb + 64 * k2), kf1 = *(const LAS bf16x8*)(kb + 16 * QI_LD * 2 + 64 * k2);
                    s0 = MFMA16(kf0, afr[k2], s0); s1 = MFMA16(kf1, afr[k2], s1);
                }
                float pv[8];
#pragma unroll
                for (int e = 0; e < 4; ++e) { const int dd0 = i_ - (32 * kk + 4 * fq + e); pv[e] = dd0 >= 0 ? s0[e] : 0.f; pv[4 + e] = dd0 >= 16 ? s1[e] : 0.f; }
                const bf16x8 pf = as_bf16x8(pack8(pv));
                const LAS unsigned char* vb = L + VI_OFF + ((32 * kk + 4 * fq + tq) * VI_LD + 4 * tp) * 2;
#pragma unroll
                for (int vt = 0; vt < 4; ++vt) oacc[vt] = MFMA16(tr16x2(vb + 32 * vt, vb + 16 * VI_LD * 2 + 32 * vt), pf, oacc[vt]);
            }
            bf16* orow = F.OB + (mrow0 + 16 * w + fr) * D + h * DVH + s * DVS + 4 * fq;
#pragma unroll
            for (int vt = 0; vt < 4; ++vt) *(v2u*)(orow + 16 * vt) = pack4(oacc[vt]);
        }
#pragma unroll
        for (int di = 0; di < 4; ++di) {
            const int dt = dg * 4 + di;
            f32x4 acc = Racc[di] * gam;
#pragma unroll
            for (int kk = 0; kk < 4; ++kk) {
                const LAS unsigned char* ka = L + KI_OFF + ((32 * kk + 8 * fq + tq) * QI_LD + 16 * dt + 4 * tp) * 2;
                const LAS unsigned char* va = L + VI_OFF + ((32 * kk + 8 * fq + tq) * VI_LD + 16 * vt_r + 4 * tp) * 2;
                acc = MFMA16(tr16x2(ka, ka + 4 * QI_LD * 2), tr16x2(va, va + 4 * VI_LD * 2), acc);
            }
            Racc[di] = acc * g127;
        }
        __syncthreads();
#pragma unroll
        for (int di = 0; di < 4; ++di) { const int dt = dg * 4 + di; *(LAS v2u*)(L + RT_OFF + ((16 * vt_r + fr) * QI_LD + 16 * dt + 4 * fq) * 2) = pack4(Racc[di]); }
    }
#undef CH_ISSUE
#undef CH_WRITE
    float* ro = F.out + O_RETP + ((size_t)(b * 8 + h) * 128) * DVH + s * DVS + 16 * vt_r + fr;
#pragma unroll
    for (int di = 0; di < 4; ++di) { const int dt = dg * 4 + di;
#pragma unroll
        for (int r = 0; r < 4; ++r) ro[(size_t)unperm_d(16 * dt + 4 * fq + r) * DVH] = Racc[di][r]; }
}

constexpr int SQ_OFF = 0, SKZ_OFF = 4096, SK_OFF = 8192, SV_OFF = 12288, SS_OFF = 20480, SRED_OFF = 24576;
__device__ __forceinline__ void sample_unit(Frame& F, int unit) {
    const int h = unit & 7, b = unit >> 3;
    int tid_ = F.tid; asm volatile("" : "+v"(tid_));
    const int tid = tid_, lane = tid & 63, w = F.wave;
    LAS unsigned char* L = F.lds;
    LAS float* qT = (LAS float*)(L + SQ_OFF); LAS float* kzT = (LAS float*)(L + SKZ_OFF); LAS float* kS = (LAS float*)(L + SK_OFF);
    LAS float* vs = (LAS float*)(L + SV_OFF); LAS float* ss = (LAS float*)(L + SS_OFF); LAS float* red = (LAS float*)(L + SRED_OFF);
    const float lg2 = __log2f(1.0f - __builtin_amdgcn_exp2f(-5.0f - (float)h));
    const float gam = __builtin_amdgcn_exp2f(lg2), g7 = __builtin_amdgcn_exp2f(7.f * lg2), g8c = __builtin_amdgcn_exp2f(8.f * lg2);
    const size_t mrow0 = (size_t)MP + (size_t)b * 8;
    const float* Rin = F.state_ret + ((size_t)(b * 8 + h) * 128) * DVH + 4 * lane;
    float* Rout = F.out + O_RETS + ((size_t)(b * 8 + h) * 128) * DVH + 4 * lane;
    f32x4 r0[16];
#pragma unroll
    for (int dd = 0; dd < 16; ++dd) r0[dd] = __builtin_nontemporal_load((const f32x4*)(Rin + (size_t)(16 * w + dd) * DVH));
    if (tid < 256) {
        const int qk = tid >> 7, it = tid & 127, i = it >> 4, ch = it & 15;
        float f[8]; unpack8(*(const v4u*)(F.PROJ + (mrow0 + i) * NIN + (qk ? C_K : C_Q) + h * 128 + 8 * ch), f);
#pragma unroll
        for (int e = 0; e < 8; ++e) { const int d = e < 4 ? 4 * ch + e : 64 + 4 * ch + (e - 4);
            if (qk == 0) qT[d * 8 + i] = f[e]; else { kS[i * 128 + d] = f[e]; kzT[d * 8 + i] = f[e] * g7; } }
    } else {
        const int it = tid - 256, j = it >> 5, g = it & 31;
        float f[8]; unpack8(*(const v4u*)(F.PROJ + (mrow0 + j) * NIN + C_V + h * DVH + 8 * g), f);
#pragma unroll
        for (int e = 0; e < 8; ++e) vs[j * 256 + 8 * g + e] = f[e];
    }
    __syncthreads();
    {
        const int pr = tid >> 3, part = tid & 7, i = pr >> 3, j = pr & 7; float dot = 0.f;
#pragma unroll
        for (int dd = 0; dd < 16; ++dd) { const int d = 16 * part + dd; dot += qT[d * 8 + i] * kS[j * 128 + d]; }
        dot += __shfl_xor(dot, 1); dot += __shfl_xor(dot, 2); dot += __shfl_xor(dot, 4);
        if (part == 0) ss[i * 8 + j] = (i >= j) ? dot : 0.f;
    }
    {
        f32x4 vreg[8], oacc[8];
#pragma unroll
        for (int j = 0; j < 8; ++j) { vreg[j] = *(const LAS f32x4*)(vs + j * 256 + 4 * lane); oacc[j] = (f32x4){0.f, 0.f, 0.f, 0.f}; }
#pragma unroll
        for (int dd = 0; dd < 16; ++dd) {
            const int d = 16 * w + dd;
            const f32x4 qa = *(const LAS f32x4*)(qT + d * 8), qb = *(const LAS f32x4*)(qT + d * 8 + 4), ka = *(const LAS f32x4*)(kzT + d * 8), kb = *(const LAS f32x4*)(kzT + d * 8 + 4);
            f32x4 rn = r0[dd] * g8c;
            rn += ka.x * vreg[0]; rn += ka.y * vreg[1]; rn += ka.z * vreg[2]; rn += ka.w * vreg[3]; rn += kb.x * vreg[4]; rn += kb.y * vreg[5]; rn += kb.z * vreg[6]; rn += kb.w * vreg[7];
            __builtin_nontemporal_store(rn, (f32x4*)(Rout + (size_t)d * DVH));
            oacc[0] += qa.x * r0[dd]; oacc[1] += qa.y * r0[dd]; oacc[2] += qa.z * r0[dd]; oacc[3] += qa.w * r0[dd];
            oacc[4] += qb.x * r0[dd]; oacc[5] += qb.y * r0[dd]; oacc[6] += qb.z * r0[dd]; oacc[7] += qb.w * r0[dd];
        }
#pragma unroll
        for (int i = 0; i < 8; ++i) *(LAS f32x4*)(red + (w * 8 + i) * 256 + 4 * lane) = oacc[i];
    }
    __syncthreads();
    {
        const int i = tid >> 6, l = tid & 63;
        f32x4 tot = (f32x4){0.f, 0.f, 0.f, 0.f};
#pragma unroll
        for (int ww = 0; ww < 8; ++ww) tot += *(const LAS f32x4*)(red + (ww * 8 + i) * 256 + 4 * l);
        tot = tot * gam;
#pragma unroll
        for (int j = 0; j < 8; ++j) tot += ss[i * 8 + j] * *(const LAS f32x4*)(vs + j * 256 + 4 * l);
        *(v2u*)(F.OB + (mrow0 + i) * D + h * DVH + 4 * l) = pack4(tot);
    }
}

constexpr int Z_LD = 264;
template <int W, int IB> __device__ __forceinline__ void pool_z(Frame& F, int g, int m0, int tid) {
    LAS unsigned char* L = F.lds;
#pragma unroll 1
    for (int it0 = tid; it0 < 4096; it0 += 512 * IB) {
        v4u raw[IB][W]; bool ok[IB][W];
#pragma unroll
        for (int ib = 0; ib < IB; ++ib) {
            const int it = it0 + 512 * ib, j = it >> 5, c8 = it & 31, m = m0 + j, col = C_POOL + 256 * g + 8 * c8;
#pragma unroll
            for (int k = 0; k < W; ++k) {
                const bf16* p;
                if (m < MP) { const int t = m & 2047; ok[ib][k] = t - k >= 0; p = F.PROJ + (size_t)(ok[ib][k] ? m - k : m) * NIN + col; }
                else { const int ms = m - MP, bb = ms >> 3, i = ms & 7, ee = 15 + i - k; ok[ib][k] = true;
                    const bf16* p1 = F.PROJ + (size_t)(MP + bb * 8 + (ee >= 15 ? ee - 15 : 0)) * NIN + col; const bf16* p2 = F.SP16 + ((size_t)bb * 15 + (ee < 15 ? ee : 0)) * 1024 + 256 * g + 8 * c8;
                    p = ee >= 15 ? p1 : p2; }
                raw[ib][k] = *(const v4u*)p;
            }
        }
#pragma unroll
        for (int ib = 0; ib < IB; ++ib) {
            const int it = it0 + 512 * ib, j = it >> 5, c8 = it & 31, m = m0 + j;
            float sum[8], cur[8], f[8];
            unpack8(raw[ib][0], cur);
#pragma unroll
            for (int e = 0; e < 8; ++e) sum[e] = cur[e];
#pragma unroll
            for (int k = 1; k < W; ++k) { unpack8(raw[ib][k], f);
#pragma unroll
                for (int e = 0; e < 8; ++e) sum[e] += ok[ib][k] ? f[e] : 0.f; }
            int cn = W; if (m < MP) { const int t = m & 2047; cn = W < t + 1 ? W : t + 1; }
            const float ic = 1.0f / (float)cn;
#pragma unroll
            for (int e = 0; e < 8; ++e) f[e] = sum[e] * ic - cur[e];
            *(LAS v4u*)(L + (j * Z_LD + 8 * c8) * 2) = pack8(f);
        }
    }
}
__device__ __forceinline__ void pool_unit(Frame& F, int unit) {
    const int g = unit & 3, tile = unit >> 2, m0 = tile * 128;
    int tid_ = F.tid; asm volatile("" : "+v"(tid_));
    const int tid = tid_, lane = tid & 63, w = F.wave, fr = lane & 15, fq = lane >> 4;
    LAS unsigned char* L = F.lds;
    bf16x8 bfr[4][8];
    {
        const bf16* wt = F.WPOOL + ((size_t)g * 512 + 64 * w + fr) * 256 + 8 * fq;
#pragma unroll
        for (int et = 0; et < 4; ++et)
#pragma unroll
            for (int kk = 0; kk < 8; ++kk) bfr[et][kk] = *(const bf16x8*)(wt + (size_t)(16 * et) * 256 + 32 * kk);
    }
    if (m0 >= MP) {
        if (g == 0) pool_z<2, 4>(F, g, m0, tid); else if (g == 1) pool_z<4, 4>(F, g, m0, tid); else if (g == 2) pool_z<8, 2>(F, g, m0, tid); else pool_z<16, 1>(F, g, m0, tid);
    } else {
        constexpr int UT_OFF = 128 * Z_LD * 2;
        static_assert(UT_OFF + 143 * Z_LD * 2 <= LDSCTL_OFF, "pool LDS");
        const bool seq0 = (m0 & 2047) == 0;
        const bf16* src = F.PROJ + (size_t)(m0 - 15) * NIN + C_POOL + 256 * g;
#pragma unroll
        for (int i = 0; i < 9; ++i) { const int ci = tid + 512 * i;
            if (ci < 143 * 32) { const int rw = ci >> 5, c8 = ci & 31; v4u v = (v4u){0u, 0u, 0u, 0u}; if (!(seq0 && rw < 15)) v = *(const v4u*)(src + (size_t)rw * NIN + 8 * c8);
                *(LAS v4u*)(L + UT_OFF + (rw * Z_LD + 8 * c8) * 2) = v; } }
        __syncthreads();
        const int W = 2 << g, c8 = tid & 31, j0 = (tid >> 5) * 8;
        const LAS unsigned char* up = L + UT_OFF + ((15 + j0) * Z_LD + 8 * c8) * 2;
        float sum[8], f[8], cur[8];
#pragma unroll
        for (int e = 0; e < 8; ++e) sum[e] = 0.f;
        for (int k = 1; k < W; ++k) { unpack8(*(const LAS v4u*)(up - k * Z_LD * 2), f);
#pragma unroll
            for (int e = 0; e < 8; ++e) sum[e] += f[e]; }
        const int t0 = (m0 & 2047) + j0;
#pragma unroll
        for (int j = 0; j < 8; ++j) {
            unpack8(*(const LAS v4u*)(up + j * Z_LD * 2), cur);
#pragma unroll
            for (int e = 0; e < 8; ++e) sum[e] += cur[e];
            const int t = t0 + j; const float ic = 1.0f / (float)(W < t + 1 ? W : t + 1);
#pragma unroll
            for (int e = 0; e < 8; ++e) f[e] = sum[e] * ic - cur[e];
            *(LAS v4u*)(L + ((j0 + j) * Z_LD + 8 * c8) * 2) = pack8(f);
            unpack8(*(const LAS v4u*)(up + (j + 1 - W) * Z_LD * 2), f);
#pragma unroll
            for (int e = 0; e < 8; ++e) sum[e] -= f[e];
        }
    }
    __syncthreads();
    f32x4 sc[4];
#pragma unroll
    for (int et = 0; et < 4; ++et) sc[et] = *(const f32x4*)(F.pool_scale + 512 * g + 64 * w + 16 * et + 4 * fq);
#pragma unroll 1
    for (int rt = 0; rt < 8; ++rt) {
        bf16x8 afr[8];
#pragma unroll
        for (int kk = 0; kk < 8; ++kk) afr[kk] = *(const LAS bf16x8*)(L + ((16 * rt + fr) * Z_LD + 32 * kk + 8 * fq) * 2);
        bf16* orow = F.AP + (size_t)(m0 + 16 * rt + fr) * D + 512 * g + 64 * w + 4 * fq;
#pragma unroll
        for (int et = 0; et < 4; ++et) {
            f32x4 acc = (f32x4){0.f, 0.f, 0.f, 0.f};
#pragma unroll
            for (int kk = 0; kk < 8; ++kk) acc = MFMA16(bfr[et][kk], afr[kk], acc);
            *(v2u*)(orow + 16 * et) = pack4(acc * sc[et]);
        }
    }
}
constexpr int N_CHAIN = 4 * 8 * NS, N_POOLU = (M / 128) * 4, N_SAMP = 128 * 8, N_P2 = N_CHAIN + N_POOLU + N_SAMP;
__device__ __forceinline__ void p2_mixers(Frame& F, int rep) {
    const int mode = rep >> 4, lo = mode == 2 ? N_CHAIN : (mode == 3 ? N_CHAIN + N_POOLU : 0), hi = mode == 1 ? N_CHAIN : (mode == 2 ? N_CHAIN + N_POOLU : N_P2);
    for (;;) {
        __syncthreads();
        if (F.tid == 0) F.MISC[0] = __hip_atomic_fetch_add(F.ctl + CW_Q2 + 64 * (rep & 15), 1u, RLX_AGENT);
        __syncthreads();
        const int u = (int)F.MISC[0] + lo;
        if (u >= hi) break;
        if (u < N_CHAIN) chain_unit(F, u);
        else if (u < N_CHAIN + N_POOLU) pool_unit(F, u - N_CHAIN);
        else sample_unit(F, u - N_CHAIN - N_POOLU);
    }
}

__device__ __forceinline__ float half_sum(float v) {
#pragma unroll
    for (int o = 1; o < 32; o <<= 1) v += __shfl_xor(v, o);
    return v;
}
__device__ __forceinline__ void p3_merge(Frame& F) {
    const int lane = F.lane, hl = lane >> 5, l32 = lane & 31;
    constexpr int NIT = M * 4;
    for (int it0 = 2 * F.gw; it0 < NIT; it0 += 2 * F.NGW) {
        v4u ov[2], gv[2], av[2], rv[2], pv[2]; int cc[2]; size_t mm[2];
#pragma unroll
        for (int u = 0; u < 2; ++u) {
            const int it = it0 + u, m = it >> 2, hp = it & 3, c = (2 * hp + hl) * DVH + 8 * l32; cc[u] = c; mm[u] = (size_t)m;
            const bf16* prow = F.PROJ + (size_t)m * NIN + c;
            ov[u] = __builtin_nontemporal_load((const v4u*)(F.OB + (size_t)m * D + c)); gv[u] = __builtin_nontemporal_load((const v4u*)(prow + C_GRET)); av[u] = __builtin_nontemporal_load((const v4u*)(prow + C_GA)); rv[u] = __builtin_nontemporal_load((const v4u*)(prow + C_GR)); pv[u] = __builtin_nontemporal_load((const v4u*)(F.AP + (size_t)m * D + c));
        }
#pragma unroll
        for (int u = 0; u < 2; ++u) {
            float o[8], g[8], ga[8], gr[8], ap[8], res[8];
            unpack8(ov[u], o); unpack8(gv[u], g); unpack8(av[u], ga); unpack8(rv[u], gr); unpack8(pv[u], ap);
            const f32x4 gn0 = *(const f32x4*)(F.gn_gain + cc[u]), gn1 = *(const f32x4*)(F.gn_gain + cc[u] + 4);
            const float gn[8] = {gn0.x, gn0.y, gn0.z, gn0.w, gn1.x, gn1.y, gn1.z, gn1.w};
            float sm = 0.f;
#pragma unroll
            for (int e = 0; e < 8; ++e) sm += o[e];
            const float mean = half_sum(sm) * (1.f / 256.f);
            float sq = 0.f;
#pragma unroll
            for (int e = 0; e < 8; ++e) { o[e] -= mean; sq += o[e] * o[e]; }
            const float rstd = 1.0f / sqrtf(half_sum(sq) * (1.f / 256.f) + EPS);
#pragma unroll
            for (int e = 0; e < 8; ++e) { const float r = g[e] * sigmoidf_(g[e]) * (o[e] * rstd * gn[e]); res[e] = sigmoidf_(ga[e]) * ap[e] + sigmoidf_(gr[e]) * r; }
            *(v4u*)(F.MM + mm[u] * D + cc[u]) = pack8(res);
        }
    }
    const int gt = blockIdx.x * 512 + F.tid, NT = F.G * 512;
    for (int idx = gt; idx < 4 * 15 * 1024; idx += NT) { const int c = idx & 1023, r = (idx >> 10) % 15, b = idx / (15 * 1024);
        F.out[O_POOLP + idx] = __uint_as_float((unsigned)F.PROJ[(size_t)(b * 2048 + 2033 + r) * NIN + C_POOL + c] << 16); }
    for (int idx = gt; idx < 128 * 15 * 1024; idx += NT) { const int c = idx & 1023, r = (idx >> 10) % 15, b = idx / (15 * 1024); const int e = 8 + r;
        F.out[O_POOLS + idx] = e < 15 ? F.state_pool[((size_t)b * 15 + e) * 1024 + c] : __uint_as_float((unsigned)F.PROJ[(size_t)(MP + b * 8 + e - 15) * NIN + C_POOL + c] << 16); }
}

__device__ __forceinline__ void p5_rows(Frame& F) {
    const int lane = F.lane;
    for (int m = F.gw; m < M; m += F.NGW) {
        const v4u* mo = (const v4u*)(F.MOB + (size_t)m * D) + lane; const f32x4* xr = (const f32x4*)xrow(F, m) + 2 * lane;
        const f32x4* g1 = (const f32x4*)F.g_post_mix + 2 * lane; const f32x4* g2 = (const f32x4*)F.g_pre_ffn + 2 * lane;
        v4u mv[4]; f32x4 x[4][2]; float v[4][8]; float s = 0.f;
#pragma unroll
        for (int j = 0; j < 4; ++j) { mv[j] = __builtin_nontemporal_load(mo + 64 * j); x[j][0] = __builtin_nontemporal_load(xr + 128 * j); x[j][1] = __builtin_nontemporal_load(xr + 128 * j + 1); }
#pragma unroll
        for (int j = 0; j < 4; ++j) { unpack8(mv[j], v[j]);
#pragma unroll
            for (int e = 0; e < 8; ++e) s += v[j][e] * v[j][e]; }
        const float rs = 1.0f / sqrtf(wave_sum(s) * (1.f / D) + EPS);
        float s2 = 0.f; v4u* yo = (v4u*)(F.X1B + (size_t)m * D) + lane;
#pragma unroll
        for (int j = 0; j < 4; ++j) {
            const f32x4 ga = g1[128 * j], gb = g1[128 * j + 1];
            x[j][0] = x[j][0] + (f32x4){v[j][0], v[j][1], v[j][2], v[j][3]} * rs * ga; x[j][1] = x[j][1] + (f32x4){v[j][4], v[j][5], v[j][6], v[j][7]} * rs * gb;
            { v4u o; o.x = pk2(x[j][0].x, x[j][0].y); o.y = pk2(x[j][0].z, x[j][0].w); o.z = pk2(x[j][1].x, x[j][1].y); o.w = pk2(x[j][1].z, x[j][1].w); yo[64 * j] = o; }
            s2 += (x[j][0].x * x[j][0].x + x[j][0].y * x[j][0].y) + (x[j][0].z * x[j][0].z + x[j][0].w * x[j][0].w) + (x[j][1].x * x[j][1].x + x[j][1].y * x[j][1].y) + (x[j][1].z * x[j][1].z + x[j][1].w * x[j][1].w);
        }
        const float rs2 = 1.0f / sqrtf(wave_sum(s2) * (1.f / D) + EPS);
        v4u* o8 = (v4u*)(F.XN + (size_t)m * D) + lane;
#pragma unroll
        for (int j = 0; j < 4; ++j) { const f32x4 ga = g2[128 * j], gb = g2[128 * j + 1]; const f32x4 a = x[j][0] * rs2 * ga, b2 = x[j][1] * rs2 * gb;
            v4u o; o.x = pk2(a.x, a.y); o.y = pk2(a.z, a.w); o.z = pk2(b2.x, b2.y); o.w = pk2(b2.z, b2.w); o8[64 * j] = o; }
    }
}
__device__ __forceinline__ void p9_rows(Frame& F, float* dst) {
    const int lane = F.lane;
    for (int m = F.gw; m < M; m += F.NGW) {
        const v4u* fo = (const v4u*)(F.MOB + (size_t)m * D) + lane; const v4u* yi = (const v4u*)(F.X1B + (size_t)m * D) + lane; f32x4* yo = (f32x4*)(dst + (size_t)m * D) + 2 * lane;
        const f32x4* g1 = (const f32x4*)F.g_post_ffn + 2 * lane;
        v4u mv[4]; f32x4 x[4][2]; float v[4][8]; float s = 0.f;
#pragma unroll
        for (int j = 0; j < 4; ++j) { mv[j] = __builtin_nontemporal_load(fo + 64 * j); const v4u xb = __builtin_nontemporal_load(yi + 64 * j); x[j][0] = (f32x4){bflo(xb.x), bfhi(xb.x), bflo(xb.y), bfhi(xb.y)}; x[j][1] = (f32x4){bflo(xb.z), bfhi(xb.z), bflo(xb.w), bfhi(xb.w)}; }
#pragma unroll
        for (int j = 0; j < 4; ++j) { unpack8(mv[j], v[j]);
#pragma unroll
            for (int e = 0; e < 8; ++e) s += v[j][e] * v[j][e]; }
        const float rs = 1.0f / sqrtf(wave_sum(s) * (1.f / D) + EPS);
#pragma unroll
        for (int j = 0; j < 4; ++j) { const f32x4 ga = g1[128 * j], gb = g1[128 * j + 1];
            __builtin_nontemporal_store(x[j][0] + (f32x4){v[j][0], v[j][1], v[j][2], v[j][3]} * rs * ga, yo + 128 * j); __builtin_nontemporal_store(x[j][1] + (f32x4){v[j][4], v[j][5], v[j][6], v[j][7]} * rs * gb, yo + 128 * j + 1); }
    }
}

__device__ __forceinline__ float gelu_tanh(float g) { const float y2 = 1.5957691216057308f * (g + 0.044715f * g * g * g); return g * __builtin_amdgcn_rcpf(1.0f + __expf(-y2)); }
__device__ __forceinline__ void ld8f(const float* p, float (&o)[8]) { const f32x4 a = *(const f32x4*)p, b = *(const f32x4*)(p + 4); o[0] = a.x; o[1] = a.y; o[2] = a.z; o[3] = a.w; o[4] = b.x; o[5] = b.y; o[6] = b.z; o[7] = b.w; }
__device__ __forceinline__ void p7_conv(Frame& F) {
    constexpr int NCG = FF / 8, NRB = M / 8, NIT = NRB * NCG;
    const int gt = blockIdx.x * 512 + F.tid, NT = F.G * 512;
    v4u rawv[10], rawg[10];
#define P7_LOAD(dv, dg, it_) do { const int rb_ = (it_) / NCG, f0_ = 8 * ((it_) - rb_ * NCG), m0_ = rb_ * 8; const bool z_ = (m0_ >= MP) || ((m0_ & 2047) == 0); \
        _Pragma("unroll") for (int r = 0; r < 10; ++r) { const int rr = (r < 2 && z_) ? 2 : r; const bf16* ur = F.UP + (size_t)(m0_ + rr - 2) * FF2; dv[r] = *(const v4u*)(ur + f0_); dg[r] = *(const v4u*)(ur + FF + f0_); } } while (0)
#pragma unroll 1
    for (int it = gt; it < NIT; it += NT) {
        const int rb = it / NCG, cg = it - rb * NCG, f0 = 8 * cg, m0 = rb * 8;
        const bool is_p = m0 < MP; const int t0 = is_p ? (m0 & 2047) : 0; const int sb = is_p ? 0 : (m0 - MP) >> 3;
        P7_LOAD(rawv, rawg, it);
        float hv[3][8], hg[3][8];
#pragma unroll
        for (int r = 0; r < 2; ++r) {
            if (t0 == 0) {
                if (is_p) {
#pragma unroll
                    for (int e = 0; e < 8; ++e) { hv[r + 1][e] = 0.f; hg[r + 1][e] = 0.f; }
                } else { const float* sc = F.state_conv + ((size_t)sb * 2 + r) * FF2; ld8f(sc + f0, hv[r + 1]); ld8f(sc + FF + f0, hg[r + 1]); }
            } else { unpack8(rawv[r], hv[r + 1]); unpack8(rawg[r], hg[r + 1]); }
        }
        float wv[3][8], wg[3][8], bv[8], bg[8];
#pragma unroll
        for (int j = 0; j < 3; ++j) { ld8f(F.conv_w + (size_t)j * FF2 + f0, wv[j]); ld8f(F.conv_w + (size_t)j * FF2 + FF + f0, wg[j]); }
        ld8f(F.conv_b + f0, bv); ld8f(F.conv_b + FF + f0, bg);
#pragma unroll
        for (int r = 0; r < 8; ++r) {
#pragma unroll
            for (int e = 0; e < 8; ++e) { hv[0][e] = hv[1][e]; hv[1][e] = hv[2][e]; hg[0][e] = hg[1][e]; hg[1][e] = hg[2][e]; }
            unpack8(rawv[r + 2], hv[2]); unpack8(rawg[r + 2], hg[2]);
            float a[8];
#pragma unroll
            for (int e = 0; e < 8; ++e) { const float val = bv[e] + wv[0][e] * hv[0][e] + wv[1][e] * hv[1][e] + wv[2][e] * hv[2][e], gate = bg[e] + wg[0][e] * hg[0][e] + wg[1][e] * hg[1][e] + wg[2][e] * hg[2][e]; a[e] = gelu_tanh(gate) * val; }
            *(v4u*)(F.ACT + (size_t)(m0 + r) * FF + f0) = pack8(a);
            if (r >= 6) {
                float* o = nullptr;
                if (is_p) { if (t0 == 2040) o = F.out + O_CONVP + ((size_t)(m0 >> 11) * 2 + (r - 6)) * FF2; } else o = F.out + O_CONVS + ((size_t)sb * 2 + (r - 6)) * FF2;
                if (o) { *(f32x4*)(o + f0) = (f32x4){hv[2][0], hv[2][1], hv[2][2], hv[2][3]}; *(f32x4*)(o + f0 + 4) = (f32x4){hv[2][4], hv[2][5], hv[2][6], hv[2][7]};
                    *(f32x4*)(o + FF + f0) = (f32x4){hg[2][0], hg[2][1], hg[2][2], hg[2][3]}; *(f32x4*)(o + FF + f0 + 4) = (f32x4){hg[2][4], hg[2][5], hg[2][6], hg[2][7]}; }
            }
        }
    }
#undef P7_LOAD
}

struct Args { const float* in[18]; float* out; unsigned char* ws; int ph_lo, ph_hi, li, pad; };
template <int LO, int HI> __global__ void __launch_bounds__(NWAVES * 64, 2) skel_fwd(Args args) {
    extern __shared__ __attribute__((aligned(16))) unsigned char lds[];
    Frame F;
    F.lds = (LAS unsigned char*)lds;
    F.MISC = (volatile LAS unsigned*)(F.lds + LDSCTL_OFF);
    F.tid = threadIdx.x; F.lane = F.tid & 63; F.wave = __builtin_amdgcn_readfirstlane(F.tid >> 6);
    F.G = gridDim.x; F.gw = blockIdx.x * NWAVES + F.wave; F.NGW = F.G * NWAVES;
    unsigned char* ws = args.ws;
    F.ctl = (unsigned*)(ws + WS_CTL);
    F.xp = args.in[0]; F.xs = args.in[1]; F.state_pool = args.in[2]; F.state_ret = args.in[3]; F.state_conv = args.in[4]; F.g_pre_mix = args.in[5]; F.w_in = args.in[6]; F.w_pool = args.in[7];
    F.pool_scale = args.in[8]; F.gn_gain = args.in[9]; F.w_out = args.in[10]; F.g_post_mix = args.in[11]; F.g_pre_ffn = args.in[12]; F.w_up = args.in[13]; F.conv_w = args.in[14]; F.conv_b = args.in[15];
    F.w_down = args.in[16]; F.g_post_ffn = args.in[17]; F.out = args.out;
    F.WIN = (bf16*)(ws + WS_WIN); F.WUP = (bf16*)(ws + WS_WUP); F.WDN = (bf16*)(ws + WS_WDN); F.WOUT = (bf16*)(ws + WS_WOUT); F.WPOOL = (bf16*)(ws + WS_WPOOL);
    F.ROPE_C = (float*)(ws + WS_ROPE); F.ROPE_S = F.ROPE_C + 2056 * 64;
    F.XN = (bf16*)(ws + WS_XN); F.PROJ = (bf16*)(ws + WS_PROJ); F.UP = (bf16*)(ws + WS_PROJ); F.MOB = (bf16*)(ws + WS_PROJ);
    F.SP16 = (bf16*)(ws + WS_SP16); F.X1B = (bf16*)(ws + WS_X1);
    F.OB = (bf16*)(ws + WS_O); F.AP = (bf16*)(ws + WS_AP); F.MM = (bf16*)(ws + WS_MM); F.ACT = (bf16*)(ws + WS_O);
    for (int u = F.tid; u < (LDS_BYTES - LDSCTL_OFF) / 4; u += NWAVES * 64) ((LAS unsigned*)(F.lds + LDSCTL_OFF))[u] = 0u;
    __syncthreads();
    XcdBarrier bar; bar.bar = F.ctl + CW_BAR; bar.x = 0; bar.st = nullptr;
    if (N_LAUNCHES == 1) bar = xcd_barrier_post(F.ctl + CW_BAR, F.MISC + 8);
#define GRID_BAR() do { if (N_LAUNCHES == 1) xcd_barrier(bar); } while (0)
#define IN(k) (LO <= (k) && (k) < HI)
#define FRESH() do { int t_ = threadIdx.x; asm volatile("" : "+v"(t_)); F.tid = t_; F.lane = t_ & 63; } while (0)
#define SEAM(k) do { if constexpr (IN(k) && IN((k) + 1)) GRID_BAR(); } while (0)

#define REPS(k)
#define DUPBAR(k)
    const int rep = args.li;
    if constexpr (IN(0)) { FRESH(); REPS(0) { p0_prologue(F); DUPBAR(0); } SEAM(0); }
    if constexpr (IN(1)) {
      REPS(1) {
        pg8::Gemm g{F.XN, F.WIN, M, NIN, D}; pg8::HybridOrder S; S.init(M, NIN, D, F.G, (int)blockIdx.x, false);
        EpiProj E{F.PROJ, F.ROPE_C, F.ROPE_S}; pg8::SplitCtx X{(float*)(ws + WS_SLAB_A), F.ctl + CW_SPLIT};
        pg8::gemm_phase<EpiProj, pg8::HybridOrder, true, PG8_SP2, 5>(F.lds, g, S, E, X);
        if (rep == 0) { FRESH(); p0_deferred_weights(F, (LAS float*)(F.lds + F.wave * 16384)); }
        DUPBAR(1);
      }
        SEAM(1);
    }
    if constexpr (IN(2)) { FRESH(); REPS(2) { p2_mixers(F, rep); DUPBAR(2); } SEAM(2); }
    if constexpr (IN(3)) { FRESH(); REPS(3) { p3_merge(F); DUPBAR(3); } SEAM(3); }
    if constexpr (IN(4)) {
      REPS(4) {
        pg8::Gemm g{F.MM, F.WOUT, M, D, D}; pg8::HybridOrder S; S.init(M, D, D, F.G, (int)blockIdx.x);
        pg8::EpiBf16<0> E{F.MOB, D}; pg8::SplitCtx X{(float*)(ws + WS_SLAB_A), F.ctl + CW_SPLIT + 4096};
        pg8::gemm_phase<pg8::EpiBf16<0>, pg8::HybridOrder, true, PG8_SP2, 8>(F.lds, g, S, E, X);
        DUPBAR(4);
      }
        SEAM(4);
    }
    if constexpr (IN(5)) { FRESH(); REPS(5) { p5_rows(F); DUPBAR(5); } SEAM(5); }
    if constexpr (IN(6)) {
      REPS(6) {
        pg8::Gemm g{F.XN, F.WUP, M, FF2, D}; pg8::HybridOrder S; S.init(M, FF2, D, F.G, (int)blockIdx.x);
        pg8::EpiBf16<0> E{F.UP, FF2}; pg8::SplitCtx X{(float*)(ws + WS_SLAB_A), F.ctl + CW_SPLIT + 2 * 4096};
        pg8::gemm_phase<pg8::EpiBf16<0>, pg8::HybridOrder, true, PG8_SP2, 5>(F.lds, g, S, E, X);
        DUPBAR(6);
      }
        SEAM(6);
    }
    if constexpr (IN(7)) { FRESH(); REPS(7) { p7_conv(F); DUPBAR(7); } SEAM(7); }
    if constexpr (IN(8)) {
      REPS(8) {
        pg8::Gemm g{F.ACT, F.WDN, M, D, FF}; pg8::HybridOrder S; S.init(M, D, FF, F.G, (int)blockIdx.x);
        pg8::EpiBf16<0> E{F.MOB, D}; pg8::SplitCtx X{(float*)(ws + WS_SLAB_B), F.ctl + CW_SPLIT + 3 * 4096};
        pg8::gemm_phase<pg8::EpiBf16<0>, pg8::HybridOrder, true, PG8_SP2, 8>(F.lds, g, S, E, X);
        DUPBAR(8);
      }
        SEAM(8);
    }
    if constexpr (IN(9)) { FRESH(); p9_rows(F, (DUP_PHASE == 9 && rep == 1) ? (float*)(ws + WS_O) : F.out + O_Y); }
#undef IN
#undef SEAM
}


#if MK_N_LAUNCHES != 1
template <int P> static void launch_one(int grid, const Args& a, hipStream_t stream) { hipLaunchKernelGGL((skel_fwd<P, P + 1>), dim3(grid), dim3(NWAVES * 64), LDS_BYTES, stream, a); }
static void launch_phase(int li, int grid, const Args& a, hipStream_t stream) {
    switch (li) { case 0: launch_one<0>(grid, a, stream); break; case 1: launch_one<1>(grid, a, stream); break; case 2: launch_one<2>(grid, a, stream); break; case 3: launch_one<3>(grid, a, stream); break;
        case 4: launch_one<4>(grid, a, stream); break; case 5: launch_one<5>(grid, a, stream); break; case 6: launch_one<6>(grid, a, stream); break; case 7: launch_one<7>(grid, a, stream); break;
        case 8: launch_one<8>(grid, a, stream); break; default: launch_one<9>(grid, a, stream); break; }
}
#endif
static hipError_t set_lds_attr() {
    hipError_t e = hipSuccess;
#if MK_N_LAUNCHES == 1
    e = hipFuncSetAttribute((const void*)skel_fwd<0, N_PHASES>, hipFuncAttributeMaxDynamicSharedMemorySize, LDS_BYTES);
#else
#define SET1(P) if (e == hipSuccess) e = hipFuncSetAttribute((const void*)skel_fwd<P, P + 1>, hipFuncAttributeMaxDynamicSharedMemorySize, LDS_BYTES)
    SET1(0); SET1(1); SET1(2); SET1(3); SET1(4); SET1(5); SET1(6); SET1(7); SET1(8); SET1(9);
#undef SET1
#endif
    return e;
}
static hipError_t occ_query(int* per_cu) {
#if MK_N_LAUNCHES == 1
    return hipOccupancyMaxActiveBlocksPerMultiprocessor(per_cu, (const void*)skel_fwd<0, N_PHASES>, NWAVES * 64, LDS_BYTES);
#else
    return hipOccupancyMaxActiveBlocksPerMultiprocessor(per_cu, (const void*)skel_fwd<1, 2>, NWAVES * 64, LDS_BYTES);
#endif
}
extern "C" void kernel_launch(void* const* d_in, const int* in_sizes, int n_in, void* d_out, int out_size, void* d_ws, size_t ws_size, hipStream_t stream) {
    static int grid = 0;
    if (grid == 0) {
        if (n_in != 18 || (size_t)out_size != O_END || ws_size < WS_END) { fprintf(stderr, "kernel_launch: unexpected shapes: n_in %d out %d ws %zu (need %zu)\n", n_in, out_size, ws_size, (size_t)WS_END); grid = -1; return; }
        int dev = 0, cus = 0, per_cu = 0;
        if (hipGetDevice(&dev) != hipSuccess || hipDeviceGetAttribute(&cus, hipDeviceAttributeMultiprocessorCount, dev) != hipSuccess) { grid = -1; return; }
        if (set_lds_attr() != hipSuccess) { fprintf(stderr, "kernel_launch: hipFuncSetAttribute failed\n"); grid = -1; return; }
        if (occ_query(&per_cu) != hipSuccess || per_cu < 1) { fprintf(stderr, "kernel_launch: occupancy query says %d blocks per CU\n", per_cu); (void)hipGetLastError(); per_cu = 1; }
        grid = cus;
        fprintf(stderr, "kernel_launch: cus %d per_cu %d grid %d ws %zu\n", cus, per_cu, grid, ws_size);
    }
    if (grid < 0) return;
    (void)hipMemsetAsync((char*)d_ws + WS_CTL, 0, CTL_ZERO_BYTES, stream);
    Args a{};
    for (int i = 0; i < 18; ++i) a.in[i] = (const float*)d_in[i];
    a.out = (float*)d_out; a.ws = (unsigned char*)d_ws;
#if MK_N_LAUNCHES == 1
    {
        a.ph_lo = 0; a.ph_hi = N_PHASES; a.li = 0;
        void* kargs[] = {&a};
        hipError_t e = hipLaunchCooperativeKernel((const void*)skel_fwd<0, N_PHASES>, dim3(grid), dim3(NWAVES * 64), kargs, LDS_BYTES, stream);
        if (e != hipSuccess) fprintf(stderr, "kernel_launch: cooperative launch failed: %s (grid %d)\n", hipGetErrorString(e), grid);
    }
#else
    for (int li = 0; li < N_PHASES; ++li) { a.ph_lo = li; a.ph_hi = li + 1; a.li = 0; launch_phase(li, grid, a, stream); if (li == DUP_PHASE) { a.li = 1; launch_phase(li, grid, a, stream); if (li == 9) { a.li = 0; } } if (li == 2 && DUP_PHASE >= 20) { a.li = 1 + 16 * (DUP_PHASE - 20); launch_phase(li, grid, a, stream); } }
#endif
}
```

```cpp
#include <hip/hip_runtime.h>
#include <cstdio>
#include <cstdint>
namespace pg8 {
#define PG8_LAS __attribute__((address_space(3)))
typedef unsigned short bf16_t;
typedef short bf16x8 __attribute__((ext_vector_type(8)));
typedef float f32x4 __attribute__((ext_vector_type(4)));
typedef unsigned u32x4 __attribute__((ext_vector_type(4)));
constexpr int BM = 256, BK = 64, HALF = 128, HTB = HALF * BK * 2  , STAGE_BYTES = 8 * HTB, NXCD = 8, WGM = 2;

__host__ __device__ __forceinline__ int lds_byte(int r, int c) { const int st = (r >> 4) * 2 + (c >> 5), rr = r & 15, cc = c & 31, ob = rr * 64 + cc * 2; return st * 1024 + (ob ^ (((ob >> 9) & 1) << 5)); }
__host__ __device__ __forceinline__ void stage_rc(int b, int& R, int& C) { const int st = b / 1024, sb = b % 1024, swz = sb ^ (((sb >> 9) & 1) << 5); R = (st >> 1) * 16 + swz / 64; C = (st & 1) * 32 + (swz % 64) / 2; }
__host__ __device__ __forceinline__ int perm32(int rho) { const int n = rho >> 4, i = rho & 15; return 8 * (i >> 2) + 4 * n + (i & 3); }

struct Unit { int pm, pn, k0, nt, np, piece, slot; };
struct Gemm { const bf16_t* A; const bf16_t* Bt; int M, N, K; };

struct StaticOrder {
    int nM, nN, nwg, G, c;
    __host__ __device__ void init(int M, int N, int G_, int c_) { nM = M / BM; nN = N / BM; nwg = nM * nN; G = G_; c = c_; }
    __host__ __device__ bool next(int i, Unit& u) const {
        const long L = (long)i * G + c; if (L >= nwg) return false;
        int wgid = (int)L;
#ifndef ORDER_NOREMAP
        { const int q = nwg / NXCD, r = nwg % NXCD, xcd = wgid % NXCD, off = wgid / NXCD; wgid = (xcd < r ? xcd * (q + 1) : r * (q + 1) + (xcd - r) * q) + off; }
#endif
        const int nig = WGM * nN, gid = wgid / nig, fm = gid * WGM, gsz = (nM - fm) < WGM ? (nM - fm) : WGM;
        u.pm = fm + ((wgid % nig) % gsz); u.pn = (wgid % nig) / gsz; return true;
    }
    __device__ __forceinline__ void a_ready(const Unit&) const {}
    __device__ __forceinline__ void done(const Unit&) const {}
};


struct HybridOrder {
    int nM, nN, nwg, G, c, ntk, nfull, nrem, np;
    __host__ __device__ void init(int M, int N, int K, int G_, int c_, bool allow_split = true) {
        nM = M / BM; nN = N / BM; nwg = nM * nN; G = G_; c = c_; ntk = K / BK; nfull = nwg / G; nrem = nwg - nfull * G; np = 0;
        if (allow_split && nrem > 0 && (G % NXCD) == 0) { const int grp = (nrem + NXCD - 1) / NXCD; int p = (G / NXCD) / grp; const int maxp = ntk / 4; if (p > maxp) p = maxp; if (p > 8) p = 8; if (p >= 2) np = p; }
    }
    __host__ __device__ void map(long L, Unit& u) const {
        int wgid = (int)L;
#ifndef ORDER_NOREMAP
        { const int q = nwg / NXCD, r = nwg % NXCD, xcd = wgid % NXCD, off = wgid / NXCD; wgid = (xcd < r ? xcd * (q + 1) : r * (q + 1) + (xcd - r) * q) + off; }
#endif
        const int nig = WGM * nN, gid = wgid / nig, fm = gid * WGM, gsz = (nM - fm) < WGM ? (nM - fm) : WGM;
        u.pm = fm + ((wgid % nig) % gsz); u.pn = (wgid % nig) / gsz; u.k0 = 0; u.nt = ntk; u.np = 0; u.piece = 0; u.slot = 0;
    }
    __host__ __device__ bool next(int i, Unit& u) const {
        if (i < nfull) { map((long)i * G + c, u); return true; }
        if (i > nfull || nrem == 0) return false;
        if (np == 0) { if (c >= nrem) return false; map((long)nfull * G + c, u); return true; }
        const int x = c % NXCD, j = c / NXCD, grp = j / np, p = j - grp * np, r = grp * NXCD + x;
        if (r >= nrem) return false;
        map((long)nfull * G + r, u);
        const int pairs = ntk / 2, base = pairs / np, extra = pairs - base * np, first_big = np - extra;
        const int start = p * base + (p > first_big ? p - first_big : 0), len = base + (p >= first_big ? 1 : 0);
        u.k0 = 2 * start; u.nt = 2 * len; u.np = np; u.piece = p; u.slot = r; return true;
    }
    __device__ __forceinline__ void a_ready(const Unit&) const {}
    __device__ __forceinline__ void done(const Unit&) const {}
};
struct SplitCtx { float* slabs; unsigned* cnt; };

__device__ __forceinline__ unsigned cvt_pk_bf16(float lo, float hi) { unsigned r; asm volatile("v_cvt_pk_bf16_f32 %0, %1, %2" : "=v"(r) : "v"(lo), "v"(hi)); return r; }
typedef float f32x2 __attribute__((ext_vector_type(2)));
__device__ __forceinline__ f32x2 gelu_pk(f32x2 v) {
    const f32x2 av = __builtin_elementwise_abs(v), d = av * 0.2316418882f + 1.0f;
    f32x2 t; t.x = __builtin_amdgcn_rcpf(d.x); t.y = __builtin_amdgcn_rcpf(d.y);
    f32x2 q = t * 0.5307027145f + (-0.7265760135f); q = q * t + 0.7107068705f; q = q * t + (-0.142248368f); q = q * t + 0.127414796f; q = q * t;
    const f32x2 s = (v * v) * (-0.72134752044f);
    f32x2 e; e.x = __builtin_amdgcn_exp2f(s.x); e.y = __builtin_amdgcn_exp2f(s.y);
    const f32x2 m = v * (q * e), r = v - m;
    f32x2 o; o.x = v.x < 0.f ? m.x : r.x; o.y = v.y < 0.f ? m.y : r.y; return o;
}

template <int ACT> struct EpiBf16 {
    static constexpr bool PERM = true, AFTER_DRAIN = false;
    bf16_t* O; int ldc;
    __device__ __forceinline__ void tri(const f32x4 v0, const f32x4 v1, const Unit& u, int ai, int bj, int m, int wr, int wc, int fr, int fq) const {
        bf16_t* p = O + (size_t)(u.pm * BM + ai * HALF + wr * 64 + m * 16 + fr) * ldc + u.pn * BM + bj * HALF + wc * 32 + 8 * fq;
        u32x4 w; w.x = cvt_pk_bf16(v0[0], v0[1]); w.y = cvt_pk_bf16(v0[2], v0[3]); w.z = cvt_pk_bf16(v1[0], v1[1]); w.w = cvt_pk_bf16(v1[2], v1[3]);
        *(u32x4*)p = w;
    }
    __device__ __forceinline__ void operator()(const f32x4 (&acc)[2][2][4][2], const Unit& u, int wr, int wc, int fr, int fq) const {
#pragma unroll
        for (int ai = 0; ai < 2; ++ai)
#pragma unroll
            for (int m = 0; m < 4; ++m)
#pragma unroll
                for (int bj = 0; bj < 2; ++bj) tri(acc[ai][bj][m][0], acc[ai][bj][m][1], u, ai, bj, m, wr, wc, fr, fq);
    }
};
struct EpiF32 {
    static constexpr bool PERM = false, AFTER_DRAIN = false;
    float* C; int ldc;
    __device__ __forceinline__ void tri(const f32x4 v0, const f32x4 v1, const Unit& u, int ai, int bj, int m, int wr, int wc, int fr, int fq) const {
        float* p = C + (size_t)(u.pm * BM + ai * HALF + wr * 64 + m * 16 + fr) * ldc + u.pn * BM + bj * HALF + wc * 32 + 4 * fq;
        *(f32x4*)p = v0; *(f32x4*)(p + 16) = v1;
    }
    __device__ __forceinline__ void operator()(const f32x4 (&acc)[2][2][4][2], const Unit& u, int wr, int wc, int fr, int fq) const {
#pragma unroll
        for (int ai = 0; ai < 2; ++ai)
#pragma unroll
            for (int m = 0; m < 4; ++m)
#pragma unroll
                for (int bj = 0; bj < 2; ++bj) tri(acc[ai][bj][m][0], acc[ai][bj][m][1], u, ai, bj, m, wr, wc, fr, fq);
    }
};
typedef unsigned u32x2 __attribute__((ext_vector_type(2)));
__device__ __forceinline__ f32x4 bf4_to_f32(u32x2 x) { f32x4 o; o[0] = __builtin_bit_cast(float, x.x << 16); o[1] = __builtin_bit_cast(float, x.x & 0xffff0000u); o[2] = __builtin_bit_cast(float, x.y << 16); o[3] = __builtin_bit_cast(float, x.y & 0xffff0000u); return o; }
template <int NP, class Epi> __device__ __forceinline__ void split_epilogue(const f32x4 (&acc)[2][2][4][2], const Unit& u, const Epi& E, const SplitCtx& X, int tid, int wr, int wc, int fr, int fq) {
    constexpr int SLAB = 32 * 512 * 8;
    const __amdgpu_buffer_rsrc_t rs = __builtin_amdgcn_make_buffer_rsrc((void*)((char*)X.slabs + (size_t)(u.slot * u.np) * SLAB), 0, u.np * SLAB, 0x00020000);
    {
        const int so = u.piece * SLAB;
#pragma unroll
        for (int r = 0; r < 32; ++r) { const f32x4 v = acc[r >> 4][(r >> 3) & 1][(r >> 1) & 3][r & 1]; u32x2 w; w.x = cvt_pk_bf16(v[0], v[1]); w.y = cvt_pk_bf16(v[2], v[3]);
            __builtin_amdgcn_raw_buffer_store_b64(w, rs, (unsigned)(tid * 8), so + r * 4096, 16); }
    }
    asm volatile("s_waitcnt vmcnt(0)" ::: "memory");
    asm volatile("" ::: "memory"); __builtin_amdgcn_s_barrier(); asm volatile("" ::: "memory");
    if (tid == 0) {
        unsigned* cw = X.cnt + 64 * u.slot;
        (void)__hip_atomic_fetch_add(cw, 1u, __ATOMIC_RELAXED, __HIP_MEMORY_SCOPE_AGENT);
        unsigned sp = 0;
        while (__hip_atomic_load(cw, __ATOMIC_RELAXED, __HIP_MEMORY_SCOPE_AGENT) < (unsigned)u.np) { __builtin_amdgcn_s_sleep(1); if (++sp > (1u << 24)) break; }
        __builtin_amdgcn_fence(__ATOMIC_ACQUIRE, "agent");
        asm volatile("s_waitcnt vmcnt(0)" ::: "memory");
    }
    asm volatile("" ::: "memory"); __builtin_amdgcn_s_barrier(); asm volatile("" ::: "memory");
    const int q0 = (16 * u.piece) / u.np, q1 = (16 * (u.piece + 1)) / u.np;
#pragma unroll 1
    for (int q = q0; q < q1; ++q) {
        const unsigned vo = (unsigned)(tid * 8 + q * 8192);
        f32x4 v0 = (f32x4){0.f, 0.f, 0.f, 0.f}, v1 = v0;
        if (u.np == NP) {
            u32x2 t0[NP], t1[NP];
#pragma unroll
            for (int pp = 0; pp < NP; ++pp) { t0[pp] = __builtin_amdgcn_raw_buffer_load_b64(rs, vo, pp * SLAB, 0); t1[pp] = __builtin_amdgcn_raw_buffer_load_b64(rs, vo, pp * SLAB + 4096, 0); }
#pragma unroll
            for (int pp = 0; pp < NP; ++pp) { v0 += bf4_to_f32(t0[pp]); v1 += bf4_to_f32(t1[pp]); }
        } else {
            for (int pp = 0; pp < u.np; ++pp) { v0 += bf4_to_f32(__builtin_amdgcn_raw_buffer_load_b64(rs, vo, pp * SLAB, 0)); v1 += bf4_to_f32(__builtin_amdgcn_raw_buffer_load_b64(rs, vo, pp * SLAB + 4096, 0)); }
        }
        E.tri(v0, v1, u, q >> 3, (q >> 2) & 1, q & 3, wr, wc, fr, fq);
    }
}
template <class Epi, class Sched, bool ALIGN_EPI = false, bool SP2 = false, int NP = 8>
__device__ __forceinline__ void gemm_phase(PG8_LAS unsigned char* lds, const Gemm g, const Sched& S, const Epi& E, const SplitCtx& X) {
    int tid_ = threadIdx.x; asm volatile("" : "+v"(tid_));
    const int tid = tid_, wid = __builtin_amdgcn_readfirstlane(tid >> 6), lane = tid & 63, wr = wid >> 2, wc = wid & 3, fr = lane & 15, fq = lane >> 4;
    const int K = g.K;
    unsigned voffA[2], voffB[2];
#pragma unroll
    for (int i = 0; i < 2; ++i) { int R, C; stage_rc(tid * 16 + i * 8192, R, C); const int Rb = Epi::PERM ? ((R & ~31) + perm32(R & 31)) : R;
        voffA[i] = (unsigned)(R * K + C) * 2u; voffB[i] = (unsigned)(Rb * K + C) * 2u; }
    const size_t kstep = (size_t)(BK * 2);
    const size_t hstep = (size_t)HALF * K * 2;
    const size_t tstep = 2 * hstep;
    const unsigned ldsw = (unsigned)wid * 1024u;
    const int aoff = lds_byte(wr * 64 + fr, fq * 8), boff = lds_byte(wc * 32 + fr, fq * 8);
#define PG8_SA(b, h) (((b) * 2 + (h)) * HTB)
#define PG8_SB(b, h) ((4 + (b) * 2 + (h)) * HTB)
#define PG8_STAGE(bufoff, gbase, voff) do { _Pragma("unroll") for (int _i = 0; _i < 2; ++_i) \
        __builtin_amdgcn_global_load_lds((const unsigned*)((const char*)(gbase) + (voff)[_i]), (PG8_LAS unsigned*)(lds + (bufoff) + ldsw + _i * 8192), 16, 0, 0); } while (0)
#define PG8_LDA(dst, b, h) do { _Pragma("unroll") for (int m = 0; m < 4; ++m) _Pragma("unroll") for (int k = 0; k < 2; ++k) dst[m][k] = *(const PG8_LAS bf16x8*)(lds + PG8_SA(b, h) + aoff + m * 2048 + k * 1024); } while (0)
#define PG8_LDB(dst, b, h) do { _Pragma("unroll") for (int n = 0; n < 2; ++n) _Pragma("unroll") for (int k = 0; k < 2; ++k) dst[n][k] = *(const PG8_LAS bf16x8*)(lds + PG8_SB(b, h) + boff + n * 2048 + k * 1024); } while (0)
#define PG8_MMA(ai, bj, At, Bt) do { __builtin_amdgcn_s_setprio(1); _Pragma("unroll") for (int m = 0; m < 4; ++m) _Pragma("unroll") for (int n = 0; n < 2; ++n) _Pragma("unroll") for (int k = 0; k < 2; ++k) \
        acc[ai][bj][m][n] = __builtin_amdgcn_mfma_f32_16x16x32_bf16(Bt[n][k], At[m][k], acc[ai][bj][m][n], 0, 0, 0); __builtin_amdgcn_s_setprio(0); } while (0)
#define PG8_WAIT_V(n) asm volatile("s_waitcnt vmcnt(" #n ")" ::: "memory")
#define PG8_WAIT_L(n) asm volatile("s_waitcnt lgkmcnt(" #n ")" ::: "memory")
#define PG8_BAR __builtin_amdgcn_s_barrier()
#define PG8_SCHED __builtin_amdgcn_sched_barrier(0)
    Unit cur, nxt; int ui = 0;
    if (!S.next(0, cur)) return;
    f32x4 acc[2][2][4][2];
#pragma unroll
    for (int a = 0; a < 2; ++a)
#pragma unroll
        for (int b = 0; b < 2; ++b)
#pragma unroll
            for (int m = 0; m < 4; ++m)
#pragma unroll
                for (int n = 0; n < 2; ++n) acc[a][b][m][n] = (f32x4){0.f, 0.f, 0.f, 0.f};
    bf16x8 At[4][2], B0[2][2], B1[2][2];
    const char* cA = (const char*)g.A + (size_t)cur.pm * tstep + (size_t)cur.k0 * kstep; const char* cB = (const char*)g.Bt + (size_t)cur.pn * tstep + (size_t)cur.k0 * kstep;
    S.a_ready(cur);
    if constexpr (SP2) {
        PG8_STAGE(PG8_SB(0, 0), cB, voffB); PG8_STAGE(PG8_SB(0, 1), cB + hstep, voffB); PG8_STAGE(PG8_SA(0, 0), cA, voffA); PG8_STAGE(PG8_SA(0, 1), cA + hstep, voffA);
        if (wr == 1) PG8_BAR;
        PG8_WAIT_V(2); PG8_BAR;
        PG8_STAGE(PG8_SB(1, 0), cB + kstep, voffB); PG8_STAGE(PG8_SA(1, 0), cA + kstep, voffA); PG8_STAGE(PG8_SB(1, 1), cB + hstep + kstep, voffB);
        PG8_WAIT_V(6); PG8_BAR;
    } else {
        PG8_STAGE(PG8_SB(0, 0), cB, voffB); PG8_STAGE(PG8_SA(0, 0), cA, voffA); PG8_STAGE(PG8_SB(0, 1), cB + hstep, voffB); PG8_STAGE(PG8_SA(0, 1), cA + hstep, voffA);
        if (wr == 1) PG8_BAR;
        PG8_WAIT_V(4); PG8_BAR;
        PG8_STAGE(PG8_SB(1, 0), cB + kstep, voffB); PG8_STAGE(PG8_SA(1, 0), cA + kstep, voffA); PG8_STAGE(PG8_SB(1, 1), cB + hstep + kstep, voffB);
        PG8_WAIT_V(6); PG8_BAR;
    }
    for (;;) {
        const bool has_next = S.next(ui + 1, nxt);
        const char* nA = has_next ? (const char*)g.A + (size_t)nxt.pm * tstep + (size_t)nxt.k0 * kstep : cA; const char* nB = has_next ? (const char*)g.Bt + (size_t)nxt.pn * tstep + (size_t)nxt.k0 * kstep : cB;
        const int nt = cur.nt;
        for (int t = 0; t < nt; t += 2) {
            const bool last = (t == nt - 2);
            const char* a1 = cA + (size_t)(t + 1) * kstep;
            const char* a2 = last ? nA : cA + (size_t)(t + 2) * kstep; const char* b2 = last ? nB : cB + (size_t)(t + 2) * kstep;
            const char* a3 = a2 + kstep; const char* b3 = b2 + kstep;
            if (last && has_next) S.a_ready(nxt);
            if constexpr (SP2) {
            PG8_LDB(B0, 0, 0); PG8_LDB(B1, 0, 1); PG8_SCHED; PG8_LDA(At, 0, 0); PG8_STAGE(PG8_SA(1, 1), a1 + hstep, voffA);
            PG8_WAIT_V(8); PG8_WAIT_L(0); PG8_BAR; PG8_MMA(0, 0, At, B0); PG8_MMA(0, 1, At, B1); PG8_BAR; PG8_SCHED;
            PG8_LDA(At, 0, 1); PG8_STAGE(PG8_SB(0, 0), b2, voffB); PG8_STAGE(PG8_SB(0, 1), b2 + hstep, voffB); PG8_STAGE(PG8_SA(0, 0), a2, voffA);
            PG8_WAIT_V(8); PG8_WAIT_L(0); PG8_BAR; PG8_MMA(1, 0, At, B0); PG8_MMA(1, 1, At, B1); PG8_BAR; PG8_SCHED;
            PG8_LDB(B0, 1, 0); PG8_LDB(B1, 1, 1); PG8_SCHED; PG8_LDA(At, 1, 0); PG8_STAGE(PG8_SA(0, 1), a2 + hstep, voffA);
            PG8_WAIT_V(8); PG8_WAIT_L(0); PG8_BAR; PG8_MMA(0, 0, At, B0); PG8_MMA(0, 1, At, B1); PG8_BAR; PG8_SCHED;
            PG8_LDA(At, 1, 1); PG8_STAGE(PG8_SB(1, 0), b3, voffB); PG8_STAGE(PG8_SB(1, 1), b3 + hstep, voffB); PG8_STAGE(PG8_SA(1, 0), a3, voffA);
            PG8_WAIT_V(8); PG8_WAIT_L(0); PG8_BAR; PG8_MMA(1, 0, At, B0); PG8_MMA(1, 1, At, B1); PG8_BAR; PG8_SCHED;
            } else {
            PG8_LDB(B0, 0, 0); PG8_SCHED; PG8_LDA(At, 0, 0); PG8_STAGE(PG8_SA(1, 1), a1 + hstep, voffA);
            PG8_WAIT_L(8); PG8_BAR; PG8_WAIT_L(0); PG8_MMA(0, 0, At, B0); PG8_BAR; PG8_SCHED;
            PG8_LDB(B1, 0, 1); PG8_STAGE(PG8_SB(0, 0), b2, voffB);
            PG8_BAR; PG8_WAIT_L(0); PG8_MMA(0, 1, At, B1); PG8_BAR;
            PG8_LDA(At, 0, 1); PG8_STAGE(PG8_SA(0, 0), a2, voffA);
            PG8_BAR; PG8_WAIT_L(0); PG8_MMA(1, 0, At, B0); PG8_BAR; PG8_SCHED;
            PG8_STAGE(PG8_SB(0, 1), b2 + hstep, voffB);
            PG8_WAIT_V(6); PG8_BAR; PG8_MMA(1, 1, At, B1); PG8_BAR;
            PG8_LDB(B0, 1, 0); PG8_SCHED; PG8_LDA(At, 1, 0); PG8_STAGE(PG8_SA(0, 1), a2 + hstep, voffA);
            PG8_WAIT_L(8); PG8_BAR; PG8_WAIT_L(0); PG8_MMA(0, 0, At, B0); PG8_BAR; PG8_SCHED;
            PG8_LDB(B1, 1, 1); PG8_STAGE(PG8_SB(1, 0), b3, voffB);
            PG8_BAR; PG8_WAIT_L(0); PG8_MMA(0, 1, At, B1); PG8_BAR;
            PG8_LDA(At, 1, 1); PG8_STAGE(PG8_SA(1, 0), a3, voffA);
            PG8_BAR; PG8_WAIT_L(0); PG8_MMA(1, 0, At, B0); PG8_BAR; PG8_SCHED;
            PG8_STAGE(PG8_SB(1, 1), b3 + hstep, voffB);
            PG8_WAIT_V(6); PG8_BAR; PG8_MMA(1, 1, At, B1); PG8_BAR;
            }
        }
        if constexpr (ALIGN_EPI) { if (wr == 0) PG8_BAR; }
        if constexpr (!Epi::AFTER_DRAIN) { if (cur.np > 0) split_epilogue<NP>(acc, cur, E, X, tid, wr, wc, fr, fq); else E(acc, cur, wr, wc, fr, fq); S.done(cur); }
        if (!has_next) break;
#pragma unroll
        for (int a = 0; a < 2; ++a)
#pragma unroll
            for (int b = 0; b < 2; ++b)
#pragma unroll
                for (int m = 0; m < 4; ++m)
#pragma unroll
                    for (int n = 0; n < 2; ++n) acc[a][b][m][n] = (f32x4){0.f, 0.f, 0.f, 0.f};
        cur = nxt; cA = nA; cB = nB; ++ui;
        if constexpr (ALIGN_EPI) { if (wr == 1) PG8_BAR; }
    }
    PG8_WAIT_V(0);
    if constexpr (!ALIGN_EPI) { if (wr == 0) PG8_BAR; }
    PG8_BAR;
    if constexpr (Epi::AFTER_DRAIN) { E.fused(acc, cur, wr, wc, fr, fq, lds, wid, lane); S.done(cur); }
#undef PG8_SA
#undef PG8_SB
#undef PG8_STAGE
#undef PG8_LDA
#undef PG8_LDB
#undef PG8_MMA
#undef PG8_WAIT_V
#undef PG8_WAIT_L
#undef PG8_BAR
#undef PG8_SCHED
}
}

#ifndef PG8_SP2
#define PG8_SP2 true
#endif
#ifndef PG8_ALIGN
#define PG8_ALIGN true
#endif
#ifndef DUP_PHASE
#define DUP_PHASE -1
#endif
#ifndef MK_N_LAUNCHES
#define MK_N_LAUNCHES 1
#endif
constexpr int NWAVES = 8;
constexpr int N_PHASES = 10;
constexpr int N_LAUNCHES = MK_N_LAUNCHES;

constexpr int MP = 8192, MS = 1024, M = MP + MS;
constexpr int D = 2048, NIN = 11264, FF = 5632, FF2 = 11264;
constexpr int NH = 8, DK = 128, DVH = 256;
constexpr int C_POOL = 0, C_Q = 1024, C_K = 2048, C_V = 3072, C_GRET = 5120, C_GA = 7168, C_GR = 9216;
constexpr float EPS = 1e-6f;
constexpr int NS = 4, DVS = DVH / NS;
constexpr size_t O_Y = 0, O_POOLP = 18874368, O_RETP = 18935808, O_CONVP = 19984384, O_POOLS = 20074496, O_RETS = 22040576, O_CONVS = 55595008, O_END = 58478592;

constexpr size_t MiB = 1u << 20;
constexpr size_t WS_CTL = 0, CTL_ZERO_BYTES = 128 * 1024;
constexpr size_t WS_WIN = 1 * MiB, WS_WUP = 45 * MiB, WS_WDN = 89 * MiB, WS_WOUT = 111 * MiB, WS_WPOOL = 119 * MiB;
constexpr size_t WS_ROPE = 120 * MiB;
constexpr size_t WS_XN = 122 * MiB;
constexpr size_t WS_PROJ = 158 * MiB;
constexpr size_t WS_O = 356 * MiB, WS_AP = 392 * MiB, WS_MM = 428 * MiB;
constexpr size_t WS_SP16 = 464 * MiB;
constexpr size_t WS_X1 = 468 * MiB;
constexpr size_t WS_END = 504 * MiB;
constexpr int CW_TMO = 0, CW_CODE = 1, CW_Q2 = 64, CW_QW = 192, CW_BAR = 4096, CW_SPLIT = 8192;
static_assert((CW_SPLIT + 4 * 4096) * 4 <= (int)CTL_ZERO_BYTES && CW_BAR + 3456 <= CW_SPLIT, "control words inside the per-call memset");
constexpr size_t WS_SLAB_A = 356 * MiB, WS_SLAB_B = 230 * MiB;

constexpr int LDS_BYTES = 147456, LDSCTL_OFF = 143360;

#define GAS __attribute__((address_space(1)))
#define LAS __attribute__((address_space(3)))
typedef unsigned short bf16;
typedef unsigned v4u __attribute__((ext_vector_type(4)));
typedef unsigned v2u __attribute__((ext_vector_type(2)));
typedef float f32x4 __attribute__((ext_vector_type(4)));
typedef short bf16x8 __attribute__((ext_vector_type(8)));
#define RLX_AGENT __ATOMIC_RELAXED, __HIP_MEMORY_SCOPE_AGENT
#define LDS_WAIT() asm volatile("s_waitcnt lgkmcnt(0)" ::: "memory")
#define VM_WAIT() asm volatile("s_waitcnt vmcnt(0)" ::: "memory")
__device__ __forceinline__ unsigned pk2(float lo, float hi) { return pg8::cvt_pk_bf16(lo, hi); }
__device__ __forceinline__ float bflo(unsigned u) { return __uint_as_float(u << 16); }
__device__ __forceinline__ float bfhi(unsigned u) { return __uint_as_float(u & 0xffff0000u); }
__device__ __forceinline__ void unpack8(v4u x, float (&f)[8]) { f[0] = bflo(x.x); f[1] = bfhi(x.x); f[2] = bflo(x.y); f[3] = bfhi(x.y); f[4] = bflo(x.z); f[5] = bfhi(x.z); f[6] = bflo(x.w); f[7] = bfhi(x.w); }
__device__ __forceinline__ v4u pack8(const float (&f)[8]) { v4u o; o.x = pk2(f[0], f[1]); o.y = pk2(f[2], f[3]); o.z = pk2(f[4], f[5]); o.w = pk2(f[6], f[7]); return o; }
__device__ __forceinline__ v2u pack4(f32x4 a) { v2u o; o.x = pk2(a[0], a[1]); o.y = pk2(a[2], a[3]); return o; }
__device__ __forceinline__ float sigmoidf_(float x) { return __builtin_amdgcn_rcpf(1.0f + __expf(-x)); }
__device__ __forceinline__ float wave_sum(float v) {
#pragma unroll
    for (int o = 1; o < 64; o <<= 1) v += __shfl_xor(v, o);
    return v;
}
__device__ __forceinline__ bf16x8 as_bf16x8(v4u x) { return __builtin_bit_cast(bf16x8, x); }
#define MFMA16(a, b, c) __builtin_amdgcn_mfma_f32_16x16x32_bf16((a), (b), (c), 0, 0, 0)

#define XB_TMO      128
#define XB_XCNT(j)  (256  + 64 * (j))
#define XB_XSUB(j)  (1280 + 64 * (j))
#define XB_XGEN(j)  (2304 + 64 * (j))
#define XB_TOP      3328
#define XB_TOPGEN   3392
#define XCD_BAR_WORDS 3456
#define XB_SPIN_CAP (1u << 22)
__device__ __forceinline__ unsigned xb_ld(unsigned* p)              { return __hip_atomic_load(p, __ATOMIC_RELAXED, __HIP_MEMORY_SCOPE_AGENT); }
__device__ __forceinline__ unsigned xb_add(unsigned* p, unsigned v) { return __hip_atomic_fetch_add(p, v, __ATOMIC_RELAXED, __HIP_MEMORY_SCOPE_AGENT); }
__device__ __forceinline__ unsigned xb_xcc_id() { return (unsigned)__builtin_amdgcn_s_getreg((3 << 11) | 20) & 0xFu; }
#define XB_SPIN(cond, bar) do { unsigned _sp = 0; while (cond) { __builtin_amdgcn_s_sleep(1); \
    if ((++_sp & 255u) == 0u) { if (xb_ld(&(bar)[XB_TMO])) break; if (_sp > XB_SPIN_CAP) { atomicAdd(&(bar)[XB_TMO], 1u); break; } } } } while (0)
struct XcdBarrier { unsigned* bar; unsigned x; volatile LAS unsigned* st; };
__device__ __forceinline__ XcdBarrier xcd_barrier_post(unsigned* bar, volatile LAS unsigned* st) {
    XcdBarrier b; b.bar = bar; b.x = xb_xcc_id(); b.st = st;
    if (threadIdx.x == 0) (void)xb_add(&bar[XB_XCNT(b.x)], 1u);
    return b;
}
__device__ __forceinline__ void xcd_barrier_complete(unsigned* bar, unsigned x, unsigned& nloc, unsigned& nx) {
    const unsigned G = gridDim.x * gridDim.y * gridDim.z;
    unsigned sum, cnt, mine, sp = 0u;
    for (;;) {
        sum = 0u; cnt = 0u; mine = 0u;
#pragma unroll
        for (unsigned j = 0; j < 16; ++j) { const unsigned c = xb_ld(&bar[XB_XCNT(j)]); sum += c; cnt += (c > 0u) ? 1u : 0u; mine = (j == x) ? c : mine; }
        if (sum == G) break;
        __builtin_amdgcn_s_sleep(1);
        if ((++sp & 255u) == 0u) { if (xb_ld(&bar[XB_TMO])) break; if (sp > XB_SPIN_CAP) { atomicAdd(&bar[XB_TMO], 1u); break; } }
    }
    nloc = mine > 0u ? mine : 1u; nx = cnt > 0u ? cnt : 1u;
}
__device__ __forceinline__ void xcd_barrier(const XcdBarrier& b) {
    asm volatile("s_waitcnt vmcnt(0)" ::: "memory");
    __syncthreads();
    if (threadIdx.x == 0) {
        unsigned* bar = b.bar;
        __builtin_amdgcn_s_waitcnt(0);
        unsigned nloc = b.st[0], nx = b.st[1];
        if (nloc == 0u) { xcd_barrier_complete(bar, b.x, nloc, nx); b.st[0] = nloc; b.st[1] = nx; }
        const unsigned old = xb_add(&bar[XB_XSUB(b.x)], 1u);
        const unsigned gen = old / nloc;
        if (old + 1u == (gen + 1u) * nloc) {
            __builtin_amdgcn_fence(__ATOMIC_RELEASE, "agent");
            asm volatile("s_waitcnt vmcnt(0)" ::: "memory");
            const unsigned og = xb_add(&bar[XB_TOP], 1u);
            const unsigned tg = og / nx;
            if (og + 1u == (tg + 1u) * nx) xb_add(&bar[XB_TOPGEN], 1u);
            else XB_SPIN(xb_ld(&bar[XB_TOPGEN]) == tg, bar);
            __builtin_amdgcn_fence(__ATOMIC_ACQUIRE, "agent");
            xb_add(&bar[XB_XGEN(b.x)], 1u);
            asm volatile("s_waitcnt vmcnt(0)" ::: "memory");
        } else {
            XB_SPIN(xb_ld(&bar[XB_XGEN(b.x)]) == gen, bar);
            __builtin_amdgcn_fence(__ATOMIC_ACQUIRE, "agent");
            asm volatile("s_waitcnt vmcnt(0)" ::: "memory");
        }
    }
    __syncthreads();
}

struct Frame {
    LAS unsigned char* lds;
    volatile LAS unsigned* MISC;
    unsigned* ctl;
    int tid, lane, wave, G, gw, NGW;
    const float *xp, *xs, *state_pool, *state_ret, *state_conv, *g_pre_mix, *w_in, *w_pool, *pool_scale, *gn_gain, *w_out, *g_post_mix, *g_pre_ffn, *w_up, *conv_w, *conv_b, *w_down, *g_post_ffn;
    float* out;
    bf16 *WIN, *WUP, *WDN, *WOUT, *WPOOL, *XN, *PROJ, *UP, *OB, *AP, *MM, *ACT;
    float *ROPE_C, *ROPE_S;
    bf16 *SP16, *MOB, *X1B;
};
__device__ __forceinline__ const float* xrow(const Frame& F, int m) { return m < MP ? F.xp + (size_t)m * D : F.xs + (size_t)(m - MP) * D; }

__host__ __device__ __forceinline__ int unperm_d(int p) { const int g8 = p >> 3, e = p & 7; return e < 4 ? 4 * g8 + e : 64 + 4 * g8 + (e - 4); }
__device__ __forceinline__ void p0_transpose_item(const float* W, int K, int N, bf16* WT, LAS float* scr, int item, int lane, bool permqk = false) {
    const int nblk = N / 32, kb = item / nblk, nb = item % nblk, k0 = 64 * kb, n0 = 32 * nb;
    int src = n0 + (lane & 31); if (permqk && src >= C_Q && src < C_V) src = (src & ~127) + unperm_d(src & 127);
#pragma unroll 8
    for (int i = 0; i < 32; ++i) { const int kk = 2 * i + (lane >> 5); scr[kk * 33 + (lane & 31)] = __builtin_nontemporal_load(W + (size_t)(k0 + kk) * N + src); }
    LDS_WAIT(); asm volatile("" ::: "memory");
    const int c = lane & 7;
#pragma unroll
    for (int j = 0; j < 4; ++j) { const int n = (lane >> 3) + 8 * j; const LAS float* s = scr + (8 * c) * 33 + n;
        v4u o; o.x = pk2(s[0 * 33], s[1 * 33]); o.y = pk2(s[2 * 33], s[3 * 33]); o.z = pk2(s[4 * 33], s[5 * 33]); o.w = pk2(s[6 * 33], s[7 * 33]);
        *(v4u*)(WT + (size_t)(n0 + n) * K + k0 + 8 * c) = o; }
    LDS_WAIT(); asm volatile("" ::: "memory");
}
__device__ __forceinline__ void rms_row_to_bf16(const float* xr_, const float* g, bf16* orow, int lane) {
    const f32x4* xr = (const f32x4*)xr_ + lane; const f32x4* gr = (const f32x4*)g + lane;
    f32x4 v[8]; float s = 0.f;
#pragma unroll
    for (int j = 0; j < 8; ++j) { v[j] = __builtin_nontemporal_load(xr + 64 * j); s += (v[j].x * v[j].x + v[j].y * v[j].y) + (v[j].z * v[j].z + v[j].w * v[j].w); }
    const float rs = 1.0f / sqrtf(wave_sum(s) * (1.f / D) + EPS);
    v2u* o8 = (v2u*)orow + lane;
#pragma unroll
    for (int j = 0; j < 8; ++j) { const f32x4 gg = gr[64 * j]; v2u o; o.x = pk2(v[j].x * rs * gg.x, v[j].y * rs * gg.y); o.y = pk2(v[j].z * rs * gg.z, v[j].w * rs * gg.w); o8[64 * j] = o; }
}
__device__ __forceinline__ void p0_deferred_weights(Frame& F, LAS float* scr) {
    constexpr int I_UP = (D / 64) * (FF2 / 32), I_DN = (FF / 64) * (D / 32), I_OUT = (D / 64) * (D / 32), I_PL = (256 / 64) * (512 / 32);
    constexpr int NITEMS = I_UP + I_DN + I_OUT + 4 * I_PL, CHUNK = 4;
    for (;;) {
        int base = 0;
        if (F.lane == 0) base = (int)__hip_atomic_fetch_add(F.ctl + CW_QW, (unsigned)CHUNK, RLX_AGENT);
        base = __builtin_amdgcn_readfirstlane(base);
        if (base >= NITEMS) break;
        for (int it = base; it < base + CHUNK && it < NITEMS; ++it) {
            int r = it;
            if (r < I_UP) { p0_transpose_item(F.w_up, D, FF2, F.WUP, scr, r, F.lane); continue; } r -= I_UP;
            if (r < I_DN) { p0_transpose_item(F.w_down, FF, D, F.WDN, scr, r, F.lane); continue; } r -= I_DN;
            if (r < I_OUT) { p0_transpose_item(F.w_out, D, D, F.WOUT, scr, r, F.lane); continue; } r -= I_OUT;
            const int g = r / I_PL; r -= g * I_PL;
            p0_transpose_item(F.w_pool + (size_t)g * 256 * 512, 256, 512, F.WPOOL + (size_t)g * 512 * 256, scr, r, F.lane);
        }
    }
}
__device__ __forceinline__ void p0_prologue(Frame& F) {
    LAS float* scr = (LAS float*)(F.lds + F.wave * 16384);
    constexpr int I_IN = (D / 64) * (NIN / 32);
    for (int it = F.gw; it < I_IN; it += F.NGW) p0_transpose_item(F.w_in, D, NIN, F.WIN, scr, it, F.lane, true);
    for (int m = F.gw; m < M; m += F.NGW) rms_row_to_bf16(xrow(F, m), F.g_pre_mix, F.XN + (size_t)m * D, F.lane);
    for (int idx = blockIdx.x * 512 + F.tid; idx < 128 * 15 * 1024 / 4; idx += F.G * 512) { const f32x4 v = ((const f32x4*)F.state_pool)[idx]; ((v2u*)F.SP16)[idx] = pack4(v); }
    for (int idx = blockIdx.x * 512 + F.tid; idx < 2056 * 64; idx += F.G * 512) {
        const int row = idx >> 6, i = idx & 63; const int pos = row < 2048 ? row : 16384 + (row - 2048);
        double th = 1.0; for (int k = 0; k < i; ++k) th *= 0.8659643233600653;
        const double a = (double)pos * th;
        const double kd = rint(a * 0.6366197723675814);
        double y = fma(-kd, 1.57079632679489655800e+00, a); y = fma(-kd, 6.12323399573676603587e-17, y);
        const int k4 = ((int)kd) & 3; const double y2 = y * y;
        const double sp = y * (1.0 + y2 * (-1.0 / 6 + y2 * (1.0 / 120 + y2 * (-1.0 / 5040 + y2 * (1.0 / 362880 + y2 * (-1.0 / 39916800 + y2 * (1.0 / 6227020800.0)))))));
        const double cp = 1.0 + y2 * (-0.5 + y2 * (1.0 / 24 + y2 * (-1.0 / 720 + y2 * (1.0 / 40320 + y2 * (-1.0 / 3628800 + y2 * (1.0 / 479001600 + y2 * (-1.0 / 87178291200.0)))))));
        double sn, cs;
        if (k4 == 0) { sn = sp; cs = cp; } else if (k4 == 1) { sn = cp; cs = -sp; } else if (k4 == 2) { sn = -sp; cs = -cp; } else { sn = -cp; cs = sp; }
        F.ROPE_C[idx] = (float)cs; F.ROPE_S[idx] = (float)sn;
    }
}

constexpr float KSCALE = 0.08838834764831845f;
struct EpiProj {
    static constexpr bool PERM = true, AFTER_DRAIN = false;
    bf16* O; const float* rc; const float* rs;
    __device__ __forceinline__ void tri(f32x4 v0, f32x4 v1, const pg8::Unit& u, int ai, int bj, int m, int wr, int wc, int fr, int fq) const {
        const int row = u.pm * 256 + ai * 128 + wr * 64 + m * 16 + fr, col = u.pn * 256 + bj * 128 + wc * 32 + 8 * fq;
        if (u.pn >= 4 && u.pn < 12) {
            const int h = ((u.pn & 3) << 1) + bj;
            int prow, tl; if (row < MP) { const int t = row & 2047; prow = t; tl = t & 127; } else { tl = row & 7; prow = 2048 + tl; }
            const int g8 = 4 * wc + fq;
            const f32x4 c = *(const f32x4*)(rc + prow * 64 + 4 * g8), sn = *(const f32x4*)(rs + prow * 64 + 4 * g8);
            const float lg2 = __log2f(1.0f - __builtin_amdgcn_exp2f(-5.0f - (float)h));
            const float sc = u.pn >= 8 ? KSCALE * __builtin_amdgcn_exp2f(-lg2 * (float)tl) : __builtin_amdgcn_exp2f(lg2 * (float)tl);
            const f32x4 y1 = (v0 * c - v1 * sn) * sc, y2 = (v1 * c + v0 * sn) * sc;
            v0 = y1; v1 = y2;
        }
        v4u w4; w4.x = pk2(v0[0], v0[1]); w4.y = pk2(v0[2], v0[3]); w4.z = pk2(v1[0], v1[1]); w4.w = pk2(v1[2], v1[3]);
        *(v4u*)(O + (size_t)row * NIN + col) = w4;
    }
    __device__ __forceinline__ void operator()(const f32x4 (&acc)[2][2][4][2], const pg8::Unit& u, int wr, int wc, int fr, int fq) const {
#pragma unroll
        for (int ai = 0; ai < 2; ++ai)
#pragma unroll
            for (int m = 0; m < 4; ++m)
#pragma unroll
                for (int bj = 0; bj < 2; ++bj) tri(acc[ai][bj][m][0], acc[ai][bj][m][1], u, ai, bj, m, wr, wc, fr, fq);
    }
};

typedef short s16x4 __attribute__((ext_vector_type(4)));
__device__ __forceinline__ bf16x8 tr16x2(const LAS unsigned char* p0, const LAS unsigned char* p1) {
    const s16x4 a = __builtin_amdgcn_ds_read_tr16_b64_v4i16((LAS s16x4*)p0), b = __builtin_amdgcn_ds_read_tr16_b64_v4i16((LAS s16x4*)p1);
    return __builtin_shufflevector(a, b, 0, 1, 2, 3, 4, 5, 6, 7);
}
static_assert(DVS == 64, "chain staging below assumes 64-wide value slices");
constexpr int QI_LD = 136, VI_LD = DVS + 8;
constexpr int QI_OFF = 0, KI_OFF = 34816, VI_OFF = 69632, RT_OFF = VI_OFF + 128 * VI_LD * 2, CH_END = RT_OFF + DVS * QI_LD * 2;
static_assert(CH_END <= LDSCTL_OFF, "chain LDS");
__device__ __forceinline__ void chain_unit(Frame& F, int unit) {
    const int s = unit % NS, h = (unit / NS) & 7, b = unit / (NS * 8);
    int tid_ = F.tid; asm volatile("" : "+v"(tid_));
    const int tid = tid_, lane = tid & 63, w = F.wave, fr = lane & 15, fq = lane >> 4, tq = (lane & 15) >> 2, tp = lane & 3;
    LAS unsigned char* L = F.lds;
    const float lg2 = __log2f(1.0f - __builtin_amdgcn_exp2f(-5.0f - (float)h));
    const float gam = __builtin_amdgcn_exp2f(lg2), g127 = __builtin_amdgcn_exp2f(127.f * lg2);
    for (int i = tid; i < DVS * QI_LD * 2 / 16; i += 512) *(LAS v4u*)(L + RT_OFF + i * 16) = (v4u){0u, 0u, 0u, 0u};
    f32x4 Racc[4];
#pragma unroll
    for (int i = 0; i < 4; ++i) Racc[i] = (f32x4){0.f, 0.f, 0.f, 0.f};
    const int vt_r = w & 3, dg = w >> 2;
    const bf16* pbase = F.PROJ + ((size_t)b * 2048) * NIN;
    v4u sq[4], sk[4], sv[2];
#define CH_ISSUE(c) do { const bf16* pr_ = pbase + (size_t)((c) * 128) * NIN; \
        _Pragma("unroll") for (int i_ = 0; i_ < 4; ++i_) { const int ci = tid + 512 * i_, j = ci >> 4, ch = ci & 15; sq[i_] = *(const v4u*)(pr_ + (size_t)j * NIN + C_Q + h * 128 + 8 * ch); sk[i_] = *(const v4u*)(pr_ + (size_t)j * NIN + C_K + h * 128 + 8 * ch); } \
        _Pragma("unroll") for (int i_ = 0; i_ < 2; ++i_) { const int ci = tid + 512 * i_, j = ci >> 3, ch = ci & 7; sv[i_] = *(const v4u*)(pr_ + (size_t)j * NIN + C_V + h * DVH + s * DVS + 8 * ch); } } while (0)
#define CH_WRITE() do { \
        _Pragma("unroll") for (int i_ = 0; i_ < 4; ++i_) { const int ci = tid + 512 * i_, j = ci >> 4, ch = ci & 15; *(LAS v4u*)(L + QI_OFF + (j * QI_LD + 8 * ch) * 2) = sq[i_]; *(LAS v4u*)(L + KI_OFF + (j * QI_LD + 8 * ch) * 2) = sk[i_]; } \
        _Pragma("unroll") for (int i_ = 0; i_ < 2; ++i_) { const int ci = tid + 512 * i_, j = ci >> 3, ch = ci & 7; *(LAS v4u*)(L + VI_OFF + (j * VI_LD + 8 * ch) * 2) = sv[i_]; } } while (0)
    CH_ISSUE(0);
#pragma unroll 1
    for (int c = 0; c < 16; ++c) {
        const size_t mrow0 = (size_t)b * 2048 + c * 128;
        CH_WRITE();
        __syncthreads();
        if (c + 1 < 16) CH_ISSUE(c + 1);
        {
            bf16x8 afr[4];
#pragma unroll
            for (int kk = 0; kk < 4; ++kk) afr[kk] = *(const LAS bf16x8*)(L + QI_OFF + ((16 * w + fr) * QI_LD + 32 * kk + 8 * fq) * 2);
            f32x4 oacc[4];
#pragma unroll
            for (int vt = 0; vt < 4; ++vt) {
                f32x4 acc = (f32x4){0.f, 0.f, 0.f, 0.f};
#pragma unroll
                for (int kk = 0; kk < 4; ++kk) { const bf16x8 rf = *(const LAS bf16x8*)(L + RT_OFF + ((16 * vt + fr) * QI_LD + 32 * kk + 8 * fq) * 2); acc = MFMA16(rf, afr[kk], acc); }
                oacc[vt] = acc * gam;
            }
            const int i_ = 16 * w + fr, nkk = (w >> 1) + 1;
#pragma unroll 1
            for (int kk = 0; kk < nkk; ++kk) {
                f32x4 s0 = (f32x4){0.f, 0.f, 0.f, 0.f}, s1 = s0;
                const LAS unsigned char* kb = L + KI_OFF + ((32 * kk + fr) * QI_LD + 8 * fq) * 2;
#pragma unroll
                for (int k2 = 0; k2 < 4; ++k2) {
                    const bf16x8 kf0 = *(const LAS bf16x8*)(kb + 64 * k2), kf1 = *(const LAS bf16x8*)(kb + 16 * QI_LD * 2 + 64 * k2);
                    s0 = MFMA16(kf0, afr[k2], s0); s1 = MFMA16(kf1, afr[k2], s1);
                }
                float pv[8];
#pragma unroll
                for (int e = 0; e < 4; ++e) { const int dd0 = i_ - (32 * kk + 4 * fq + e); pv[e] = dd0 >= 0 ? s0[e] : 0.f; pv[4 + e] = dd0 >= 16 ? s1[e] : 0.f; }
                const bf16x8 pf = as_bf16x8(pack8(pv));
                const LAS unsigned char* vb = L + VI_OFF + ((32 * kk + 4 * fq + tq) * VI_LD + 4 * tp) * 2;
#pragma unroll
                for (int vt = 0; vt < 4; ++vt) oacc[vt] = MFMA16(tr16x2(vb + 32 * vt, vb + 16 * VI_LD * 2 + 32 * vt), pf, oacc[vt]);
            }
            bf16* orow = F.OB + (mrow0 + 16 * w + fr) * D + h * DVH + s * DVS + 4 * fq;
#pragma unroll
            for (int vt = 0; vt < 4; ++vt) *(v2u*)(orow + 16 * vt) = pack4(oacc[vt]);
        }
#pragma unroll
        for (int di = 0; di < 4; ++di) {
            const int dt = dg * 4 + di;
            f32x4 acc = Racc[di] * gam;
#pragma unroll
            for (int kk = 0; kk < 4; ++kk) {
                const LAS unsigned char* ka = L + KI_OFF + ((32 * kk + 8 * fq + tq) * QI_LD + 16 * dt + 4 * tp) * 2;
                const LAS unsigned char* va = L + VI_OFF + ((32 * kk + 8 * fq + tq) * VI_LD + 16 * vt_r + 4 * tp) * 2;
                acc = MFMA16(tr16x2(ka, ka + 4 * QI_LD * 2), tr16x2(va, va + 4 * VI_LD * 2), acc);
            }
            Racc[di] = acc * g127;
        }
        __syncthreads();
#pragma unroll
        for (int di = 0; di < 4; ++di) { const int dt = dg * 4 + di; *(LAS v2u*)(L + RT_OFF + ((16 * vt_r + fr) * QI_LD + 16 * dt + 4 * fq) * 2) = pack4(Racc[di]); }
    }
#undef CH_ISSUE
#undef CH_WRITE
    float* ro = F.out + O_RETP + ((size_t)(b * 8 + h) * 128) * DVH + s * DVS + 16 * vt_r + fr;
#pragma unroll
    for (int di = 0; di < 4; ++di) { const int dt = dg * 4 + di;
#pragma unroll
        for (int r = 0; r < 4; ++r) ro[(size_t)unperm_d(16 * dt + 4 * fq + r) * DVH] = Racc[di][r]; }
}

constexpr int SQ_OFF = 0, SKZ_OFF = 4096, SK_OFF = 8192, SV_OFF = 12288, SS_OFF = 20480, SRED_OFF = 24576;
__device__ __forceinline__ void sample_unit(Frame& F, int unit) {
    const int h = unit & 7, b = unit >> 3;
    int tid_ = F.tid; asm volatile("" : "+v"(tid_));
    const int tid = tid_, lane = tid & 63, w = F.wave;
    LAS unsigned char* L = F.lds;
    LAS float* qT = (LAS float*)(L + SQ_OFF); LAS float* kzT = (LAS float*)(L + SKZ_OFF); LAS float* kS = (LAS float*)(L + SK_OFF);
    LAS float* vs = (LAS float*)(L + SV_OFF); LAS float* ss = (LAS float*)(L + SS_OFF); LAS float* red = (LAS float*)(L + SRED_OFF);
    const float lg2 = __log2f(1.0f - __builtin_amdgcn_exp2f(-5.0f - (float)h));
    const float gam = __builtin_amdgcn_exp2f(lg2), g7 = __builtin_amdgcn_exp2f(7.f * lg2), g8c = __builtin_amdgcn_exp2f(8.f * lg2);
    const size_t mrow0 = (size_t)MP + (size_t)b * 8;
    const float* Rin = F.state_ret + ((size_t)(b * 8 + h) * 128) * DVH + 4 * lane;
    float* Rout = F.out + O_RETS + ((size_t)(b * 8 + h) * 128) * DVH + 4 * lane;
    f32x4 r0[16];
#pragma unroll
    for (int dd = 0; dd < 16; ++dd) r0[dd] = __builtin_nontemporal_load((const f32x4*)(Rin + (size_t)(16 * w + dd) * DVH));
    if (tid < 256) {
        const int qk = tid >> 7, it = tid & 127, i = it >> 4, ch = it & 15;
        float f[8]; unpack8(*(const v4u*)(F.PROJ + (mrow0 + i) * NIN + (qk ? C_K : C_Q) + h * 128 + 8 * ch), f);
#pragma unroll
        for (int e = 0; e < 8; ++e) { const int d = e < 4 ? 4 * ch + e : 64 + 4 * ch + (e - 4);
            if (qk == 0) qT[d * 8 + i] = f[e]; else { kS[i * 128 + d] = f[e]; kzT[d * 8 + i] = f[e] * g7; } }
    } else {
        const int it = tid - 256, j = it >> 5, g = it & 31;
        float f[8]; unpack8(*(const v4u*)(F.PROJ + (mrow0 + j) * NIN + C_V + h * DVH + 8 * g), f);
#pragma unroll
        for (int e = 0; e < 8; ++e) vs[j * 256 + 8 * g + e] = f[e];
    }
    __syncthreads();
    {
        const int pr = tid >> 3, part = tid & 7, i = pr >> 3, j = pr & 7; float dot = 0.f;
#pragma unroll
        for (int dd = 0; dd < 16; ++dd) { const int d = 16 * part + dd; dot += qT[d * 8 + i] * kS[j * 128 + d]; }
        dot += __shfl_xor(dot, 1); dot += __shfl_xor(dot, 2); dot += __shfl_xor(dot, 4);
        if (part == 0) ss[i * 8 + j] = (i >= j) ? dot : 0.f;
    }
    {
        f32x4 vreg[8], oacc[8];
#pragma unroll
        for (int j = 0; j < 8; ++j) { vreg[j] = *(const LAS f32x4*)(vs + j * 256 + 4 * lane); oacc[j] = (f32x4){0.f, 0.f, 0.f, 0.f}; }
#pragma unroll
        for (int dd = 0; dd < 16; ++dd) {
            const int d = 16 * w + dd;
            const f32x4 qa = *(const LAS f32x4*)(qT + d * 8), qb = *(const LAS f32x4*)(qT + d * 8 + 4), ka = *(const LAS f32x4*)(kzT + d * 8), kb = *(const LAS f32x4*)(kzT + d * 8 + 4);
            f32x4 rn = r0[dd] * g8c;
            rn += ka.x * vreg[0]; rn += ka.y * vreg[1]; rn += ka.z * vreg[2]; rn += ka.w * vreg[3]; rn += kb.x * vreg[4]; rn += kb.y * vreg[5]; rn += kb.z * vreg[6]; rn += kb.w * vreg[7];
            __builtin_nontemporal_store(rn, (f32x4*)(Rout + (size_t)d * DVH));
            oacc[0] += qa.x * r0[dd]; oacc[1] += qa.y * r0[dd]; oacc[2] += qa.z * r0[dd]; oacc[3] += qa.w * r0[dd];
            oacc[4] += qb.x * r0[dd]; oacc[5] += qb.y * r0[dd]; oacc[6] += qb.z * r0[dd]; oacc[7] += qb.w * r0[dd];
        }
#pragma unroll
        for (int i = 0; i < 8; ++i) *(LAS f32x4*)(red + (w * 8 + i) * 256 + 4 * lane) = oacc[i];
    }
    __syncthreads();
    {
        const int i = tid >> 6, l = tid & 63;
        f32x4 tot = (f32x4){0.f, 0.f, 0.f, 0.f};
#pragma unroll
        for (int ww = 0; ww < 8; ++ww) tot += *(const LAS f32x4*)(red + (ww * 8 + i) * 256 + 4 * l);
        tot = tot * gam;
#pragma unroll
        for (int j = 0; j < 8; ++j) tot += ss[i * 8 + j] * *(const LAS f32x4*)(vs + j * 256 + 4 * l);
        *(v2u*)(F.OB + (mrow0 + i) * D + h * DVH + 4 * l) = pack4(tot);
    }
}

constexpr int Z_LD = 264;
template <int W, int IB> __device__ __forceinline__ void pool_z(Frame& F, int g, int m0, int tid) {
    LAS unsigned char* L = F.lds;
#pragma unroll 1
    for (int it0 = tid; it0 < 4096; it0 += 512 * IB) {
        v4u raw[IB][W]; bool ok[IB][W];
#pragma unroll
        for (int ib = 0; ib < IB; ++ib) {
            const int it = it0 + 512 * ib, j = it >> 5, c8 = it & 31, m = m0 + j, col = C_POOL + 256 * g + 8 * c8;
#pragma unroll
            for (int k = 0; k < W; ++k) {
                const bf16* p;
                if (m < MP) { const int t = m & 2047; ok[ib][k] = t - k >= 0; p = F.PROJ + (size_t)(ok[ib][k] ? m - k : m) * NIN + col; }
                else { const int ms = m - MP, bb = ms >> 3, i = ms & 7, ee = 15 + i - k; ok[ib][k] = true;
                    const bf16* p1 = F.PROJ + (size_t)(MP + bb * 8 + (ee >= 15 ? ee - 15 : 0)) * NIN + col; const bf16* p2 = F.SP16 + ((size_t)bb * 15 + (ee < 15 ? ee : 0)) * 1024 + 256 * g + 8 * c8;
                    p = ee >= 15 ? p1 : p2; }
                raw[ib][k] = *(const v4u*)p;
            }
        }
#pragma unroll
        for (int ib = 0; ib < IB; ++ib) {
            const int it = it0 + 512 * ib, j = it >> 5, c8 = it & 31, m = m0 + j;
            float sum[8], cur[8], f[8];
            unpack8(raw[ib][0], cur);
#pragma unroll
            for (int e = 0; e < 8; ++e) sum[e] = cur[e];
#pragma unroll
            for (int k = 1; k < W; ++k) { unpack8(raw[ib][k], f);
#pragma unroll
                for (int e = 0; e < 8; ++e) sum[e] += ok[ib][k] ? f[e] : 0.f; }
            int cn = W; if (m < MP) { const int t = m & 2047; cn = W < t + 1 ? W : t + 1; }
            const float ic = 1.0f / (float)cn;
#pragma unroll
            for (int e = 0; e < 8; ++e) f[e] = sum[e] * ic - cur[e];
            *(LAS v4u*)(L + (j * Z_LD + 8 * c8) * 2) = pack8(f);
        }
    }
}
__device__ __forceinline__ void pool_unit(Frame& F, int unit) {
    const int g = unit & 3, tile = unit >> 2, m0 = tile * 128;
    int tid_ = F.tid; asm volatile("" : "+v"(tid_));
    const int tid = tid_, lane = tid & 63, w = F.wave, fr = lane & 15, fq = lane >> 4;
    LAS unsigned char* L = F.lds;
    bf16x8 bfr[4][8];
    {
        const bf16* wt = F.WPOOL + ((size_t)g * 512 + 64 * w + fr) * 256 + 8 * fq;
#pragma unroll
        for (int et = 0; et < 4; ++et)
#pragma unroll
            for (int kk = 0; kk < 8; ++kk) bfr[et][kk] = *(const bf16x8*)(wt + (size_t)(16 * et) * 256 + 32 * kk);
    }
    if (m0 >= MP) {
        if (g == 0) pool_z<2, 4>(F, g, m0, tid); else if (g == 1) pool_z<4, 4>(F, g, m0, tid); else if (g == 2) pool_z<8, 2>(F, g, m0, tid); else pool_z<16, 1>(F, g, m0, tid);
    } else {
        constexpr int UT_OFF = 128 * Z_LD * 2;
        static_assert(UT_OFF + 143 * Z_LD * 2 <= LDSCTL_OFF, "pool LDS");
        const bool seq0 = (m0 & 2047) == 0;
        const bf16* src = F.PROJ + (size_t)(m0 - 15) * NIN + C_POOL + 256 * g;
#pragma unroll
        for (int i = 0; i < 9; ++i) { const int ci = tid + 512 * i;
            if (ci < 143 * 32) { const int rw = ci >> 5, c8 = ci & 31; v4u v = (v4u){0u, 0u, 0u, 0u}; if (!(seq0 && rw < 15)) v = *(const v4u*)(src + (size_t)rw * NIN + 8 * c8);
                *(LAS v4u*)(L + UT_OFF + (rw * Z_LD + 8 * c8) * 2) = v; } }
        __syncthreads();
        const int W = 2 << g, c8 = tid & 31, j0 = (tid >> 5) * 8;
        const LAS unsigned char* up = L + UT_OFF + ((15 + j0) * Z_LD + 8 * c8) * 2;
        float sum[8], f[8], cur[8];
#pragma unroll
        for (int e = 0; e < 8; ++e) sum[e] = 0.f;
        for (int k = 1; k < W; ++k) { unpack8(*(const LAS v4u*)(up - k * Z_LD * 2), f);
#pragma unroll
            for (int e = 0; e < 8; ++e) sum[e] += f[e]; }
        const int t0 = (m0 & 2047) + j0;
#pragma unroll
        for (int j = 0; j < 8; ++j) {
            unpack8(*(const LAS v4u*)(up + j * Z_LD * 2), cur);
#pragma unroll
            for (int e = 0; e < 8; ++e) sum[e] += cur[e];
            const int t = t0 + j; const float ic = 1.0f / (float)(W < t + 1 ? W : t + 1);
#pragma unroll
            for (int e = 0; e < 8; ++e) f[e] = sum[e] * ic - cur[e];
            *(LAS v4u*)(L + ((j0 + j) * Z_LD + 8 * c8) * 2) = pack8(f);
            unpack8(*(const LAS v4u*)(up + (j + 1 - W) * Z_LD * 2), f);
#pragma unroll
            for (int e = 0; e < 8; ++e) sum[e] -= f[e];
        }
    }
    __syncthreads();
    f32x4 sc[4];
#pragma unroll
    for (int et = 0; et < 4; ++et) sc[et] = *(const f32x4*)(F.pool_scale + 512 * g + 64 * w + 16 * et + 4 * fq);
#pragma unroll 1
    for (int rt = 0; rt < 8; ++rt) {
        bf16x8 afr[8];
#pragma unroll
        for (int kk = 0; kk < 8; ++kk) afr[kk] = *(const LAS bf16x8*)(L + ((16 * rt + fr) * Z_LD + 32 * kk + 8 * fq) * 2);
        bf16* orow = F.AP + (size_t)(m0 + 16 * rt + fr) * D + 512 * g + 64 * w + 4 * fq;
#pragma unroll
        for (int et = 0; et < 4; ++et) {
            f32x4 acc = (f32x4){0.f, 0.f, 0.f, 0.f};
#pragma unroll
            for (int kk = 0; kk < 8; ++kk) acc = MFMA16(bfr[et][kk], afr[kk], acc);
            *(v2u*)(orow + 16 * et) = pack4(acc * sc[et]);
        }
    }
}
constexpr int N_CHAIN = 4 * 8 * NS, N_POOLU = (M / 128) * 4, N_SAMP = 128 * 8, N_P2 = N_CHAIN + N_POOLU + N_SAMP;
__device__ __forceinline__ void p2_mixers(Frame& F, int rep) {
    const int mode = rep >> 4, lo = mode == 2 ? N_CHAIN : (mode == 3 ? N_CHAIN + N_POOLU : 0), hi = mode == 1 ? N_CHAIN : (mode == 2 ? N_CHAIN + N_POOLU : N_P2);
    for (;;) {
        __syncthreads();
        if (F.tid == 0) F.MISC[0] = __hip_atomic_fetch_add(F.ctl + CW_Q2 + 64 * (rep & 15), 1u, RLX_AGENT);
        __syncthreads();
        const int u = (int)F.MISC[0] + lo;
        if (u >= hi) break;
        if (u < N_CHAIN) chain_unit(F, u);
        else if (u < N_CHAIN + N_POOLU) pool_unit(F, u - N_CHAIN);
        else sample_unit(F, u - N_CHAIN - N_POOLU);
    }
}

__device__ __forceinline__ float half_sum(float v) {
#pragma unroll
    for (int o = 1; o < 32; o <<= 1) v += __shfl_xor(v, o);
    return v;
}
__device__ __forceinline__ void p3_merge(Frame& F) {
    const int lane = F.lane, hl = lane >> 5, l32 = lane & 31;
    constexpr int NIT = M * 4;
    for (int it0 = 2 * F.gw; it0 < NIT; it0 += 2 * F.NGW) {
        v4u ov[2], gv[2], av[2], rv[2], pv[2]; int cc[2]; size_t mm[2];
#pragma unroll
        for (int u = 0; u < 2; ++u) {
            const int it = it0 + u, m = it >> 2, hp = it & 3, c = (2 * hp + hl) * DVH + 8 * l32; cc[u] = c; mm[u] = (size_t)m;
            const bf16* prow = F.PROJ + (size_t)m * NIN + c;
            ov[u] = __builtin_nontemporal_load((const v4u*)(F.OB + (size_t)m * D + c)); gv[u] = __builtin_nontemporal_load((const v4u*)(prow + C_GRET)); av[u] = __builtin_nontemporal_load((const v4u*)(prow + C_GA)); rv[u] = __builtin_nontemporal_load((const v4u*)(prow + C_GR)); pv[u] = __builtin_nontemporal_load((const v4u*)(F.AP + (size_t)m * D + c));
        }
#pragma unroll
        for (int u = 0; u < 2; ++u) {
            float o[8], g[8], ga[8], gr[8], ap[8], res[8];
            unpack8(ov[u], o); unpack8(gv[u], g); unpack8(av[u], ga); unpack8(rv[u], gr); unpack8(pv[u], ap);
            const f32x4 gn0 = *(const f32x4*)(F.gn_gain + cc[u]), gn1 = *(const f32x4*)(F.gn_gain + cc[u] + 4);
            const float gn[8] = {gn0.x, gn0.y, gn0.z, gn0.w, gn1.x, gn1.y, gn1.z, gn1.w};
            float sm = 0.f;
#pragma unroll
            for (int e = 0; e < 8; ++e) sm += o[e];
            const float mean = half_sum(sm) * (1.f / 256.f);
            float sq = 0.f;
#pragma unroll
            for (int e = 0; e < 8; ++e) { o[e] -= mean; sq += o[e] * o[e]; }
            const float rstd = 1.0f / sqrtf(half_sum(sq) * (1.f / 256.f) + EPS);
#pragma unroll
            for (int e = 0; e < 8; ++e) { const float r = g[e] * sigmoidf_(g[e]) * (o[e] * rstd * gn[e]); res[e] = sigmoidf_(ga[e]) * ap[e] + sigmoidf_(gr[e]) * r; }
            *(v4u*)(F.MM + mm[u] * D + cc[u]) = pack8(res);
        }
    }
    const int gt = blockIdx.x * 512 + F.tid, NT = F.G * 512;
    for (int idx = gt; idx < 4 * 15 * 1024; idx += NT) { const int c = idx & 1023, r = (idx >> 10) % 15, b = idx / (15 * 1024);
        F.out[O_POOLP + idx] = __uint_as_float((unsigned)F.PROJ[(size_t)(b * 2048 + 2033 + r) * NIN + C_POOL + c] << 16); }
    for (int idx = gt; idx < 128 * 15 * 1024; idx += NT) { const int c = idx & 1023, r = (idx >> 10) % 15, b = idx / (15 * 1024); const int e = 8 + r;
        F.out[O_POOLS + idx] = e < 15 ? F.state_pool[((size_t)b * 15 + e) * 1024 + c] : __uint_as_float((unsigned)F.PROJ[(size_t)(MP + b * 8 + e - 15) * NIN + C_POOL + c] << 16); }
}

__device__ __forceinline__ void p5_rows(Frame& F) {
    const int lane = F.lane;
    for (int m = F.gw; m < M; m += F.NGW) {
        const v4u* mo = (const v4u*)(F.MOB + (size_t)m * D) + lane; const f32x4* xr = (const f32x4*)xrow(F, m) + 2 * lane;
        const f32x4* g1 = (const f32x4*)F.g_post_mix + 2 * lane; const f32x4* g2 = (const f32x4*)F.g_pre_ffn + 2 * lane;
        v4u mv[4]; f32x4 x[4][2]; float v[4][8]; float s = 0.f;
#pragma unroll
        for (int j = 0; j < 4; ++j) { mv[j] = __builtin_nontemporal_load(mo + 64 * j); x[j][0] = __builtin_nontemporal_load(xr + 128 * j); x[j][1] = __builtin_nontemporal_load(xr + 128 * j + 1); }
#pragma unroll
        for (int j = 0; j < 4; ++j) { unpack8(mv[j], v[j]);
#pragma unroll
            for (int e = 0; e < 8; ++e) s += v[j][e] * v[j][e]; }
        const float rs = 1.0f / sqrtf(wave_sum(s) * (1.f / D) + EPS);
        float s2 = 0.f; v4u* yo = (v4u*)(F.X1B + (size_t)m * D) + lane;
#pragma unroll
        for (int j = 0; j < 4; ++j) {
            const f32x4 ga = g1[128 * j], gb = g1[128 * j + 1];
            x[j][0] = x[j][0] + (f32x4){v[j][0], v[j][1], v[j][2], v[j][3]} * rs * ga; x[j][1] = x[j][1] + (f32x4){v[j][4], v[j][5], v[j][6], v[j][7]} * rs * gb;
            { v4u o; o.x = pk2(x[j][0].x, x[j][0].y); o.y = pk2(x[j][0].z, x[j][0].w); o.z = pk2(x[j][1].x, x[j][1].y); o.w = pk2(x[j][1].z, x[j][1].w); yo[64 * j] = o; }
            s2 += (x[j][0].x * x[j][0].x + x[j][0].y * x[j][0].y) + (x[j][0].z * x[j][0].z + x[j][0].w * x[j][0].w) + (x[j][1].x * x[j][1].x + x[j][1].y * x[j][1].y) + (x[j][1].z * x[j][1].z + x[j][1].w * x[j][1].w);
        }
        const float rs2 = 1.0f / sqrtf(wave_sum(s2) * (1.f / D) + EPS);
        v4u* o8 = (v4u*)(F.XN + (size_t)m * D) + lane;
#pragma unroll
        for (int j = 0; j < 4; ++j) { const f32x4 ga = g2[128 * j], gb = g2[128 * j + 1]; const f32x4 a = x[j][0] * rs2 * ga, b2 = x[j][1] * rs2 * gb;
            v4u o; o.x = pk2(a.x, a.y); o.y = pk2(a.z, a.w); o.z = pk2(b2.x, b2.y); o.w = pk2(b2.z, b2.w); o8[64 * j] = o; }
    }
}
__device__ __forceinline__ void p9_rows(Frame& F, float* dst) {
    const int lane = F.lane;
    for (int m = F.gw; m < M; m += F.NGW) {
        const v4u* fo = (const v4u*)(F.MOB + (size_t)m * D) + lane; const v4u* yi = (const v4u*)(F.X1B + (size_t)m * D) + lane; f32x4* yo = (f32x4*)(dst + (size_t)m * D) + 2 * lane;
        const f32x4* g1 = (const f32x4*)F.g_post_ffn + 2 * lane;
        v4u mv[4]; f32x4 x[4][2]; float v[4][8]; float s = 0.f;
#pragma unroll
        for (int j = 0; j < 4; ++j) { mv[j] = __builtin_nontemporal_load(fo + 64 * j); const v4u xb = __builtin_nontemporal_load(yi + 64 * j); x[j][0] = (f32x4){bflo(xb.x), bfhi(xb.x), bflo(xb.y), bfhi(xb.y)}; x[j][1] = (f32x4){bflo(xb.z), bfhi(xb.z), bflo(xb.w), bfhi(xb.w)}; }
#pragma unroll
        for (int j = 0; j < 4; ++j) { unpack8(mv[j], v[j]);
#pragma unroll
            for (int e = 0; e < 8; ++e) s += v[j][e] * v[j][e]; }
        const float rs = 1.0f / sqrtf(wave_sum(s) * (1.f / D) + EPS);
#pragma unroll
        for (int j = 0; j < 4; ++j) { const f32x4 ga = g1[128 * j], gb = g1[128 * j + 1];
            __builtin_nontemporal_store(x[j][0] + (f32x4){v[j][0], v[j][1], v[j][2], v[j][3]} * rs * ga, yo + 128 * j); __builtin_nontemporal_store(x[j][1] + (f32x4){v[j][4], v[j][5], v[j][6], v[j][7]} * rs * gb, yo + 128 * j + 1); }
    }
}

__device__ __forceinline__ float gelu_tanh(float g) {
    const float u = (g * g) * (1.5957691216057308f * 0.044715f * 1.4426950408889634f) + (1.5957691216057308f * 1.4426950408889634f);
    return g * __builtin_amdgcn_rcpf(1.0f + __builtin_amdgcn_exp2f(-(g * u)));
}
__device__ __forceinline__ void ld8f(const float* p, float (&o)[8]) { const f32x4 a = *(const f32x4*)p, b = *(const f32x4*)(p + 4); o[0] = a.x; o[1] = a.y; o[2] = a.z; o[3] = a.w; o[4] = b.x; o[5] = b.y; o[6] = b.z; o[7] = b.w; }
__device__ __forceinline__ void p7_conv(Frame& F) {
    constexpr int NCG = FF / 8, NRB = M / 8, NIT = NRB * NCG;
    const int gt = blockIdx.x * 512 + F.tid, NT = F.G * 512;
    v4u rawv[10], rawg[10];
#define P7_LOAD(dv, dg, it_) do { const int rb_ = (it_) / NCG, f0_ = 8 * ((it_) - rb_ * NCG), m0_ = rb_ * 8; const bool z_ = (m0_ >= MP) || ((m0_ & 2047) == 0); \
        _Pragma("unroll") for (int r = 0; r < 10; ++r) { const int rr = (r < 2 && z_) ? 2 : r; const bf16* ur = F.UP + (size_t)(m0_ + rr - 2) * FF2; dv[r] = *(const v4u*)(ur + f0_); dg[r] = *(const v4u*)(ur + FF + f0_); } } while (0)
#pragma unroll 1
    for (int it = gt; it < NIT; it += NT) {
        const int rb = it / NCG, cg = it - rb * NCG, f0 = 8 * cg, m0 = rb * 8;
        const bool is_p = m0 < MP; const int t0 = is_p ? (m0 & 2047) : 0; const int sb = is_p ? 0 : (m0 - MP) >> 3;
        P7_LOAD(rawv, rawg, it);
        float hv[3][8], hg[3][8];
#pragma unroll
        for (int r = 0; r < 2; ++r) {
            if (t0 == 0) {
                if (is_p) {
#pragma unroll
                    for (int e = 0; e < 8; ++e) { hv[r + 1][e] = 0.f; hg[r + 1][e] = 0.f; }
                } else { const float* sc = F.state_conv + ((size_t)sb * 2 + r) * FF2; ld8f(sc + f0, hv[r + 1]); ld8f(sc + FF + f0, hg[r + 1]); }
            } else { unpack8(rawv[r], hv[r + 1]); unpack8(rawg[r], hg[r + 1]); }
        }
        float wv[3][8], wg[3][8], bv[8], bg[8];
#pragma unroll
        for (int j = 0; j < 3; ++j) { ld8f(F.conv_w + (size_t)j * FF2 + f0, wv[j]); ld8f(F.conv_w + (size_t)j * FF2 + FF + f0, wg[j]); }
        ld8f(F.conv_b + f0, bv); ld8f(F.conv_b + FF + f0, bg);
#pragma unroll
        for (int r = 0; r < 8; ++r) {
#pragma unroll
            for (int e = 0; e < 8; ++e) { hv[0][e] = hv[1][e]; hv[1][e] = hv[2][e]; hg[0][e] = hg[1][e]; hg[1][e] = hg[2][e]; }
            unpack8(rawv[r + 2], hv[2]); unpack8(rawg[r + 2], hg[2]);
            float a[8];
#pragma unroll
            for (int e = 0; e < 8; ++e) { const float val = bv[e] + wv[0][e] * hv[0][e] + wv[1][e] * hv[1][e] + wv[2][e] * hv[2][e], gate = bg[e] + wg[0][e] * hg[0][e] + wg[1][e] * hg[1][e] + wg[2][e] * hg[2][e]; a[e] = gelu_tanh(gate) * val; }
            *(v4u*)(F.ACT + (size_t)(m0 + r) * FF + f0) = pack8(a);
            if (r >= 6) {
                float* o = nullptr;
                if (is_p) { if (t0 == 2040) o = F.out + O_CONVP + ((size_t)(m0 >> 11) * 2 + (r - 6)) * FF2; } else o = F.out + O_CONVS + ((size_t)sb * 2 + (r - 6)) * FF2;
                if (o) { *(f32x4*)(o + f0) = (f32x4){hv[2][0], hv[2][1], hv[2][2], hv[2][3]}; *(f32x4*)(o + f0 + 4) = (f32x4){hv[2][4], hv[2][5], hv[2][6], hv[2][7]};
                    *(f32x4*)(o + FF + f0) = (f32x4){hg[2][0], hg[2][1], hg[2][2], hg[2][3]}; *(f32x4*)(o + FF + f0 + 4) = (f32x4){hg[2][4], hg[2][5], hg[2][6], hg[2][7]}; }
            }
        }
    }
#undef P7_LOAD
}

struct Args { const float* in[18]; float* out; unsigned char* ws; int ph_lo, ph_hi, li, pad; };
template <int LO, int HI> __global__ void __launch_bounds__(NWAVES * 64, 2) skel_fwd(Args args) {
    extern __shared__ __attribute__((aligned(16))) unsigned char lds[];
    Frame F;
    F.lds = (LAS unsigned char*)lds;
    F.MISC = (volatile LAS unsigned*)(F.lds + LDSCTL_OFF);
    F.tid = threadIdx.x; F.lane = F.tid & 63; F.wave = __builtin_amdgcn_readfirstlane(F.tid >> 6);
    F.G = gridDim.x; F.gw = blockIdx.x * NWAVES + F.wave; F.NGW = F.G * NWAVES;
    unsigned char* ws = args.ws;
    F.ctl = (unsigned*)(ws + WS_CTL);
    F.xp = args.in[0]; F.xs = args.in[1]; F.state_pool = args.in[2]; F.state_ret = args.in[3]; F.state_conv = args.in[4]; F.g_pre_mix = args.in[5]; F.w_in = args.in[6]; F.w_pool = args.in[7];
    F.pool_scale = args.in[8]; F.gn_gain = args.in[9]; F.w_out = args.in[10]; F.g_post_mix = args.in[11]; F.g_pre_ffn = args.in[12]; F.w_up = args.in[13]; F.conv_w = args.in[14]; F.conv_b = args.in[15];
    F.w_down = args.in[16]; F.g_post_ffn = args.in[17]; F.out = args.out;
    F.WIN = (bf16*)(ws + WS_WIN); F.WUP = (bf16*)(ws + WS_WUP); F.WDN = (bf16*)(ws + WS_WDN); F.WOUT = (bf16*)(ws + WS_WOUT); F.WPOOL = (bf16*)(ws + WS_WPOOL);
    F.ROPE_C = (float*)(ws + WS_ROPE); F.ROPE_S = F.ROPE_C + 2056 * 64;
    F.XN = (bf16*)(ws + WS_XN); F.PROJ = (bf16*)(ws + WS_PROJ); F.UP = (bf16*)(ws + WS_PROJ); F.MOB = (bf16*)(ws + WS_PROJ);
    F.SP16 = (bf16*)(ws + WS_SP16); F.X1B = (bf16*)(ws + WS_X1);
    F.OB = (bf16*)(ws + WS_O); F.AP = (bf16*)(ws + WS_AP); F.MM = (bf16*)(ws + WS_MM); F.ACT = (bf16*)(ws + WS_O);
    for (int u = F.tid; u < (LDS_BYTES - LDSCTL_OFF) / 4; u += NWAVES * 64) ((LAS unsigned*)(F.lds + LDSCTL_OFF))[u] = 0u;
    __syncthreads();
    XcdBarrier bar; bar.bar = F.ctl + CW_BAR; bar.x = 0; bar.st = nullptr;
    if (N_LAUNCHES == 1) bar = xcd_barrier_post(F.ctl + CW_BAR, F.MISC + 8);
#define GRID_BAR() do { if (N_LAUNCHES == 1) xcd_barrier(bar); } while (0)
#define IN(k) (LO <= (k) && (k) < HI)
#define FRESH() do { int t_ = threadIdx.x; asm volatile("" : "+v"(t_)); F.tid = t_; F.lane = t_ & 63; } while (0)
#define SEAM(k) do { if constexpr (IN(k) && IN((k) + 1)) GRID_BAR(); } while (0)

#define REPS(k)
#define DUPBAR(k)
    const int rep = args.li;
    if constexpr (IN(0)) { FRESH(); REPS(0) { p0_prologue(F); DUPBAR(0); } SEAM(0); }
    if constexpr (IN(1)) {
      REPS(1) {
        pg8::Gemm g{F.XN, F.WIN, M, NIN, D}; pg8::HybridOrder S; S.init(M, NIN, D, F.G, (int)blockIdx.x, false);
        EpiProj E{F.PROJ, F.ROPE_C, F.ROPE_S}; pg8::SplitCtx X{(float*)(ws + WS_SLAB_A), F.ctl + CW_SPLIT};
        pg8::gemm_phase<EpiProj, pg8::HybridOrder, true, PG8_SP2, 5>(F.lds, g, S, E, X);
        if (rep == 0) { FRESH(); p0_deferred_weights(F, (LAS float*)(F.lds + F.wave * 16384)); }
        DUPBAR(1);
      }
        SEAM(1);
    }
    if constexpr (IN(2)) { FRESH(); REPS(2) { p2_mixers(F, rep); DUPBAR(2); } SEAM(2); }
    if constexpr (IN(3)) { FRESH(); REPS(3) { p3_merge(F); DUPBAR(3); } SEAM(3); }
    if constexpr (IN(4)) {
      REPS(4) {
        pg8::Gemm g{F.MM, F.WOUT, M, D, D}; pg8::HybridOrder S; S.init(M, D, D, F.G, (int)blockIdx.x);
        pg8::EpiBf16<0> E{F.MOB, D}; pg8::SplitCtx X{(float*)(ws + WS_SLAB_A), F.ctl + CW_SPLIT + 4096};
        pg8::gemm_phase<pg8::EpiBf16<0>, pg8::HybridOrder, true, PG8_SP2, 8>(F.lds, g, S, E, X);
        DUPBAR(4);
      }
        SEAM(4);
    }
    if constexpr (IN(5)) { FRESH(); REPS(5) { p5_rows(F); DUPBAR(5); } SEAM(5); }
    if constexpr (IN(6)) {
      REPS(6) {
        pg8::Gemm g{F.XN, F.WUP, M, FF2, D}; pg8::HybridOrder S; S.init(M, FF2, D, F.G, (int)blockIdx.x);
        pg8::EpiBf16<0> E{F.UP, FF2}; pg8::SplitCtx X{(float*)(ws + WS_SLAB_A), F.ctl + CW_SPLIT + 2 * 4096};
        pg8::gemm_phase<pg8::EpiBf16<0>, pg8::HybridOrder, true, PG8_SP2, 5>(F.lds, g, S, E, X);
        DUPBAR(6);
      }
        SEAM(6);
    }
    if constexpr (IN(7)) { FRESH(); REPS(7) { p7_conv(F); DUPBAR(7); } SEAM(7); }
    if constexpr (IN(8)) {
      REPS(8) {
        pg8::Gemm g{F.ACT, F.WDN, M, D, FF}; pg8::HybridOrder S; S.init(M, D, FF, F.G, (int)blockIdx.x);
        pg8::EpiBf16<0> E{F.MOB, D}; pg8::SplitCtx X{(float*)(ws + WS_SLAB_B), F.ctl + CW_SPLIT + 3 * 4096};
        pg8::gemm_phase<pg8::EpiBf16<0>, pg8::HybridOrder, true, PG8_SP2, 8>(F.lds, g, S, E, X);
        DUPBAR(8);
      }
        SEAM(8);
    }
    if constexpr (IN(9)) { FRESH(); p9_rows(F, (DUP_PHASE == 9 && rep == 1) ? (float*)(ws + WS_O) : F.out + O_Y); }
#undef IN
#undef SEAM
}


#if MK_N_LAUNCHES != 1
template <int P> static void launch_one(int grid, const Args& a, hipStream_t stream) { hipLaunchKernelGGL((skel_fwd<P, P + 1>), dim3(grid), dim3(NWAVES * 64), LDS_BYTES, stream, a); }
static void launch_phase(int li, int grid, const Args& a, hipStream_t stream) {
    switch (li) { case 0: launch_one<0>(grid, a, stream); break; case 1: launch_one<1>(grid, a, stream); break; case 2: launch_one<2>(grid, a, stream); break; case 3: launch_one<3>(grid, a, stream); break;
        case 4: launch_one<4>(grid, a, stream); break; case 5: launch_one<5>(grid, a, stream); break; case 6: launch_one<6>(grid, a, stream); break; case 7: launch_one<7>(grid, a, stream); break;
        case 8: launch_one<8>(grid, a, stream); break; default: launch_one<9>(grid, a, stream); break; }
}
#endif
static hipError_t set_lds_attr() {
    hipError_t e = hipSuccess;
#if MK_N_LAUNCHES == 1
    e = hipFuncSetAttribute((const void*)skel_fwd<0, N_PHASES>, hipFuncAttributeMaxDynamicSharedMemorySize, LDS_BYTES);
#else
#define SET1(P) if (e == hipSuccess) e = hipFuncSetAttribute((const void*)skel_fwd<P, P + 1>, hipFuncAttributeMaxDynamicSharedMemorySize, LDS_BYTES)
    SET1(0); SET1(1); SET1(2); SET1(3); SET1(4); SET1(5); SET1(6); SET1(7); SET1(8); SET1(9);
#undef SET1
#endif
    return e;
}
static hipError_t occ_query(int* per_cu) {
#if MK_N_LAUNCHES == 1
    return hipOccupancyMaxActiveBlocksPerMultiprocessor(per_cu, (const void*)skel_fwd<0, N_PHASES>, NWAVES * 64, LDS_BYTES);
#else
    return hipOccupancyMaxActiveBlocksPerMultiprocessor(per_cu, (const void*)skel_fwd<1, 2>, NWAVES * 64, LDS_BYTES);
#endif
}
extern "C" void kernel_launch(void* const* d_in, const int* in_sizes, int n_in, void* d_out, int out_size, void* d_ws, size_t ws_size, hipStream_t stream) {
    static int grid = 0;
    if (grid == 0) {
        if (n_in != 18 || (size_t)out_size != O_END || ws_size < WS_END) { fprintf(stderr, "kernel_launch: unexpected shapes: n_in %d out %d ws %zu (need %zu)\n", n_in, out_size, ws_size, (size_t)WS_END); grid = -1; return; }
        int dev = 0, cus = 0, per_cu = 0;
        if (hipGetDevice(&dev) != hipSuccess || hipDeviceGetAttribute(&cus, hipDeviceAttributeMultiprocessorCount, dev) != hipSuccess) { grid = -1; return; }
        if (set_lds_attr() != hipSuccess) { fprintf(stderr, "kernel_launch: hipFuncSetAttribute failed\n"); grid = -1; return; }
        if (occ_query(&per_cu) != hipSuccess || per_cu < 1) { fprintf(stderr, "kernel_launch: occupancy query says %d blocks per CU\n", per_cu); (void)hipGetLastError(); per_cu = 1; }
        grid = cus;
        fprintf(stderr, "kernel_launch: cus %d per_cu %d grid %d ws %zu\n", cus, per_cu, grid, ws_size);
    }
    if (grid < 0) return;
    (void)hipMemsetAsync((char*)d_ws + WS_CTL, 0, CTL_ZERO_BYTES, stream);
    Args a{};
    for (int i = 0; i < 18; ++i) a.in[i] = (const float*)d_in[i];
    a.out = (float*)d_out; a.ws = (unsigned char*)d_ws;
#if MK_N_LAUNCHES == 1
    {
        a.ph_lo = 0; a.ph_hi = N_PHASES; a.li = 0;
        void* kargs[] = {&a};
        hipError_t e = hipLaunchCooperativeKernel((const void*)skel_fwd<0, N_PHASES>, dim3(grid), dim3(NWAVES * 64), kargs, LDS_BYTES, stream);
        if (e != hipSuccess) fprintf(stderr, "kernel_launch: cooperative launch failed: %s (grid %d)\n", hipGetErrorString(e), grid);
    }
#else
    for (int li = 0; li < N_PHASES; ++li) { a.ph_lo = li; a.ph_hi = li + 1; a.li = 0; launch_phase(li, grid, a, stream); if (li == DUP_PHASE) { a.li = 1; launch_phase(li, grid, a, stream); if (li == 9) { a.li = 0; } } if (li == 2 && DUP_PHASE >= 20) { a.li = 1 + 16 * (DUP_PHASE - 20); launch_phase(li, grid, a, stream); } }
#endif
}
```

```cpp
#include <hip/hip_runtime.h>
#include <cstdio>
#include <cstdint>
namespace pg8 {
#define PG8_LAS __attribute__((address_space(3)))
typedef unsigned short bf16_t;
typedef short bf16x8 __attribute__((ext_vector_type(8)));
typedef float f32x4 __attribute__((ext_vector_type(4)));
typedef unsigned u32x4 __attribute__((ext_vector_type(4)));
constexpr int BM = 256, BK = 64, HALF = 128, HTB = HALF * BK * 2  , STAGE_BYTES = 8 * HTB, NXCD = 8, WGM = 2;

__host__ __device__ __forceinline__ int lds_byte(int r, int c) { const int st = (r >> 4) * 2 + (c >> 5), rr = r & 15, cc = c & 31, ob = rr * 64 + cc * 2; return st * 1024 + (ob ^ (((ob >> 9) & 1) << 5)); }
__host__ __device__ __forceinline__ void stage_rc(int b, int& R, int& C) { const int st = b / 1024, sb = b % 1024, swz = sb ^ (((sb >> 9) & 1) << 5); R = (st >> 1) * 16 + swz / 64; C = (st & 1) * 32 + (swz % 64) / 2; }
__host__ __device__ __forceinline__ int perm32(int rho) { const int n = rho >> 4, i = rho & 15; return 8 * (i >> 2) + 4 * n + (i & 3); }

struct Unit { int pm, pn, k0, nt, np, piece, slot; };
struct Gemm { const bf16_t* A; const bf16_t* Bt; int M, N, K; };

struct StaticOrder {
    int nM, nN, nwg, G, c;
    __host__ __device__ void init(int M, int N, int G_, int c_) { nM = M / BM; nN = N / BM; nwg = nM * nN; G = G_; c = c_; }
    __host__ __device__ bool next(int i, Unit& u) const {
        const long L = (long)i * G + c; if (L >= nwg) return false;
        int wgid = (int)L;
#ifndef ORDER_NOREMAP
        { const int q = nwg / NXCD, r = nwg % NXCD, xcd = wgid % NXCD, off = wgid / NXCD; wgid = (xcd < r ? xcd * (q + 1) : r * (q + 1) + (xcd - r) * q) + off; }
#endif
        const int nig = WGM * nN, gid = wgid / nig, fm = gid * WGM, gsz = (nM - fm) < WGM ? (nM - fm) : WGM;
        u.pm = fm + ((wgid % nig) % gsz); u.pn = (wgid % nig) / gsz; return true;
    }
    __device__ __forceinline__ void a_ready(const Unit&) const {}
    __device__ __forceinline__ void done(const Unit&) const {}
};


struct HybridOrder {
    int nM, nN, nwg, G, c, ntk, nfull, nrem, np;
    __host__ __device__ void init(int M, int N, int K, int G_, int c_, bool allow_split = true) {
        nM = M / BM; nN = N / BM; nwg = nM * nN; G = G_; c = c_; ntk = K / BK; nfull = nwg / G; nrem = nwg - nfull * G; np = 0;
        if (allow_split && nrem > 0 && (G % NXCD) == 0) { const int grp = (nrem + NXCD - 1) / NXCD; int p = (G / NXCD) / grp; const int maxp = ntk / 4; if (p > maxp) p = maxp; if (p > 8) p = 8; if (p >= 2) np = p; }
    }
    __host__ __device__ void map(long L, Unit& u) const {
        int wgid = (int)L;
#ifndef ORDER_NOREMAP
        { const int q = nwg / NXCD, r = nwg % NXCD, xcd = wgid % NXCD, off = wgid / NXCD; wgid = (xcd < r ? xcd * (q + 1) : r * (q + 1) + (xcd - r) * q) + off; }
#endif
        const int nig = WGM * nN, gid = wgid / nig, fm = gid * WGM, gsz = (nM - fm) < WGM ? (nM - fm) : WGM;
        u.pm = fm + ((wgid % nig) % gsz); u.pn = (wgid % nig) / gsz; u.k0 = 0; u.nt = ntk; u.np = 0; u.piece = 0; u.slot = 0;
    }
    __host__ __device__ bool next(int i, Unit& u) const {
        if (i < nfull) { map((long)i * G + c, u); return true; }
        if (i > nfull || nrem == 0) return false;
        if (np == 0) { if (c >= nrem) return false; map((long)nfull * G + c, u); return true; }
        const int x = c % NXCD, j = c / NXCD, grp = j / np, p = j - grp * np, r = grp * NXCD + x;
        if (r >= nrem) return false;
        map((long)nfull * G + r, u);
        const int pairs = ntk / 2, base = pairs / np, extra = pairs - base * np, first_big = np - extra;
        const int start = p * base + (p > first_big ? p - first_big : 0), len = base + (p >= first_big ? 1 : 0);
        u.k0 = 2 * start; u.nt = 2 * len; u.np = np; u.piece = p; u.slot = r; return true;
    }
    __device__ __forceinline__ void a_ready(const Unit&) const {}
    __device__ __forceinline__ void done(const Unit&) const {}
};
struct SplitCtx { float* slabs; unsigned* cnt; };

__device__ __forceinline__ unsigned cvt_pk_bf16(float lo, float hi) { unsigned r; asm volatile("v_cvt_pk_bf16_f32 %0, %1, %2" : "=v"(r) : "v"(lo), "v"(hi)); return r; }
typedef float f32x2 __attribute__((ext_vector_type(2)));
__device__ __forceinline__ f32x2 gelu_pk(f32x2 v) {
    const f32x2 av = __builtin_elementwise_abs(v), d = av * 0.2316418882f + 1.0f;
    f32x2 t; t.x = __builtin_amdgcn_rcpf(d.x); t.y = __builtin_amdgcn_rcpf(d.y);
    f32x2 q = t * 0.5307027145f + (-0.7265760135f); q = q * t + 0.7107068705f; q = q * t + (-0.142248368f); q = q * t + 0.127414796f; q = q * t;
    const f32x2 s = (v * v) * (-0.72134752044f);
    f32x2 e; e.x = __builtin_amdgcn_exp2f(s.x); e.y = __builtin_amdgcn_exp2f(s.y);
    const f32x2 m = v * (q * e), r = v - m;
    f32x2 o; o.x = v.x < 0.f ? m.x : r.x; o.y = v.y < 0.f ? m.y : r.y; return o;
}

template <int ACT> struct EpiBf16 {
    static constexpr bool PERM = true, AFTER_DRAIN = false;
    bf16_t* O; int ldc;
    __device__ __forceinline__ void tri(const f32x4 v0, const f32x4 v1, const Unit& u, int ai, int bj, int m, int wr, int wc, int fr, int fq) const {
        bf16_t* p = O + (size_t)(u.pm * BM + ai * HALF + wr * 64 + m * 16 + fr) * ldc + u.pn * BM + bj * HALF + wc * 32 + 8 * fq;
        u32x4 w; w.x = cvt_pk_bf16(v0[0], v0[1]); w.y = cvt_pk_bf16(v0[2], v0[3]); w.z = cvt_pk_bf16(v1[0], v1[1]); w.w = cvt_pk_bf16(v1[2], v1[3]);
        *(u32x4*)p = w;
    }
    __device__ __forceinline__ void operator()(const f32x4 (&acc)[2][2][4][2], const Unit& u, int wr, int wc, int fr, int fq) const {
#pragma unroll
        for (int ai = 0; ai < 2; ++ai)
#pragma unroll
            for (int m = 0; m < 4; ++m)
#pragma unroll
                for (int bj = 0; bj < 2; ++bj) tri(acc[ai][bj][m][0], acc[ai][bj][m][1], u, ai, bj, m, wr, wc, fr, fq);
    }
};
struct EpiF32 {
    static constexpr bool PERM = false, AFTER_DRAIN = false;
    float* C; int ldc;
    __device__ __forceinline__ void tri(const f32x4 v0, const f32x4 v1, const Unit& u, int ai, int bj, int m, int wr, int wc, int fr, int fq) const {
        float* p = C + (size_t)(u.pm * BM + ai * HALF + wr * 64 + m * 16 + fr) * ldc + u.pn * BM + bj * HALF + wc * 32 + 4 * fq;
        *(f32x4*)p = v0; *(f32x4*)(p + 16) = v1;
    }
    __device__ __forceinline__ void operator()(const f32x4 (&acc)[2][2][4][2], const Unit& u, int wr, int wc, int fr, int fq) const {
#pragma unroll
        for (int ai = 0; ai < 2; ++ai)
#pragma unroll
            for (int m = 0; m < 4; ++m)
#pragma unroll
                for (int bj = 0; bj < 2; ++bj) tri(acc[ai][bj][m][0], acc[ai][bj][m][1], u, ai, bj, m, wr, wc, fr, fq);
    }
};
typedef unsigned u32x2 __attribute__((ext_vector_type(2)));
__device__ __forceinline__ f32x4 bf4_to_f32(u32x2 x) { f32x4 o; o[0] = __builtin_bit_cast(float, x.x << 16); o[1] = __builtin_bit_cast(float, x.x & 0xffff0000u); o[2] = __builtin_bit_cast(float, x.y << 16); o[3] = __builtin_bit_cast(float, x.y & 0xffff0000u); return o; }
template <int NP, class Epi> __device__ __forceinline__ void split_epilogue(const f32x4 (&acc)[2][2][4][2], const Unit& u, const Epi& E, const SplitCtx& X, int tid, int wr, int wc, int fr, int fq) {
    constexpr int SLAB = 32 * 512 * 8;
    const __amdgpu_buffer_rsrc_t rs = __builtin_amdgcn_make_buffer_rsrc((void*)((char*)X.slabs + (size_t)(u.slot * u.np) * SLAB), 0, u.np * SLAB, 0x00020000);
    {
        const int so = u.piece * SLAB;
#pragma unroll
        for (int r = 0; r < 32; ++r) { const f32x4 v = acc[r >> 4][(r >> 3) & 1][(r >> 1) & 3][r & 1]; u32x2 w; w.x = cvt_pk_bf16(v[0], v[1]); w.y = cvt_pk_bf16(v[2], v[3]);
            __builtin_amdgcn_raw_buffer_store_b64(w, rs, (unsigned)(tid * 8), so + r * 4096, 16); }
    }
    asm volatile("s_waitcnt vmcnt(0)" ::: "memory");
    asm volatile("" ::: "memory"); __builtin_amdgcn_s_barrier(); asm volatile("" ::: "memory");
    if (tid == 0) {
        unsigned* cw = X.cnt + 64 * u.slot;
        (void)__hip_atomic_fetch_add(cw, 1u, __ATOMIC_RELAXED, __HIP_MEMORY_SCOPE_AGENT);
        unsigned sp = 0;
        while (__hip_atomic_load(cw, __ATOMIC_RELAXED, __HIP_MEMORY_SCOPE_AGENT) < (unsigned)u.np) { __builtin_amdgcn_s_sleep(1); if (++sp > (1u << 24)) break; }
        __builtin_amdgcn_fence(__ATOMIC_ACQUIRE, "agent");
        asm volatile("s_waitcnt vmcnt(0)" ::: "memory");
    }
    asm volatile("" ::: "memory"); __builtin_amdgcn_s_barrier(); asm volatile("" ::: "memory");
    const int q0 = (16 * u.piece) / u.np, q1 = (16 * (u.piece + 1)) / u.np;
#pragma unroll 1
    for (int q = q0; q < q1; ++q) {
        const unsigned vo = (unsigned)(tid * 8 + q * 8192);
        f32x4 v0 = (f32x4){0.f, 0.f, 0.f, 0.f}, v1 = v0;
        if (u.np == NP) {
            u32x2 t0[NP], t1[NP];
#pragma unroll
            for (int pp = 0; pp < NP; ++pp) { t0[pp] = __builtin_amdgcn_raw_buffer_load_b64(rs, vo, pp * SLAB, 0); t1[pp] = __builtin_amdgcn_raw_buffer_load_b64(rs, vo, pp * SLAB + 4096, 0); }
#pragma unroll
            for (int pp = 0; pp < NP; ++pp) { v0 += bf4_to_f32(t0[pp]); v1 += bf4_to_f32(t1[pp]); }
        } else {
            for (int pp = 0; pp < u.np; ++pp) { v0 += bf4_to_f32(__builtin_amdgcn_raw_buffer_load_b64(rs, vo, pp * SLAB, 0)); v1 += bf4_to_f32(__builtin_amdgcn_raw_buffer_load_b64(rs, vo, pp * SLAB + 4096, 0)); }
        }
        E.tri(v0, v1, u, q >> 3, (q >> 2) & 1, q & 3, wr, wc, fr, fq);
    }
}
template <class Epi, class Sched, bool ALIGN_EPI = false, bool SP2 = false, int NP = 8>
__device__ __forceinline__ void gemm_phase(PG8_LAS unsigned char* lds, const Gemm g, const Sched& S, const Epi& E, const SplitCtx& X) {
    int tid_ = threadIdx.x; asm volatile("" : "+v"(tid_));
    const int tid = tid_, wid = __builtin_amdgcn_readfirstlane(tid >> 6), lane = tid & 63, wr = wid >> 2, wc = wid & 3, fr = lane & 15, fq = lane >> 4;
    const int K = g.K;
    unsigned voffA[2], voffB[2];
#pragma unroll
    for (int i = 0; i < 2; ++i) { int R, C; stage_rc(tid * 16 + i * 8192, R, C); const int Rb = Epi::PERM ? ((R & ~31) + perm32(R & 31)) : R;
        voffA[i] = (unsigned)(R * K + C) * 2u; voffB[i] = (unsigned)(Rb * K + C) * 2u; }
    const size_t kstep = (size_t)(BK * 2);
    const size_t hstep = (size_t)HALF * K * 2;
    const size_t tstep = 2 * hstep;
    const unsigned ldsw = (unsigned)wid * 1024u;
    const int aoff = lds_byte(wr * 64 + fr, fq * 8), boff = lds_byte(wc * 32 + fr, fq * 8);
#define PG8_SA(b, h) (((b) * 2 + (h)) * HTB)
#define PG8_SB(b, h) ((4 + (b) * 2 + (h)) * HTB)
#define PG8_STAGE(bufoff, gbase, voff) do { _Pragma("unroll") for (int _i = 0; _i < 2; ++_i) \
        __builtin_amdgcn_global_load_lds((const unsigned*)((const char*)(gbase) + (voff)[_i]), (PG8_LAS unsigned*)(lds + (bufoff) + ldsw + _i * 8192), 16, 0, 0); } while (0)
#define PG8_LDA(dst, b, h) do { _Pragma("unroll") for (int m = 0; m < 4; ++m) _Pragma("unroll") for (int k = 0; k < 2; ++k) dst[m][k] = *(const PG8_LAS bf16x8*)(lds + PG8_SA(b, h) + aoff + m * 2048 + k * 1024); } while (0)
#define PG8_LDB(dst, b, h) do { _Pragma("unroll") for (int n = 0; n < 2; ++n) _Pragma("unroll") for (int k = 0; k < 2; ++k) dst[n][k] = *(const PG8_LAS bf16x8*)(lds + PG8_SB(b, h) + boff + n * 2048 + k * 1024); } while (0)
#define PG8_MMA(ai, bj, At, Bt) do { __builtin_amdgcn_s_setprio(1); _Pragma("unroll") for (int m = 0; m < 4; ++m) _Pragma("unroll") for (int n = 0; n < 2; ++n) _Pragma("unroll") for (int k = 0; k < 2; ++k) \
        acc[ai][bj][m][n] = __builtin_amdgcn_mfma_f32_16x16x32_bf16(Bt[n][k], At[m][k], acc[ai][bj][m][n], 0, 0, 0); __builtin_amdgcn_s_setprio(0); } while (0)
#define PG8_WAIT_V(n) asm volatile("s_waitcnt vmcnt(" #n ")" ::: "memory")
#define PG8_WAIT_L(n) asm volatile("s_waitcnt lgkmcnt(" #n ")" ::: "memory")
#define PG8_BAR __builtin_amdgcn_s_barrier()
#define PG8_SCHED __builtin_amdgcn_sched_barrier(0)
    Unit cur, nxt; int ui = 0;
    if (!S.next(0, cur)) return;
    f32x4 acc[2][2][4][2];
#pragma unroll
    for (int a = 0; a < 2; ++a)
#pragma unroll
        for (int b = 0; b < 2; ++b)
#pragma unroll
            for (int m = 0; m < 4; ++m)
#pragma unroll
                for (int n = 0; n < 2; ++n) acc[a][b][m][n] = (f32x4){0.f, 0.f, 0.f, 0.f};
    bf16x8 At[4][2], B0[2][2], B1[2][2];
    const char* cA = (const char*)g.A + (size_t)cur.pm * tstep + (size_t)cur.k0 * kstep; const char* cB = (const char*)g.Bt + (size_t)cur.pn * tstep + (size_t)cur.k0 * kstep;
    S.a_ready(cur);
    if constexpr (SP2) {
        PG8_STAGE(PG8_SB(0, 0), cB, voffB); PG8_STAGE(PG8_SB(0, 1), cB + hstep, voffB); PG8_STAGE(PG8_SA(0, 0), cA, voffA); PG8_STAGE(PG8_SA(0, 1), cA + hstep, voffA);
        if (wr == 1) PG8_BAR;
        PG8_WAIT_V(2); PG8_BAR;
        PG8_STAGE(PG8_SB(1, 0), cB + kstep, voffB); PG8_STAGE(PG8_SA(1, 0), cA + kstep, voffA); PG8_STAGE(PG8_SB(1, 1), cB + hstep + kstep, voffB);
        PG8_WAIT_V(6); PG8_BAR;
    } else {
        PG8_STAGE(PG8_SB(0, 0), cB, voffB); PG8_STAGE(PG8_SA(0, 0), cA, voffA); PG8_STAGE(PG8_SB(0, 1), cB + hstep, voffB); PG8_STAGE(PG8_SA(0, 1), cA + hstep, voffA);
        if (wr == 1) PG8_BAR;
        PG8_WAIT_V(4); PG8_BAR;
        PG8_STAGE(PG8_SB(1, 0), cB + kstep, voffB); PG8_STAGE(PG8_SA(1, 0), cA + kstep, voffA); PG8_STAGE(PG8_SB(1, 1), cB + hstep + kstep, voffB);
        PG8_WAIT_V(6); PG8_BAR;
    }
    for (;;) {
        const bool has_next = S.next(ui + 1, nxt);
        const char* nA = has_next ? (const char*)g.A + (size_t)nxt.pm * tstep + (size_t)nxt.k0 * kstep : cA; const char* nB = has_next ? (const char*)g.Bt + (size_t)nxt.pn * tstep + (size_t)nxt.k0 * kstep : cB;
        const int nt = cur.nt;
        for (int t = 0; t < nt; t += 2) {
            const bool last = (t == nt - 2);
            const char* a1 = cA + (size_t)(t + 1) * kstep;
            const char* a2 = last ? nA : cA + (size_t)(t + 2) * kstep; const char* b2 = last ? nB : cB + (size_t)(t + 2) * kstep;
            const char* a3 = a2 + kstep; const char* b3 = b2 + kstep;
            if (last && has_next) S.a_ready(nxt);
            if constexpr (SP2) {
            PG8_LDB(B0, 0, 0); PG8_LDB(B1, 0, 1); PG8_SCHED; PG8_LDA(At, 0, 0); PG8_STAGE(PG8_SA(1, 1), a1 + hstep, voffA);
            PG8_WAIT_V(8); PG8_WAIT_L(0); PG8_BAR; PG8_MMA(0, 0, At, B0); PG8_MMA(0, 1, At, B1); PG8_BAR; PG8_SCHED;
            PG8_LDA(At, 0, 1); PG8_STAGE(PG8_SB(0, 0), b2, voffB); PG8_STAGE(PG8_SB(0, 1), b2 + hstep, voffB); PG8_STAGE(PG8_SA(0, 0), a2, voffA);
            PG8_WAIT_V(8); PG8_WAIT_L(0); PG8_BAR; PG8_MMA(1, 0, At, B0); PG8_MMA(1, 1, At, B1); PG8_BAR; PG8_SCHED;
            PG8_LDB(B0, 1, 0); PG8_LDB(B1, 1, 1); PG8_SCHED; PG8_LDA(At, 1, 0); PG8_STAGE(PG8_SA(0, 1), a2 + hstep, voffA);
            PG8_WAIT_V(8); PG8_WAIT_L(0); PG8_BAR; PG8_MMA(0, 0, At, B0); PG8_MMA(0, 1, At, B1); PG8_BAR; PG8_SCHED;
            PG8_LDA(At, 1, 1); PG8_STAGE(PG8_SB(1, 0), b3, voffB); PG8_STAGE(PG8_SB(1, 1), b3 + hstep, voffB); PG8_STAGE(PG8_SA(1, 0), a3, voffA);
            PG8_WAIT_V(8); PG8_WAIT_L(0); PG8_BAR; PG8_MMA(1, 0, At, B0); PG8_MMA(1, 1, At, B1); PG8_BAR; PG8_SCHED;
            } else {
            PG8_LDB(B0, 0, 0); PG8_SCHED; PG8_LDA(At, 0, 0); PG8_STAGE(PG8_SA(1, 1), a1 + hstep, voffA);
            PG8_WAIT_L(8); PG8_BAR; PG8_WAIT_L(0); PG8_MMA(0, 0, At, B0); PG8_BAR; PG8_SCHED;
            PG8_LDB(B1, 0, 1); PG8_STAGE(PG8_SB(0, 0), b2, voffB);
            PG8_BAR; PG8_WAIT_L(0); PG8_MMA(0, 1, At, B1); PG8_BAR;
            PG8_LDA(At, 0, 1); PG8_STAGE(PG8_SA(0, 0), a2, voffA);
            PG8_BAR; PG8_WAIT_L(0); PG8_MMA(1, 0, At, B0); PG8_BAR; PG8_SCHED;
            PG8_STAGE(PG8_SB(0, 1), b2 + hstep, voffB);
            PG8_WAIT_V(6); PG8_BAR; PG8_MMA(1, 1, At, B1); PG8_BAR;
            PG8_LDB(B0, 1, 0); PG8_SCHED; PG8_LDA(At, 1, 0); PG8_STAGE(PG8_SA(0, 1), a2 + hstep, voffA);
            PG8_WAIT_L(8); PG8_BAR; PG8_WAIT_L(0); PG8_MMA(0, 0, At, B0); PG8_BAR; PG8_SCHED;
            PG8_LDB(B1, 1, 1); PG8_STAGE(PG8_SB(1, 0), b3, voffB);
            PG8_BAR; PG8_WAIT_L(0); PG8_MMA(0, 1, At, B1); PG8_BAR;
            PG8_LDA(At, 1, 1); PG8_STAGE(PG8_SA(1, 0), a3, voffA);
            PG8_BAR; PG8_WAIT_L(0); PG8_MMA(1, 0, At, B0); PG8_BAR; PG8_SCHED;
            PG8_STAGE(PG8_SB(1, 1), b3 + hstep, voffB);
            PG8_WAIT_V(6); PG8_BAR; PG8_MMA(1, 1, At, B1); PG8_BAR;
            }
        }
        if constexpr (ALIGN_EPI) { if (wr == 0) PG8_BAR; }
        if constexpr (!Epi::AFTER_DRAIN) { if (cur.np > 0) split_epilogue<NP>(acc, cur, E, X, tid, wr, wc, fr, fq); else E(acc, cur, wr, wc, fr, fq); S.done(cur); }
        if (!has_next) break;
#pragma unroll
        for (int a = 0; a < 2; ++a)
#pragma unroll
            for (int b = 0; b < 2; ++b)
#pragma unroll
                for (int m = 0; m < 4; ++m)
#pragma unroll
                    for (int n = 0; n < 2; ++n) acc[a][b][m][n] = (f32x4){0.f, 0.f, 0.f, 0.f};
        cur = nxt; cA = nA; cB = nB; ++ui;
        if constexpr (ALIGN_EPI) { if (wr == 1) PG8_BAR; }
    }
    PG8_WAIT_V(0);
    if constexpr (!ALIGN_EPI) { if (wr == 0) PG8_BAR; }
    PG8_BAR;
    if constexpr (Epi::AFTER_DRAIN) { E.fused(acc, cur, wr, wc, fr, fq, lds, wid, lane); S.done(cur); }
#undef PG8_SA
#undef PG8_SB
#undef PG8_STAGE
#undef PG8_LDA
#undef PG8_LDB
#undef PG8_MMA
#undef PG8_WAIT_V
#undef PG8_WAIT_L
#undef PG8_BAR
#undef PG8_SCHED
}
}

#ifndef PG8_SP2
#define PG8_SP2 true
#endif
#ifndef PG8_ALIGN
#define PG8_ALIGN true
#endif
#ifndef DUP_PHASE
#define DUP_PHASE -1
#endif
#ifndef MK_N_LAUNCHES
#define MK_N_LAUNCHES 1
#endif
constexpr int NWAVES = 8;
constexpr int N_PHASES = 10;
constexpr int N_LAUNCHES = MK_N_LAUNCHES;

constexpr int MP = 8192, MS = 1024, M = MP + MS;
constexpr int D = 2048, NIN = 11264, FF = 5632, FF2 = 11264;
constexpr int NH = 8, DK = 128, DVH = 256;
constexpr int C_POOL = 0, C_Q = 1024, C_K = 2048, C_V = 3072, C_GRET = 5120, C_GA = 7168, C_GR = 9216;
constexpr float EPS = 1e-6f;
constexpr int NS = 4, DVS = DVH / NS;
constexpr size_t O_Y = 0, O_POOLP = 18874368, O_RETP = 18935808, O_CONVP = 19984384, O_POOLS = 20074496, O_RETS = 22040576, O_CONVS = 55595008, O_END = 58478592;

constexpr size_t MiB = 1u << 20;
constexpr size_t WS_CTL = 0, CTL_ZERO_BYTES = 128 * 1024;
constexpr size_t WS_WIN = 1 * MiB, WS_WUP = 45 * MiB, WS_WDN = 89 * MiB, WS_WOUT = 111 * MiB, WS_WPOOL = 119 * MiB;
constexpr size_t WS_ROPE = 120 * MiB;
constexpr size_t WS_XN = 122 * MiB;
constexpr size_t WS_PROJ = 158 * MiB;
constexpr size_t WS_O = 356 * MiB, WS_AP = 392 * MiB, WS_MM = 428 * MiB;
constexpr size_t WS_SP16 = 464 * MiB;
constexpr size_t WS_X1 = 468 * MiB;
constexpr size_t WS_END = 504 * MiB;
constexpr int CW_TMO = 0, CW_CODE = 1, CW_Q2 = 64, CW_QW = 192, CW_BAR = 4096, CW_SPLIT = 8192;
static_assert((CW_SPLIT + 4 * 4096) * 4 <= (int)CTL_ZERO_BYTES && CW_BAR + 3456 <= CW_SPLIT, "control words inside the per-call memset");
constexpr size_t WS_SLAB_A = 356 * MiB, WS_SLAB_B = 230 * MiB;

constexpr int LDS_BYTES = 147456, LDSCTL_OFF = 143360;

#define GAS __attribute__((address_space(1)))
#define LAS __attribute__((address_space(3)))
typedef unsigned short bf16;
typedef unsigned v4u __attribute__((ext_vector_type(4)));
typedef unsigned v2u __attribute__((ext_vector_type(2)));
typedef float f32x4 __attribute__((ext_vector_type(4)));
typedef short bf16x8 __attribute__((ext_vector_type(8)));
#define RLX_AGENT __ATOMIC_RELAXED, __HIP_MEMORY_SCOPE_AGENT
#define LDS_WAIT() asm volatile("s_waitcnt lgkmcnt(0)" ::: "memory")
#define VM_WAIT() asm volatile("s_waitcnt vmcnt(0)" ::: "memory")
__device__ __forceinline__ unsigned pk2(float lo, float hi) { return pg8::cvt_pk_bf16(lo, hi); }
__device__ __forceinline__ float bflo(unsigned u) { return __uint_as_float(u << 16); }
__device__ __forceinline__ float bfhi(unsigned u) { return __uint_as_float(u & 0xffff0000u); }
__device__ __forceinline__ void unpack8(v4u x, float (&f)[8]) { f[0] = bflo(x.x); f[1] = bfhi(x.x); f[2] = bflo(x.y); f[3] = bfhi(x.y); f[4] = bflo(x.z); f[5] = bfhi(x.z); f[6] = bflo(x.w); f[7] = bfhi(x.w); }
__device__ __forceinline__ v4u pack8(const float (&f)[8]) { v4u o; o.x = pk2(f[0], f[1]); o.y = pk2(f[2], f[3]); o.z = pk2(f[4], f[5]); o.w = pk2(f[6], f[7]); return o; }
__device__ __forceinline__ v2u pack4(f32x4 a) { v2u o; o.x = pk2(a[0], a[1]); o.y = pk2(a[2], a[3]); return o; }
__device__ __forceinline__ float sigmoidf_(float x) { return __builtin_amdgcn_rcpf(1.0f + __expf(-x)); }
__device__ __forceinline__ float wave_sum(float v) {
#pragma unroll
    for (int o = 1; o < 64; o <<= 1) v += __shfl_xor(v, o);
    return v;
}
__device__ __forceinline__ bf16x8 as_bf16x8(v4u x) { return __builtin_bit_cast(bf16x8, x); }
#define MFMA16(a, b, c) __builtin_amdgcn_mfma_f32_16x16x32_bf16((a), (b), (c), 0, 0, 0)

#define XB_TMO      128
#define XB_XCNT(j)  (256  + 64 * (j))
#define XB_XSUB(j)  (1280 + 64 * (j))
#define XB_XGEN(j)  (2304 + 64 * (j))
#define XB_TOP      3328
#define XB_TOPGEN   3392
#define XCD_BAR_WORDS 3456
#define XB_SPIN_CAP (1u << 22)
__device__ __forceinline__ unsigned xb_ld(unsigned* p)              { return __hip_atomic_load(p, __ATOMIC_RELAXED, __HIP_MEMORY_SCOPE_AGENT); }
__device__ __forceinline__ unsigned xb_add(unsigned* p, unsigned v) { return __hip_atomic_fetch_add(p, v, __ATOMIC_RELAXED, __HIP_MEMORY_SCOPE_AGENT); }
__device__ __forceinline__ unsigned xb_xcc_id() { return (unsigned)__builtin_amdgcn_s_getreg((3 << 11) | 20) & 0xFu; }
#define XB_SPIN(cond, bar) do { unsigned _sp = 0; while (cond) { __builtin_amdgcn_s_sleep(1); \
    if ((++_sp & 255u) == 0u) { if (xb_ld(&(bar)[XB_TMO])) break; if (_sp > XB_SPIN_CAP) { atomicAdd(&(bar)[XB_TMO], 1u); break; } } } } while (0)
struct XcdBarrier { unsigned* bar; unsigned x; volatile LAS unsigned* st; };
__device__ __forceinline__ XcdBarrier xcd_barrier_post(unsigned* bar, volatile LAS unsigned* st) {
    XcdBarrier b; b.bar = bar; b.x = xb_xcc_id(); b.st = st;
    if (threadIdx.x == 0) (void)xb_add(&bar[XB_XCNT(b.x)], 1u);
    return b;
}
__device__ __forceinline__ void xcd_barrier_complete(unsigned* bar, unsigned x, unsigned& nloc, unsigned& nx) {
    const unsigned G = gridDim.x * gridDim.y * gridDim.z;
    unsigned sum, cnt, mine, sp = 0u;
    for (;;) {
        sum = 0u; cnt = 0u; mine = 0u;
#pragma unroll
        for (unsigned j = 0; j < 16; ++j) { const unsigned c = xb_ld(&bar[XB_XCNT(j)]); sum += c; cnt += (c > 0u) ? 1u : 0u; mine = (j == x) ? c : mine; }
        if (sum == G) break;
        __builtin_amdgcn_s_sleep(1);
        if ((++sp & 255u) == 0u) { if (xb_ld(&bar[XB_TMO])) break; if (sp > XB_SPIN_CAP) { atomicAdd(&bar[XB_TMO], 1u); break; } }
    }
    nloc = mine > 0u ? mine : 1u; nx = cnt > 0u ? cnt : 1u;
}
__device__ __forceinline__ void xcd_barrier(const XcdBarrier& b) {
    asm volatile("s_waitcnt vmcnt(0)" ::: "memory");
    __syncthreads();
    if (threadIdx.x == 0) {
        unsigned* bar = b.bar;
        __builtin_amdgcn_s_waitcnt(0);
        unsigned nloc = b.st[0], nx = b.st[1];
        if (nloc == 0u) { xcd_barrier_complete(bar, b.x, nloc, nx); b.st[0] = nloc; b.st[1] = nx; }
        const unsigned old = xb_add(&bar[XB_XSUB(b.x)], 1u);
        const unsigned gen = old / nloc;
        if (old + 1u == (gen + 1u) * nloc) {
            __builtin_amdgcn_fence(__ATOMIC_RELEASE, "agent");
            asm volatile("s_waitcnt vmcnt(0)" ::: "memory");
            const unsigned og = xb_add(&bar[XB_TOP], 1u);
            const unsigned tg = og / nx;
            if (og + 1u == (tg + 1u) * nx) xb_add(&bar[XB_TOPGEN], 1u);
            else XB_SPIN(xb_ld(&bar[XB_TOPGEN]) == tg, bar);
            __builtin_amdgcn_fence(__ATOMIC_ACQUIRE, "agent");
            xb_add(&bar[XB_XGEN(b.x)], 1u);
            asm volatile("s_waitcnt vmcnt(0)" ::: "memory");
        } else {
            XB_SPIN(xb_ld(&bar[XB_XGEN(b.x)]) == gen, bar);
            __builtin_amdgcn_fence(__ATOMIC_ACQUIRE, "agent");
            asm volatile("s_waitcnt vmcnt(0)" ::: "memory");
        }
    }
    __syncthreads();
}

struct Frame {
    LAS unsigned char* lds;
    volatile LAS unsigned* MISC;
    unsigned* ctl;
    int tid, lane, wave, G, gw, NGW;
    const float *xp, *xs, *state_pool, *state_ret, *state_conv, *g_pre_mix, *w_in, *w_pool, *pool_scale, *gn_gain, *w_out, *g_post_mix, *g_pre_ffn, *w_up, *conv_w, *conv_b, *w_down, *g_post_ffn;
    float* out;
    bf16 *WIN, *WUP, *WDN, *WOUT, *WPOOL, *XN, *PROJ, *UP, *OB, *AP, *MM, *ACT;
    float *ROPE_C, *ROPE_S;
    bf16 *SP16, *MOB, *X1B;
};
__device__ __forceinline__ const float* xrow(const Frame& F, int m) { return m < MP ? F.xp + (size_t)m * D : F.xs + (size_t)(m - MP) * D; }

__host__ __device__ __forceinline__ int unperm_d(int p) { const int g8 = p >> 3, e = p & 7; return e < 4 ? 4 * g8 + e : 64 + 4 * g8 + (e - 4); }
__device__ __forceinline__ void p0_transpose_item(const float* W, int K, int N, bf16* WT, LAS float* scr, int item, int lane, bool permqk = false) {
    const int nblk = N / 32, kb = item / nblk, nb = item % nblk, k0 = 64 * kb, n0 = 32 * nb;
    int src = n0 + (lane & 31); if (permqk && src >= C_Q && src < C_V) src = (src & ~127) + unperm_d(src & 127);
#pragma unroll 8
    for (int i = 0; i < 32; ++i) { const int kk = 2 * i + (lane >> 5); scr[kk * 33 + (lane & 31)] = __builtin_nontemporal_load(W + (size_t)(k0 + kk) * N + src); }
    LDS_WAIT(); asm volatile("" ::: "memory");
    const int c = lane & 7;
#pragma unroll
    for (int j = 0; j < 4; ++j) { const int n = (lane >> 3) + 8 * j; const LAS float* s = scr + (8 * c) * 33 + n;
        v4u o; o.x = pk2(s[0 * 33], s[1 * 33]); o.y = pk2(s[2 * 33], s[3 * 33]); o.z = pk2(s[4 * 33], s[5 * 33]); o.w = pk2(s[6 * 33], s[7 * 33]);
        *(v4u*)(WT + (size_t)(n0 + n) * K + k0 + 8 * c) = o; }
    LDS_WAIT(); asm volatile("" ::: "memory");
}
__device__ __forceinline__ void rms_row_to_bf16(const float* xr_, const float* g, bf16* orow, int lane) {
    const f32x4* xr = (const f32x4*)xr_ + lane; const f32x4* gr = (const f32x4*)g + lane;
    f32x4 v[8]; float s = 0.f;
#pragma unroll
    for (int j = 0; j < 8; ++j) { v[j] = __builtin_nontemporal_load(xr + 64 * j); s += (v[j].x * v[j].x + v[j].y * v[j].y) + (v[j].z * v[j].z + v[j].w * v[j].w); }
    const float rs = 1.0f / sqrtf(wave_sum(s) * (1.f / D) + EPS);
    v2u* o8 = (v2u*)orow + lane;
#pragma unroll
    for (int j = 0; j < 8; ++j) { const f32x4 gg = gr[64 * j]; v2u o; o.x = pk2(v[j].x * rs * gg.x, v[j].y * rs * gg.y); o.y = pk2(v[j].z * rs * gg.z, v[j].w * rs * gg.w); o8[64 * j] = o; }
}
__device__ __forceinline__ void p0_deferred_weights(Frame& F, LAS float* scr) {
    constexpr int I_UP = (D / 64) * (FF2 / 32), I_DN = (FF / 64) * (D / 32), I_OUT = (D / 64) * (D / 32), I_PL = (256 / 64) * (512 / 32);
    constexpr int NITEMS = I_UP + I_DN + I_OUT + 4 * I_PL, CHUNK = 4;
    for (;;) {
        int base = 0;
        if (F.lane == 0) base = (int)__hip_atomic_fetch_add(F.ctl + CW_QW, (unsigned)CHUNK, RLX_AGENT);
        base = __builtin_amdgcn_readfirstlane(base);
        if (base >= NITEMS) break;
        for (int it = base; it < base + CHUNK && it < NITEMS; ++it) {
            int r = it;
            if (r < I_UP) { p0_transpose_item(F.w_up, D, FF2, F.WUP, scr, r, F.lane); continue; } r -= I_UP;
            if (r < I_DN) { p0_transpose_item(F.w_down, FF, D, F.WDN, scr, r, F.lane); continue; } r -= I_DN;
            if (r < I_OUT) { p0_transpose_item(F.w_out, D, D, F.WOUT, scr, r, F.lane); continue; } r -= I_OUT;
            const int g = r / I_PL; r -= g * I_PL;
            p0_transpose_item(F.w_pool + (size_t)g * 256 * 512, 256, 512, F.WPOOL + (size_t)g * 512 * 256, scr, r, F.lane);
        }
    }
}
__device__ __forceinline__ void p0_prologue(Frame& F) {
    LAS float* scr = (LAS float*)(F.lds + F.wave * 16384);
    constexpr int I_IN = (D / 64) * (NIN / 32);
    for (int it = F.gw; it < I_IN; it += F.NGW) p0_transpose_item(F.w_in, D, NIN, F.WIN, scr, it, F.lane, true);
    for (int m = F.gw; m < M; m += F.NGW) rms_row_to_bf16(xrow(F, m), F.g_pre_mix, F.XN + (size_t)m * D, F.lane);
    for (int idx = blockIdx.x * 512 + F.tid; idx < 128 * 15 * 1024 / 4; idx += F.G * 512) { const f32x4 v = ((const f32x4*)F.state_pool)[idx]; ((v2u*)F.SP16)[idx] = pack4(v); }
    for (int idx = blockIdx.x * 512 + F.tid; idx < 2056 * 64; idx += F.G * 512) {
        const int row = idx >> 6, i = idx & 63; const int pos = row < 2048 ? row : 16384 + (row - 2048);
        double th = 1.0; for (int k = 0; k < i; ++k) th *= 0.8659643233600653;
        const double a = (double)pos * th;
        const double kd = rint(a * 0.6366197723675814);
        double y = fma(-kd, 1.57079632679489655800e+00, a); y = fma(-kd, 6.12323399573676603587e-17, y);
        const int k4 = ((int)kd) & 3; const double y2 = y * y;
        const double sp = y * (1.0 + y2 * (-1.0 / 6 + y2 * (1.0 / 120 + y2 * (-1.0 / 5040 + y2 * (1.0 / 362880 + y2 * (-1.0 / 39916800 + y2 * (1.0 / 6227020800.0)))))));
        const double cp = 1.0 + y2 * (-0.5 + y2 * (1.0 / 24 + y2 * (-1.0 / 720 + y2 * (1.0 / 40320 + y2 * (-1.0 / 3628800 + y2 * (1.0 / 479001600 + y2 * (-1.0 / 87178291200.0)))))));
        double sn, cs;
        if (k4 == 0) { sn = sp; cs = cp; } else if (k4 == 1) { sn = cp; cs = -sp; } else if (k4 == 2) { sn = -sp; cs = -cp; } else { sn = -cp; cs = sp; }
        F.ROPE_C[idx] = (float)cs; F.ROPE_S[idx] = (float)sn;
    }
}

constexpr float KSCALE = 0.08838834764831845f;
struct EpiProj {
    static constexpr bool PERM = true, AFTER_DRAIN = false;
    bf16* O; const float* rc; const float* rs;
    __device__ __forceinline__ void tri(f32x4 v0, f32x4 v1, const pg8::Unit& u, int ai, int bj, int m, int wr, int wc, int fr, int fq) const {
        const int row = u.pm * 256 + ai * 128 + wr * 64 + m * 16 + fr, col = u.pn * 256 + bj * 128 + wc * 32 + 8 * fq;
        if (u.pn >= 4 && u.pn < 12) {
            const int h = ((u.pn & 3) << 1) + bj;
            int prow, tl; if (row < MP) { const int t = row & 2047; prow = t; tl = t & 127; } else { tl = row & 7; prow = 2048 + tl; }
            const int g8 = 4 * wc + fq;
            const f32x4 c = *(const f32x4*)(rc + prow * 64 + 4 * g8), sn = *(const f32x4*)(rs + prow * 64 + 4 * g8);
            const float lg2 = __log2f(1.0f - __builtin_amdgcn_exp2f(-5.0f - (float)h));
            const float sc = u.pn >= 8 ? KSCALE * __builtin_amdgcn_exp2f(-lg2 * (float)tl) : __builtin_amdgcn_exp2f(lg2 * (float)tl);
            const f32x4 y1 = (v0 * c - v1 * sn) * sc, y2 = (v1 * c + v0 * sn) * sc;
            v0 = y1; v1 = y2;
        }
        v4u w4; w4.x = pk2(v0[0], v0[1]); w4.y = pk2(v0[2], v0[3]); w4.z = pk2(v1[0], v1[1]); w4.w = pk2(v1[2], v1[3]);
        *(v4u*)(O + (size_t)row * NIN + col) = w4;
    }
    __device__ __forceinline__ void operator()(const f32x4 (&acc)[2][2][4][2], const pg8::Unit& u, int wr, int wc, int fr, int fq) const {
#pragma unroll
        for (int ai = 0; ai < 2; ++ai)
#pragma unroll
            for (int m = 0; m < 4; ++m)
#pragma unroll
                for (int bj = 0; bj < 2; ++bj) tri(acc[ai][bj][m][0], acc[ai][bj][m][1], u, ai, bj, m, wr, wc, fr, fq);
    }
};

typedef short s16x4 __attribute__((ext_vector_type(4)));
__device__ __forceinline__ bf16x8 tr16x2(const LAS unsigned char* p0, const LAS unsigned char* p1) {
    const s16x4 a = __builtin_amdgcn_ds_read_tr16_b64_v4i16((LAS s16x4*)p0), b = __builtin_amdgcn_ds_read_tr16_b64_v4i16((LAS s16x4*)p1);
    return __builtin_shufflevector(a, b, 0, 1, 2, 3, 4, 5, 6, 7);
}
static_assert(DVS == 64, "chain staging below assumes 64-wide value slices");
constexpr int QI_LD = 136, VI_LD = DVS + 8;
constexpr int QI_OFF = 0, KI_OFF = 34816, VI_OFF = 69632, RT_OFF = VI_OFF + 128 * VI_LD * 2, CH_END = RT_OFF + DVS * QI_LD * 2;
static_assert(CH_END <= LDSCTL_OFF, "chain LDS");
__device__ __forceinline__ void chain_unit(Frame& F, int unit) {
    const int s = unit % NS, h = (unit / NS) & 7, b = unit / (NS * 8);
    int tid_ = F.tid; asm volatile("" : "+v"(tid_));
    const int tid = tid_, lane = tid & 63, w = F.wave, fr = lane & 15, fq = lane >> 4, tq = (lane & 15) >> 2, tp = lane & 3;
    LAS unsigned char* L = F.lds;
    const float lg2 = __log2f(1.0f - __builtin_amdgcn_exp2f(-5.0f - (float)h));
    const float gam = __builtin_amdgcn_exp2f(lg2), g127 = __builtin_amdgcn_exp2f(127.f * lg2);
    for (int i = tid; i < DVS * QI_LD * 2 / 16; i += 512) *(LAS v4u*)(L + RT_OFF + i * 16) = (v4u){0u, 0u, 0u, 0u};
    f32x4 Racc[4];
#pragma unroll
    for (int i = 0; i < 4; ++i) Racc[i] = (f32x4){0.f, 0.f, 0.f, 0.f};
    const int vt_r = w & 3, dg = w >> 2;
    const bf16* pbase = F.PROJ + ((size_t)b * 2048) * NIN;
    v4u sq[4], sk[4], sv[2];
#define CH_ISSUE(c) do { const bf16* pr_ = pbase + (size_t)((c) * 128) * NIN; \
        _Pragma("unroll") for (int i_ = 0; i_ < 4; ++i_) { const int ci = tid + 512 * i_, j = ci >> 4, ch = ci & 15; sq[i_] = *(const v4u*)(pr_ + (size_t)j * NIN + C_Q + h * 128 + 8 * ch); sk[i_] = *(const v4u*)(pr_ + (size_t)j * NIN + C_K + h * 128 + 8 * ch); } \
        _Pragma("unroll") for (int i_ = 0; i_ < 2; ++i_) { const int ci = tid + 512 * i_, j = ci >> 3, ch = ci & 7; sv[i_] = *(const v4u*)(pr_ + (size_t)j * NIN + C_V + h * DVH + s * DVS + 8 * ch); } } while (0)
#define CH_WRITE() do { \
        _Pragma("unroll") for (int i_ = 0; i_ < 4; ++i_) { const int ci = tid + 512 * i_, j = ci >> 4, ch = ci & 15; *(LAS v4u*)(L + QI_OFF + (j * QI_LD + 8 * ch) * 2) = sq[i_]; *(LAS v4u*)(L + KI_OFF + (j * QI_LD + 8 * ch) * 2) = sk[i_]; } \
        _Pragma("unroll") for (int i_ = 0; i_ < 2; ++i_) { const int ci = tid + 512 * i_, j = ci >> 3, ch = ci & 7; *(LAS v4u*)(L + VI_OFF + (j * VI_LD + 8 * ch) * 2) = sv[i_]; } } while (0)
    CH_ISSUE(0);
#pragma unroll 1
    for (int c = 0; c < 16; ++c) {
        const size_t mrow0 = (size_t)b * 2048 + c * 128;
        CH_WRITE();
        __syncthreads();
        if (c + 1 < 16) CH_ISSUE(c + 1);
        {
            bf16x8 afr[4];
#pragma unroll
            for (int kk = 0; kk < 4; ++kk) afr[kk] = *(const LAS bf16x8*)(L + QI_OFF + ((16 * w + fr) * QI_LD + 32 * kk + 8 * fq) * 2);
            f32x4 oacc[4];
#pragma unroll
            for (int vt = 0; vt < 4; ++vt) {
                f32x4 acc = (f32x4){0.f, 0.f, 0.f, 0.f};
#pragma unroll
                for (int kk = 0; kk < 4; ++kk) { const bf16x8 rf = *(const LAS bf16x8*)(L + RT_OFF + ((16 * vt + fr) * QI_LD + 32 * kk + 8 * fq) * 2); acc = MFMA16(rf, afr[kk], acc); }
                oacc[vt] = acc * gam;
            }
            const int i_ = 16 * w + fr, nkk = (w >> 1) + 1;
#pragma unroll 1
            for (int kk = 0; kk < nkk; ++kk) {
                f32x4 s0 = (f32x4){0.f, 0.f, 0.f, 0.f}, s1 = s0;
                const LAS unsigned char* kb = L + KI_OFF + ((32 * kk + fr) * QI_LD + 8 * fq) * 2;
#pragma unroll
                for (int k2 = 0; k2 < 4; ++k2) {
                    const bf16x8 kf0 = *(const LAS bf16x8*)(kb + 64 * k2), kf1 = *(const LAS bf16x8*)(kb + 16 * QI_LD * 2 + 64 * k2);
                    s0 = MFMA16(kf0, afr[k2], s0); s1 = MFMA16(kf1, afr[k2], s1);
                }
                float pv[8];
#pragma unroll
                for (int e = 0; e < 4; ++e) { const int dd0 = i_ - (32 * kk + 4 * fq + e); pv[e] = dd0 >= 0 ? s0[e] : 0.f; pv[4 + e] = dd0 >= 16 ? s1[e] : 0.f; }
                const bf16x8 pf = as_bf16x8(pack8(pv));
                const LAS unsigned char* vb = L + VI_OFF + ((32 * kk + 4 * fq + tq) * VI_LD + 4 * tp) * 2;
#pragma unroll
                for (int vt = 0; vt < 4; ++vt) oacc[vt] = MFMA16(tr16x2(vb + 32 * vt, vb + 16 * VI_LD * 2 + 32 * vt), pf, oacc[vt]);
            }
            bf16* orow = F.OB + (mrow0 + 16 * w + fr) * D + h * DVH + s * DVS + 4 * fq;
#pragma unroll
            for (int vt = 0; vt < 4; ++vt) *(v2u*)(orow + 16 * vt) = pack4(oacc[vt]);
        }
#pragma unroll
        for (int di = 0; di < 4; ++di) {
            const int dt = dg * 4 + di;
            f32x4 acc = Racc[di] * gam;
#pragma unroll
            for (int kk = 0; kk < 4; ++kk) {
                const LAS unsigned char* ka = L + KI_OFF + ((32 * kk + 8 * fq + tq) * QI_LD + 16 * dt + 4 * tp) * 2;
                const LAS unsigned char* va = L + VI_OFF + ((32 * kk + 8 * fq + tq) * VI_LD + 16 * vt_r + 4 * tp) * 2;
                acc = MFMA16(tr16x2(ka, ka + 4 * QI_LD * 2), tr16x2(va, va + 4 * VI_LD * 2), acc);
            }
            Racc[di] = acc * g127;
        }
        __syncthreads();
#pragma unroll
        for (int di = 0; di < 4; ++di) { const int dt = dg * 4 + di; *(LAS v2u*)(L + RT_OFF + ((16 * vt_r + fr) * QI_LD + 16 * dt + 4 * fq) * 2) = pack4(Racc[di]); }
    }
#undef CH_ISSUE
#undef CH_WRITE
    float* ro = F.out + O_RETP + ((size_t)(b * 8 + h) * 128) * DVH + s * DVS + 16 * vt_r + fr;
#pragma unroll
    for (int di = 0; di < 4; ++di) { const int dt = dg * 4 + di;
#pragma unroll
        for (int r = 0; r < 4; ++r) ro[(size_t)unperm_d(16 * dt + 4 * fq + r) * DVH] = Racc[di][r]; }
}

constexpr int SQ_OFF = 0, SKZ_OFF = 4096, SK_OFF = 8192, SV_OFF = 12288, SS_OFF = 20480, SRED_OFF = 24576;
__device__ __forceinline__ void sample_unit(Frame& F, int unit) {
    const int h = unit & 7, b = unit >> 3;
    int tid_ = F.tid; asm volatile("" : "+v"(tid_));
    const int tid = tid_, lane = tid & 63, w = F.wave;
    LAS unsigned char* L = F.lds;
    LAS float* qT = (LAS float*)(L + SQ_OFF); LAS float* kzT = (LAS float*)(L + SKZ_OFF); LAS float* kS = (LAS float*)(L + SK_OFF);
    LAS float* vs = (LAS float*)(L + SV_OFF); LAS float* ss = (LAS float*)(L + SS_OFF); LAS float* red = (LAS float*)(L + SRED_OFF);
    const float lg2 = __log2f(1.0f - __builtin_amdgcn_exp2f(-5.0f - (float)h));
    const float gam = __builtin_amdgcn_exp2f(lg2), g7 = __builtin_amdgcn_exp2f(7.f * lg2), g8c = __builtin_amdgcn_exp2f(8.f * lg2);
    const size_t mrow0 = (size_t)MP + (size_t)b * 8;
    const float* Rin = F.state_ret + ((size_t)(b * 8 + h) * 128) * DVH + 4 * lane;
    float* Rout = F.out + O_RETS + ((size_t)(b * 8 + h) * 128) * DVH + 4 * lane;
    f32x4 r0[16];
#pragma unroll
    for (int dd = 0; dd < 16; ++dd) r0[dd] = __builtin_nontemporal_load((const f32x4*)(Rin + (size_t)(16 * w + dd) * DVH));
    if (tid < 256) {
        const int qk = tid >> 7, it = tid & 127, i = it >> 4, ch = it & 15;
        float f[8]; unpack8(*(const v4u*)(F.PROJ + (mrow0 + i) * NIN + (qk ? C_K : C_Q) + h * 128 + 8 * ch), f);
#pragma unroll
        for (int e = 0; e < 8; ++e) { const int d = e < 4 ? 4 * ch + e : 64 + 4 * ch + (e - 4);
            if (qk == 0) qT[d * 8 + i] = f[e]; else { kS[i * 128 + d] = f[e]; kzT[d * 8 + i] = f[e] * g7; } }
    } else {
        const int it = tid - 256, j = it >> 5, g = it & 31;
        float f[8]; unpack8(*(const v4u*)(F.PROJ + (mrow0 + j) * NIN + C_V + h * DVH + 8 * g), f);
#pragma unroll
        for (int e = 0; e < 8; ++e) vs[j * 256 + 8 * g + e] = f[e];
    }
    __syncthreads();
    {
        const int pr = tid >> 3, part = tid & 7, i = pr >> 3, j = pr & 7; float dot = 0.f;
#pragma unroll
        for (int dd = 0; dd < 16; ++dd) { const int d = 16 * part + dd; dot += qT[d * 8 + i] * kS[j * 128 + d]; }
        dot += __shfl_xor(dot, 1); dot += __shfl_xor(dot, 2); dot += __shfl_xor(dot, 4);
        if (part == 0) ss[i * 8 + j] = (i >= j) ? dot : 0.f;
    }
    {
        f32x4 vreg[8], oacc[8];
#pragma unroll
        for (int j = 0; j < 8; ++j) { vreg[j] = *(const LAS f32x4*)(vs + j * 256 + 4 * lane); oacc[j] = (f32x4){0.f, 0.f, 0.f, 0.f}; }
#pragma unroll
        for (int dd = 0; dd < 16; ++dd) {
            const int d = 16 * w + dd;
            const f32x4 qa = *(const LAS f32x4*)(qT + d * 8), qb = *(const LAS f32x4*)(qT + d * 8 + 4), ka = *(const LAS f32x4*)(kzT + d * 8), kb = *(const LAS f32x4*)(kzT + d * 8 + 4);
            f32x4 rn = r0[dd] * g8c;
            rn += ka.x * vreg[0]; rn += ka.y * vreg[1]; rn += ka.z * vreg[2]; rn += ka.w * vreg[3]; rn += kb.x * vreg[4]; rn += kb.y * vreg[5]; rn += kb.z * vreg[6]; rn += kb.w * vreg[7];
            __builtin_nontemporal_store(rn, (f32x4*)(Rout + (size_t)d * DVH));
            oacc[0] += qa.x * r0[dd]; oacc[1] += qa.y * r0[dd]; oacc[2] += qa.z * r0[dd]; oacc[3] += qa.w * r0[dd];
            oacc[4] += qb.x * r0[dd]; oacc[5] += qb.y * r0[dd]; oacc[6] += qb.z * r0[dd]; oacc[7] += qb.w * r0[dd];
        }
#pragma unroll
        for (int i = 0; i < 8; ++i) *(LAS f32x4*)(red + (w * 8 + i) * 256 + 4 * lane) = oacc[i];
    }
    __syncthreads();
    {
        const int i = tid >> 6, l = tid & 63;
        f32x4 tot = (f32x4){0.f, 0.f, 0.f, 0.f};
#pragma unroll
        for (int ww = 0; ww < 8; ++ww) tot += *(const LAS f32x4*)(red + (ww * 8 + i) * 256 + 4 * l);
        tot = tot * gam;
#pragma unroll
        for (int j = 0; j < 8; ++j) tot += ss[i * 8 + j] * *(const LAS f32x4*)(vs + j * 256 + 4 * l);
        *(v2u*)(F.OB + (mrow0 + i) * D + h * DVH + 4 * l) = pack4(tot);
    }
}

constexpr int Z_LD = 264;
template <int W, int IB> __device__ __forceinline__ void pool_z(Frame& F, int g, int m0, int tid) {
    LAS unsigned char* L = F.lds;
#pragma unroll 1
    for (int it0 = tid; it0 < 4096; it0 += 512 * IB) {
        v4u raw[IB][W]; bool ok[IB][W];
#pragma unroll
        for (int ib = 0; ib < IB; ++ib) {
            const int it = it0 + 512 * ib, j = it >> 5, c8 = it & 31, m = m0 + j, col = C_POOL + 256 * g + 8 * c8;
#pragma unroll
            for (int k = 0; k < W; ++k) {
                const bf16* p;
                if (m < MP) { const int t = m & 2047; ok[ib][k] = t - k >= 0; p = F.PROJ + (size_t)(ok[ib][k] ? m - k : m) * NIN + col; }
                else { const int ms = m - MP, bb = ms >> 3, i = ms & 7, ee = 15 + i - k; ok[ib][k] = true;
                    const bf16* p1 = F.PROJ + (size_t)(MP + bb * 8 + (ee >= 15 ? ee - 15 : 0)) * NIN + col; const bf16* p2 = F.SP16 + ((size_t)bb * 15 + (ee < 15 ? ee : 0)) * 1024 + 256 * g + 8 * c8;
                    p = ee >= 15 ? p1 : p2; }
                raw[ib][k] = *(const v4u*)p;
            }
        }
#pragma unroll
        for (int ib = 0; ib < IB; ++ib) {
            const int it = it0 + 512 * ib, j = it >> 5, c8 = it & 31, m = m0 + j;
            float sum[8], cur[8], f[8];
            unpack8(raw[ib][0], cur);
#pragma unroll
            for (int e = 0; e < 8; ++e) sum[e] = cur[e];
#pragma unroll
            for (int k = 1; k < W; ++k) { unpack8(raw[ib][k], f);
#pragma unroll
                for (int e = 0; e < 8; ++e) sum[e] += ok[ib][k] ? f[e] : 0.f; }
            int cn = W; if (m < MP) { const int t = m & 2047; cn = W < t + 1 ? W : t + 1; }
            const float ic = 1.0f / (float)cn;
#pragma unroll
            for (int e = 0; e < 8; ++e) f[e] = sum[e] * ic - cur[e];
            *(LAS v4u*)(L + (j * Z_LD + 8 * c8) * 2) = pack8(f);
        }
    }
}
__device__ __forceinline__ void pool_unit(Frame& F, int unit) {
    const int g = unit & 3, tile = unit >> 2, m0 = tile * 128;
    int tid_ = F.tid; asm volatile("" : "+v"(tid_));
    const int tid = tid_, lane = tid & 63, w = F.wave, fr = lane & 15, fq = lane >> 4;
    LAS unsigned char* L = F.lds;
    bf16x8 bfr[4][8];
    {
        const bf16* wt = F.WPOOL + ((size_t)g * 512 + 64 * w + fr) * 256 + 8 * fq;
#pragma unroll
        for (int et = 0; et < 4; ++et)
#pragma unroll
            for (int kk = 0; kk < 8; ++kk) bfr[et][kk] = *(const bf16x8*)(wt + (size_t)(16 * et) * 256 + 32 * kk);
    }
    if (m0 >= MP) {
        if (g == 0) pool_z<2, 4>(F, g, m0, tid); else if (g == 1) pool_z<4, 4>(F, g, m0, tid); else if (g == 2) pool_z<8, 2>(F, g, m0, tid); else pool_z<16, 1>(F, g, m0, tid);
    } else {
        constexpr int UT_OFF = 128 * Z_LD * 2;
        static_assert(UT_OFF + 143 * Z_LD * 2 <= LDSCTL_OFF, "pool LDS");
        const bool seq0 = (m0 & 2047) == 0;
        const bf16* src = F.PROJ + (size_t)(m0 - 15) * NIN + C_POOL + 256 * g;
#pragma unroll
        for (int i = 0; i < 9; ++i) { const int ci = tid + 512 * i;
            if (ci < 143 * 32) { const int rw = ci >> 5, c8 = ci & 31; v4u v = (v4u){0u, 0u, 0u, 0u}; if (!(seq0 && rw < 15)) v = *(const v4u*)(src + (size_t)rw * NIN + 8 * c8);
                *(LAS v4u*)(L + UT_OFF + (rw * Z_LD + 8 * c8) * 2) = v; } }
        __syncthreads();
        const int W = 2 << g, c8 = tid & 31, j0 = (tid >> 5) * 8;
        const LAS unsigned char* up = L + UT_OFF + ((15 + j0) * Z_LD + 8 * c8) * 2;
        float sum[8], f[8], cur[8];
#pragma unroll
        for (int e = 0; e < 8; ++e) sum[e] = 0.f;
        for (int k = 1; k < W; ++k) { unpack8(*(const LAS v4u*)(up - k * Z_LD * 2), f);
#pragma unroll
            for (int e = 0; e < 8; ++e) sum[e] += f[e]; }
        const int t0 = (m0 & 2047) + j0;
#pragma unroll
        for (int j = 0; j < 8; ++j) {
            unpack8(*(const LAS v4u*)(up + j * Z_LD * 2), cur);
#pragma unroll
            for (int e = 0; e < 8; ++e) sum[e] += cur[e];
            const int t = t0 + j; const float ic = 1.0f / (float)(W < t + 1 ? W : t + 1);
#pragma unroll
            for (int e = 0; e < 8; ++e) f[e] = sum[e] * ic - cur[e];
            *(LAS v4u*)(L + ((j0 + j) * Z_LD + 8 * c8) * 2) = pack8(f);
            unpack8(*(const LAS v4u*)(up + (j + 1 - W) * Z_LD * 2), f);
#pragma unroll
            for (int e = 0; e < 8; ++e) sum[e] -= f[e];
        }
    }
    __syncthreads();
    f32x4 sc[4];
#pragma unroll
    for (int et = 0; et < 4; ++et) sc[et] = *(const f32x4*)(F.pool_scale + 512 * g + 64 * w + 16 * et + 4 * fq);
#pragma unroll 1
    for (int rt = 0; rt < 8; ++rt) {
        bf16x8 afr[8];
#pragma unroll
        for (int kk = 0; kk < 8; ++kk) afr[kk] = *(const LAS bf16x8*)(L + ((16 * rt + fr) * Z_LD + 32 * kk + 8 * fq) * 2);
        bf16* orow = F.AP + (size_t)(m0 + 16 * rt + fr) * D + 512 * g + 64 * w + 4 * fq;
#pragma unroll
        for (int et = 0; et < 4; ++et) {
            f32x4 acc = (f32x4){0.f, 0.f, 0.f, 0.f};
#pragma unroll
            for (int kk = 0; kk < 8; ++kk) acc = MFMA16(bfr[et][kk], afr[kk], acc);
            *(v2u*)(orow + 16 * et) = pack4(acc * sc[et]);
        }
    }
}
constexpr int N_CHAIN = 4 * 8 * NS, N_POOLU = (M / 128) * 4, N_SAMP = 128 * 8, N_P2 = N_CHAIN + N_POOLU + N_SAMP;
__device__ __forceinline__ void p2_mixers(Frame& F, int rep) {
    const int mode = rep >> 4, lo = mode == 2 ? N_CHAIN : (mode == 3 ? N_CHAIN + N_POOLU : 0), hi = mode == 1 ? N_CHAIN : (mode == 2 ? N_CHAIN + N_POOLU : N_P2);
    const bool static_chain = mode == 0 && (F.G % 8) == 0 && F.G >= N_CHAIN && NS == 4;
    if (static_chain && (int)blockIdx.x < N_CHAIN) { __syncthreads(); const int c = (int)blockIdx.x, slot = c >> 3, bh = (c & 7) + 8 * (slot >> 2); chain_unit(F, bh * NS + (slot & 3)); }
    for (;;) {
        __syncthreads();
        if (F.tid == 0) F.MISC[0] = __hip_atomic_fetch_add(F.ctl + CW_Q2 + 64 * (rep & 15), 1u, RLX_AGENT);
        __syncthreads();
        const int u = (int)F.MISC[0] + (static_chain ? N_CHAIN : lo);
        if (u >= hi) break;
        if (u < N_CHAIN) chain_unit(F, u);
        else if (u < N_CHAIN + N_POOLU) pool_unit(F, u - N_CHAIN);
        else sample_unit(F, u - N_CHAIN - N_POOLU);
    }
}

__device__ __forceinline__ float half_sum(float v) {
#pragma unroll
    for (int o = 1; o < 32; o <<= 1) v += __shfl_xor(v, o);
    return v;
}
__device__ __forceinline__ void p3_merge(Frame& F) {
    const int lane = F.lane, hl = lane >> 5, l32 = lane & 31;
    constexpr int NIT = M * 4;
    for (int it0 = 2 * F.gw; it0 < NIT; it0 += 2 * F.NGW) {
        v4u ov[2], gv[2], av[2], rv[2], pv[2]; int cc[2]; size_t mm[2];
#pragma unroll
        for (int u = 0; u < 2; ++u) {
            const int it = it0 + u, m = it >> 2, hp = it & 3, c = (2 * hp + hl) * DVH + 8 * l32; cc[u] = c; mm[u] = (size_t)m;
            const bf16* prow = F.PROJ + (size_t)m * NIN + c;
            ov[u] = __builtin_nontemporal_load((const v4u*)(F.OB + (size_t)m * D + c)); gv[u] = __builtin_nontemporal_load((const v4u*)(prow + C_GRET)); av[u] = __builtin_nontemporal_load((const v4u*)(prow + C_GA)); rv[u] = __builtin_nontemporal_load((const v4u*)(prow + C_GR)); pv[u] = __builtin_nontemporal_load((const v4u*)(F.AP + (size_t)m * D + c));
        }
#pragma unroll
        for (int u = 0; u < 2; ++u) {
            float o[8], g[8], ga[8], gr[8], ap[8], res[8];
            unpack8(ov[u], o); unpack8(gv[u], g); unpack8(av[u], ga); unpack8(rv[u], gr); unpack8(pv[u], ap);
            const f32x4 gn0 = *(const f32x4*)(F.gn_gain + cc[u]), gn1 = *(const f32x4*)(F.gn_gain + cc[u] + 4);
            const float gn[8] = {gn0.x, gn0.y, gn0.z, gn0.w, gn1.x, gn1.y, gn1.z, gn1.w};
            float sm = 0.f;
#pragma unroll
            for (int e = 0; e < 8; ++e) sm += o[e];
            const float mean = half_sum(sm) * (1.f / 256.f);
            float sq = 0.f;
#pragma unroll
            for (int e = 0; e < 8; ++e) { o[e] -= mean; sq += o[e] * o[e]; }
            const float rstd = 1.0f / sqrtf(half_sum(sq) * (1.f / 256.f) + EPS);
#pragma unroll
            for (int e = 0; e < 8; ++e) { const float r = g[e] * sigmoidf_(g[e]) * (o[e] * rstd * gn[e]); res[e] = sigmoidf_(ga[e]) * ap[e] + sigmoidf_(gr[e]) * r; }
            *(v4u*)(F.MM + mm[u] * D + cc[u]) = pack8(res);
        }
    }
    const int gt = blockIdx.x * 512 + F.tid, NT = F.G * 512;
    for (int idx = gt; idx < 4 * 15 * 1024; idx += NT) { const int c = idx & 1023, r = (idx >> 10) % 15, b = idx / (15 * 1024);
        F.out[O_POOLP + idx] = __uint_as_float((unsigned)F.PROJ[(size_t)(b * 2048 + 2033 + r) * NIN + C_POOL + c] << 16); }
    for (int idx = gt; idx < 128 * 15 * 1024; idx += NT) { const int c = idx & 1023, r = (idx >> 10) % 15, b = idx / (15 * 1024); const int e = 8 + r;
        F.out[O_POOLS + idx] = e < 15 ? F.state_pool[((size_t)b * 15 + e) * 1024 + c] : __uint_as_float((unsigned)F.PROJ[(size_t)(MP + b * 8 + e - 15) * NIN + C_POOL + c] << 16); }
}

__device__ __forceinline__ void p5_rows(Frame& F) {
    const int lane = F.lane;
    for (int m = F.gw; m < M; m += F.NGW) {
        const v4u* mo = (const v4u*)(F.MOB + (size_t)m * D) + lane; const f32x4* xr = (const f32x4*)xrow(F, m) + 2 * lane;
        const f32x4* g1 = (const f32x4*)F.g_post_mix + 2 * lane; const f32x4* g2 = (const f32x4*)F.g_pre_ffn + 2 * lane;
        v4u mv[4]; f32x4 x[4][2]; float v[4][8]; float s = 0.f;
#pragma unroll
        for (int j = 0; j < 4; ++j) { mv[j] = __builtin_nontemporal_load(mo + 64 * j); x[j][0] = __builtin_nontemporal_load(xr + 128 * j); x[j][1] = __builtin_nontemporal_load(xr + 128 * j + 1); }
#pragma unroll
        for (int j = 0; j < 4; ++j) { unpack8(mv[j], v[j]);
#pragma unroll
            for (int e = 0; e < 8; ++e) s += v[j][e] * v[j][e]; }
        const float rs = 1.0f / sqrtf(wave_sum(s) * (1.f / D) + EPS);
        float s2 = 0.f; v4u* yo = (v4u*)(F.X1B + (size_t)m * D) + lane;
#pragma unroll
        for (int j = 0; j < 4; ++j) {
            const f32x4 ga = g1[128 * j], gb = g1[128 * j + 1];
            x[j][0] = x[j][0] + (f32x4){v[j][0], v[j][1], v[j][2], v[j][3]} * rs * ga; x[j][1] = x[j][1] + (f32x4){v[j][4], v[j][5], v[j][6], v[j][7]} * rs * gb;
            { v4u o; o.x = pk2(x[j][0].x, x[j][0].y); o.y = pk2(x[j][0].z, x[j][0].w); o.z = pk2(x[j][1].x, x[j][1].y); o.w = pk2(x[j][1].z, x[j][1].w); yo[64 * j] = o; }
            s2 += (x[j][0].x * x[j][0].x + x[j][0].y * x[j][0].y) + (x[j][0].z * x[j][0].z + x[j][0].w * x[j][0].w) + (x[j][1].x * x[j][1].x + x[j][1].y * x[j][1].y) + (x[j][1].z * x[j][1].z + x[j][1].w * x[j][1].w);
        }
        const float rs2 = 1.0f / sqrtf(wave_sum(s2) * (1.f / D) + EPS);
        v4u* o8 = (v4u*)(F.XN + (size_t)m * D) + lane;
#pragma unroll
        for (int j = 0; j < 4; ++j) { const f32x4 ga = g2[128 * j], gb = g2[128 * j + 1]; const f32x4 a = x[j][0] * rs2 * ga, b2 = x[j][1] * rs2 * gb;
            v4u o; o.x = pk2(a.x, a.y); o.y = pk2(a.z, a.w); o.z = pk2(b2.x, b2.y); o.w = pk2(b2.z, b2.w); o8[64 * j] = o; }
    }
}
__device__ __forceinline__ void p9_rows(Frame& F, float* dst) {
    const int lane = F.lane;
    for (int m = F.gw; m < M; m += F.NGW) {
        const v4u* fo = (const v4u*)(F.MOB + (size_t)m * D) + lane; const v4u* yi = (const v4u*)(F.X1B + (size_t)m * D) + lane; f32x4* yo = (f32x4*)(dst + (size_t)m * D) + 2 * lane;
        const f32x4* g1 = (const f32x4*)F.g_post_ffn + 2 * lane;
        v4u mv[4]; f32x4 x[4][2]; float v[4][8]; float s = 0.f;
#pragma unroll
        for (int j = 0; j < 4; ++j) { mv[j] = __builtin_nontemporal_load(fo + 64 * j); const v4u xb = __builtin_nontemporal_load(yi + 64 * j); x[j][0] = (f32x4){bflo(xb.x), bfhi(xb.x), bflo(xb.y), bfhi(xb.y)}; x[j][1] = (f32x4){bflo(xb.z), bfhi(xb.z), bflo(xb.w), bfhi(xb.w)}; }
#pragma unroll
        for (int j = 0; j < 4; ++j) { unpack8(mv[j], v[j]);
#pragma unroll
            for (int e = 0; e < 8; ++e) s += v[j][e] * v[j][e]; }
        const float rs = 1.0f / sqrtf(wave_sum(s) * (1.f / D) + EPS);
#pragma unroll
        for (int j = 0; j < 4; ++j) { const f32x4 ga = g1[128 * j], gb = g1[128 * j + 1];
            __builtin_nontemporal_store(x[j][0] + (f32x4){v[j][0], v[j][1], v[j][2], v[j][3]} * rs * ga, yo + 128 * j); __builtin_nontemporal_store(x[j][1] + (f32x4){v[j][4], v[j][5], v[j][6], v[j][7]} * rs * gb, yo + 128 * j + 1); }
    }
}

__device__ __forceinline__ float gelu_tanh(float g) {
    const float u = (g * g) * (1.5957691216057308f * 0.044715f * 1.4426950408889634f) + (1.5957691216057308f * 1.4426950408889634f);
    return g * __builtin_amdgcn_rcpf(1.0f + __builtin_amdgcn_exp2f(-(g * u)));
}
__device__ __forceinline__ void ld8f(const float* p, float (&o)[8]) { const f32x4 a = *(const f32x4*)p, b = *(const f32x4*)(p + 4); o[0] = a.x; o[1] = a.y; o[2] = a.z; o[3] = a.w; o[4] = b.x; o[5] = b.y; o[6] = b.z; o[7] = b.w; }
__device__ __forceinline__ void p7_conv(Frame& F) {
    constexpr int NCG = FF / 8, NRB = M / 8, NIT = NRB * NCG;
    const int gt = blockIdx.x * 512 + F.tid, NT = F.G * 512;
    v4u rawv[10], rawg[10];
#define P7_LOAD(dv, dg, it_) do { const int rb_ = (it_) / NCG, f0_ = 8 * ((it_) - rb_ * NCG), m0_ = rb_ * 8; const bool z_ = (m0_ >= MP) || ((m0_ & 2047) == 0); \
        _Pragma("unroll") for (int r = 0; r < 10; ++r) { const int rr = (r < 2 && z_) ? 2 : r; const bf16* ur = F.UP + (size_t)(m0_ + rr - 2) * FF2; dv[r] = *(const v4u*)(ur + f0_); dg[r] = *(const v4u*)(ur + FF + f0_); } } while (0)
#pragma unroll 1
    for (int it = gt; it < NIT; it += NT) {
        const int rb = it / NCG, cg = it - rb * NCG, f0 = 8 * cg, m0 = rb * 8;
        const bool is_p = m0 < MP; const int t0 = is_p ? (m0 & 2047) : 0; const int sb = is_p ? 0 : (m0 - MP) >> 3;
        P7_LOAD(rawv, rawg, it);
        float hv[3][8], hg[3][8];
#pragma unroll
        for (int r = 0; r < 2; ++r) {
            if (t0 == 0) {
                if (is_p) {
#pragma unroll
                    for (int e = 0; e < 8; ++e) { hv[r + 1][e] = 0.f; hg[r + 1][e] = 0.f; }
                } else { const float* sc = F.state_conv + ((size_t)sb * 2 + r) * FF2; ld8f(sc + f0, hv[r + 1]); ld8f(sc + FF + f0, hg[r + 1]); }
            } else { unpack8(rawv[r], hv[r + 1]); unpack8(rawg[r], hg[r + 1]); }
        }
        float wv[3][8], wg[3][8], bv[8], bg[8];
#pragma unroll
        for (int j = 0; j < 3; ++j) { ld8f(F.conv_w + (size_t)j * FF2 + f0, wv[j]); ld8f(F.conv_w + (size_t)j * FF2 + FF + f0, wg[j]); }
        ld8f(F.conv_b + f0, bv); ld8f(F.conv_b + FF + f0, bg);
#pragma unroll
        for (int r = 0; r < 8; ++r) {
#pragma unroll
            for (int e = 0; e < 8; ++e) { hv[0][e] = hv[1][e]; hv[1][e] = hv[2][e]; hg[0][e] = hg[1][e]; hg[1][e] = hg[2][e]; }
            unpack8(rawv[r + 2], hv[2]); unpack8(rawg[r + 2], hg[2]);
            float a[8];
#pragma unroll
            for (int e = 0; e < 8; ++e) { const float val = bv[e] + wv[0][e] * hv[0][e] + wv[1][e] * hv[1][e] + wv[2][e] * hv[2][e], gate = bg[e] + wg[0][e] * hg[0][e] + wg[1][e] * hg[1][e] + wg[2][e] * hg[2][e]; a[e] = gelu_tanh(gate) * val; }
            *(v4u*)(F.ACT + (size_t)(m0 + r) * FF + f0) = pack8(a);
            if (r >= 6) {
                float* o = nullptr;
                if (is_p) { if (t0 == 2040) o = F.out + O_CONVP + ((size_t)(m0 >> 11) * 2 + (r - 6)) * FF2; } else o = F.out + O_CONVS + ((size_t)sb * 2 + (r - 6)) * FF2;
                if (o) { *(f32x4*)(o + f0) = (f32x4){hv[2][0], hv[2][1], hv[2][2], hv[2][3]}; *(f32x4*)(o + f0 + 4) = (f32x4){hv[2][4], hv[2][5], hv[2][6], hv[2][7]};
                    *(f32x4*)(o + FF + f0) = (f32x4){hg[2][0], hg[2][1], hg[2][2], hg[2][3]}; *(f32x4*)(o + FF + f0 + 4) = (f32x4){hg[2][4], hg[2][5], hg[2][6], hg[2][7]}; }
            }
        }
    }
#undef P7_LOAD
}

struct Args { const float* in[18]; float* out; unsigned char* ws; int ph_lo, ph_hi, li, pad; };
template <int LO, int HI> __global__ void __launch_bounds__(NWAVES * 64, 2) skel_fwd(Args args) {
    extern __shared__ __attribute__((aligned(16))) unsigned char lds[];
    Frame F;
    F.lds = (LAS unsigned char*)lds;
    F.MISC = (volatile LAS unsigned*)(F.lds + LDSCTL_OFF);
    F.tid = threadIdx.x; F.lane = F.tid & 63; F.wave = __builtin_amdgcn_readfirstlane(F.tid >> 6);
    F.G = gridDim.x; F.gw = blockIdx.x * NWAVES + F.wave; F.NGW = F.G * NWAVES;
    unsigned char* ws = args.ws;
    F.ctl = (unsigned*)(ws + WS_CTL);
    F.xp = args.in[0]; F.xs = args.in[1]; F.state_pool = args.in[2]; F.state_ret = args.in[3]; F.state_conv = args.in[4]; F.g_pre_mix = args.in[5]; F.w_in = args.in[6]; F.w_pool = args.in[7];
    F.pool_scale = args.in[8]; F.gn_gain = args.in[9]; F.w_out = args.in[10]; F.g_post_mix = args.in[11]; F.g_pre_ffn = args.in[12]; F.w_up = args.in[13]; F.conv_w = args.in[14]; F.conv_b = args.in[15];
    F.w_down = args.in[16]; F.g_post_ffn = args.in[17]; F.out = args.out;
    F.WIN = (bf16*)(ws + WS_WIN); F.WUP = (bf16*)(ws + WS_WUP); F.WDN = (bf16*)(ws + WS_WDN); F.WOUT = (bf16*)(ws + WS_WOUT); F.WPOOL = (bf16*)(ws + WS_WPOOL);
    F.ROPE_C = (float*)(ws + WS_ROPE); F.ROPE_S = F.ROPE_C + 2056 * 64;
    F.XN = (bf16*)(ws + WS_XN); F.PROJ = (bf16*)(ws + WS_PROJ); F.UP = (bf16*)(ws + WS_PROJ); F.MOB = (bf16*)(ws + WS_PROJ);
    F.SP16 = (bf16*)(ws + WS_SP16); F.X1B = (bf16*)(ws + WS_X1);
    F.OB = (bf16*)(ws + WS_O); F.AP = (bf16*)(ws + WS_AP); F.MM = (bf16*)(ws + WS_MM); F.ACT = (bf16*)(ws + WS_O);
    for (int u = F.tid; u < (LDS_BYTES - LDSCTL_OFF) / 4; u += NWAVES * 64) ((LAS unsigned*)(F.lds + LDSCTL_OFF))[u] = 0u;
    __syncthreads();
    XcdBarrier bar; bar.bar = F.ctl + CW_BAR; bar.x = 0; bar.st = nullptr;
    if (N_LAUNCHES == 1) bar = xcd_barrier_post(F.ctl + CW_BAR, F.MISC + 8);
#define GRID_BAR() do { if (N_LAUNCHES == 1) xcd_barrier(bar); } while (0)
#define IN(k) (LO <= (k) && (k) < HI)
#define FRESH() do { int t_ = threadIdx.x; asm volatile("" : "+v"(t_)); F.tid = t_; F.lane = t_ & 63; } while (0)
#define SEAM(k) do { if constexpr (IN(k) && IN((k) + 1)) GRID_BAR(); } while (0)

#define REPS(k)
#define DUPBAR(k)
    const int rep = args.li;
    if constexpr (IN(0)) { FRESH(); REPS(0) { p0_prologue(F); DUPBAR(0); } SEAM(0); }
    if constexpr (IN(1)) {
      REPS(1) {
        pg8::Gemm g{F.XN, F.WIN, M, NIN, D}; pg8::HybridOrder S; S.init(M, NIN, D, F.G, (int)blockIdx.x, false);
        EpiProj E{F.PROJ, F.ROPE_C, F.ROPE_S}; pg8::SplitCtx X{(float*)(ws + WS_SLAB_A), F.ctl + CW_SPLIT};
        pg8::gemm_phase<EpiProj, pg8::HybridOrder, true, PG8_SP2, 5>(F.lds, g, S, E, X);
        if (rep == 0) { FRESH(); p0_deferred_weights(F, (LAS float*)(F.lds + F.wave * 16384)); }
        DUPBAR(1);
      }
        SEAM(1);
    }
    if constexpr (IN(2)) { FRESH(); REPS(2) { p2_mixers(F, rep); DUPBAR(2); } SEAM(2); }
    if constexpr (IN(3)) { FRESH(); REPS(3) { p3_merge(F); DUPBAR(3); } SEAM(3); }
    if constexpr (IN(4)) {
      REPS(4) {
        pg8::Gemm g{F.MM, F.WOUT, M, D, D}; pg8::HybridOrder S; S.init(M, D, D, F.G, (int)blockIdx.x);
        pg8::EpiBf16<0> E{F.MOB, D}; pg8::SplitCtx X{(float*)(ws + WS_SLAB_A), F.ctl + CW_SPLIT + 4096};
        pg8::gemm_phase<pg8::EpiBf16<0>, pg8::HybridOrder, true, PG8_SP2, 8>(F.lds, g, S, E, X);
        DUPBAR(4);
      }
        SEAM(4);
    }
    if constexpr (IN(5)) { FRESH(); REPS(5) { p5_rows(F); DUPBAR(5); } SEAM(5); }
    if constexpr (IN(6)) {
      REPS(6) {
        pg8::Gemm g{F.XN, F.WUP, M, FF2, D}; pg8::HybridOrder S; S.init(M, FF2, D, F.G, (int)blockIdx.x);
        pg8::EpiBf16<0> E{F.UP, FF2}; pg8::SplitCtx X{(float*)(ws + WS_SLAB_A), F.ctl + CW_SPLIT + 2 * 4096};
        pg8::gemm_phase<pg8::EpiBf16<0>, pg8::HybridOrder, true, PG8_SP2, 5>(F.lds, g, S, E, X);
        DUPBAR(6);
      }
        SEAM(6);
    }
    if constexpr (IN(7)) { FRESH(); REPS(7) { p7_conv(F); DUPBAR(7); } SEAM(7); }
    if constexpr (IN(8)) {
      REPS(8) {
        pg8::Gemm g{F.ACT, F.WDN, M, D, FF}; pg8::HybridOrder S; S.init(M, D, FF, F.G, (int)blockIdx.x);
        pg8::EpiBf16<0> E{F.MOB, D}; pg8::SplitCtx X{(float*)(ws + WS_SLAB_B), F.ctl + CW_SPLIT + 3 * 4096};
        pg8::gemm_phase<pg8::EpiBf16<0>, pg8::HybridOrder, true, PG8_SP2, 8>(F.lds, g, S, E, X);
        DUPBAR(8);
      }
        SEAM(8);
    }
    if constexpr (IN(9)) { FRESH(); p9_rows(F, (DUP_PHASE == 9 && rep == 1) ? (float*)(ws + WS_O) : F.out + O_Y); }
#undef IN
#undef SEAM
}


#if MK_N_LAUNCHES != 1
template <int P> static void launch_one(int grid, const Args& a, hipStream_t stream) { hipLaunchKernelGGL((skel_fwd<P, P + 1>), dim3(grid), dim3(NWAVES * 64), LDS_BYTES, stream, a); }
static void launch_phase(int li, int grid, const Args& a, hipStream_t stream) {
    switch (li) { case 0: launch_one<0>(grid, a, stream); break; case 1: launch_one<1>(grid, a, stream); break; case 2: launch_one<2>(grid, a, stream); break; case 3: launch_one<3>(grid, a, stream); break;
        case 4: launch_one<4>(grid, a, stream); break; case 5: launch_one<5>(grid, a, stream); break; case 6: launch_one<6>(grid, a, stream); break; case 7: launch_one<7>(grid, a, stream); break;
        case 8: launch_one<8>(grid, a, stream); break; default: launch_one<9>(grid, a, stream); break; }
}
#endif
static hipError_t set_lds_attr() {
    hipError_t e = hipSuccess;
#if MK_N_LAUNCHES == 1
    e = hipFuncSetAttribute((const void*)skel_fwd<0, N_PHASES>, hipFuncAttributeMaxDynamicSharedMemorySize, LDS_BYTES);
#else
#define SET1(P) if (e == hipSuccess) e = hipFuncSetAttribute((const void*)skel_fwd<P, P + 1>, hipFuncAttributeMaxDynamicSharedMemorySize, LDS_BYTES)
    SET1(0); SET1(1); SET1(2); SET1(3); SET1(4); SET1(5); SET1(6); SET1(7); SET1(8); SET1(9);
#undef SET1
#endif
    return e;
}
static hipError_t occ_query(int* per_cu) {
#if MK_N_LAUNCHES == 1
    return hipOccupancyMaxActiveBlocksPerMultiprocessor(per_cu, (const void*)skel_fwd<0, N_PHASES>, NWAVES * 64, LDS_BYTES);
#else
    return hipOccupancyMaxActiveBlocksPerMultiprocessor(per_cu, (const void*)skel_fwd<1, 2>, NWAVES * 64, LDS_BYTES);
#endif
}
extern "C" void kernel_launch(void* const* d_in, const int* in_sizes, int n_in, void* d_out, int out_size, void* d_ws, size_t ws_size, hipStream_t stream) {
    static int grid = 0;
    if (grid == 0) {
        if (n_in != 18 || (size_t)out_size != O_END || ws_size < WS_END) { fprintf(stderr, "kernel_launch: unexpected shapes: n_in %d out %d ws %zu (need %zu)\n", n_in, out_size, ws_size, (size_t)WS_END); grid = -1; return; }
        int dev = 0, cus = 0, per_cu = 0;
        if (hipGetDevice(&dev) != hipSuccess || hipDeviceGetAttribute(&cus, hipDeviceAttributeMultiprocessorCount, dev) != hipSuccess) { grid = -1; return; }
        if (set_lds_attr() != hipSuccess) { fprintf(stderr, "kernel_launch: hipFuncSetAttribute failed\n"); grid = -1; return; }
        if (occ_query(&per_cu) != hipSuccess || per_cu < 1) { fprintf(stderr, "kernel_launch: occupancy query says %d blocks per CU\n", per_cu); (void)hipGetLastError(); per_cu = 1; }
        grid = cus;
        fprintf(stderr, "kernel_launch: cus %d per_cu %d grid %d ws %zu\n", cus, per_cu, grid, ws_size);
    }
    if (grid < 0) return;
    (void)hipMemsetAsync((char*)d_ws + WS_CTL, 0, CTL_ZERO_BYTES, stream);
    Args a{};
    for (int i = 0; i < 18; ++i) a.in[i] = (const float*)d_in[i];
    a.out = (float*)d_out; a.ws = (unsigned char*)d_ws;
#if MK_N_LAUNCHES == 1
    {
        a.ph_lo = 0; a.ph_hi = N_PHASES; a.li = 0;
        void* kargs[] = {&a};
        hipError_t e = hipLaunchCooperativeKernel((const void*)skel_fwd<0, N_PHASES>, dim3(grid), dim3(NWAVES * 64), kargs, LDS_BYTES, stream);
        if (e != hipSuccess) fprintf(stderr, "kernel_launch: cooperative launch failed: %s (grid %d)\n", hipGetErrorString(e), grid);
    }
#else
    for (int li = 0; li < N_PHASES; ++li) { a.ph_lo = li; a.ph_hi = li + 1; a.li = 0; launch_phase(li, grid, a, stream); if (li == DUP_PHASE) { a.li = 1; launch_phase(li, grid, a, stream); if (li == 9) { a.li = 0; } } if (li == 2 && DUP_PHASE >= 20) { a.li = 1 + 16 * (DUP_PHASE - 20); launch_phase(li, grid, a, stream); } }
#endif
}
```

```cpp
#include <hip/hip_runtime.h>
#include <cstdio>
#include <cstdint>
namespace pg8 {
#define PG8_LAS __attribute__((address_space(3)))
typedef unsigned short bf16_t;
typedef short bf16x8 __attribute__((ext_vector_type(8)));
typedef float f32x4 __attribute__((ext_vector_type(4)));
typedef unsigned u32x4 __attribute__((ext_vector_type(4)));
constexpr int BM = 256, BK = 64, HALF = 128, HTB = HALF * BK * 2  , STAGE_BYTES = 8 * HTB, NXCD = 8, WGM = 2;

__host__ __device__ __forceinline__ int lds_byte(int r, int c) { const int st = (r >> 4) * 2 + (c >> 5), rr = r & 15, cc = c & 31, ob = rr * 64 + cc * 2; return st * 1024 + (ob ^ (((ob >> 9) & 1) << 5)); }
__host__ __device__ __forceinline__ void stage_rc(int b, int& R, int& C) { const int st = b / 1024, sb = b % 1024, swz = sb ^ (((sb >> 9) & 1) << 5); R = (st >> 1) * 16 + swz / 64; C = (st & 1) * 32 + (swz % 64) / 2; }
__host__ __device__ __forceinline__ int perm32(int rho) { const int n = rho >> 4, i = rho & 15; return 8 * (i >> 2) + 4 * n + (i & 3); }

struct Unit { int pm, pn, k0, nt, np, piece, slot; };
struct Gemm { const bf16_t* A; const bf16_t* Bt; int M, N, K; };

struct StaticOrder {
    int nM, nN, nwg, G, c;
    __host__ __device__ void init(int M, int N, int G_, int c_) { nM = M / BM; nN = N / BM; nwg = nM * nN; G = G_; c = c_; }
    __host__ __device__ bool next(int i, Unit& u) const {
        const long L = (long)i * G + c; if (L >= nwg) return false;
        int wgid = (int)L;
#ifndef ORDER_NOREMAP
        { const int q = nwg / NXCD, r = nwg % NXCD, xcd = wgid % NXCD, off = wgid / NXCD; wgid = (xcd < r ? xcd * (q + 1) : r * (q + 1) + (xcd - r) * q) + off; }
#endif
        const int nig = WGM * nN, gid = wgid / nig, fm = gid * WGM, gsz = (nM - fm) < WGM ? (nM - fm) : WGM;
        u.pm = fm + ((wgid % nig) % gsz); u.pn = (wgid % nig) / gsz; return true;
    }
    __device__ __forceinline__ void a_ready(const Unit&) const {}
    __device__ __forceinline__ void done(const Unit&) const {}
};


struct HybridOrder {
    int nM, nN, nwg, G, c, ntk, nfull, nrem, np;
    __host__ __device__ void init(int M, int N, int K, int G_, int c_, bool allow_split = true) {
        nM = M / BM; nN = N / BM; nwg = nM * nN; G = G_; c = c_; ntk = K / BK; nfull = nwg / G; nrem = nwg - nfull * G; np = 0;
        if (allow_split && nrem > 0 && (G % NXCD) == 0) { const int grp = (nrem + NXCD - 1) / NXCD; int p = (G / NXCD) / grp; const int maxp = ntk / 4; if (p > maxp) p = maxp; if (p > 8) p = 8; if (p >= 2) np = p; }
    }
    __host__ __device__ void map(long L, Unit& u) const {
        int wgid = (int)L;
#ifndef ORDER_NOREMAP
        { const int q = nwg / NXCD, r = nwg % NXCD, xcd = wgid % NXCD, off = wgid / NXCD; wgid = (xcd < r ? xcd * (q + 1) : r * (q + 1) + (xcd - r) * q) + off; }
#endif
        const int nig = WGM * nN, gid = wgid / nig, fm = gid * WGM, gsz = (nM - fm) < WGM ? (nM - fm) : WGM;
        u.pm = fm + ((wgid % nig) % gsz); u.pn = (wgid % nig) / gsz; u.k0 = 0; u.nt = ntk; u.np = 0; u.piece = 0; u.slot = 0;
    }
    __host__ __device__ bool next(int i, Unit& u) const {
        if (i < nfull) { map((long)i * G + c, u); return true; }
        if (i > nfull || nrem == 0) return false;
        if (np == 0) { if (c >= nrem) return false; map((long)nfull * G + c, u); return true; }
        const int x = c % NXCD, j = c / NXCD, grp = j / np, p = j - grp * np, r = grp * NXCD + x;
        if (r >= nrem) return false;
        map((long)nfull * G + r, u);
        const int pairs = ntk / 2, base = pairs / np, extra = pairs - base * np, first_big = np - extra;
        const int start = p * base + (p > first_big ? p - first_big : 0), len = base + (p >= first_big ? 1 : 0);
        u.k0 = 2 * start; u.nt = 2 * len; u.np = np; u.piece = p; u.slot = r; return true;
    }
    __device__ __forceinline__ void a_ready(const Unit&) const {}
    __device__ __forceinline__ void done(const Unit&) const {}
};
struct SplitCtx { float* slabs; unsigned* cnt; };

__device__ __forceinline__ unsigned cvt_pk_bf16(float lo, float hi) { unsigned r; asm volatile("v_cvt_pk_bf16_f32 %0, %1, %2" : "=v"(r) : "v"(lo), "v"(hi)); return r; }
typedef float f32x2 __attribute__((ext_vector_type(2)));
__device__ __forceinline__ f32x2 gelu_pk(f32x2 v) {
    const f32x2 av = __builtin_elementwise_abs(v), d = av * 0.2316418882f + 1.0f;
    f32x2 t; t.x = __builtin_amdgcn_rcpf(d.x); t.y = __builtin_amdgcn_rcpf(d.y);
    f32x2 q = t * 0.5307027145f + (-0.7265760135f); q = q * t + 0.7107068705f; q = q * t + (-0.142248368f); q = q * t + 0.127414796f; q = q * t;
    const f32x2 s = (v * v) * (-0.72134752044f);
    f32x2 e; e.x = __builtin_amdgcn_exp2f(s.x); e.y = __builtin_amdgcn_exp2f(s.y);
    const f32x2 m = v * (q * e), r = v - m;
    f32x2 o; o.x = v.x < 0.f ? m.x : r.x; o.y = v.y < 0.f ? m.y : r.y; return o;
}

template <int ACT> struct EpiBf16 {
    static constexpr bool PERM = true, AFTER_DRAIN = false;
    bf16_t* O; int ldc;
    __device__ __forceinline__ void tri(const f32x4 v0, const f32x4 v1, const Unit& u, int ai, int bj, int m, int wr, int wc, int fr, int fq) const {
        bf16_t* p = O + (size_t)(u.pm * BM + ai * HALF + wr * 64 + m * 16 + fr) * ldc + u.pn * BM + bj * HALF + wc * 32 + 8 * fq;
        u32x4 w; w.x = cvt_pk_bf16(v0[0], v0[1]); w.y = cvt_pk_bf16(v0[2], v0[3]); w.z = cvt_pk_bf16(v1[0], v1[1]); w.w = cvt_pk_bf16(v1[2], v1[3]);
        *(u32x4*)p = w;
    }
    __device__ __forceinline__ void operator()(const f32x4 (&acc)[2][2][4][2], const Unit& u, int wr, int wc, int fr, int fq) const {
#pragma unroll
        for (int ai = 0; ai < 2; ++ai)
#pragma unroll
            for (int m = 0; m < 4; ++m)
#pragma unroll
                for (int bj = 0; bj < 2; ++bj) tri(acc[ai][bj][m][0], acc[ai][bj][m][1], u, ai, bj, m, wr, wc, fr, fq);
    }
};
struct EpiF32 {
    static constexpr bool PERM = false, AFTER_DRAIN = false;
    float* C; int ldc;
    __device__ __forceinline__ void tri(const f32x4 v0, const f32x4 v1, const Unit& u, int ai, int bj, int m, int wr, int wc, int fr, int fq) const {
        float* p = C + (size_t)(u.pm * BM + ai * HALF + wr * 64 + m * 16 + fr) * ldc + u.pn * BM + bj * HALF + wc * 32 + 4 * fq;
        *(f32x4*)p = v0; *(f32x4*)(p + 16) = v1;
    }
    __device__ __forceinline__ void operator()(const f32x4 (&acc)[2][2][4][2], const Unit& u, int wr, int wc, int fr, int fq) const {
#pragma unroll
        for (int ai = 0; ai < 2; ++ai)
#pragma unroll
            for (int m = 0; m < 4; ++m)
#pragma unroll
                for (int bj = 0; bj < 2; ++bj) tri(acc[ai][bj][m][0], acc[ai][bj][m][1], u, ai, bj, m, wr, wc, fr, fq);
    }
};
typedef unsigned u32x2 __attribute__((ext_vector_type(2)));
__device__ __forceinline__ f32x4 bf4_to_f32(u32x2 x) { f32x4 o; o[0] = __builtin_bit_cast(float, x.x << 16); o[1] = __builtin_bit_cast(float, x.x & 0xffff0000u); o[2] = __builtin_bit_cast(float, x.y << 16); o[3] = __builtin_bit_cast(float, x.y & 0xffff0000u); return o; }
template <int NP, class Epi> __device__ __forceinline__ void split_epilogue(const f32x4 (&acc)[2][2][4][2], const Unit& u, const Epi& E, const SplitCtx& X, int tid, int wr, int wc, int fr, int fq) {
    constexpr int SLAB = 32 * 512 * 8;
    const __amdgpu_buffer_rsrc_t rs = __builtin_amdgcn_make_buffer_rsrc((void*)((char*)X.slabs + (size_t)(u.slot * u.np) * SLAB), 0, u.np * SLAB, 0x00020000);
    {
        const int so = u.piece * SLAB;
#pragma unroll
        for (int r = 0; r < 32; ++r) { const f32x4 v = acc[r >> 4][(r >> 3) & 1][(r >> 1) & 3][r & 1]; u32x2 w; w.x = cvt_pk_bf16(v[0], v[1]); w.y = cvt_pk_bf16(v[2], v[3]);
            __builtin_amdgcn_raw_buffer_store_b64(w, rs, (unsigned)(tid * 8), so + r * 4096, 16); }
    }
    asm volatile("s_waitcnt vmcnt(0)" ::: "memory");
    asm volatile("" ::: "memory"); __builtin_amdgcn_s_barrier(); asm volatile("" ::: "memory");
    if (tid == 0) {
        unsigned* cw = X.cnt + 64 * u.slot;
        (void)__hip_atomic_fetch_add(cw, 1u, __ATOMIC_RELAXED, __HIP_MEMORY_SCOPE_AGENT);
        unsigned sp = 0;
        while (__hip_atomic_load(cw, __ATOMIC_RELAXED, __HIP_MEMORY_SCOPE_AGENT) < (unsigned)u.np) { __builtin_amdgcn_s_sleep(1); if (++sp > (1u << 24)) break; }
        __builtin_amdgcn_fence(__ATOMIC_ACQUIRE, "agent");
        asm volatile("s_waitcnt vmcnt(0)" ::: "memory");
    }
    asm volatile("" ::: "memory"); __builtin_amdgcn_s_barrier(); asm volatile("" ::: "memory");
    const int q0 = (16 * u.piece) / u.np, q1 = (16 * (u.piece + 1)) / u.np;
#pragma unroll 1
    for (int q = q0; q < q1; ++q) {
        const unsigned vo = (unsigned)(tid * 8 + q * 8192);
        f32x4 v0 = (f32x4){0.f, 0.f, 0.f, 0.f}, v1 = v0;
        if (u.np == NP) {
            u32x2 t0[NP], t1[NP];
#pragma unroll
            for (int pp = 0; pp < NP; ++pp) { t0[pp] = __builtin_amdgcn_raw_buffer_load_b64(rs, vo, pp * SLAB, 0); t1[pp] = __builtin_amdgcn_raw_buffer_load_b64(rs, vo, pp * SLAB + 4096, 0); }
#pragma unroll
            for (int pp = 0; pp < NP; ++pp) { v0 += bf4_to_f32(t0[pp]); v1 += bf4_to_f32(t1[pp]); }
        } else {
            for (int pp = 0; pp < u.np; ++pp) { v0 += bf4_to_f32(__builtin_amdgcn_raw_buffer_load_b64(rs, vo, pp * SLAB, 0)); v1 += bf4_to_f32(__builtin_amdgcn_raw_buffer_load_b64(rs, vo, pp * SLAB + 4096, 0)); }
        }
        E.tri(v0, v1, u, q >> 3, (q >> 2) & 1, q & 3, wr, wc, fr, fq);
    }
}
template <class Epi, class Sched, bool ALIGN_EPI = false, bool SP2 = false, int NP = 8>
__device__ __forceinline__ void gemm_phase(PG8_LAS unsigned char* lds, const Gemm g, const Sched& S, const Epi& E, const SplitCtx& X) {
    int tid_ = threadIdx.x; asm volatile("" : "+v"(tid_));
    const int tid = tid_, wid = __builtin_amdgcn_readfirstlane(tid >> 6), lane = tid & 63, wr = wid >> 2, wc = wid & 3, fr = lane & 15, fq = lane >> 4;
    const int K = g.K;
    unsigned voffA[2], voffB[2];
#pragma unroll
    for (int i = 0; i < 2; ++i) { int R, C; stage_rc(tid * 16 + i * 8192, R, C); const int Rb = Epi::PERM ? ((R & ~31) + perm32(R & 31)) : R;
        voffA[i] = (unsigned)(R * K + C) * 2u; voffB[i] = (unsigned)(Rb * K + C) * 2u; }
    const size_t kstep = (size_t)(BK * 2);
    const size_t hstep = (size_t)HALF * K * 2;
    const size_t tstep = 2 * hstep;
    const unsigned ldsw = (unsigned)wid * 1024u;
    const int aoff = lds_byte(wr * 64 + fr, fq * 8), boff = lds_byte(wc * 32 + fr, fq * 8);
#define PG8_SA(b, h) (((b) * 2 + (h)) * HTB)
#define PG8_SB(b, h) ((4 + (b) * 2 + (h)) * HTB)
#define PG8_STAGE(bufoff, gbase, voff) do { _Pragma("unroll") for (int _i = 0; _i < 2; ++_i) \
        __builtin_amdgcn_global_load_lds((const unsigned*)((const char*)(gbase) + (voff)[_i]), (PG8_LAS unsigned*)(lds + (bufoff) + ldsw + _i * 8192), 16, 0, 0); } while (0)
#define PG8_LDA(dst, b, h) do { _Pragma("unroll") for (int m = 0; m < 4; ++m) _Pragma("unroll") for (int k = 0; k < 2; ++k) dst[m][k] = *(const PG8_LAS bf16x8*)(lds + PG8_SA(b, h) + aoff + m * 2048 + k * 1024); } while (0)
#define PG8_LDB(dst, b, h) do { _Pragma("unroll") for (int n = 0; n < 2; ++n) _Pragma("unroll") for (int k = 0; k < 2; ++k) dst[n][k] = *(const PG8_LAS bf16x8*)(lds + PG8_SB(b, h) + boff + n * 2048 + k * 1024); } while (0)
#define PG8_MMA(ai, bj, At, Bt) do { __builtin_amdgcn_s_setprio(1); _Pragma("unroll") for (int m = 0; m < 4; ++m) _Pragma("unroll") for (int n = 0; n < 2; ++n) _Pragma("unroll") for (int k = 0; k < 2; ++k) \
        acc[ai][bj][m][n] = __builtin_amdgcn_mfma_f32_16x16x32_bf16(Bt[n][k], At[m][k], acc[ai][bj][m][n], 0, 0, 0); __builtin_amdgcn_s_setprio(0); } while (0)
#define PG8_WAIT_V(n) asm volatile("s_waitcnt vmcnt(" #n ")" ::: "memory")
#define PG8_WAIT_L(n) asm volatile("s_waitcnt lgkmcnt(" #n ")" ::: "memory")
#define PG8_BAR __builtin_amdgcn_s_barrier()
#define PG8_SCHED __builtin_amdgcn_sched_barrier(0)
    Unit cur, nxt; int ui = 0;
    if (!S.next(0, cur)) return;
    f32x4 acc[2][2][4][2];
#pragma unroll
    for (int a = 0; a < 2; ++a)
#pragma unroll
        for (int b = 0; b < 2; ++b)
#pragma unroll
            for (int m = 0; m < 4; ++m)
#pragma unroll
                for (int n = 0; n < 2; ++n) acc[a][b][m][n] = (f32x4){0.f, 0.f, 0.f, 0.f};
    bf16x8 At[4][2], B0[2][2], B1[2][2];
    const char* cA = (const char*)g.A + (size_t)cur.pm * tstep + (size_t)cur.k0 * kstep; const char* cB = (const char*)g.Bt + (size_t)cur.pn * tstep + (size_t)cur.k0 * kstep;
    S.a_ready(cur);
    if constexpr (SP2) {
        PG8_STAGE(PG8_SB(0, 0), cB, voffB); PG8_STAGE(PG8_SB(0, 1), cB + hstep, voffB); PG8_STAGE(PG8_SA(0, 0), cA, voffA); PG8_STAGE(PG8_SA(0, 1), cA + hstep, voffA);
        if (wr == 1) PG8_BAR;
        PG8_WAIT_V(2); PG8_BAR;
        PG8_STAGE(PG8_SB(1, 0), cB + kstep, voffB); PG8_STAGE(PG8_SA(1, 0), cA + kstep, voffA); PG8_STAGE(PG8_SB(1, 1), cB + hstep + kstep, voffB);
        PG8_WAIT_V(6); PG8_BAR;
    } else {
        PG8_STAGE(PG8_SB(0, 0), cB, voffB); PG8_STAGE(PG8_SA(0, 0), cA, voffA); PG8_STAGE(PG8_SB(0, 1), cB + hstep, voffB); PG8_STAGE(PG8_SA(0, 1), cA + hstep, voffA);
        if (wr == 1) PG8_BAR;
        PG8_WAIT_V(4); PG8_BAR;
        PG8_STAGE(PG8_SB(1, 0), cB + kstep, voffB); PG8_STAGE(PG8_SA(1, 0), cA + kstep, voffA); PG8_STAGE(PG8_SB(1, 1), cB + hstep + kstep, voffB);
        PG8_WAIT_V(6); PG8_BAR;
    }
    for (;;) {
        const bool has_next = S.next(ui + 1, nxt);
        const char* nA = has_next ? (const char*)g.A + (size_t)nxt.pm * tstep + (size_t)nxt.k0 * kstep : cA; const char* nB = has_next ? (const char*)g.Bt + (size_t)nxt.pn * tstep + (size_t)nxt.k0 * kstep : cB;
        const int nt = cur.nt;
        for (int t = 0; t < nt; t += 2) {
            const bool last = (t == nt - 2);
            const char* a1 = cA + (size_t)(t + 1) * kstep;
            const char* a2 = last ? nA : cA + (size_t)(t + 2) * kstep; const char* b2 = last ? nB : cB + (size_t)(t + 2) * kstep;
            const char* a3 = a2 + kstep; const char* b3 = b2 + kstep;
            if (last && has_next) S.a_ready(nxt);
            if constexpr (SP2) {
            PG8_LDB(B0, 0, 0); PG8_LDB(B1, 0, 1); PG8_SCHED; PG8_LDA(At, 0, 0); PG8_STAGE(PG8_SA(1, 1), a1 + hstep, voffA);
            PG8_WAIT_V(8); PG8_WAIT_L(0); PG8_BAR; PG8_MMA(0, 0, At, B0); PG8_MMA(0, 1, At, B1); PG8_BAR; PG8_SCHED;
            PG8_LDA(At, 0, 1); PG8_STAGE(PG8_SB(0, 0), b2, voffB); PG8_STAGE(PG8_SB(0, 1), b2 + hstep, voffB); PG8_STAGE(PG8_SA(0, 0), a2, voffA);
            PG8_WAIT_V(8); PG8_WAIT_L(0); PG8_BAR; PG8_MMA(1, 0, At, B0); PG8_MMA(1, 1, At, B1); PG8_BAR; PG8_SCHED;
            PG8_LDB(B0, 1, 0); PG8_LDB(B1, 1, 1); PG8_SCHED; PG8_LDA(At, 1, 0); PG8_STAGE(PG8_SA(0, 1), a2 + hstep, voffA);
            PG8_WAIT_V(8); PG8_WAIT_L(0); PG8_BAR; PG8_MMA(0, 0, At, B0); PG8_MMA(0, 1, At, B1); PG8_BAR; PG8_SCHED;
            PG8_LDA(At, 1, 1); PG8_STAGE(PG8_SB(1, 0), b3, voffB); PG8_STAGE(PG8_SB(1, 1), b3 + hstep, voffB); PG8_STAGE(PG8_SA(1, 0), a3, voffA);
            PG8_WAIT_V(8); PG8_WAIT_L(0); PG8_BAR; PG8_MMA(1, 0, At, B0); PG8_MMA(1, 1, At, B1); PG8_BAR; PG8_SCHED;
            } else {
            PG8_LDB(B0, 0, 0); PG8_SCHED; PG8_LDA(At, 0, 0); PG8_STAGE(PG8_SA(1, 1), a1 + hstep, voffA);
            PG8_WAIT_L(8); PG8_BAR; PG8_WAIT_L(0); PG8_MMA(0, 0, At, B0); PG8_BAR; PG8_SCHED;
            PG8_LDB(B1, 0, 1); PG8_STAGE(PG8_SB(0, 0), b2, voffB);
            PG8_BAR; PG8_WAIT_L(0); PG8_MMA(0, 1, At, B1); PG8_BAR;
            PG8_LDA(At, 0, 1); PG8_STAGE(PG8_SA(0, 0), a2, voffA);
            PG8_BAR; PG8_WAIT_L(0); PG8_MMA(1, 0, At, B0); PG8_BAR; PG8_SCHED;
            PG8_STAGE(PG8_SB(0, 1), b2 + hstep, voffB);
            PG8_WAIT_V(6); PG8_BAR; PG8_MMA(1, 1, At, B1); PG8_BAR;
            PG8_LDB(B0, 1, 0); PG8_SCHED; PG8_LDA(At, 1, 0); PG8_STAGE(PG8_SA(0, 1), a2 + hstep, voffA);
            PG8_WAIT_L(8); PG8_BAR; PG8_WAIT_L(0); PG8_MMA(0, 0, At, B0); PG8_BAR; PG8_SCHED;
            PG8_LDB(B1, 1, 1); PG8_STAGE(PG8_SB(1, 0), b3, voffB);
            PG8_BAR; PG8_WAIT_L(0); PG8_MMA(0, 1, At, B1); PG8_BAR;
            PG8_LDA(At, 1, 1); PG8_STAGE(PG8_SA(1, 0), a3, voffA);
            PG8_BAR; PG8_WAIT_L(0); PG8_MMA(1, 0, At, B0); PG8_BAR; PG8_SCHED;
            PG8_STAGE(PG8_SB(1, 1), b3 + hstep, voffB);
            PG8_WAIT_V(6); PG8_BAR; PG8_MMA(1, 1, At, B1); PG8_BAR;
            }
        }
        if constexpr (ALIGN_EPI) { if (wr == 0) PG8_BAR; }
        if constexpr (!Epi::AFTER_DRAIN) { if (cur.np > 0) split_epilogue<NP>(acc, cur, E, X, tid, wr, wc, fr, fq); else E(acc, cur, wr, wc, fr, fq); S.done(cur); }
        if (!has_next) break;
#pragma unroll
        for (int a = 0; a < 2; ++a)
#pragma unroll
            for (int b = 0; b < 2; ++b)
#pragma unroll
                for (int m = 0; m < 4; ++m)
#pragma unroll
                    for (int n = 0; n < 2; ++n) acc[a][b][m][n] = (f32x4){0.f, 0.f, 0.f, 0.f};
        cur = nxt; cA = nA; cB = nB; ++ui;
        if constexpr (ALIGN_EPI) { if (wr == 1) PG8_BAR; }
    }
    PG8_WAIT_V(0);
    if constexpr (!ALIGN_EPI) { if (wr == 0) PG8_BAR; }
    PG8_BAR;
    if constexpr (Epi::AFTER_DRAIN) { E.fused(acc, cur, wr, wc, fr, fq, lds, wid, lane); S.done(cur); }
#undef PG8_SA
#undef PG8_SB
#undef PG8_STAGE
#undef PG8_LDA
#undef PG8_LDB
#undef PG8_MMA
#undef PG8_WAIT_V
#undef PG8_WAIT_L
#undef PG8_BAR
#undef PG8_SCHED
}
}

#ifndef PG8_SP2
#define PG8_SP2 true
#endif
#ifndef PG8_ALIGN
#define PG8_ALIGN true
#endif
#ifndef DUP_PHASE
#define DUP_PHASE -1
#endif
#ifndef MK_N_LAUNCHES
#define MK_N_LAUNCHES 1
#endif
constexpr int NWAVES = 8;
constexpr int N_PHASES = 10;
constexpr int N_LAUNCHES = MK_N_LAUNCHES;

constexpr int MP = 8192, MS = 1024, M = MP + MS;
constexpr int D = 2048, NIN = 11264, FF = 5632, FF2 = 11264;
constexpr int NH = 8, DK = 128, DVH = 256;
constexpr int C_POOL = 0, C_Q = 1024, C_K = 2048, C_V = 3072, C_GRET = 5120, C_GA = 7168, C_GR = 9216;
constexpr float EPS = 1e-6f;
constexpr int NS = 4, DVS = DVH / NS;
constexpr size_t O_Y = 0, O_POOLP = 18874368, O_RETP = 18935808, O_CONVP = 19984384, O_POOLS = 20074496, O_RETS = 22040576, O_CONVS = 55595008, O_END = 58478592;

constexpr size_t MiB = 1u << 20;
constexpr size_t WS_CTL = 0, CTL_ZERO_BYTES = 128 * 1024;
constexpr size_t WS_WIN = 1 * MiB, WS_WUP = 45 * MiB, WS_WDN = 89 * MiB, WS_WOUT = 111 * MiB, WS_WPOOL = 119 * MiB;
constexpr size_t WS_ROPE = 120 * MiB;
constexpr size_t WS_XN = 122 * MiB;
constexpr size_t WS_PROJ = 158 * MiB;
constexpr size_t WS_O = 356 * MiB, WS_AP = 392 * MiB, WS_MM = 428 * MiB;
constexpr size_t WS_SP16 = 464 * MiB;
constexpr size_t WS_X1 = 468 * MiB;
constexpr size_t WS_END = 504 * MiB;
constexpr int CW_TMO = 0, CW_CODE = 1, CW_Q2 = 64, CW_QW = 192, CW_BAR = 4096, CW_SPLIT = 8192;
static_assert((CW_SPLIT + 4 * 4096) * 4 <= (int)CTL_ZERO_BYTES && CW_BAR + 3456 <= CW_SPLIT, "control words inside the per-call memset");
constexpr size_t WS_SLAB_A = 356 * MiB, WS_SLAB_B = 230 * MiB;

constexpr int LDS_BYTES = 147456, LDSCTL_OFF = 143360;

#define GAS __attribute__((address_space(1)))
#define LAS __attribute__((address_space(3)))
typedef unsigned short bf16;
typedef unsigned v4u __attribute__((ext_vector_type(4)));
typedef unsigned v2u __attribute__((ext_vector_type(2)));
typedef float f32x4 __attribute__((ext_vector_type(4)));
typedef short bf16x8 __attribute__((ext_vector_type(8)));
#define RLX_AGENT __ATOMIC_RELAXED, __HIP_MEMORY_SCOPE_AGENT
#define LDS_WAIT() asm volatile("s_waitcnt lgkmcnt(0)" ::: "memory")
#define VM_WAIT() asm volatile("s_waitcnt vmcnt(0)" ::: "memory")
__device__ __forceinline__ unsigned pk2(float lo, float hi) { return pg8::cvt_pk_bf16(lo, hi); }
__device__ __forceinline__ float bflo(unsigned u) { return __uint_as_float(u << 16); }
__device__ __forceinline__ float bfhi(unsigned u) { return __uint_as_float(u & 0xffff0000u); }
__device__ __forceinline__ void unpack8(v4u x, float (&f)[8]) { f[0] = bflo(x.x); f[1] = bfhi(x.x); f[2] = bflo(x.y); f[3] = bfhi(x.y); f[4] = bflo(x.z); f[5] = bfhi(x.z); f[6] = bflo(x.w); f[7] = bfhi(x.w); }
__device__ __forceinline__ v4u pack8(const float (&f)[8]) { v4u o; o.x = pk2(f[0], f[1]); o.y = pk2(f[2], f[3]); o.z = pk2(f[4], f[5]); o.w = pk2(f[6], f[7]); return o; }
__device__ __forceinline__ v2u pack4(f32x4 a) { v2u o; o.x = pk2(a[0], a[1]); o.y = pk2(a[2], a[3]); return o; }
__device__ __forceinline__ float sigmoidf_(float x) { return __builtin_amdgcn_rcpf(1.0f + __expf(-x)); }
__device__ __forceinline__ float wave_sum(float v) {
#pragma unroll
    for (int o = 1; o < 64; o <<= 1) v += __shfl_xor(v, o);
    return v;
}
__device__ __forceinline__ bf16x8 as_bf16x8(v4u x) { return __builtin_bit_cast(bf16x8, x); }
#define MFMA16(a, b, c) __builtin_amdgcn_mfma_f32_16x16x32_bf16((a), (b), (c), 0, 0, 0)

#define XB_TMO      128
#define XB_XCNT(j)  (256  + 64 * (j))
#define XB_XSUB(j)  (1280 + 64 * (j))
#define XB_XGEN(j)  (2304 + 64 * (j))
#define XB_TOP      3328
#define XB_TOPGEN   3392
#define XCD_BAR_WORDS 3456
#define XB_SPIN_CAP (1u << 22)
__device__ __forceinline__ unsigned xb_ld(unsigned* p)              { return __hip_atomic_load(p, __ATOMIC_RELAXED, __HIP_MEMORY_SCOPE_AGENT); }
__device__ __forceinline__ unsigned xb_add(unsigned* p, unsigned v) { return __hip_atomic_fetch_add(p, v, __ATOMIC_RELAXED, __HIP_MEMORY_SCOPE_AGENT); }
__device__ __forceinline__ unsigned xb_xcc_id() { return (unsigned)__builtin_amdgcn_s_getreg((3 << 11) | 20) & 0xFu; }
#define XB_SPIN(cond, bar) do { unsigned _sp = 0; while (cond) { __builtin_amdgcn_s_sleep(1); \
    if ((++_sp & 255u) == 0u) { if (xb_ld(&(bar)[XB_TMO])) break; if (_sp > XB_SPIN_CAP) { atomicAdd(&(bar)[XB_TMO], 1u); break; } } } } while (0)
struct XcdBarrier { unsigned* bar; unsigned x; volatile LAS unsigned* st; };
__device__ __forceinline__ XcdBarrier xcd_barrier_post(unsigned* bar, volatile LAS unsigned* st) {
    XcdBarrier b; b.bar = bar; b.x = xb_xcc_id(); b.st = st;
    if (threadIdx.x == 0) (void)xb_add(&bar[XB_XCNT(b.x)], 1u);
    return b;
}
__device__ __forceinline__ void xcd_barrier_complete(unsigned* bar, unsigned x, unsigned& nloc, unsigned& nx) {
    const unsigned G = gridDim.x * gridDim.y * gridDim.z;
    unsigned sum, cnt, mine, sp = 0u;
    for (;;) {
        sum = 0u; cnt = 0u; mine = 0u;
#pragma unroll
        for (unsigned j = 0; j < 16; ++j) { const unsigned c = xb_ld(&bar[XB_XCNT(j)]); sum += c; cnt += (c > 0u) ? 1u : 0u; mine = (j == x) ? c : mine; }
        if (sum == G) break;
        __builtin_amdgcn_s_sleep(1);
        if ((++sp & 255u) == 0u) { if (xb_ld(&bar[XB_TMO])) break; if (sp > XB_SPIN_CAP) { atomicAdd(&bar[XB_TMO], 1u); break; } }
    }
    nloc = mine > 0u ? mine : 1u; nx = cnt > 0u ? cnt : 1u;
}
__device__ __forceinline__ void xcd_barrier(const XcdBarrier& b) {
    asm volatile("s_waitcnt vmcnt(0)" ::: "memory");
    __syncthreads();
    if (threadIdx.x == 0) {
        unsigned* bar = b.bar;
        __builtin_amdgcn_s_waitcnt(0);
        unsigned nloc = b.st[0], nx = b.st[1];
        if (nloc == 0u) { xcd_barrier_complete(bar, b.x, nloc, nx); b.st[0] = nloc; b.st[1] = nx; }
        const unsigned old = xb_add(&bar[XB_XSUB(b.x)], 1u);
        const unsigned gen = old / nloc;
        if (old + 1u == (gen + 1u) * nloc) {
            __builtin_amdgcn_fence(__ATOMIC_RELEASE, "agent");
            asm volatile("s_waitcnt vmcnt(0)" ::: "memory");
            const unsigned og = xb_add(&bar[XB_TOP], 1u);
            const unsigned tg = og / nx;
            if (og + 1u == (tg + 1u) * nx) xb_add(&bar[XB_TOPGEN], 1u);
            else XB_SPIN(xb_ld(&bar[XB_TOPGEN]) == tg, bar);
            __builtin_amdgcn_fence(__ATOMIC_ACQUIRE, "agent");
            xb_add(&bar[XB_XGEN(b.x)], 1u);
            asm volatile("s_waitcnt vmcnt(0)" ::: "memory");
        } else {
            XB_SPIN(xb_ld(&bar[XB_XGEN(b.x)]) == gen, bar);
            __builtin_amdgcn_fence(__ATOMIC_ACQUIRE, "agent");
            asm volatile("s_waitcnt vmcnt(0)" ::: "memory");
        }
    }
    __syncthreads();
}

struct Frame {
    LAS unsigned char* lds;
    volatile LAS unsigned* MISC;
    unsigned* ctl;
    int tid, lane, wave, G, gw, NGW;
    const float *xp, *xs, *state_pool, *state_ret, *state_conv, *g_pre_mix, *w_in, *w_pool, *pool_scale, *gn_gain, *w_out, *g_post_mix, *g_pre_ffn, *w_up, *conv_w, *conv_b, *w_down, *g_post_ffn;
    float* out;
    bf16 *WIN, *WUP, *WDN, *WOUT, *WPOOL, *XN, *PROJ, *UP, *OB, *AP, *MM, *ACT;
    float *ROPE_C, *ROPE_S;
    bf16 *SP16, *MOB, *X1B;
};
__device__ __forceinline__ const float* xrow(const Frame& F, int m) { return m < MP ? F.xp + (size_t)m * D : F.xs + (size_t)(m - MP) * D; }

__host__ __device__ __forceinline__ int unperm_d(int p) { const int g8 = p >> 3, e = p & 7; return e < 4 ? 4 * g8 + e : 64 + 4 * g8 + (e - 4); }
__device__ __forceinline__ void p0_transpose_item(const float* W, int K, int N, bf16* WT, LAS float* scr, int item, int lane, bool permqk = false) {
    const int nblk = N / 32, kb = item / nblk, nb = item % nblk, k0 = 64 * kb, n0 = 32 * nb;
    int src = n0 + (lane & 31); if (permqk && src >= C_Q && src < C_V) src = (src & ~127) + unperm_d(src & 127);
#pragma unroll 8
    for (int i = 0; i < 32; ++i) { const int kk = 2 * i + (lane >> 5); scr[kk * 33 + (lane & 31)] = __builtin_nontemporal_load(W + (size_t)(k0 + kk) * N + src); }
    LDS_WAIT(); asm volatile("" ::: "memory");
    const int c = lane & 7;
#pragma unroll
    for (int j = 0; j < 4; ++j) { const int n = (lane >> 3) + 8 * j; const LAS float* s = scr + (8 * c) * 33 + n;
        v4u o; o.x = pk2(s[0 * 33], s[1 * 33]); o.y = pk2(s[2 * 33], s[3 * 33]); o.z = pk2(s[4 * 33], s[5 * 33]); o.w = pk2(s[6 * 33], s[7 * 33]);
        *(v4u*)(WT + (size_t)(n0 + n) * K + k0 + 8 * c) = o; }
    LDS_WAIT(); asm volatile("" ::: "memory");
}
__device__ __forceinline__ void rms_row_to_bf16(const float* xr_, const float* g, bf16* orow, int lane) {
    const f32x4* xr = (const f32x4*)xr_ + lane; const f32x4* gr = (const f32x4*)g + lane;
    f32x4 v[8]; float s = 0.f;
#pragma unroll
    for (int j = 0; j < 8; ++j) { v[j] = __builtin_nontemporal_load(xr + 64 * j); s += (v[j].x * v[j].x + v[j].y * v[j].y) + (v[j].z * v[j].z + v[j].w * v[j].w); }
    const float rs = 1.0f / sqrtf(wave_sum(s) * (1.f / D) + EPS);
    v2u* o8 = (v2u*)orow + lane;
#pragma unroll
    for (int j = 0; j < 8; ++j) { const f32x4 gg = gr[64 * j]; v2u o; o.x = pk2(v[j].x * rs * gg.x, v[j].y * rs * gg.y); o.y = pk2(v[j].z * rs * gg.z, v[j].w * rs * gg.w); o8[64 * j] = o; }
}
__device__ __forceinline__ void p0_deferred_weights(Frame& F, LAS float* scr) {
    constexpr int I_UP = (D / 64) * (FF2 / 32), I_DN = (FF / 64) * (D / 32), I_OUT = (D / 64) * (D / 32), I_PL = (256 / 64) * (512 / 32);
    constexpr int NITEMS = I_UP + I_DN + I_OUT + 4 * I_PL, CHUNK = 4;
    for (;;) {
        int base = 0;
        if (F.lane == 0) base = (int)__hip_atomic_fetch_add(F.ctl + CW_QW, (unsigned)CHUNK, RLX_AGENT);
        base = __builtin_amdgcn_readfirstlane(base);
        if (base >= NITEMS) break;
        for (int it = base; it < base + CHUNK && it < NITEMS; ++it) {
            int r = it;
            if (r < I_UP) { p0_transpose_item(F.w_up, D, FF2, F.WUP, scr, r, F.lane); continue; } r -= I_UP;
            if (r < I_DN) { p0_transpose_item(F.w_down, FF, D, F.WDN, scr, r, F.lane); continue; } r -= I_DN;
            if (r < I_OUT) { p0_transpose_item(F.w_out, D, D, F.WOUT, scr, r, F.lane); continue; } r -= I_OUT;
            const int g = r / I_PL; r -= g * I_PL;
            p0_transpose_item(F.w_pool + (size_t)g * 256 * 512, 256, 512, F.WPOOL + (size_t)g * 512 * 256, scr, r, F.lane);
        }
    }
}
__device__ __forceinline__ void p0_prologue(Frame& F) {
    LAS float* scr = (LAS float*)(F.lds + F.wave * 16384);
    constexpr int I_IN = (D / 64) * (NIN / 32);
    for (int it = F.gw; it < I_IN; it += F.NGW) p0_transpose_item(F.w_in, D, NIN, F.WIN, scr, it, F.lane, true);
    for (int m = F.gw; m < M; m += F.NGW) rms_row_to_bf16(xrow(F, m), F.g_pre_mix, F.XN + (size_t)m * D, F.lane);
    for (int idx = blockIdx.x * 512 + F.tid; idx < 128 * 15 * 1024 / 4; idx += F.G * 512) { const f32x4 v = ((const f32x4*)F.state_pool)[idx]; ((v2u*)F.SP16)[idx] = pack4(v); }
    for (int idx = blockIdx.x * 512 + F.tid; idx < 2056 * 64; idx += F.G * 512) {
        const int row = idx >> 6, i = idx & 63; const int pos = row < 2048 ? row : 16384 + (row - 2048);
        double th = 1.0; for (int k = 0; k < i; ++k) th *= 0.8659643233600653;
        const double a = (double)pos * th;
        const double kd = rint(a * 0.6366197723675814);
        double y = fma(-kd, 1.57079632679489655800e+00, a); y = fma(-kd, 6.12323399573676603587e-17, y);
        const int k4 = ((int)kd) & 3; const double y2 = y * y;
        const double sp = y * (1.0 + y2 * (-1.0 / 6 + y2 * (1.0 / 120 + y2 * (-1.0 / 5040 + y2 * (1.0 / 362880 + y2 * (-1.0 / 39916800 + y2 * (1.0 / 6227020800.0)))))));
        const double cp = 1.0 + y2 * (-0.5 + y2 * (1.0 / 24 + y2 * (-1.0 / 720 + y2 * (1.0 / 40320 + y2 * (-1.0 / 3628800 + y2 * (1.0 / 479001600 + y2 * (-1.0 / 87178291200.0)))))));
        double sn, cs;
        if (k4 == 0) { sn = sp; cs = cp; } else if (k4 == 1) { sn = cp; cs = -sp; } else if (k4 == 2) { sn = -sp; cs = -cp; } else { sn = -cp; cs = sp; }
        F.ROPE_C[idx] = (float)cs; F.ROPE_S[idx] = (float)sn;
    }
}

constexpr float KSCALE = 0.08838834764831845f;
struct EpiProj {
    static constexpr bool PERM = true, AFTER_DRAIN = false;
    bf16* O; const float* rc; const float* rs;
    __device__ __forceinline__ void tri(f32x4 v0, f32x4 v1, const pg8::Unit& u, int ai, int bj, int m, int wr, int wc, int fr, int fq) const {
        const int row = u.pm * 256 + ai * 128 + wr * 64 + m * 16 + fr, col = u.pn * 256 + bj * 128 + wc * 32 + 8 * fq;
        if (u.pn >= 4 && u.pn < 12) {
            const int h = ((u.pn & 3) << 1) + bj;
            int prow, tl; if (row < MP) { const int t = row & 2047; prow = t; tl = t & 127; } else { tl = row & 7; prow = 2048 + tl; }
            const int g8 = 4 * wc + fq;
            const f32x4 c = *(const f32x4*)(rc + prow * 64 + 4 * g8), sn = *(const f32x4*)(rs + prow * 64 + 4 * g8);
            const float lg2 = __log2f(1.0f - __builtin_amdgcn_exp2f(-5.0f - (float)h));
            const float sc = u.pn >= 8 ? KSCALE * __builtin_amdgcn_exp2f(-lg2 * (float)tl) : __builtin_amdgcn_exp2f(lg2 * (float)tl);
            const f32x4 y1 = (v0 * c - v1 * sn) * sc, y2 = (v1 * c + v0 * sn) * sc;
            v0 = y1; v1 = y2;
        }
        v4u w4; w4.x = pk2(v0[0], v0[1]); w4.y = pk2(v0[2], v0[3]); w4.z = pk2(v1[0], v1[1]); w4.w = pk2(v1[2], v1[3]);
        *(v4u*)(O + (size_t)row * NIN + col) = w4;
    }
    __device__ __forceinline__ void operator()(const f32x4 (&acc)[2][2][4][2], const pg8::Unit& u, int wr, int wc, int fr, int fq) const {
#pragma unroll
        for (int ai = 0; ai < 2; ++ai)
#pragma unroll
            for (int m = 0; m < 4; ++m)
#pragma unroll
                for (int bj = 0; bj < 2; ++bj) tri(acc[ai][bj][m][0], acc[ai][bj][m][1], u, ai, bj, m, wr, wc, fr, fq);
    }
};

typedef short s16x4 __attribute__((ext_vector_type(4)));
__device__ __forceinline__ bf16x8 tr16x2(const LAS unsigned char* p0, const LAS unsigned char* p1) {
    const s16x4 a = __builtin_amdgcn_ds_read_tr16_b64_v4i16((LAS s16x4*)p0), b = __builtin_amdgcn_ds_read_tr16_b64_v4i16((LAS s16x4*)p1);
    return __builtin_shufflevector(a, b, 0, 1, 2, 3, 4, 5, 6, 7);
}
static_assert(DVS == 64, "chain staging below assumes 64-wide value slices");
constexpr int QI_LD = 136, VI_LD = DVS + 8;
constexpr int QI_OFF = 0, KI_OFF = 34816, VI_OFF = 69632, RT_OFF = VI_OFF + 128 * VI_LD * 2, CH_END = RT_OFF + DVS * QI_LD * 2;
static_assert(CH_END <= LDSCTL_OFF, "chain LDS");
__device__ __forceinline__ void chain_unit(Frame& F, int unit) {
    const int s = unit % NS, h = (unit / NS) & 7, b = unit / (NS * 8);
    int tid_ = F.tid; asm volatile("" : "+v"(tid_));
    const int tid = tid_, lane = tid & 63, w = F.wave, fr = lane & 15, fq = lane >> 4, tq = (lane & 15) >> 2, tp = lane & 3;
    LAS unsigned char* L = F.lds;
    const float lg2 = __log2f(1.0f - __builtin_amdgcn_exp2f(-5.0f - (float)h));
    const float gam = __builtin_amdgcn_exp2f(lg2), g127 = __builtin_amdgcn_exp2f(127.f * lg2);
    for (int i = tid; i < DVS * QI_LD * 2 / 16; i += 512) *(LAS v4u*)(L + RT_OFF + i * 16) = (v4u){0u, 0u, 0u, 0u};
    f32x4 Racc[4];
#pragma unroll
    for (int i = 0; i < 4; ++i) Racc[i] = (f32x4){0.f, 0.f, 0.f, 0.f};
    const int vt_r = w & 3, dg = w >> 2;
    const bf16* pbase = F.PROJ + ((size_t)b * 2048) * NIN;
    v4u sq[4], sk[4], sv[2];
#define CH_ISSUE(c) do { const bf16* pr_ = pbase + (size_t)((c) * 128) * NIN; \
        _Pragma("unroll") for (int i_ = 0; i_ < 4; ++i_) { const int ci = tid + 512 * i_, j = ci >> 4, ch = ci & 15; sq[i_] = *(const v4u*)(pr_ + (size_t)j * NIN + C_Q + h * 128 + 8 * ch); sk[i_] = *(const v4u*)(pr_ + (size_t)j * NIN + C_K + h * 128 + 8 * ch); } \
        _Pragma("unroll") for (int i_ = 0; i_ < 2; ++i_) { const int ci = tid + 512 * i_, j = ci >> 3, ch = ci & 7; sv[i_] = *(const v4u*)(pr_ + (size_t)j * NIN + C_V + h * DVH + s * DVS + 8 * ch); } } while (0)
#define CH_WRITE() do { \
        _Pragma("unroll") for (int i_ = 0; i_ < 4; ++i_) { const int ci = tid + 512 * i_, j = ci >> 4, ch = ci & 15; *(LAS v4u*)(L + QI_OFF + (j * QI_LD + 8 * ch) * 2) = sq[i_]; *(LAS v4u*)(L + KI_OFF + (j * QI_LD + 8 * ch) * 2) = sk[i_]; } \
        _Pragma("unroll") for (int i_ = 0; i_ < 2; ++i_) { const int ci = tid + 512 * i_, j = ci >> 3, ch = ci & 7; *(LAS v4u*)(L + VI_OFF + (j * VI_LD + 8 * ch) * 2) = sv[i_]; } } while (0)
    CH_ISSUE(0);
#pragma unroll 1
    for (int c = 0; c < 16; ++c) {
        const size_t mrow0 = (size_t)b * 2048 + c * 128;
        CH_WRITE();
        __syncthreads();
        if (c + 1 < 16) CH_ISSUE(c + 1);
        {
            bf16x8 afr[4];
#pragma unroll
            for (int kk = 0; kk < 4; ++kk) afr[kk] = *(const LAS bf16x8*)(L + QI_OFF + ((16 * w + fr) * QI_LD + 32 * kk + 8 * fq) * 2);
            f32x4 oacc[4];
#pragma unroll
            for (int vt = 0; vt < 4; ++vt) {
                f32x4 acc = (f32x4){0.f, 0.f, 0.f, 0.f};
#pragma unroll
                for (int kk = 0; kk < 4; ++kk) { const bf16x8 rf = *(const LAS bf16x8*)(L + RT_OFF + ((16 * vt + fr) * QI_LD + 32 * kk + 8 * fq) * 2); acc = MFMA16(rf, afr[kk], acc); }
                oacc[vt] = acc * gam;
            }
            const int i_ = 16 * w + fr, nkk = (w >> 1) + 1;
#pragma unroll 1
            for (int kk = 0; kk < nkk; ++kk) {
                f32x4 s0 = (f32x4){0.f, 0.f, 0.f, 0.f}, s1 = s0;
                const LAS unsigned char* kb = L + KI_OFF + ((32 * kk + fr) * QI_LD + 8 * fq) * 2;
#pragma unroll
                for (int k2 = 0; k2 < 4; ++k2) {
                    const bf16x8 kf0 = *(const LAS bf16x8*)(kb + 64 * k2), kf1 = *(const LAS bf16x8*)(kb + 16 * QI_LD * 2 + 64 * k2);
                    s0 = MFMA16(kf0, afr[k2], s0); s1 = MFMA16(kf1, afr[k2], s1);
                }
                float pv[8];
#pragma unroll
                for (int e = 0; e < 4; ++e) { const int dd0 = i_ - (32 * kk + 4 * fq + e); pv[e] = dd0 >= 0 ? s0[e] : 0.f; pv[4 + e] = dd0 >= 16 ? s1[e] : 0.f; }
                const bf16x8 pf = as_bf16x8(pack8(pv));
                const LAS unsigned char* vb = L + VI_OFF + ((32 * kk + 4 * fq + tq) * VI_LD + 4 * tp) * 2;
#pragma unroll
                for (int vt = 0; vt < 4; ++vt) oacc[vt] = MFMA16(tr16x2(vb + 32 * vt, vb + 16 * VI_LD * 2 + 32 * vt), pf, oacc[vt]);
            }
            bf16* orow = F.OB + (mrow0 + 16 * w + fr) * D + h * DVH + s * DVS + 4 * fq;
#pragma unroll
            for (int vt = 0; vt < 4; ++vt) *(v2u*)(orow + 16 * vt) = pack4(oacc[vt]);
        }
#pragma unroll
        for (int di = 0; di < 4; ++di) {
            const int dt = dg * 4 + di;
            f32x4 acc = Racc[di] * gam;
#pragma unroll
            for (int kk = 0; kk < 4; ++kk) {
                const LAS unsigned char* ka = L + KI_OFF + ((32 * kk + 8 * fq + tq) * QI_LD + 16 * dt + 4 * tp) * 2;
                const LAS unsigned char* va = L + VI_OFF + ((32 * kk + 8 * fq + tq) * VI_LD + 16 * vt_r + 4 * tp) * 2;
                acc = MFMA16(tr16x2(ka, ka + 4 * QI_LD * 2), tr16x2(va, va + 4 * VI_LD * 2), acc);
            }
            Racc[di] = acc * g127;
        }
        __syncthreads();
#pragma unroll
        for (int di = 0; di < 4; ++di) { const int dt = dg * 4 + di; *(LAS v2u*)(L + RT_OFF + ((16 * vt_r + fr) * QI_LD + 16 * dt + 4 * fq) * 2) = pack4(Racc[di]); }
    }
#undef CH_ISSUE
#undef CH_WRITE
    float* ro = F.out + O_RETP + ((size_t)(b * 8 + h) * 128) * DVH + s * DVS + 16 * vt_r + fr;
#pragma unroll
    for (int di = 0; di < 4; ++di) { const int dt = dg * 4 + di;
#pragma unroll
        for (int r = 0; r < 4; ++r) ro[(size_t)unperm_d(16 * dt + 4 * fq + r) * DVH] = Racc[di][r]; }
}

constexpr int SQ_OFF = 0, SKZ_OFF = 4096, SK_OFF = 8192, SV_OFF = 12288, SS_OFF = 20480, SRED_OFF = 24576;
__device__ __forceinline__ void sample_unit(Frame& F, int unit) {
    const int h = unit & 7, b = unit >> 3;
    int tid_ = F.tid; asm volatile("" : "+v"(tid_));
    const int tid = tid_, lane = tid & 63, w = F.wave;
    LAS unsigned char* L = F.lds;
    LAS float* qT = (LAS float*)(L + SQ_OFF); LAS float* kzT = (LAS float*)(L + SKZ_OFF); LAS float* kS = (LAS float*)(L + SK_OFF);
    LAS float* vs = (LAS float*)(L + SV_OFF); LAS float* ss = (LAS float*)(L + SS_OFF); LAS float* red = (LAS float*)(L + SRED_OFF);
    const float lg2 = __log2f(1.0f - __builtin_amdgcn_exp2f(-5.0f - (float)h));
    const float gam = __builtin_amdgcn_exp2f(lg2), g7 = __builtin_amdgcn_exp2f(7.f * lg2), g8c = __builtin_amdgcn_exp2f(8.f * lg2);
    const size_t mrow0 = (size_t)MP + (size_t)b * 8;
    const float* Rin = F.state_ret + ((size_t)(b * 8 + h) * 128) * DVH + 4 * lane;
    float* Rout = F.out + O_RETS + ((size_t)(b * 8 + h) * 128) * DVH + 4 * lane;
    f32x4 r0[16];
#pragma unroll
    for (int dd = 0; dd < 16; ++dd) r0[dd] = __builtin_nontemporal_load((const f32x4*)(Rin + (size_t)(16 * w + dd) * DVH));
    if (tid < 256) {
        const int qk = tid >> 7, it = tid & 127, i = it >> 4, ch = it & 15;
        float f[8]; unpack8(*(const v4u*)(F.PROJ + (mrow0 + i) * NIN + (qk ? C_K : C_Q) + h * 128 + 8 * ch), f);
#pragma unroll
        for (int e = 0; e < 8; ++e) { const int d = e < 4 ? 4 * ch + e : 64 + 4 * ch + (e - 4);
            if (qk == 0) qT[d * 8 + i] = f[e]; else { kS[i * 128 + d] = f[e]; kzT[d * 8 + i] = f[e] * g7; } }
    } else {
        const int it = tid - 256, j = it >> 5, g = it & 31;
        float f[8]; unpack8(*(const v4u*)(F.PROJ + (mrow0 + j) * NIN + C_V + h * DVH + 8 * g), f);
#pragma unroll
        for (int e = 0; e < 8; ++e) vs[j * 256 + 8 * g + e] = f[e];
    }
    __syncthreads();
    {
        const int pr = tid >> 3, part = tid & 7, i = pr >> 3, j = pr & 7; float dot = 0.f;
#pragma unroll
        for (int dd = 0; dd < 16; ++dd) { const int d = 16 * part + dd; dot += qT[d * 8 + i] * kS[j * 128 + d]; }
        dot += __shfl_xor(dot, 1); dot += __shfl_xor(dot, 2); dot += __shfl_xor(dot, 4);
        if (part == 0) ss[i * 8 + j] = (i >= j) ? dot : 0.f;
    }
    {
        f32x4 vreg[8], oacc[8];
#pragma unroll
        for (int j = 0; j < 8; ++j) { vreg[j] = *(const LAS f32x4*)(vs + j * 256 + 4 * lane); oacc[j] = (f32x4){0.f, 0.f, 0.f, 0.f}; }
#pragma unroll
        for (int dd = 0; dd < 16; ++dd) {
            const int d = 16 * w + dd;
            const f32x4 qa = *(const LAS f32x4*)(qT + d * 8), qb = *(const LAS f32x4*)(qT + d * 8 + 4), ka = *(const LAS f32x4*)(kzT + d * 8), kb = *(const LAS f32x4*)(kzT + d * 8 + 4);
            f32x4 rn = r0[dd] * g8c;
            rn += ka.x * vreg[0]; rn += ka.y * vreg[1]; rn += ka.z * vreg[2]; rn += ka.w * vreg[3]; rn += kb.x * vreg[4]; rn += kb.y * vreg[5]; rn += kb.z * vreg[6]; rn += kb.w * vreg[7];
            __builtin_nontemporal_store(rn, (f32x4*)(Rout + (size_t)d * DVH));
            oacc[0] += qa.x * r0[dd]; oacc[1] += qa.y * r0[dd]; oacc[2] += qa.z * r0[dd]; oacc[3] += qa.w * r0[dd];
            oacc[4] += qb.x * r0[dd]; oacc[5] += qb.y * r0[dd]; oacc[6] += qb.z * r0[dd]; oacc[7] += qb.w * r0[dd];
        }
#pragma unroll
        for (int i = 0; i < 8; ++i) *(LAS f32x4*)(red + (w * 8 + i) * 256 + 4 * lane) = oacc[i];
    }
    __syncthreads();
    {
        const int i = tid >> 6, l = tid & 63;
        f32x4 tot = (f32x4){0.f, 0.f, 0.f, 0.f};
#pragma unroll
        for (int ww = 0; ww < 8; ++ww) tot += *(const LAS f32x4*)(red + (ww * 8 + i) * 256 + 4 * l);
        tot = tot * gam;
#pragma unroll
        for (int j = 0; j < 8; ++j) tot += ss[i * 8 + j] * *(const LAS f32x4*)(vs + j * 256 + 4 * l);
        *(v2u*)(F.OB + (mrow0 + i) * D + h * DVH + 4 * l) = pack4(tot);
    }
}

constexpr int Z_LD = 264;
template <int W, int IB> __device__ __forceinline__ void pool_z(Frame& F, int g, int m0, int tid) {
    LAS unsigned char* L = F.lds;
#pragma unroll 1
    for (int it0 = tid; it0 < 4096; it0 += 512 * IB) {
        v4u raw[IB][W]; bool ok[IB][W];
#pragma unroll
        for (int ib = 0; ib < IB; ++ib) {
            const int it = it0 + 512 * ib, j = it >> 5, c8 = it & 31, m = m0 + j, col = C_POOL + 256 * g + 8 * c8;
#pragma unroll
            for (int k = 0; k < W; ++k) {
                const bf16* p;
                if (m < MP) { const int t = m & 2047; ok[ib][k] = t - k >= 0; p = F.PROJ + (size_t)(ok[ib][k] ? m - k : m) * NIN + col; }
                else { const int ms = m - MP, bb = ms >> 3, i = ms & 7, ee = 15 + i - k; ok[ib][k] = true;
                    const bf16* p1 = F.PROJ + (size_t)(MP + bb * 8 + (ee >= 15 ? ee - 15 : 0)) * NIN + col; const bf16* p2 = F.SP16 + ((size_t)bb * 15 + (ee < 15 ? ee : 0)) * 1024 + 256 * g + 8 * c8;
                    p = ee >= 15 ? p1 : p2; }
                raw[ib][k] = *(const v4u*)p;
            }
        }
#pragma unroll
        for (int ib = 0; ib < IB; ++ib) {
            const int it = it0 + 512 * ib, j = it >> 5, c8 = it & 31, m = m0 + j;
            float sum[8], cur[8], f[8];
            unpack8(raw[ib][0], cur);
#pragma unroll
            for (int e = 0; e < 8; ++e) sum[e] = cur[e];
#pragma unroll
            for (int k = 1; k < W; ++k) { unpack8(raw[ib][k], f);
#pragma unroll
                for (int e = 0; e < 8; ++e) sum[e] += ok[ib][k] ? f[e] : 0.f; }
            int cn = W; if (m < MP) { const int t = m & 2047; cn = W < t + 1 ? W : t + 1; }
            const float ic = 1.0f / (float)cn;
#pragma unroll
            for (int e = 0; e < 8; ++e) f[e] = sum[e] * ic - cur[e];
            *(LAS v4u*)(L + (j * Z_LD + 8 * c8) * 2) = pack8(f);
        }
    }
}
__device__ __forceinline__ void pool_unit(Frame& F, int unit) {
    const int g = unit & 3, tile = unit >> 2, m0 = tile * 128;
    int tid_ = F.tid; asm volatile("" : "+v"(tid_));
    const int tid = tid_, lane = tid & 63, w = F.wave, fr = lane & 15, fq = lane >> 4;
    LAS unsigned char* L = F.lds;
    bf16x8 bfr[4][8];
    {
        const bf16* wt = F.WPOOL + ((size_t)g * 512 + 64 * w + fr) * 256 + 8 * fq;
#pragma unroll
        for (int et = 0; et < 4; ++et)
#pragma unroll
            for (int kk = 0; kk < 8; ++kk) bfr[et][kk] = *(const bf16x8*)(wt + (size_t)(16 * et) * 256 + 32 * kk);
    }
    if (m0 >= MP) {
        if (g == 0) pool_z<2, 4>(F, g, m0, tid); else if (g == 1) pool_z<4, 4>(F, g, m0, tid); else if (g == 2) pool_z<8, 2>(F, g, m0, tid); else pool_z<16, 1>(F, g, m0, tid);
    } else {
        constexpr int UT_OFF = 128 * Z_LD * 2;
        static_assert(UT_OFF + 143 * Z_LD * 2 <= LDSCTL_OFF, "pool LDS");
        const bool seq0 = (m0 & 2047) == 0;
        const bf16* src = F.PROJ + (size_t)(m0 - 15) * NIN + C_POOL + 256 * g;
#pragma unroll
        for (int i = 0; i < 9; ++i) { const int ci = tid + 512 * i;
            if (ci < 143 * 32) { const int rw = ci >> 5, c8 = ci & 31; v4u v = (v4u){0u, 0u, 0u, 0u}; if (!(seq0 && rw < 15)) v = *(const v4u*)(src + (size_t)rw * NIN + 8 * c8);
                *(LAS v4u*)(L + UT_OFF + (rw * Z_LD + 8 * c8) * 2) = v; } }
        __syncthreads();
        const int W = 2 << g, c8 = tid & 31, j0 = (tid >> 5) * 8;
        const LAS unsigned char* up = L + UT_OFF + ((15 + j0) * Z_LD + 8 * c8) * 2;
        float sum[8], f[8], cur[8];
#pragma unroll
        for (int e = 0; e < 8; ++e) sum[e] = 0.f;
        for (int k = 1; k < W; ++k) { unpack8(*(const LAS v4u*)(up - k * Z_LD * 2), f);
#pragma unroll
            for (int e = 0; e < 8; ++e) sum[e] += f[e]; }
        const int t0 = (m0 & 2047) + j0;
#pragma unroll
        for (int j = 0; j < 8; ++j) {
            unpack8(*(const LAS v4u*)(up + j * Z_LD * 2), cur);
#pragma unroll
            for (int e = 0; e < 8; ++e) sum[e] += cur[e];
            const int t = t0 + j; const float ic = 1.0f / (float)(W < t + 1 ? W : t + 1);
#pragma unroll
            for (int e = 0; e < 8; ++e) f[e] = sum[e] * ic - cur[e];
            *(LAS v4u*)(L + ((j0 + j) * Z_LD + 8 * c8) * 2) = pack8(f);
            unpack8(*(const LAS v4u*)(up + (j + 1 - W) * Z_LD * 2), f);
#pragma unroll
            for (int e = 0; e < 8; ++e) sum[e] -= f[e];
        }
    }
    __syncthreads();
    f32x4 sc[4];
#pragma unroll
    for (int et = 0; et < 4; ++et) sc[et] = *(const f32x4*)(F.pool_scale + 512 * g + 64 * w + 16 * et + 4 * fq);
#pragma unroll 1
    for (int rt = 0; rt < 8; ++rt) {
        bf16x8 afr[8];
#pragma unroll
        for (int kk = 0; kk < 8; ++kk) afr[kk] = *(const LAS bf16x8*)(L + ((16 * rt + fr) * Z_LD + 32 * kk + 8 * fq) * 2);
        bf16* orow = F.AP + (size_t)(m0 + 16 * rt + fr) * D + 512 * g + 64 * w + 4 * fq;
#pragma unroll
        for (int et = 0; et < 4; ++et) {
            f32x4 acc = (f32x4){0.f, 0.f, 0.f, 0.f};
#pragma unroll
            for (int kk = 0; kk < 8; ++kk) acc = MFMA16(bfr[et][kk], afr[kk], acc);
            *(v2u*)(orow + 16 * et) = pack4(acc * sc[et]);
        }
    }
}
constexpr int N_CHAIN = 4 * 8 * NS, N_POOLU = (M / 128) * 4, N_SAMP = 128 * 8, N_P2 = N_CHAIN + N_POOLU + N_SAMP;
__device__ __forceinline__ void p2_mixers(Frame& F, int rep) {
    const int mode = rep >> 4, lo = mode == 2 ? N_CHAIN : (mode == 3 ? N_CHAIN + N_POOLU : 0), hi = mode == 1 ? N_CHAIN : (mode == 2 ? N_CHAIN + N_POOLU : N_P2);
    const bool static_chain = mode == 0 && (F.G % 8) == 0 && F.G >= N_CHAIN && NS == 4;
    if (static_chain && (int)blockIdx.x < N_CHAIN) { __syncthreads(); const int c = (int)blockIdx.x, slot = c >> 3, bh = (c & 7) + 8 * (slot >> 2); chain_unit(F, bh * NS + (slot & 3)); }
    for (;;) {
        __syncthreads();
        if (F.tid == 0) F.MISC[0] = __hip_atomic_fetch_add(F.ctl + CW_Q2 + 64 * (rep & 15), 1u, RLX_AGENT);
        __syncthreads();
        const int u = (int)F.MISC[0] + (static_chain ? N_CHAIN : lo);
        if (u >= hi) break;
        if (u < N_CHAIN) chain_unit(F, u);
        else if (u < N_CHAIN + N_POOLU) pool_unit(F, u - N_CHAIN);
        else sample_unit(F, u - N_CHAIN - N_POOLU);
    }
}

__device__ __forceinline__ void ld8f(const float* p, float (&o)[8]) { const f32x4 a = *(const f32x4*)p, b = *(const f32x4*)(p + 4); o[0] = a.x; o[1] = a.y; o[2] = a.z; o[3] = a.w; o[4] = b.x; o[5] = b.y; o[6] = b.z; o[7] = b.w; }
__device__ __forceinline__ float half_sum(float v) {
#pragma unroll
    for (int o = 1; o < 32; o <<= 1) v += __shfl_xor(v, o);
    return v;
}
__device__ __forceinline__ void p3_merge(Frame& F) {
    const int lane = F.lane, hl = lane >> 5, l32 = lane & 31;
    constexpr int NIT = M * 4;
    for (int it0 = 2 * F.gw; it0 < NIT; it0 += 2 * F.NGW) {
        v4u ov[2], gv[2], av[2], rv[2], pv[2]; int cc[2]; size_t mm[2];
#pragma unroll
        for (int u = 0; u < 2; ++u) {
            const int it = it0 + u, m = it >> 2, hp = it & 3, c = (2 * hp + hl) * DVH + 8 * l32; cc[u] = c; mm[u] = (size_t)m;
            const bf16* prow = F.PROJ + (size_t)m * NIN + c;
            ov[u] = __builtin_nontemporal_load((const v4u*)(F.OB + (size_t)m * D + c)); gv[u] = __builtin_nontemporal_load((const v4u*)(prow + C_GRET)); av[u] = __builtin_nontemporal_load((const v4u*)(prow + C_GA)); rv[u] = __builtin_nontemporal_load((const v4u*)(prow + C_GR)); pv[u] = __builtin_nontemporal_load((const v4u*)(F.AP + (size_t)m * D + c));
        }
#pragma unroll
        for (int u = 0; u < 2; ++u) {
            float o[8], g[8], ga[8], gr[8], ap[8], res[8];
            unpack8(ov[u], o); unpack8(gv[u], g); unpack8(av[u], ga); unpack8(rv[u], gr); unpack8(pv[u], ap);
            const f32x4 gn0 = *(const f32x4*)(F.gn_gain + cc[u]), gn1 = *(const f32x4*)(F.gn_gain + cc[u] + 4);
            const float gn[8] = {gn0.x, gn0.y, gn0.z, gn0.w, gn1.x, gn1.y, gn1.z, gn1.w};
            float sm = 0.f;
#pragma unroll
            for (int e = 0; e < 8; ++e) sm += o[e];
            const float mean = half_sum(sm) * (1.f / 256.f);
            float sq = 0.f;
#pragma unroll
            for (int e = 0; e < 8; ++e) { o[e] -= mean; sq += o[e] * o[e]; }
            const float rstd = 1.0f / sqrtf(half_sum(sq) * (1.f / 256.f) + EPS);
#pragma unroll
            for (int e = 0; e < 8; ++e) { const float r = g[e] * sigmoidf_(g[e]) * (o[e] * rstd * gn[e]); res[e] = sigmoidf_(ga[e]) * ap[e] + sigmoidf_(gr[e]) * r; }
            *(v4u*)(F.MM + mm[u] * D + cc[u]) = pack8(res);
        }
    }
    const int gt = blockIdx.x * 512 + F.tid, NT = F.G * 512;
    for (int gi = gt; gi < (4 + 128) * 15 * 128; gi += NT) {
        const int c8 = gi & 127, rr = gi >> 7, r = rr % 15, bb = rr / 15;
        float v8[8]; float* dst;
        if (bb < 4) { unpack8(*(const v4u*)(F.PROJ + (size_t)(bb * 2048 + 2033 + r) * NIN + C_POOL + 8 * c8), v8); dst = F.out + O_POOLP + ((size_t)bb * 15 + r) * 1024 + 8 * c8; }
        else { const int b = bb - 4, e = 8 + r; dst = F.out + O_POOLS + ((size_t)b * 15 + r) * 1024 + 8 * c8;
            if (e < 15) ld8f(F.state_pool + ((size_t)b * 15 + e) * 1024 + 8 * c8, v8); else unpack8(*(const v4u*)(F.PROJ + (size_t)(MP + b * 8 + e - 15) * NIN + C_POOL + 8 * c8), v8); }
        *(f32x4*)dst = (f32x4){v8[0], v8[1], v8[2], v8[3]}; *(f32x4*)(dst + 4) = (f32x4){v8[4], v8[5], v8[6], v8[7]};
    }
}

__device__ __forceinline__ void p5_rows(Frame& F) {
    const int lane = F.lane;
    for (int m = F.gw; m < M; m += F.NGW) {
        const v4u* mo = (const v4u*)(F.MOB + (size_t)m * D) + lane; const f32x4* xr = (const f32x4*)xrow(F, m) + 2 * lane;
        const f32x4* g1 = (const f32x4*)F.g_post_mix + 2 * lane; const f32x4* g2 = (const f32x4*)F.g_pre_ffn + 2 * lane;
        v4u mv[4]; f32x4 x[4][2]; float v[4][8]; float s = 0.f;
#pragma unroll
        for (int j = 0; j < 4; ++j) { mv[j] = __builtin_nontemporal_load(mo + 64 * j); x[j][0] = __builtin_nontemporal_load(xr + 128 * j); x[j][1] = __builtin_nontemporal_load(xr + 128 * j + 1); }
#pragma unroll
        for (int j = 0; j < 4; ++j) { unpack8(mv[j], v[j]);
#pragma unroll
            for (int e = 0; e < 8; ++e) s += v[j][e] * v[j][e]; }
        const float rs = 1.0f / sqrtf(wave_sum(s) * (1.f / D) + EPS);
        float s2 = 0.f; v4u* yo = (v4u*)(F.X1B + (size_t)m * D) + lane;
#pragma unroll
        for (int j = 0; j < 4; ++j) {
            const f32x4 ga = g1[128 * j], gb = g1[128 * j + 1];
            x[j][0] = x[j][0] + (f32x4){v[j][0], v[j][1], v[j][2], v[j][3]} * rs * ga; x[j][1] = x[j][1] + (f32x4){v[j][4], v[j][5], v[j][6], v[j][7]} * rs * gb;
            { v4u o; o.x = pk2(x[j][0].x, x[j][0].y); o.y = pk2(x[j][0].z, x[j][0].w); o.z = pk2(x[j][1].x, x[j][1].y); o.w = pk2(x[j][1].z, x[j][1].w); yo[64 * j] = o; }
            s2 += (x[j][0].x * x[j][0].x + x[j][0].y * x[j][0].y) + (x[j][0].z * x[j][0].z + x[j][0].w * x[j][0].w) + (x[j][1].x * x[j][1].x + x[j][1].y * x[j][1].y) + (x[j][1].z * x[j][1].z + x[j][1].w * x[j][1].w);
        }
        const float rs2 = 1.0f / sqrtf(wave_sum(s2) * (1.f / D) + EPS);
        v4u* o8 = (v4u*)(F.XN + (size_t)m * D) + lane;
#pragma unroll
        for (int j = 0; j < 4; ++j) { const f32x4 ga = g2[128 * j], gb = g2[128 * j + 1]; const f32x4 a = x[j][0] * rs2 * ga, b2 = x[j][1] * rs2 * gb;
            v4u o; o.x = pk2(a.x, a.y); o.y = pk2(a.z, a.w); o.z = pk2(b2.x, b2.y); o.w = pk2(b2.z, b2.w); o8[64 * j] = o; }
    }
}
__device__ __forceinline__ void p9_rows(Frame& F, float* dst) {
    const int lane = F.lane;
    for (int m = F.gw; m < M; m += F.NGW) {
        const v4u* fo = (const v4u*)(F.MOB + (size_t)m * D) + lane; const v4u* yi = (const v4u*)(F.X1B + (size_t)m * D) + lane; f32x4* yo = (f32x4*)(dst + (size_t)m * D) + 2 * lane;
        const f32x4* g1 = (const f32x4*)F.g_post_ffn + 2 * lane;
        v4u mv[4]; f32x4 x[4][2]; float v[4][8]; float s = 0.f;
#pragma unroll
        for (int j = 0; j < 4; ++j) { mv[j] = __builtin_nontemporal_load(fo + 64 * j); const v4u xb = __builtin_nontemporal_load(yi + 64 * j); x[j][0] = (f32x4){bflo(xb.x), bfhi(xb.x), bflo(xb.y), bfhi(xb.y)}; x[j][1] = (f32x4){bflo(xb.z), bfhi(xb.z), bflo(xb.w), bfhi(xb.w)}; }
#pragma unroll
        for (int j = 0; j < 4; ++j) { unpack8(mv[j], v[j]);
#pragma unroll
            for (int e = 0; e < 8; ++e) s += v[j][e] * v[j][e]; }
        const float rs = 1.0f / sqrtf(wave_sum(s) * (1.f / D) + EPS);
#pragma unroll
        for (int j = 0; j < 4; ++j) { const f32x4 ga = g1[128 * j], gb = g1[128 * j + 1];
            __builtin_nontemporal_store(x[j][0] + (f32x4){v[j][0], v[j][1], v[j][2], v[j][3]} * rs * ga, yo + 128 * j); __builtin_nontemporal_store(x[j][1] + (f32x4){v[j][4], v[j][5], v[j][6], v[j][7]} * rs * gb, yo + 128 * j + 1); }
    }
}

__device__ __forceinline__ float gelu_tanh(float g) {
    const float u = (g * g) * (1.5957691216057308f * 0.044715f * 1.4426950408889634f) + (1.5957691216057308f * 1.4426950408889634f);
    return g * __builtin_amdgcn_rcpf(1.0f + __builtin_amdgcn_exp2f(-(g * u)));
}
__device__ __forceinline__ void p7_conv(Frame& F) {
    constexpr int NCG = FF / 8, NRB = M / 8, NIT = NRB * NCG;
    const int gt = blockIdx.x * 512 + F.tid, NT = F.G * 512;
    v4u rawv[10], rawg[10];
#define P7_LOAD(dv, dg, it_) do { const int rb_ = (it_) / NCG, f0_ = 8 * ((it_) - rb_ * NCG), m0_ = rb_ * 8; const bool z_ = (m0_ >= MP) || ((m0_ & 2047) == 0); \
        _Pragma("unroll") for (int r = 0; r < 10; ++r) { const int rr = (r < 2 && z_) ? 2 : r; const bf16* ur = F.UP + (size_t)(m0_ + rr - 2) * FF2; dv[r] = *(const v4u*)(ur + f0_); dg[r] = *(const v4u*)(ur + FF + f0_); } } while (0)
#pragma unroll 1
    for (int it = gt; it < NIT; it += NT) {
        const int rb = it / NCG, cg = it - rb * NCG, f0 = 8 * cg, m0 = rb * 8;
        const bool is_p = m0 < MP; const int t0 = is_p ? (m0 & 2047) : 0; const int sb = is_p ? 0 : (m0 - MP) >> 3;
        P7_LOAD(rawv, rawg, it);
        float hv[3][8], hg[3][8];
#pragma unroll
        for (int r = 0; r < 2; ++r) {
            if (t0 == 0) {
                if (is_p) {
#pragma unroll
                    for (int e = 0; e < 8; ++e) { hv[r + 1][e] = 0.f; hg[r + 1][e] = 0.f; }
                } else { const float* sc = F.state_conv + ((size_t)sb * 2 + r) * FF2; ld8f(sc + f0, hv[r + 1]); ld8f(sc + FF + f0, hg[r + 1]); }
            } else { unpack8(rawv[r], hv[r + 1]); unpack8(rawg[r], hg[r + 1]); }
        }
        float wv[3][8], wg[3][8], bv[8], bg[8];
#pragma unroll
        for (int j = 0; j < 3; ++j) { ld8f(F.conv_w + (size_t)j * FF2 + f0, wv[j]); ld8f(F.conv_w + (size_t)j * FF2 + FF + f0, wg[j]); }
        ld8f(F.conv_b + f0, bv); ld8f(F.conv_b + FF + f0, bg);
#pragma unroll
        for (int r = 0; r < 8; ++r) {
#pragma unroll
            for (int e = 0; e < 8; ++e) { hv[0][e] = hv[1][e]; hv[1][e] = hv[2][e]; hg[0][e] = hg[1][e]; hg[1][e] = hg[2][e]; }
            unpack8(rawv[r + 2], hv[2]); unpack8(rawg[r + 2], hg[2]);
            float a[8];
#pragma unroll
            for (int e = 0; e < 8; ++e) { const float val = bv[e] + wv[0][e] * hv[0][e] + wv[1][e] * hv[1][e] + wv[2][e] * hv[2][e], gate = bg[e] + wg[0][e] * hg[0][e] + wg[1][e] * hg[1][e] + wg[2][e] * hg[2][e]; a[e] = gelu_tanh(gate) * val; }
            *(v4u*)(F.ACT + (size_t)(m0 + r) * FF + f0) = pack8(a);
            if (r >= 6) {
                float* o = nullptr;
                if (is_p) { if (t0 == 2040) o = F.out + O_CONVP + ((size_t)(m0 >> 11) * 2 + (r - 6)) * FF2; } else o = F.out + O_CONVS + ((size_t)sb * 2 + (r - 6)) * FF2;
                if (o) { *(f32x4*)(o + f0) = (f32x4){hv[2][0], hv[2][1], hv[2][2], hv[2][3]}; *(f32x4*)(o + f0 + 4) = (f32x4){hv[2][4], hv[2][5], hv[2][6], hv[2][7]};
                    *(f32x4*)(o + FF + f0) = (f32x4){hg[2][0], hg[2][1], hg[2][2], hg[2][3]}; *(f32x4*)(o + FF + f0 + 4) = (f32x4){hg[2][4], hg[2][5], hg[2][6], hg[2][7]}; }
            }
        }
    }
#undef P7_LOAD
}

struct Args { const float* in[18]; float* out; unsigned char* ws; int ph_lo, ph_hi, li, pad; };
template <int LO, int HI> __global__ void __launch_bounds__(NWAVES * 64, 2) skel_fwd(Args args) {
    extern __shared__ __attribute__((aligned(16))) unsigned char lds[];
    Frame F;
    F.lds = (LAS unsigned char*)lds;
    F.MISC = (volatile LAS unsigned*)(F.lds + LDSCTL_OFF);
    F.tid = threadIdx.x; F.lane = F.tid & 63; F.wave = __builtin_amdgcn_readfirstlane(F.tid >> 6);
    F.G = gridDim.x; F.gw = blockIdx.x * NWAVES + F.wave; F.NGW = F.G * NWAVES;
    unsigned char* ws = args.ws;
    F.ctl = (unsigned*)(ws + WS_CTL);
    F.xp = args.in[0]; F.xs = args.in[1]; F.state_pool = args.in[2]; F.state_ret = args.in[3]; F.state_conv = args.in[4]; F.g_pre_mix = args.in[5]; F.w_in = args.in[6]; F.w_pool = args.in[7];
    F.pool_scale = args.in[8]; F.gn_gain = args.in[9]; F.w_out = args.in[10]; F.g_post_mix = args.in[11]; F.g_pre_ffn = args.in[12]; F.w_up = args.in[13]; F.conv_w = args.in[14]; F.conv_b = args.in[15];
    F.w_down = args.in[16]; F.g_post_ffn = args.in[17]; F.out = args.out;
    F.WIN = (bf16*)(ws + WS_WIN); F.WUP = (bf16*)(ws + WS_WUP); F.WDN = (bf16*)(ws + WS_WDN); F.WOUT = (bf16*)(ws + WS_WOUT); F.WPOOL = (bf16*)(ws + WS_WPOOL);
    F.ROPE_C = (float*)(ws + WS_ROPE); F.ROPE_S = F.ROPE_C + 2056 * 64;
    F.XN = (bf16*)(ws + WS_XN); F.PROJ = (bf16*)(ws + WS_PROJ); F.UP = (bf16*)(ws + WS_PROJ); F.MOB = (bf16*)(ws + WS_PROJ);
    F.SP16 = (bf16*)(ws + WS_SP16); F.X1B = (bf16*)(ws + WS_X1);
    F.OB = (bf16*)(ws + WS_O); F.AP = (bf16*)(ws + WS_AP); F.MM = (bf16*)(ws + WS_MM); F.ACT = (bf16*)(ws + WS_O);
    for (int u = F.tid; u < (LDS_BYTES - LDSCTL_OFF) / 4; u += NWAVES * 64) ((LAS unsigned*)(F.lds + LDSCTL_OFF))[u] = 0u;
    __syncthreads();
    XcdBarrier bar; bar.bar = F.ctl + CW_BAR; bar.x = 0; bar.st = nullptr;
    if (N_LAUNCHES == 1) bar = xcd_barrier_post(F.ctl + CW_BAR, F.MISC + 8);
#define GRID_BAR() do { if (N_LAUNCHES == 1) xcd_barrier(bar); } while (0)
#define IN(k) (LO <= (k) && (k) < HI)
#define FRESH() do { int t_ = threadIdx.x; asm volatile("" : "+v"(t_)); F.tid = t_; F.lane = t_ & 63; } while (0)
#define SEAM(k) do { if constexpr (IN(k) && IN((k) + 1)) GRID_BAR(); } while (0)

#define REPS(k)
#define DUPBAR(k)
    const int rep = args.li;
    if constexpr (IN(0)) { FRESH(); REPS(0) { p0_prologue(F); DUPBAR(0); } SEAM(0); }
    if constexpr (IN(1)) {
      REPS(1) {
        pg8::Gemm g{F.XN, F.WIN, M, NIN, D}; pg8::HybridOrder S; S.init(M, NIN, D, F.G, (int)blockIdx.x, false);
        EpiProj E{F.PROJ, F.ROPE_C, F.ROPE_S}; pg8::SplitCtx X{(float*)(ws + WS_SLAB_A), F.ctl + CW_SPLIT};
        pg8::gemm_phase<EpiProj, pg8::HybridOrder, true, PG8_SP2, 5>(F.lds, g, S, E, X);
        if (rep == 0) { FRESH(); p0_deferred_weights(F, (LAS float*)(F.lds + F.wave * 16384)); }
        DUPBAR(1);
      }
        SEAM(1);
    }
    if constexpr (IN(2)) { FRESH(); REPS(2) { p2_mixers(F, rep); DUPBAR(2); } SEAM(2); }
    if constexpr (IN(3)) { FRESH(); REPS(3) { p3_merge(F); DUPBAR(3); } SEAM(3); }
    if constexpr (IN(4)) {
      REPS(4) {
        pg8::Gemm g{F.MM, F.WOUT, M, D, D}; pg8::HybridOrder S; S.init(M, D, D, F.G, (int)blockIdx.x);
        pg8::EpiBf16<0> E{F.MOB, D}; pg8::SplitCtx X{(float*)(ws + WS_SLAB_A), F.ctl + CW_SPLIT + 4096};
        pg8::gemm_phase<pg8::EpiBf16<0>, pg8::HybridOrder, true, PG8_SP2, 8>(F.lds, g, S, E, X);
        DUPBAR(4);
      }
        SEAM(4);
    }
    if constexpr (IN(5)) { FRESH(); REPS(5) { p5_rows(F); DUPBAR(5); } SEAM(5); }
    if constexpr (IN(6)) {
      REPS(6) {
        pg8::Gemm g{F.XN, F.WUP, M, FF2, D}; pg8::HybridOrder S; S.init(M, FF2, D, F.G, (int)blockIdx.x);
        pg8::EpiBf16<0> E{F.UP, FF2}; pg8::SplitCtx X{(float*)(ws + WS_SLAB_A), F.ctl + CW_SPLIT + 2 * 4096};
        pg8::gemm_phase<pg8::EpiBf16<0>, pg8::HybridOrder, true, PG8_SP2, 5>(F.lds, g, S, E, X);
        DUPBAR(6);
      }
        SEAM(6);
    }
    if constexpr (IN(7)) { FRESH(); REPS(7) { p7_conv(F); DUPBAR(7); } SEAM(7); }
    if constexpr (IN(8)) {
      REPS(8) {
        pg8::Gemm g{F.ACT, F.WDN, M, D, FF}; pg8::HybridOrder S; S.init(M, D, FF, F.G, (int)blockIdx.x);
        pg8::EpiBf16<0> E{F.MOB, D}; pg8::SplitCtx X{(float*)(ws + WS_SLAB_B), F.ctl + CW_SPLIT + 3 * 4096};
        pg8::gemm_phase<pg8::EpiBf16<0>, pg8::HybridOrder, true, PG8_SP2, 8>(F.lds, g, S, E, X);
        DUPBAR(8);
      }
        SEAM(8);
    }
    if constexpr (IN(9)) { FRESH(); p9_rows(F, (DUP_PHASE == 9 && rep == 1) ? (float*)(ws + WS_O) : F.out + O_Y); }
#undef IN
#undef SEAM
}


#if MK_N_LAUNCHES != 1
template <int P> static void launch_one(int grid, const Args& a, hipStream_t stream) { hipLaunchKernelGGL((skel_fwd<P, P + 1>), dim3(grid), dim3(NWAVES * 64), LDS_BYTES, stream, a); }
static void launch_phase(int li, int grid, const Args& a, hipStream_t stream) {
    switch (li) { case 0: launch_one<0>(grid, a, stream); break; case 1: launch_one<1>(grid, a, stream); break; case 2: launch_one<2>(grid, a, stream); break; case 3: launch_one<3>(grid, a, stream); break;
        case 4: launch_one<4>(grid, a, stream); break; case 5: launch_one<5>(grid, a, stream); break; case 6: launch_one<6>(grid, a, stream); break; case 7: launch_one<7>(grid, a, stream); break;
        case 8: launch_one<8>(grid, a, stream); break; default: launch_one<9>(grid, a, stream); break; }
}
#endif
static hipError_t set_lds_attr() {
    hipError_t e = hipSuccess;
#if MK_N_LAUNCHES == 1
    e = hipFuncSetAttribute((const void*)skel_fwd<0, N_PHASES>, hipFuncAttributeMaxDynamicSharedMemorySize, LDS_BYTES);
#else
#define SET1(P) if (e == hipSuccess) e = hipFuncSetAttribute((const void*)skel_fwd<P, P + 1>, hipFuncAttributeMaxDynamicSharedMemorySize, LDS_BYTES)
    SET1(0); SET1(1); SET1(2); SET1(3); SET1(4); SET1(5); SET1(6); SET1(7); SET1(8); SET1(9);
#undef SET1
#endif
    return e;
}
static hipError_t occ_query(int* per_cu) {
#if MK_N_LAUNCHES == 1
    return hipOccupancyMaxActiveBlocksPerMultiprocessor(per_cu, (const void*)skel_fwd<0, N_PHASES>, NWAVES * 64, LDS_BYTES);
#else
    return hipOccupancyMaxActiveBlocksPerMultiprocessor(per_cu, (const void*)skel_fwd<1, 2>, NWAVES * 64, LDS_BYTES);
#endif
}
extern "C" void kernel_launch(void* const* d_in, const int* in_sizes, int n_in, void* d_out, int out_size, void* d_ws, size_t ws_size, hipStream_t stream) {
    static int grid = 0;
    if (grid == 0) {
        if (n_in != 18 || (size_t)out_size != O_END || ws_size < WS_END) { fprintf(stderr, "kernel_launch: unexpected shapes: n_in %d out %d ws %zu (need %zu)\n", n_in, out_size, ws_size, (size_t)WS_END); grid = -1; return; }
        int dev = 0, cus = 0, per_cu = 0;
        if (hipGetDevice(&dev) != hipSuccess || hipDeviceGetAttribute(&cus, hipDeviceAttributeMultiprocessorCount, dev) != hipSuccess) { grid = -1; return; }
        if (set_lds_attr() != hipSuccess) { fprintf(stderr, "kernel_launch: hipFuncSetAttribute failed\n"); grid = -1; return; }
        if (occ_query(&per_cu) != hipSuccess || per_cu < 1) { fprintf(stderr, "kernel_launch: occupancy query says %d blocks per CU\n", per_cu); (void)hipGetLastError(); per_cu = 1; }
        grid = cus;
        fprintf(stderr, "kernel_launch: cus %d per_cu %d grid %d ws %zu\n", cus, per_cu, grid, ws_size);
    }
    if (grid < 0) return;
    (void)hipMemsetAsync((char*)d_ws + WS_CTL, 0, CTL_ZERO_BYTES, stream);
    Args a{};
    for (int i = 0; i < 18; ++i) a.in[i] = (const float*)d_in[i];
    a.out = (float*)d_out; a.ws = (unsigned char*)d_ws;
#if MK_N_LAUNCHES == 1
    {
        a.ph_lo = 0; a.ph_hi = N_PHASES; a.li = 0;
        void* kargs[] = {&a};
        hipError_t e = hipLaunchCooperativeKernel((const void*)skel_fwd<0, N_PHASES>, dim3(grid), dim3(NWAVES * 64), kargs, LDS_BYTES, stream);
        if (e != hipSuccess) fprintf(stderr, "kernel_launch: cooperative launch failed: %s (grid %d)\n", hipGetErrorString(e), grid);
    }
#else
    for (int li = 0; li < N_PHASES; ++li) { a.ph_lo = li; a.ph_hi = li + 1; a.li = 0; launch_phase(li, grid, a, stream); if (li == DUP_PHASE) { a.li = 1; launch_phase(li, grid, a, stream); if (li == 9) { a.li = 0; } } if (li == 2 && DUP_PHASE >= 20) { a.li = 1 + 16 * (DUP_PHASE - 20); launch_phase(li, grid, a, stream); } }
#endif
}
```

```cpp
#include <hip/hip_runtime.h>
#include <cstdio>
#include <cstdint>
namespace pg8 {
#define PG8_LAS __attribute__((address_space(3)))
typedef unsigned short bf16_t;
typedef short bf16x8 __attribute__((ext_vector_type(8)));
typedef float f32x4 __attribute__((ext_vector_type(4)));
typedef unsigned u32x4 __attribute__((ext_vector_type(4)));
constexpr int BM = 256, BK = 64, HALF = 128, HTB = HALF * BK * 2  , STAGE_BYTES = 8 * HTB, NXCD = 8, WGM = 2;

__host__ __device__ __forceinline__ int lds_byte(int r, int c) { const int st = (r >> 4) * 2 + (c >> 5), rr = r & 15, cc = c & 31, ob = rr * 64 + cc * 2; return st * 1024 + (ob ^ (((ob >> 9) & 1) << 5)); }
__host__ __device__ __forceinline__ void stage_rc(int b, int& R, int& C) { const int st = b / 1024, sb = b % 1024, swz = sb ^ (((sb >> 9) & 1) << 5); R = (st >> 1) * 16 + swz / 64; C = (st & 1) * 32 + (swz % 64) / 2; }
__host__ __device__ __forceinline__ int perm32(int rho) { const int n = rho >> 4, i = rho & 15; return 8 * (i >> 2) + 4 * n + (i & 3); }

struct Unit { int pm, pn, k0, nt, np, piece, slot; };
struct Gemm { const bf16_t* A; const bf16_t* Bt; int M, N, K; };

struct StaticOrder {
    int nM, nN, nwg, G, c;
    __host__ __device__ void init(int M, int N, int G_, int c_) { nM = M / BM; nN = N / BM; nwg = nM * nN; G = G_; c = c_; }
    __host__ __device__ bool next(int i, Unit& u) const {
        const long L = (long)i * G + c; if (L >= nwg) return false;
        int wgid = (int)L;
#ifndef ORDER_NOREMAP
        { const int q = nwg / NXCD, r = nwg % NXCD, xcd = wgid % NXCD, off = wgid / NXCD; wgid = (xcd < r ? xcd * (q + 1) : r * (q + 1) + (xcd - r) * q) + off; }
#endif
        const int nig = WGM * nN, gid = wgid / nig, fm = gid * WGM, gsz = (nM - fm) < WGM ? (nM - fm) : WGM;
        u.pm = fm + ((wgid % nig) % gsz); u.pn = (wgid % nig) / gsz; return true;
    }
    __device__ __forceinline__ void a_ready(const Unit&) const {}
    __device__ __forceinline__ void done(const Unit&) const {}
};


struct HybridOrder {
    int nM, nN, nwg, G, c, ntk, nfull, nrem, np;
    __host__ __device__ void init(int M, int N, int K, int G_, int c_, bool allow_split = true) {
        nM = M / BM; nN = N / BM; nwg = nM * nN; G = G_; c = c_; ntk = K / BK; nfull = nwg / G; nrem = nwg - nfull * G; np = 0;
        if (allow_split && nrem > 0 && (G % NXCD) == 0) { const int grp = (nrem + NXCD - 1) / NXCD; int p = (G / NXCD) / grp; const int maxp = ntk / 4; if (p > maxp) p = maxp; if (p > 8) p = 8; if (p >= 2) np = p; }
    }
    __host__ __device__ void map(long L, Unit& u) const {
        int wgid = (int)L;
#ifndef ORDER_NOREMAP
        { const int q = nwg / NXCD, r = nwg % NXCD, xcd = wgid % NXCD, off = wgid / NXCD; wgid = (xcd < r ? xcd * (q + 1) : r * (q + 1) + (xcd - r) * q) + off; }
#endif
        const int nig = WGM * nN, gid = wgid / nig, fm = gid * WGM, gsz = (nM - fm) < WGM ? (nM - fm) : WGM;
        u.pm = fm + ((wgid % nig) % gsz); u.pn = (wgid % nig) / gsz; u.k0 = 0; u.nt = ntk; u.np = 0; u.piece = 0; u.slot = 0;
    }
    __host__ __device__ bool next(int i, Unit& u) const {
        if (i < nfull) { map((long)i * G + c, u); return true; }
        if (i > nfull || nrem == 0) return false;
        if (np == 0) { if (c >= nrem) return false; map((long)nfull * G + c, u); return true; }
        const int x = c % NXCD, j = c / NXCD, grp = j / np, p = j - grp * np, r = grp * NXCD + x;
        if (r >= nrem) return false;
        map((long)nfull * G + r, u);
        const int pairs = ntk / 2, base = pairs / np, extra = pairs - base * np, first_big = np - extra;
        const int start = p * base + (p > first_big ? p - first_big : 0), len = base + (p >= first_big ? 1 : 0);
        u.k0 = 2 * start; u.nt = 2 * len; u.np = np; u.piece = p; u.slot = r; return true;
    }
    __device__ __forceinline__ void a_ready(const Unit&) const {}
    __device__ __forceinline__ void done(const Unit&) const {}
};
struct SplitCtx { float* slabs; unsigned* cnt; };

__device__ __forceinline__ unsigned cvt_pk_bf16(float lo, float hi) { unsigned r; asm volatile("v_cvt_pk_bf16_f32 %0, %1, %2" : "=v"(r) : "v"(lo), "v"(hi)); return r; }
typedef float f32x2 __attribute__((ext_vector_type(2)));
__device__ __forceinline__ f32x2 gelu_pk(f32x2 v) {
    const f32x2 av = __builtin_elementwise_abs(v), d = av * 0.2316418882f + 1.0f;
    f32x2 t; t.x = __builtin_amdgcn_rcpf(d.x); t.y = __builtin_amdgcn_rcpf(d.y);
    f32x2 q = t * 0.5307027145f + (-0.7265760135f); q = q * t + 0.7107068705f; q = q * t + (-0.142248368f); q = q * t + 0.127414796f; q = q * t;
    const f32x2 s = (v * v) * (-0.72134752044f);
    f32x2 e; e.x = __builtin_amdgcn_exp2f(s.x); e.y = __builtin_amdgcn_exp2f(s.y);
    const f32x2 m = v * (q * e), r = v - m;
    f32x2 o; o.x = v.x < 0.f ? m.x : r.x; o.y = v.y < 0.f ? m.y : r.y; return o;
}

template <int ACT> struct EpiBf16 {
    static constexpr bool PERM = true, AFTER_DRAIN = false;
    bf16_t* O; int ldc;
    __device__ __forceinline__ void tri(const f32x4 v0, const f32x4 v1, const Unit& u, int ai, int bj, int m, int wr, int wc, int fr, int fq) const {
        bf16_t* p = O + (size_t)(u.pm * BM + ai * HALF + wr * 64 + m * 16 + fr) * ldc + u.pn * BM + bj * HALF + wc * 32 + 8 * fq;
        u32x4 w; w.x = cvt_pk_bf16(v0[0], v0[1]); w.y = cvt_pk_bf16(v0[2], v0[3]); w.z = cvt_pk_bf16(v1[0], v1[1]); w.w = cvt_pk_bf16(v1[2], v1[3]);
        *(u32x4*)p = w;
    }
    __device__ __forceinline__ void operator()(const f32x4 (&acc)[2][2][4][2], const Unit& u, int wr, int wc, int fr, int fq) const {
#pragma unroll
        for (int ai = 0; ai < 2; ++ai)
#pragma unroll
            for (int m = 0; m < 4; ++m)
#pragma unroll
                for (int bj = 0; bj < 2; ++bj) tri(acc[ai][bj][m][0], acc[ai][bj][m][1], u, ai, bj, m, wr, wc, fr, fq);
    }
};
struct EpiF32 {
    static constexpr bool PERM = false, AFTER_DRAIN = false;
    float* C; int ldc;
    __device__ __forceinline__ void tri(const f32x4 v0, const f32x4 v1, const Unit& u, int ai, int bj, int m, int wr, int wc, int fr, int fq) const {
        float* p = C + (size_t)(u.pm * BM + ai * HALF + wr * 64 + m * 16 + fr) * ldc + u.pn * BM + bj * HALF + wc * 32 + 4 * fq;
        *(f32x4*)p = v0; *(f32x4*)(p + 16) = v1;
    }
    __device__ __forceinline__ void operator()(const f32x4 (&acc)[2][2][4][2], const Unit& u, int wr, int wc, int fr, int fq) const {
#pragma unroll
        for (int ai = 0; ai < 2; ++ai)
#pragma unroll
            for (int m = 0; m < 4; ++m)
#pragma unroll
                for (int bj = 0; bj < 2; ++bj) tri(acc[ai][bj][m][0], acc[ai][bj][m][1], u, ai, bj, m, wr, wc, fr, fq);
    }
};
typedef unsigned u32x2 __attribute__((ext_vector_type(2)));
__device__ __forceinline__ f32x4 bf4_to_f32(u32x2 x) { f32x4 o; o[0] = __builtin_bit_cast(float, x.x << 16); o[1] = __builtin_bit_cast(float, x.x & 0xffff0000u); o[2] = __builtin_bit_cast(float, x.y << 16); o[3] = __builtin_bit_cast(float, x.y & 0xffff0000u); return o; }
template <int NP, class Epi> __device__ __forceinline__ void split_epilogue(const f32x4 (&acc)[2][2][4][2], const Unit& u, const Epi& E, const SplitCtx& X, int tid, int wr, int wc, int fr, int fq) {
    constexpr int SLAB = 32 * 512 * 8;
    const __amdgpu_buffer_rsrc_t rs = __builtin_amdgcn_make_buffer_rsrc((void*)((char*)X.slabs + (size_t)(u.slot * u.np) * SLAB), 0, u.np * SLAB, 0x00020000);
    {
        const int so = u.piece * SLAB;
#pragma unroll
        for (int r = 0; r < 32; ++r) { const f32x4 v = acc[r >> 4][(r >> 3) & 1][(r >> 1) & 3][r & 1]; u32x2 w; w.x = cvt_pk_bf16(v[0], v[1]); w.y = cvt_pk_bf16(v[2], v[3]);
            __builtin_amdgcn_raw_buffer_store_b64(w, rs, (unsigned)(tid * 8), so + r * 4096, 16); }
    }
    asm volatile("s_waitcnt vmcnt(0)" ::: "memory");
    asm volatile("" ::: "memory"); __builtin_amdgcn_s_barrier(); asm volatile("" ::: "memory");
    if (tid == 0) {
        unsigned* cw = X.cnt + 64 * u.slot;
        (void)__hip_atomic_fetch_add(cw, 1u, __ATOMIC_RELAXED, __HIP_MEMORY_SCOPE_AGENT);
        unsigned sp = 0;
        while (__hip_atomic_load(cw, __ATOMIC_RELAXED, __HIP_MEMORY_SCOPE_AGENT) < (unsigned)u.np) { __builtin_amdgcn_s_sleep(1); if (++sp > (1u << 24)) break; }
        __builtin_amdgcn_fence(__ATOMIC_ACQUIRE, "agent");
        asm volatile("s_waitcnt vmcnt(0)" ::: "memory");
    }
    asm volatile("" ::: "memory"); __builtin_amdgcn_s_barrier(); asm volatile("" ::: "memory");
    const int q0 = (16 * u.piece) / u.np, q1 = (16 * (u.piece + 1)) / u.np;
#pragma unroll 1
    for (int q = q0; q < q1; ++q) {
        const unsigned vo = (unsigned)(tid * 8 + q * 8192);
        f32x4 v0 = (f32x4){0.f, 0.f, 0.f, 0.f}, v1 = v0;
        if (u.np == NP) {
            u32x2 t0[NP], t1[NP];
#pragma unroll
            for (int pp = 0; pp < NP; ++pp) { t0[pp] = __builtin_amdgcn_raw_buffer_load_b64(rs, vo, pp * SLAB, 0); t1[pp] = __builtin_amdgcn_raw_buffer_load_b64(rs, vo, pp * SLAB + 4096, 0); }
#pragma unroll
            for (int pp = 0; pp < NP; ++pp) { v0 += bf4_to_f32(t0[pp]); v1 += bf4_to_f32(t1[pp]); }
        } else {
            for (int pp = 0; pp < u.np; ++pp) { v0 += bf4_to_f32(__builtin_amdgcn_raw_buffer_load_b64(rs, vo, pp * SLAB, 0)); v1 += bf4_to_f32(__builtin_amdgcn_raw_buffer_load_b64(rs, vo, pp * SLAB + 4096, 0)); }
        }
        E.tri(v0, v1, u, q >> 3, (q >> 2) & 1, q & 3, wr, wc, fr, fq);
    }
}
template <class Epi, class Sched, bool ALIGN_EPI = false, bool SP2 = false, int NP = 8>
__device__ __forceinline__ void gemm_phase(PG8_LAS unsigned char* lds, const Gemm g, const Sched& S, const Epi& E, const SplitCtx& X) {
    int tid_ = threadIdx.x; asm volatile("" : "+v"(tid_));
    const int tid = tid_, wid = __builtin_amdgcn_readfirstlane(tid >> 6), lane = tid & 63, wr = wid >> 2, wc = wid & 3, fr = lane & 15, fq = lane >> 4;
    const int K = g.K;
    unsigned voffA[2], voffB[2];
#pragma unroll
    for (int i = 0; i < 2; ++i) { int R, C; stage_rc(tid * 16 + i * 8192, R, C); const int Rb = Epi::PERM ? ((R & ~31) + perm32(R & 31)) : R;
        voffA[i] = (unsigned)(R * K + C) * 2u; voffB[i] = (unsigned)(Rb * K + C) * 2u; }
    const size_t kstep = (size_t)(BK * 2);
    const size_t hstep = (size_t)HALF * K * 2;
    const size_t tstep = 2 * hstep;
    const unsigned ldsw = (unsigned)wid * 1024u;
    const int aoff = lds_byte(wr * 64 + fr, fq * 8), boff = lds_byte(wc * 32 + fr, fq * 8);
#define PG8_SA(b, h) (((b) * 2 + (h)) * HTB)
#define PG8_SB(b, h) ((4 + (b) * 2 + (h)) * HTB)
#define PG8_STAGE(bufoff, gbase, voff) do { _Pragma("unroll") for (int _i = 0; _i < 2; ++_i) \
        __builtin_amdgcn_global_load_lds((const unsigned*)((const char*)(gbase) + (voff)[_i]), (PG8_LAS unsigned*)(lds + (bufoff) + ldsw + _i * 8192), 16, 0, 0); } while (0)
#define PG8_LDA(dst, b, h) do { _Pragma("unroll") for (int m = 0; m < 4; ++m) _Pragma("unroll") for (int k = 0; k < 2; ++k) dst[m][k] = *(const PG8_LAS bf16x8*)(lds + PG8_SA(b, h) + aoff + m * 2048 + k * 1024); } while (0)
#define PG8_LDB(dst, b, h) do { _Pragma("unroll") for (int n = 0; n < 2; ++n) _Pragma("unroll") for (int k = 0; k < 2; ++k) dst[n][k] = *(const PG8_LAS bf16x8*)(lds + PG8_SB(b, h) + boff + n * 2048 + k * 1024); } while (0)
#define PG8_MMA(ai, bj, At, Bt) do { __builtin_amdgcn_s_setprio(1); _Pragma("unroll") for (int m = 0; m < 4; ++m) _Pragma("unroll") for (int n = 0; n < 2; ++n) _Pragma("unroll") for (int k = 0; k < 2; ++k) \
        acc[ai][bj][m][n] = __builtin_amdgcn_mfma_f32_16x16x32_bf16(Bt[n][k], At[m][k], acc[ai][bj][m][n], 0, 0, 0); __builtin_amdgcn_s_setprio(0); } while (0)
#define PG8_WAIT_V(n) asm volatile("s_waitcnt vmcnt(" #n ")" ::: "memory")
#define PG8_WAIT_L(n) asm volatile("s_waitcnt lgkmcnt(" #n ")" ::: "memory")
#define PG8_BAR __builtin_amdgcn_s_barrier()
#define PG8_SCHED __builtin_amdgcn_sched_barrier(0)
    Unit cur, nxt; int ui = 0;
    if (!S.next(0, cur)) return;
    f32x4 acc[2][2][4][2];
#pragma unroll
    for (int a = 0; a < 2; ++a)
#pragma unroll
        for (int b = 0; b < 2; ++b)
#pragma unroll
            for (int m = 0; m < 4; ++m)
#pragma unroll
                for (int n = 0; n < 2; ++n) acc[a][b][m][n] = (f32x4){0.f, 0.f, 0.f, 0.f};
    bf16x8 At[4][2], B0[2][2], B1[2][2];
    const char* cA = (const char*)g.A + (size_t)cur.pm * tstep + (size_t)cur.k0 * kstep; const char* cB = (const char*)g.Bt + (size_t)cur.pn * tstep + (size_t)cur.k0 * kstep;
    S.a_ready(cur);
    if constexpr (SP2) {
        PG8_STAGE(PG8_SB(0, 0), cB, voffB); PG8_STAGE(PG8_SB(0, 1), cB + hstep, voffB); PG8_STAGE(PG8_SA(0, 0), cA, voffA); PG8_STAGE(PG8_SA(0, 1), cA + hstep, voffA);
        if (wr == 1) PG8_BAR;
        PG8_WAIT_V(2); PG8_BAR;
        PG8_STAGE(PG8_SB(1, 0), cB + kstep, voffB); PG8_STAGE(PG8_SA(1, 0), cA + kstep, voffA); PG8_STAGE(PG8_SB(1, 1), cB + hstep + kstep, voffB);
        PG8_WAIT_V(6); PG8_BAR;
    } else {
        PG8_STAGE(PG8_SB(0, 0), cB, voffB); PG8_STAGE(PG8_SA(0, 0), cA, voffA); PG8_STAGE(PG8_SB(0, 1), cB + hstep, voffB); PG8_STAGE(PG8_SA(0, 1), cA + hstep, voffA);
        if (wr == 1) PG8_BAR;
        PG8_WAIT_V(4); PG8_BAR;
        PG8_STAGE(PG8_SB(1, 0), cB + kstep, voffB); PG8_STAGE(PG8_SA(1, 0), cA + kstep, voffA); PG8_STAGE(PG8_SB(1, 1), cB + hstep + kstep, voffB);
        PG8_WAIT_V(6); PG8_BAR;
    }
    for (;;) {
        const bool has_next = S.next(ui + 1, nxt);
        const char* nA = has_next ? (const char*)g.A + (size_t)nxt.pm * tstep + (size_t)nxt.k0 * kstep : cA; const char* nB = has_next ? (const char*)g.Bt + (size_t)nxt.pn * tstep + (size_t)nxt.k0 * kstep : cB;
        const int nt = cur.nt;
        for (int t = 0; t < nt; t += 2) {
            const bool last = (t == nt - 2);
            const char* a1 = cA + (size_t)(t + 1) * kstep;
            const char* a2 = last ? nA : cA + (size_t)(t + 2) * kstep; const char* b2 = last ? nB : cB + (size_t)(t + 2) * kstep;
            const char* a3 = a2 + kstep; const char* b3 = b2 + kstep;
            if (last && has_next) S.a_ready(nxt);
            if constexpr (SP2) {
            PG8_LDB(B0, 0, 0); PG8_LDB(B1, 0, 1); PG8_SCHED; PG8_LDA(At, 0, 0); PG8_STAGE(PG8_SA(1, 1), a1 + hstep, voffA);
            PG8_WAIT_V(8); PG8_WAIT_L(0); PG8_BAR; PG8_MMA(0, 0, At, B0); PG8_MMA(0, 1, At, B1); PG8_BAR; PG8_SCHED;
            PG8_LDA(At, 0, 1); PG8_STAGE(PG8_SB(0, 0), b2, voffB); PG8_STAGE(PG8_SB(0, 1), b2 + hstep, voffB); PG8_STAGE(PG8_SA(0, 0), a2, voffA);
            PG8_WAIT_V(8); PG8_WAIT_L(0); PG8_BAR; PG8_MMA(1, 0, At, B0); PG8_MMA(1, 1, At, B1); PG8_BAR; PG8_SCHED;
            PG8_LDB(B0, 1, 0); PG8_LDB(B1, 1, 1); PG8_SCHED; PG8_LDA(At, 1, 0); PG8_STAGE(PG8_SA(0, 1), a2 + hstep, voffA);
            PG8_WAIT_V(8); PG8_WAIT_L(0); PG8_BAR; PG8_MMA(0, 0, At, B0); PG8_MMA(0, 1, At, B1); PG8_BAR; PG8_SCHED;
            PG8_LDA(At, 1, 1); PG8_STAGE(PG8_SB(1, 0), b3, voffB); PG8_STAGE(PG8_SB(1, 1), b3 + hstep, voffB); PG8_STAGE(PG8_SA(1, 0), a3, voffA);
            PG8_WAIT_V(8); PG8_WAIT_L(0); PG8_BAR; PG8_MMA(1, 0, At, B0); PG8_MMA(1, 1, At, B1); PG8_BAR; PG8_SCHED;
            } else {
            PG8_LDB(B0, 0, 0); PG8_SCHED; PG8_LDA(At, 0, 0); PG8_STAGE(PG8_SA(1, 1), a1 + hstep, voffA);
            PG8_WAIT_L(8); PG8_BAR; PG8_WAIT_L(0); PG8_MMA(0, 0, At, B0); PG8_BAR; PG8_SCHED;
            PG8_LDB(B1, 0, 1); PG8_STAGE(PG8_SB(0, 0), b2, voffB);
            PG8_BAR; PG8_WAIT_L(0); PG8_MMA(0, 1, At, B1); PG8_BAR;
            PG8_LDA(At, 0, 1); PG8_STAGE(PG8_SA(0, 0), a2, voffA);
            PG8_BAR; PG8_WAIT_L(0); PG8_MMA(1, 0, At, B0); PG8_BAR; PG8_SCHED;
            PG8_STAGE(PG8_SB(0, 1), b2 + hstep, voffB);
            PG8_WAIT_V(6); PG8_BAR; PG8_MMA(1, 1, At, B1); PG8_BAR;
            PG8_LDB(B0, 1, 0); PG8_SCHED; PG8_LDA(At, 1, 0); PG8_STAGE(PG8_SA(0, 1), a2 + hstep, voffA);
            PG8_WAIT_L(8); PG8_BAR; PG8_WAIT_L(0); PG8_MMA(0, 0, At, B0); PG8_BAR; PG8_SCHED;
            PG8_LDB(B1, 1, 1); PG8_STAGE(PG8_SB(1, 0), b3, voffB);
            PG8_BAR; PG8_WAIT_L(0); PG8_MMA(0, 1, At, B1); PG8_BAR;
            PG8_LDA(At, 1, 1); PG8_STAGE(PG8_SA(1, 0), a3, voffA);
            PG8_BAR; PG8_WAIT_L(0); PG8_MMA(1, 0, At, B0); PG8_BAR; PG8_SCHED;
            PG8_STAGE(PG8_SB(1, 1), b3 + hstep, voffB);
            PG8_WAIT_V(6); PG8_BAR; PG8_MMA(1, 1, At, B1); PG8_BAR;
            }
        }
        if constexpr (ALIGN_EPI) { if (wr == 0) PG8_BAR; }
        if constexpr (!Epi::AFTER_DRAIN) { if (cur.np > 0) split_epilogue<NP>(acc, cur, E, X, tid, wr, wc, fr, fq); else E(acc, cur, wr, wc, fr, fq); S.done(cur); }
        if (!has_next) break;
#pragma unroll
        for (int a = 0; a < 2; ++a)
#pragma unroll
            for (int b = 0; b < 2; ++b)
#pragma unroll
                for (int m = 0; m < 4; ++m)
#pragma unroll
                    for (int n = 0; n < 2; ++n) acc[a][b][m][n] = (f32x4){0.f, 0.f, 0.f, 0.f};
        cur = nxt; cA = nA; cB = nB; ++ui;
        if constexpr (ALIGN_EPI) { if (wr == 1) PG8_BAR; }
    }
    PG8_WAIT_V(0);
    if constexpr (!ALIGN_EPI) { if (wr == 0) PG8_BAR; }
    PG8_BAR;
    if constexpr (Epi::AFTER_DRAIN) { E.fused(acc, cur, wr, wc, fr, fq, lds, wid, lane); S.done(cur); }
#undef PG8_SA
#undef PG8_SB
#undef PG8_STAGE
#undef PG8_LDA
#undef PG8_LDB
#undef PG8_MMA
#undef PG8_WAIT_V
#undef PG8_WAIT_L
#undef PG8_BAR
#undef PG8_SCHED
}
}

#ifndef PG8_SP2
#define PG8_SP2 true
#endif
#ifndef PG8_ALIGN
#define PG8_ALIGN true
#endif
#ifndef DUP_PHASE
#define DUP_PHASE -1
#endif
#ifndef MK_N_LAUNCHES
#define MK_N_LAUNCHES 1
#endif
constexpr int NWAVES = 8;
constexpr int N_PHASES = 10;
constexpr int N_LAUNCHES = MK_N_LAUNCHES;

constexpr int MP = 8192, MS = 1024, M = MP + MS;
constexpr int D = 2048, NIN = 11264, FF = 5632, FF2 = 11264;
constexpr int NH = 8, DK = 128, DVH = 256;
constexpr int C_POOL = 0, C_Q = 1024, C_K = 2048, C_V = 3072, C_GRET = 5120, C_GA = 7168, C_GR = 9216;
constexpr float EPS = 1e-6f;
constexpr int NS = 4, DVS = DVH / NS;
constexpr size_t O_Y = 0, O_POOLP = 18874368, O_RETP = 18935808, O_CONVP = 19984384, O_POOLS = 20074496, O_RETS = 22040576, O_CONVS = 55595008, O_END = 58478592;

constexpr size_t MiB = 1u << 20;
constexpr size_t WS_CTL = 0, CTL_ZERO_BYTES = 128 * 1024;
constexpr size_t WS_WIN = 1 * MiB, WS_WUP = 45 * MiB, WS_WDN = 89 * MiB, WS_WOUT = 111 * MiB, WS_WPOOL = 119 * MiB;
constexpr size_t WS_ROPE = 120 * MiB;
constexpr size_t WS_XN = 122 * MiB;
constexpr size_t WS_PROJ = 158 * MiB;
constexpr size_t WS_O = 356 * MiB, WS_AP = 392 * MiB, WS_MM = 428 * MiB;
constexpr size_t WS_SP16 = 464 * MiB;
constexpr size_t WS_X1 = 468 * MiB;
constexpr size_t WS_END = 504 * MiB;
constexpr int CW_TMO = 0, CW_CODE = 1, CW_Q2 = 64, CW_QW = 2048, CW_BAR = 4096, CW_SPLIT = 8192;
static_assert((CW_SPLIT + 4 * 4096) * 4 <= (int)CTL_ZERO_BYTES && CW_BAR + 3456 <= CW_SPLIT, "control words inside the per-call memset");
constexpr size_t WS_SLAB_A = 356 * MiB, WS_SLAB_B = 230 * MiB;

constexpr int LDS_BYTES = 147456, LDSCTL_OFF = 143360;

#define GAS __attribute__((address_space(1)))
#define LAS __attribute__((address_space(3)))
typedef unsigned short bf16;
typedef unsigned v4u __attribute__((ext_vector_type(4)));
typedef unsigned v2u __attribute__((ext_vector_type(2)));
typedef float f32x4 __attribute__((ext_vector_type(4)));
typedef short bf16x8 __attribute__((ext_vector_type(8)));
#define RLX_AGENT __ATOMIC_RELAXED, __HIP_MEMORY_SCOPE_AGENT
#define LDS_WAIT() asm volatile("s_waitcnt lgkmcnt(0)" ::: "memory")
#define VM_WAIT() asm volatile("s_waitcnt vmcnt(0)" ::: "memory")
__device__ __forceinline__ unsigned pk2(float lo, float hi) { return pg8::cvt_pk_bf16(lo, hi); }
__device__ __forceinline__ float bflo(unsigned u) { return __uint_as_float(u << 16); }
__device__ __forceinline__ float bfhi(unsigned u) { return __uint_as_float(u & 0xffff0000u); }
__device__ __forceinline__ void unpack8(v4u x, float (&f)[8]) { f[0] = bflo(x.x); f[1] = bfhi(x.x); f[2] = bflo(x.y); f[3] = bfhi(x.y); f[4] = bflo(x.z); f[5] = bfhi(x.z); f[6] = bflo(x.w); f[7] = bfhi(x.w); }
__device__ __forceinline__ v4u pack8(const float (&f)[8]) { v4u o; o.x = pk2(f[0], f[1]); o.y = pk2(f[2], f[3]); o.z = pk2(f[4], f[5]); o.w = pk2(f[6], f[7]); return o; }
__device__ __forceinline__ v2u pack4(f32x4 a) { v2u o; o.x = pk2(a[0], a[1]); o.y = pk2(a[2], a[3]); return o; }
__device__ __forceinline__ float sigmoidf_(float x) { return __builtin_amdgcn_rcpf(1.0f + __expf(-x)); }
__device__ __forceinline__ float wave_sum(float v) {
#pragma unroll
    for (int o = 1; o < 64; o <<= 1) v += __shfl_xor(v, o);
    return v;
}
__device__ __forceinline__ bf16x8 as_bf16x8(v4u x) { return __builtin_bit_cast(bf16x8, x); }
#define MFMA16(a, b, c) __builtin_amdgcn_mfma_f32_16x16x32_bf16((a), (b), (c), 0, 0, 0)

#define XB_TMO      128
#define XB_XCNT(j)  (256  + 64 * (j))
#define XB_XSUB(j)  (1280 + 64 * (j))
#define XB_XGEN(j)  (2304 + 64 * (j))
#define XB_TOP      3328
#define XB_TOPGEN   3392
#define XCD_BAR_WORDS 3456
#define XB_SPIN_CAP (1u << 22)
__device__ __forceinline__ unsigned xb_ld(unsigned* p)              { return __hip_atomic_load(p, __ATOMIC_RELAXED, __HIP_MEMORY_SCOPE_AGENT); }
__device__ __forceinline__ unsigned xb_add(unsigned* p, unsigned v) { return __hip_atomic_fetch_add(p, v, __ATOMIC_RELAXED, __HIP_MEMORY_SCOPE_AGENT); }
__device__ __forceinline__ unsigned xb_xcc_id() { return (unsigned)__builtin_amdgcn_s_getreg((3 << 11) | 20) & 0xFu; }
#define XB_SPIN(cond, bar) do { unsigned _sp = 0; while (cond) { __builtin_amdgcn_s_sleep(1); \
    if ((++_sp & 255u) == 0u) { if (xb_ld(&(bar)[XB_TMO])) break; if (_sp > XB_SPIN_CAP) { atomicAdd(&(bar)[XB_TMO], 1u); break; } } } } while (0)
struct XcdBarrier { unsigned* bar; unsigned x; volatile LAS unsigned* st; };
__device__ __forceinline__ XcdBarrier xcd_barrier_post(unsigned* bar, volatile LAS unsigned* st) {
    XcdBarrier b; b.bar = bar; b.x = xb_xcc_id(); b.st = st;
    if (threadIdx.x == 0) (void)xb_add(&bar[XB_XCNT(b.x)], 1u);
    return b;
}
__device__ __forceinline__ void xcd_barrier_complete(unsigned* bar, unsigned x, unsigned& nloc, unsigned& nx) {
    const unsigned G = gridDim.x * gridDim.y * gridDim.z;
    unsigned sum, cnt, mine, sp = 0u;
    for (;;) {
        sum = 0u; cnt = 0u; mine = 0u;
#pragma unroll
        for (unsigned j = 0; j < 16; ++j) { const unsigned c = xb_ld(&bar[XB_XCNT(j)]); sum += c; cnt += (c > 0u) ? 1u : 0u; mine = (j == x) ? c : mine; }
        if (sum == G) break;
        __builtin_amdgcn_s_sleep(1);
        if ((++sp & 255u) == 0u) { if (xb_ld(&bar[XB_TMO])) break; if (sp > XB_SPIN_CAP) { atomicAdd(&bar[XB_TMO], 1u); break; } }
    }
    nloc = mine > 0u ? mine : 1u; nx = cnt > 0u ? cnt : 1u;
}
__device__ __forceinline__ void xcd_barrier(const XcdBarrier& b) {
    asm volatile("s_waitcnt vmcnt(0)" ::: "memory");
    __syncthreads();
    if (threadIdx.x == 0) {
        unsigned* bar = b.bar;
        __builtin_amdgcn_s_waitcnt(0);
        unsigned nloc = b.st[0], nx = b.st[1];
        if (nloc == 0u) { xcd_barrier_complete(bar, b.x, nloc, nx); b.st[0] = nloc; b.st[1] = nx; }
        const unsigned old = xb_add(&bar[XB_XSUB(b.x)], 1u);
        const unsigned gen = old / nloc;
        if (old + 1u == (gen + 1u) * nloc) {
            __builtin_amdgcn_fence(__ATOMIC_RELEASE, "agent");
            asm volatile("s_waitcnt vmcnt(0)" ::: "memory");
            const unsigned og = xb_add(&bar[XB_TOP], 1u);
            const unsigned tg = og / nx;
            if (og + 1u == (tg + 1u) * nx) xb_add(&bar[XB_TOPGEN], 1u);
            else XB_SPIN(xb_ld(&bar[XB_TOPGEN]) == tg, bar);
            __builtin_amdgcn_fence(__ATOMIC_ACQUIRE, "agent");
            xb_add(&bar[XB_XGEN(b.x)], 1u);
            asm volatile("s_waitcnt vmcnt(0)" ::: "memory");
        } else {
            XB_SPIN(xb_ld(&bar[XB_XGEN(b.x)]) == gen, bar);
            __builtin_amdgcn_fence(__ATOMIC_ACQUIRE, "agent");
            asm volatile("s_waitcnt vmcnt(0)" ::: "memory");
        }
    }
    __syncthreads();
}

struct Frame {
    LAS unsigned char* lds;
    volatile LAS unsigned* MISC;
    unsigned* ctl;
    int tid, lane, wave, G, gw, NGW;
    const float *xp, *xs, *state_pool, *state_ret, *state_conv, *g_pre_mix, *w_in, *w_pool, *pool_scale, *gn_gain, *w_out, *g_post_mix, *g_pre_ffn, *w_up, *conv_w, *conv_b, *w_down, *g_post_ffn;
    float* out;
    bf16 *WIN, *WUP, *WDN, *WOUT, *WPOOL, *XN, *PROJ, *UP, *OB, *AP, *MM, *ACT;
    float *ROPE_C, *ROPE_S;
    bf16 *SP16, *MOB, *X1B;
};
__device__ __forceinline__ const float* xrow(const Frame& F, int m) { return m < MP ? F.xp + (size_t)m * D : F.xs + (size_t)(m - MP) * D; }

__host__ __device__ __forceinline__ int unperm_d(int p) { const int g8 = p >> 3, e = p & 7; return e < 4 ? 4 * g8 + e : 64 + 4 * g8 + (e - 4); }
__device__ __forceinline__ void p0_transpose_item(const float* W, int K, int N, bf16* WT, LAS float* scr, int item, int lane, bool permqk = false) {
    const int nblk = N / 32, kb = item / nblk, nb = item % nblk, k0 = 64 * kb, n0 = 32 * nb;
    int src = n0 + (lane & 31); if (permqk && src >= C_Q && src < C_V) src = (src & ~127) + unperm_d(src & 127);
#pragma unroll 8
    for (int i = 0; i < 32; ++i) { const int kk = 2 * i + (lane >> 5); scr[kk * 33 + (lane & 31)] = __builtin_nontemporal_load(W + (size_t)(k0 + kk) * N + src); }
    LDS_WAIT(); asm volatile("" ::: "memory");
    const int c = lane & 7;
#pragma unroll
    for (int j = 0; j < 4; ++j) { const int n = (lane >> 3) + 8 * j; const LAS float* s = scr + (8 * c) * 33 + n;
        v4u o; o.x = pk2(s[0 * 33], s[1 * 33]); o.y = pk2(s[2 * 33], s[3 * 33]); o.z = pk2(s[4 * 33], s[5 * 33]); o.w = pk2(s[6 * 33], s[7 * 33]);
        *(v4u*)(WT + (size_t)(n0 + n) * K + k0 + 8 * c) = o; }
    LDS_WAIT(); asm volatile("" ::: "memory");
}
__device__ __forceinline__ void rms_row_to_bf16(const float* xr_, const float* g, bf16* orow, int lane) {
    const f32x4* xr = (const f32x4*)xr_ + lane; const f32x4* gr = (const f32x4*)g + lane;
    f32x4 v[8]; float s = 0.f;
#pragma unroll
    for (int j = 0; j < 8; ++j) { v[j] = __builtin_nontemporal_load(xr + 64 * j); s += (v[j].x * v[j].x + v[j].y * v[j].y) + (v[j].z * v[j].z + v[j].w * v[j].w); }
    const float rs = 1.0f / sqrtf(wave_sum(s) * (1.f / D) + EPS);
    v2u* o8 = (v2u*)orow + lane;
#pragma unroll
    for (int j = 0; j < 8; ++j) { const f32x4 gg = gr[64 * j]; v2u o; o.x = pk2(v[j].x * rs * gg.x, v[j].y * rs * gg.y); o.y = pk2(v[j].z * rs * gg.z, v[j].w * rs * gg.w); o8[64 * j] = o; }
}
__device__ __forceinline__ void p0_deferred_weights(Frame& F, LAS float* scr) {
    constexpr int I_UP = (D / 64) * (FF2 / 32), I_DN = (FF / 64) * (D / 32), I_OUT = (D / 64) * (D / 32), I_PL = (256 / 64) * (512 / 32);
    constexpr int NITEMS = I_UP + I_DN + I_OUT + 4 * I_PL, CHUNK = 2, NQ = 16, PERQ = NITEMS / NQ;
    static_assert(NITEMS % NQ == 0 && PERQ % CHUNK == 0, "deferred-weight queue split");
    const int qi = blockIdx.x & (NQ - 1);
    for (;;) {
        int base = 0;
        if (F.lane == 0) base = (int)__hip_atomic_fetch_add(F.ctl + CW_QW + 64 * qi, (unsigned)CHUNK, RLX_AGENT);
        base = __builtin_amdgcn_readfirstlane(base);
        if (base >= PERQ) break;
        base += qi * PERQ;
        for (int it = base; it < base + CHUNK; ++it) {
            int r = it;
            if (r < I_UP) { p0_transpose_item(F.w_up, D, FF2, F.WUP, scr, r, F.lane); continue; } r -= I_UP;
            if (r < I_DN) { p0_transpose_item(F.w_down, FF, D, F.WDN, scr, r, F.lane); continue; } r -= I_DN;
            if (r < I_OUT) { p0_transpose_item(F.w_out, D, D, F.WOUT, scr, r, F.lane); continue; } r -= I_OUT;
            const int g = r / I_PL; r -= g * I_PL;
            p0_transpose_item(F.w_pool + (size_t)g * 256 * 512, 256, 512, F.WPOOL + (size_t)g * 512 * 256, scr, r, F.lane);
        }
    }
}
__device__ __forceinline__ void p0_prologue(Frame& F) {
    LAS float* scr = (LAS float*)(F.lds + F.wave * 16384);
    constexpr int I_IN = (D / 64) * (NIN / 32);
    for (int it = F.gw; it < I_IN; it += F.NGW) p0_transpose_item(F.w_in, D, NIN, F.WIN, scr, it, F.lane, true);
    for (int m = F.gw; m < M; m += F.NGW) rms_row_to_bf16(xrow(F, m), F.g_pre_mix, F.XN + (size_t)m * D, F.lane);
    for (int idx = blockIdx.x * 512 + F.tid; idx < 128 * 15 * 1024 / 4; idx += F.G * 512) { const f32x4 v = ((const f32x4*)F.state_pool)[idx]; ((v2u*)F.SP16)[idx] = pack4(v); }
    for (int idx = blockIdx.x * 512 + F.tid; idx < 2056 * 64; idx += F.G * 512) {
        const int row = idx >> 6, i = idx & 63; const int pos = row < 2048 ? row : 16384 + (row - 2048);
        double th = 1.0; for (int k = 0; k < i; ++k) th *= 0.8659643233600653;
        const double a = (double)pos * th;
        const double kd = rint(a * 0.6366197723675814);
        double y = fma(-kd, 1.57079632679489655800e+00, a); y = fma(-kd, 6.12323399573676603587e-17, y);
        const int k4 = ((int)kd) & 3; const double y2 = y * y;
        const double sp = y * (1.0 + y2 * (-1.0 / 6 + y2 * (1.0 / 120 + y2 * (-1.0 / 5040 + y2 * (1.0 / 362880 + y2 * (-1.0 / 39916800 + y2 * (1.0 / 6227020800.0)))))));
        const double cp = 1.0 + y2 * (-0.5 + y2 * (1.0 / 24 + y2 * (-1.0 / 720 + y2 * (1.0 / 40320 + y2 * (-1.0 / 3628800 + y2 * (1.0 / 479001600 + y2 * (-1.0 / 87178291200.0)))))));
        double sn, cs;
        if (k4 == 0) { sn = sp; cs = cp; } else if (k4 == 1) { sn = cp; cs = -sp; } else if (k4 == 2) { sn = -sp; cs = -cp; } else { sn = -cp; cs = sp; }
        F.ROPE_C[idx] = (float)cs; F.ROPE_S[idx] = (float)sn;
    }
}

constexpr float KSCALE = 0.08838834764831845f;
struct EpiProj {
    static constexpr bool PERM = true, AFTER_DRAIN = false;
    bf16* O; const float* rc; const float* rs;
    __device__ __forceinline__ void tri(f32x4 v0, f32x4 v1, const pg8::Unit& u, int ai, int bj, int m, int wr, int wc, int fr, int fq) const {
        const int row = u.pm * 256 + ai * 128 + wr * 64 + m * 16 + fr, col = u.pn * 256 + bj * 128 + wc * 32 + 8 * fq;
        if (u.pn >= 4 && u.pn < 12) {
            const int h = ((u.pn & 3) << 1) + bj;
            int prow, tl; if (row < MP) { const int t = row & 2047; prow = t; tl = t & 127; } else { tl = row & 7; prow = 2048 + tl; }
            const int g8 = 4 * wc + fq;
            const f32x4 c = *(const f32x4*)(rc + prow * 64 + 4 * g8), sn = *(const f32x4*)(rs + prow * 64 + 4 * g8);
            const float lg2 = __log2f(1.0f - __builtin_amdgcn_exp2f(-5.0f - (float)h));
            const float sc = u.pn >= 8 ? KSCALE * __builtin_amdgcn_exp2f(-lg2 * (float)tl) : __builtin_amdgcn_exp2f(lg2 * (float)tl);
            const f32x4 y1 = (v0 * c - v1 * sn) * sc, y2 = (v1 * c + v0 * sn) * sc;
            v0 = y1; v1 = y2;
        }
        v4u w4; w4.x = pk2(v0[0], v0[1]); w4.y = pk2(v0[2], v0[3]); w4.z = pk2(v1[0], v1[1]); w4.w = pk2(v1[2], v1[3]);
        *(v4u*)(O + (size_t)row * NIN + col) = w4;
    }
    __device__ __forceinline__ void operator()(const f32x4 (&acc)[2][2][4][2], const pg8::Unit& u, int wr, int wc, int fr, int fq) const {
#pragma unroll
        for (int ai = 0; ai < 2; ++ai)
#pragma unroll
            for (int m = 0; m < 4; ++m)
#pragma unroll
                for (int bj = 0; bj < 2; ++bj) tri(acc[ai][bj][m][0], acc[ai][bj][m][1], u, ai, bj, m, wr, wc, fr, fq);
    }
};

typedef short s16x4 __attribute__((ext_vector_type(4)));
__device__ __forceinline__ bf16x8 tr16x2(const LAS unsigned char* p0, const LAS unsigned char* p1) {
    const s16x4 a = __builtin_amdgcn_ds_read_tr16_b64_v4i16((LAS s16x4*)p0), b = __builtin_amdgcn_ds_read_tr16_b64_v4i16((LAS s16x4*)p1);
    return __builtin_shufflevector(a, b, 0, 1, 2, 3, 4, 5, 6, 7);
}
static_assert(DVS == 64, "chain staging below assumes 64-wide value slices");
constexpr int QI_LD = 136, VI_LD = DVS + 8;
constexpr int QI_OFF = 0, KI_OFF = 34816, VI_OFF = 69632, RT_OFF = VI_OFF + 128 * VI_LD * 2, CH_END = RT_OFF + DVS * QI_LD * 2;
static_assert(CH_END <= LDSCTL_OFF, "chain LDS");
__device__ __forceinline__ void chain_unit(Frame& F, int unit) {
    const int s = unit % NS, h = (unit / NS) & 7, b = unit / (NS * 8);
    int tid_ = F.tid; asm volatile("" : "+v"(tid_));
    const int tid = tid_, lane = tid & 63, w = F.wave, fr = lane & 15, fq = lane >> 4, tq = (lane & 15) >> 2, tp = lane & 3;
    LAS unsigned char* L = F.lds;
    const float lg2 = __log2f(1.0f - __builtin_amdgcn_exp2f(-5.0f - (float)h));
    const float gam = __builtin_amdgcn_exp2f(lg2), g127 = __builtin_amdgcn_exp2f(127.f * lg2);
    for (int i = tid; i < DVS * QI_LD * 2 / 16; i += 512) *(LAS v4u*)(L + RT_OFF + i * 16) = (v4u){0u, 0u, 0u, 0u};
    f32x4 Racc[4];
#pragma unroll
    for (int i = 0; i < 4; ++i) Racc[i] = (f32x4){0.f, 0.f, 0.f, 0.f};
    const int vt_r = w & 3, dg = w >> 2;
    const bf16* pbase = F.PROJ + ((size_t)b * 2048) * NIN;
    v4u sq[4], sk[4], sv[2];
#define CH_ISSUE(c) do { const bf16* pr_ = pbase + (size_t)((c) * 128) * NIN; \
        _Pragma("unroll") for (int i_ = 0; i_ < 4; ++i_) { const int ci = tid + 512 * i_, j = ci >> 4, ch = ci & 15; sq[i_] = *(const v4u*)(pr_ + (size_t)j * NIN + C_Q + h * 128 + 8 * ch); sk[i_] = *(const v4u*)(pr_ + (size_t)j * NIN + C_K + h * 128 + 8 * ch); } \
        _Pragma("unroll") for (int i_ = 0; i_ < 2; ++i_) { const int ci = tid + 512 * i_, j = ci >> 3, ch = ci & 7; sv[i_] = *(const v4u*)(pr_ + (size_t)j * NIN + C_V + h * DVH + s * DVS + 8 * ch); } } while (0)
#define CH_WRITE() do { \
        _Pragma("unroll") for (int i_ = 0; i_ < 4; ++i_) { const int ci = tid + 512 * i_, j = ci >> 4, ch = ci & 15; *(LAS v4u*)(L + QI_OFF + (j * QI_LD + 8 * ch) * 2) = sq[i_]; *(LAS v4u*)(L + KI_OFF + (j * QI_LD + 8 * ch) * 2) = sk[i_]; } \
        _Pragma("unroll") for (int i_ = 0; i_ < 2; ++i_) { const int ci = tid + 512 * i_, j = ci >> 3, ch = ci & 7; *(LAS v4u*)(L + VI_OFF + (j * VI_LD + 8 * ch) * 2) = sv[i_]; } } while (0)
    CH_ISSUE(0);
#pragma unroll 1
    for (int c = 0; c < 16; ++c) {
        const size_t mrow0 = (size_t)b * 2048 + c * 128;
        CH_WRITE();
        __syncthreads();
        if (c + 1 < 16) CH_ISSUE(c + 1);
        {
            bf16x8 afr[4];
#pragma unroll
            for (int kk = 0; kk < 4; ++kk) afr[kk] = *(const LAS bf16x8*)(L + QI_OFF + ((16 * w + fr) * QI_LD + 32 * kk + 8 * fq) * 2);
            f32x4 oacc[4];
#pragma unroll
            for (int vt = 0; vt < 4; ++vt) {
                f32x4 acc = (f32x4){0.f, 0.f, 0.f, 0.f};
#pragma unroll
                for (int kk = 0; kk < 4; ++kk) { const bf16x8 rf = *(const LAS bf16x8*)(L + RT_OFF + ((16 * vt + fr) * QI_LD + 32 * kk + 8 * fq) * 2); acc = MFMA16(rf, afr[kk], acc); }
                oacc[vt] = acc * gam;
            }
            const int i_ = 16 * w + fr, nkk = (w >> 1) + 1;
#pragma unroll 1
            for (int kk = 0; kk < nkk; ++kk) {
                f32x4 s0 = (f32x4){0.f, 0.f, 0.f, 0.f}, s1 = s0;
                const LAS unsigned char* kb = L + KI_OFF + ((32 * kk + fr) * QI_LD + 8 * fq) * 2;
#pragma unroll
                for (int k2 = 0; k2 < 4; ++k2) {
                    const bf16x8 kf0 = *(const LAS bf16x8*)(kb + 64 * k2), kf1 = *(const LAS bf16x8*)(kb + 16 * QI_LD * 2 + 64 * k2);
                    s0 = MFMA16(kf0, afr[k2], s0); s1 = MFMA16(kf1, afr[k2], s1);
                }
                float pv[8];
#pragma unroll
                for (int e = 0; e < 4; ++e) { const int dd0 = i_ - (32 * kk + 4 * fq + e); pv[e] = dd0 >= 0 ? s0[e] : 0.f; pv[4 + e] = dd0 >= 16 ? s1[e] : 0.f; }
                const bf16x8 pf = as_bf16x8(pack8(pv));
                const LAS unsigned char* vb = L + VI_OFF + ((32 * kk + 4 * fq + tq) * VI_LD + 4 * tp) * 2;
#pragma unroll
                for (int vt = 0; vt < 4; ++vt) oacc[vt] = MFMA16(tr16x2(vb + 32 * vt, vb + 16 * VI_LD * 2 + 32 * vt), pf, oacc[vt]);
            }
            bf16* orow = F.OB + (mrow0 + 16 * w + fr) * D + h * DVH + s * DVS + 4 * fq;
#pragma unroll
            for (int vt = 0; vt < 4; ++vt) *(v2u*)(orow + 16 * vt) = pack4(oacc[vt]);
        }
#pragma unroll
        for (int di = 0; di < 4; ++di) {
            const int dt = dg * 4 + di;
            f32x4 acc = Racc[di] * gam;
#pragma unroll
            for (int kk = 0; kk < 4; ++kk) {
                const LAS unsigned char* ka = L + KI_OFF + ((32 * kk + 8 * fq + tq) * QI_LD + 16 * dt + 4 * tp) * 2;
                const LAS unsigned char* va = L + VI_OFF + ((32 * kk + 8 * fq + tq) * VI_LD + 16 * vt_r + 4 * tp) * 2;
                acc = MFMA16(tr16x2(ka, ka + 4 * QI_LD * 2), tr16x2(va, va + 4 * VI_LD * 2), acc);
            }
            Racc[di] = acc * g127;
        }
        __syncthreads();
#pragma unroll
        for (int di = 0; di < 4; ++di) { const int dt = dg * 4 + di; *(LAS v2u*)(L + RT_OFF + ((16 * vt_r + fr) * QI_LD + 16 * dt + 4 * fq) * 2) = pack4(Racc[di]); }
    }
#undef CH_ISSUE
#undef CH_WRITE
    float* ro = F.out + O_RETP + ((size_t)(b * 8 + h) * 128) * DVH + s * DVS + 16 * vt_r + fr;
#pragma unroll
    for (int di = 0; di < 4; ++di) { const int dt = dg * 4 + di;
#pragma unroll
        for (int r = 0; r < 4; ++r) ro[(size_t)unperm_d(16 * dt + 4 * fq + r) * DVH] = Racc[di][r]; }
}

constexpr int SQ_OFF = 0, SKZ_OFF = 4096, SK_OFF = 8192, SV_OFF = 12288, SS_OFF = 20480, SRED_OFF = 24576;
__device__ __forceinline__ void sample_unit(Frame& F, int unit) {
    const int h = unit & 7, b = unit >> 3;
    int tid_ = F.tid; asm volatile("" : "+v"(tid_));
    const int tid = tid_, lane = tid & 63, w = F.wave;
    LAS unsigned char* L = F.lds;
    LAS float* qT = (LAS float*)(L + SQ_OFF); LAS float* kzT = (LAS float*)(L + SKZ_OFF); LAS float* kS = (LAS float*)(L + SK_OFF);
    LAS float* vs = (LAS float*)(L + SV_OFF); LAS float* ss = (LAS float*)(L + SS_OFF); LAS float* red = (LAS float*)(L + SRED_OFF);
    const float lg2 = __log2f(1.0f - __builtin_amdgcn_exp2f(-5.0f - (float)h));
    const float gam = __builtin_amdgcn_exp2f(lg2), g7 = __builtin_amdgcn_exp2f(7.f * lg2), g8c = __builtin_amdgcn_exp2f(8.f * lg2);
    const size_t mrow0 = (size_t)MP + (size_t)b * 8;
    const float* Rin = F.state_ret + ((size_t)(b * 8 + h) * 128) * DVH + 4 * lane;
    float* Rout = F.out + O_RETS + ((size_t)(b * 8 + h) * 128) * DVH + 4 * lane;
    f32x4 r0[16];
#pragma unroll
    for (int dd = 0; dd < 16; ++dd) r0[dd] = __builtin_nontemporal_load((const f32x4*)(Rin + (size_t)(16 * w + dd) * DVH));
    if (tid < 256) {
        const int qk = tid >> 7, it = tid & 127, i = it >> 4, ch = it & 15;
        float f[8]; unpack8(*(const v4u*)(F.PROJ + (mrow0 + i) * NIN + (qk ? C_K : C_Q) + h * 128 + 8 * ch), f);
#pragma unroll
        for (int e = 0; e < 8; ++e) { const int d = e < 4 ? 4 * ch + e : 64 + 4 * ch + (e - 4);
            if (qk == 0) qT[d * 8 + i] = f[e]; else { kS[i * 128 + d] = f[e]; kzT[d * 8 + i] = f[e] * g7; } }
    } else {
        const int it = tid - 256, j = it >> 5, g = it & 31;
        float f[8]; unpack8(*(const v4u*)(F.PROJ + (mrow0 + j) * NIN + C_V + h * DVH + 8 * g), f);
#pragma unroll
        for (int e = 0; e < 8; ++e) vs[j * 256 + 8 * g + e] = f[e];
    }
    __syncthreads();
    {
        const int pr = tid >> 3, part = tid & 7, i = pr >> 3, j = pr & 7; float dot = 0.f;
#pragma unroll
        for (int dd = 0; dd < 16; ++dd) { const int d = 16 * part + dd; dot += qT[d * 8 + i] * kS[j * 128 + d]; }
        dot += __shfl_xor(dot, 1); dot += __shfl_xor(dot, 2); dot += __shfl_xor(dot, 4);
        if (part == 0) ss[i * 8 + j] = (i >= j) ? dot : 0.f;
    }
    {
        f32x4 vreg[8], oacc[8];
#pragma unroll
        for (int j = 0; j < 8; ++j) { vreg[j] = *(const LAS f32x4*)(vs + j * 256 + 4 * lane); oacc[j] = (f32x4){0.f, 0.f, 0.f, 0.f}; }
#pragma unroll
        for (int dd = 0; dd < 16; ++dd) {
            const int d = 16 * w + dd;
            const f32x4 qa = *(const LAS f32x4*)(qT + d * 8), qb = *(const LAS f32x4*)(qT + d * 8 + 4), ka = *(const LAS f32x4*)(kzT + d * 8), kb = *(const LAS f32x4*)(kzT + d * 8 + 4);
            f32x4 rn = r0[dd] * g8c;
            rn += ka.x * vreg[0]; rn += ka.y * vreg[1]; rn += ka.z * vreg[2]; rn += ka.w * vreg[3]; rn += kb.x * vreg[4]; rn += kb.y * vreg[5]; rn += kb.z * vreg[6]; rn += kb.w * vreg[7];
            __builtin_nontemporal_store(rn, (f32x4*)(Rout + (size_t)d * DVH));
            oacc[0] += qa.x * r0[dd]; oacc[1] += qa.y * r0[dd]; oacc[2] += qa.z * r0[dd]; oacc[3] += qa.w * r0[dd];
            oacc[4] += qb.x * r0[dd]; oacc[5] += qb.y * r0[dd]; oacc[6] += qb.z * r0[dd]; oacc[7] += qb.w * r0[dd];
        }
#pragma unroll
        for (int i = 0; i < 8; ++i) *(LAS f32x4*)(red + (w * 8 + i) * 256 + 4 * lane) = oacc[i];
    }
    __syncthreads();
    {
        const int i = tid >> 6, l = tid & 63;
        f32x4 tot = (f32x4){0.f, 0.f, 0.f, 0.f};
#pragma unroll
        for (int ww = 0; ww < 8; ++ww) tot += *(const LAS f32x4*)(red + (ww * 8 + i) * 256 + 4 * l);
        tot = tot * gam;
#pragma unroll
        for (int j = 0; j < 8; ++j) tot += ss[i * 8 + j] * *(const LAS f32x4*)(vs + j * 256 + 4 * l);
        *(v2u*)(F.OB + (mrow0 + i) * D + h * DVH + 4 * l) = pack4(tot);
    }
}

constexpr int Z_LD = 264;
template <int W, int IB> __device__ __forceinline__ void pool_z(Frame& F, int g, int m0, int tid) {
    LAS unsigned char* L = F.lds;
#pragma unroll 1
    for (int it0 = tid; it0 < 4096; it0 += 512 * IB) {
        v4u raw[IB][W]; bool ok[IB][W];
#pragma unroll
        for (int ib = 0; ib < IB; ++ib) {
            const int it = it0 + 512 * ib, j = it >> 5, c8 = it & 31, m = m0 + j, col = C_POOL + 256 * g + 8 * c8;
#pragma unroll
            for (int k = 0; k < W; ++k) {
                const bf16* p;
                if (m < MP) { const int t = m & 2047; ok[ib][k] = t - k >= 0; p = F.PROJ + (size_t)(ok[ib][k] ? m - k : m) * NIN + col; }
                else { const int ms = m - MP, bb = ms >> 3, i = ms & 7, ee = 15 + i - k; ok[ib][k] = true;
                    const bf16* p1 = F.PROJ + (size_t)(MP + bb * 8 + (ee >= 15 ? ee - 15 : 0)) * NIN + col; const bf16* p2 = F.SP16 + ((size_t)bb * 15 + (ee < 15 ? ee : 0)) * 1024 + 256 * g + 8 * c8;
                    p = ee >= 15 ? p1 : p2; }
                raw[ib][k] = *(const v4u*)p;
            }
        }
#pragma unroll
        for (int ib = 0; ib < IB; ++ib) {
            const int it = it0 + 512 * ib, j = it >> 5, c8 = it & 31, m = m0 + j;
            float sum[8], cur[8], f[8];
            unpack8(raw[ib][0], cur);
#pragma unroll
            for (int e = 0; e < 8; ++e) sum[e] = cur[e];
#pragma unroll
            for (int k = 1; k < W; ++k) { unpack8(raw[ib][k], f);
#pragma unroll
                for (int e = 0; e < 8; ++e) sum[e] += ok[ib][k] ? f[e] : 0.f; }
            int cn = W; if (m < MP) { const int t = m & 2047; cn = W < t + 1 ? W : t + 1; }
            const float ic = 1.0f / (float)cn;
#pragma unroll
            for (int e = 0; e < 8; ++e) f[e] = sum[e] * ic - cur[e];
            *(LAS v4u*)(L + (j * Z_LD + 8 * c8) * 2) = pack8(f);
        }
    }
}
__device__ __forceinline__ void pool_unit(Frame& F, int unit) {
    const int g = unit & 3, tile = unit >> 2, m0 = tile * 128;
    int tid_ = F.tid; asm volatile("" : "+v"(tid_));
    const int tid = tid_, lane = tid & 63, w = F.wave, fr = lane & 15, fq = lane >> 4;
    LAS unsigned char* L = F.lds;
    bf16x8 bfr[4][8];
    {
        const bf16* wt = F.WPOOL + ((size_t)g * 512 + 64 * w + fr) * 256 + 8 * fq;
#pragma unroll
        for (int et = 0; et < 4; ++et)
#pragma unroll
            for (int kk = 0; kk < 8; ++kk) bfr[et][kk] = *(const bf16x8*)(wt + (size_t)(16 * et) * 256 + 32 * kk);
    }
    if (m0 >= MP) {
        if (g == 0) pool_z<2, 4>(F, g, m0, tid); else if (g == 1) pool_z<4, 4>(F, g, m0, tid); else if (g == 2) pool_z<8, 2>(F, g, m0, tid); else pool_z<16, 1>(F, g, m0, tid);
    } else {
        constexpr int UT_OFF = 128 * Z_LD * 2;
        static_assert(UT_OFF + 143 * Z_LD * 2 <= LDSCTL_OFF, "pool LDS");
        const bool seq0 = (m0 & 2047) == 0;
        const bf16* src = F.PROJ + (size_t)(m0 - 15) * NIN + C_POOL + 256 * g;
#pragma unroll
        for (int i = 0; i < 9; ++i) { const int ci = tid + 512 * i;
            if (ci < 143 * 32) { const int rw = ci >> 5, c8 = ci & 31; v4u v = (v4u){0u, 0u, 0u, 0u}; if (!(seq0 && rw < 15)) v = *(const v4u*)(src + (size_t)rw * NIN + 8 * c8);
                *(LAS v4u*)(L + UT_OFF + (rw * Z_LD + 8 * c8) * 2) = v; } }
        __syncthreads();
        const int W = 2 << g, c8 = tid & 31, j0 = (tid >> 5) * 8;
        const LAS unsigned char* up = L + UT_OFF + ((15 + j0) * Z_LD + 8 * c8) * 2;
        float sum[8], f[8], cur[8];
#pragma unroll
        for (int e = 0; e < 8; ++e) sum[e] = 0.f;
        for (int k = 1; k < W; ++k) { unpack8(*(const LAS v4u*)(up - k * Z_LD * 2), f);
#pragma unroll
            for (int e = 0; e < 8; ++e) sum[e] += f[e]; }
        const int t0 = (m0 & 2047) + j0;
#pragma unroll
        for (int j = 0; j < 8; ++j) {
            unpack8(*(const LAS v4u*)(up + j * Z_LD * 2), cur);
#pragma unroll
            for (int e = 0; e < 8; ++e) sum[e] += cur[e];
            const int t = t0 + j; const float ic = 1.0f / (float)(W < t + 1 ? W : t + 1);
#pragma unroll
            for (int e = 0; e < 8; ++e) f[e] = sum[e] * ic - cur[e];
            *(LAS v4u*)(L + ((j0 + j) * Z_LD + 8 * c8) * 2) = pack8(f);
            unpack8(*(const LAS v4u*)(up + (j + 1 - W) * Z_LD * 2), f);
#pragma unroll
            for (int e = 0; e < 8; ++e) sum[e] -= f[e];
        }
    }
    __syncthreads();
    f32x4 sc[4];
#pragma unroll
    for (int et = 0; et < 4; ++et) sc[et] = *(const f32x4*)(F.pool_scale + 512 * g + 64 * w + 16 * et + 4 * fq);
#pragma unroll 1
    for (int rt = 0; rt < 8; ++rt) {
        bf16x8 afr[8];
#pragma unroll
        for (int kk = 0; kk < 8; ++kk) afr[kk] = *(const LAS bf16x8*)(L + ((16 * rt + fr) * Z_LD + 32 * kk + 8 * fq) * 2);
        bf16* orow = F.AP + (size_t)(m0 + 16 * rt + fr) * D + 512 * g + 64 * w + 4 * fq;
#pragma unroll
        for (int et = 0; et < 4; ++et) {
            f32x4 acc = (f32x4){0.f, 0.f, 0.f, 0.f};
#pragma unroll
            for (int kk = 0; kk < 8; ++kk) acc = MFMA16(bfr[et][kk], afr[kk], acc);
            *(v2u*)(orow + 16 * et) = pack4(acc * sc[et]);
        }
    }
}
constexpr int N_CHAIN = 4 * 8 * NS, N_POOLU = (M / 128) * 4, N_SAMP = 128 * 8, N_P2 = N_CHAIN + N_POOLU + N_SAMP;
__device__ __forceinline__ void p2_mixers(Frame& F, int rep) {
    const int mode = rep >> 4, lo = mode == 2 ? N_CHAIN : (mode == 3 ? N_CHAIN + N_POOLU : 0), hi = mode == 1 ? N_CHAIN : (mode == 2 ? N_CHAIN + N_POOLU : N_P2);
    const bool static_chain = mode == 0 && (F.G % 8) == 0 && F.G >= N_CHAIN && NS == 4;
    if (static_chain && (int)blockIdx.x < N_CHAIN) { __syncthreads(); const int c = (int)blockIdx.x, slot = c >> 3, bh = (c & 7) + 8 * (slot >> 2); chain_unit(F, bh * NS + (slot & 3)); }
    for (;;) {
        __syncthreads();
        if (F.tid == 0) F.MISC[0] = __hip_atomic_fetch_add(F.ctl + CW_Q2 + 64 * (rep & 15), 1u, RLX_AGENT);
        __syncthreads();
        const int u = (int)F.MISC[0] + (static_chain ? N_CHAIN : lo);
        if (u >= hi) break;
        if (u < N_CHAIN) chain_unit(F, u);
        else if (u < N_CHAIN + N_POOLU) pool_unit(F, u - N_CHAIN);
        else sample_unit(F, u - N_CHAIN - N_POOLU);
    }
}

__device__ __forceinline__ void ld8f(const float* p, float (&o)[8]) { const f32x4 a = *(const f32x4*)p, b = *(const f32x4*)(p + 4); o[0] = a.x; o[1] = a.y; o[2] = a.z; o[3] = a.w; o[4] = b.x; o[5] = b.y; o[6] = b.z; o[7] = b.w; }
__device__ __forceinline__ float half_sum(float v) {
#pragma unroll
    for (int o = 1; o < 32; o <<= 1) v += __shfl_xor(v, o);
    return v;
}
__device__ __forceinline__ void p3_merge(Frame& F) {
    const int lane = F.lane, hl = lane >> 5, l32 = lane & 31;
    constexpr int NIT = M * 4;
    for (int it0 = 2 * F.gw; it0 < NIT; it0 += 2 * F.NGW) {
        v4u ov[2], gv[2], av[2], rv[2], pv[2]; int cc[2]; size_t mm[2];
#pragma unroll
        for (int u = 0; u < 2; ++u) {
            const int it = it0 + u, m = it >> 2, hp = it & 3, c = (2 * hp + hl) * DVH + 8 * l32; cc[u] = c; mm[u] = (size_t)m;
            const bf16* prow = F.PROJ + (size_t)m * NIN + c;
            ov[u] = __builtin_nontemporal_load((const v4u*)(F.OB + (size_t)m * D + c)); gv[u] = __builtin_nontemporal_load((const v4u*)(prow + C_GRET)); av[u] = __builtin_nontemporal_load((const v4u*)(prow + C_GA)); rv[u] = __builtin_nontemporal_load((const v4u*)(prow + C_GR)); pv[u] = __builtin_nontemporal_load((const v4u*)(F.AP + (size_t)m * D + c));
        }
#pragma unroll
        for (int u = 0; u < 2; ++u) {
            float o[8], g[8], ga[8], gr[8], ap[8], res[8];
            unpack8(ov[u], o); unpack8(gv[u], g); unpack8(av[u], ga); unpack8(rv[u], gr); unpack8(pv[u], ap);
            const f32x4 gn0 = *(const f32x4*)(F.gn_gain + cc[u]), gn1 = *(const f32x4*)(F.gn_gain + cc[u] + 4);
            const float gn[8] = {gn0.x, gn0.y, gn0.z, gn0.w, gn1.x, gn1.y, gn1.z, gn1.w};
            float sm = 0.f;
#pragma unroll
            for (int e = 0; e < 8; ++e) sm += o[e];
            const float mean = half_sum(sm) * (1.f / 256.f);
            float sq = 0.f;
#pragma unroll
            for (int e = 0; e < 8; ++e) { o[e] -= mean; sq += o[e] * o[e]; }
            const float rstd = 1.0f / sqrtf(half_sum(sq) * (1.f / 256.f) + EPS);
#pragma unroll
            for (int e = 0; e < 8; ++e) { const float r = g[e] * sigmoidf_(g[e]) * (o[e] * rstd * gn[e]); res[e] = sigmoidf_(ga[e]) * ap[e] + sigmoidf_(gr[e]) * r; }
            *(v4u*)(F.MM + mm[u] * D + cc[u]) = pack8(res);
        }
    }
    const int gt = blockIdx.x * 512 + F.tid, NT = F.G * 512;
    for (int gi = gt; gi < (4 + 128) * 15 * 128; gi += NT) {
        const int c8 = gi & 127, rr = gi >> 7, r = rr % 15, bb = rr / 15;
        float v8[8]; float* dst;
        if (bb < 4) { unpack8(*(const v4u*)(F.PROJ + (size_t)(bb * 2048 + 2033 + r) * NIN + C_POOL + 8 * c8), v8); dst = F.out + O_POOLP + ((size_t)bb * 15 + r) * 1024 + 8 * c8; }
        else { const int b = bb - 4, e = 8 + r; dst = F.out + O_POOLS + ((size_t)b * 15 + r) * 1024 + 8 * c8;
            if (e < 15) ld8f(F.state_pool + ((size_t)b * 15 + e) * 1024 + 8 * c8, v8); else unpack8(*(const v4u*)(F.PROJ + (size_t)(MP + b * 8 + e - 15) * NIN + C_POOL + 8 * c8), v8); }
        *(f32x4*)dst = (f32x4){v8[0], v8[1], v8[2], v8[3]}; *(f32x4*)(dst + 4) = (f32x4){v8[4], v8[5], v8[6], v8[7]};
    }
}

__device__ __forceinline__ void p5_rows(Frame& F) {
    const int lane = F.lane;
    for (int m = F.gw; m < M; m += F.NGW) {
        const v4u* mo = (const v4u*)(F.MOB + (size_t)m * D) + lane; const f32x4* xr = (const f32x4*)xrow(F, m) + 2 * lane;
        const f32x4* g1 = (const f32x4*)F.g_post_mix + 2 * lane; const f32x4* g2 = (const f32x4*)F.g_pre_ffn + 2 * lane;
        v4u mv[4]; f32x4 x[4][2]; float v[4][8]; float s = 0.f;
#pragma unroll
        for (int j = 0; j < 4; ++j) { mv[j] = __builtin_nontemporal_load(mo + 64 * j); x[j][0] = __builtin_nontemporal_load(xr + 128 * j); x[j][1] = __builtin_nontemporal_load(xr + 128 * j + 1); }
#pragma unroll
        for (int j = 0; j < 4; ++j) { unpack8(mv[j], v[j]);
#pragma unroll
            for (int e = 0; e < 8; ++e) s += v[j][e] * v[j][e]; }
        const float rs = 1.0f / sqrtf(wave_sum(s) * (1.f / D) + EPS);
        float s2 = 0.f; v4u* yo = (v4u*)(F.X1B + (size_t)m * D) + lane;
#pragma unroll
        for (int j = 0; j < 4; ++j) {
            const f32x4 ga = g1[128 * j], gb = g1[128 * j + 1];
            x[j][0] = x[j][0] + (f32x4){v[j][0], v[j][1], v[j][2], v[j][3]} * rs * ga; x[j][1] = x[j][1] + (f32x4){v[j][4], v[j][5], v[j][6], v[j][7]} * rs * gb;
            { v4u o; o.x = pk2(x[j][0].x, x[j][0].y); o.y = pk2(x[j][0].z, x[j][0].w); o.z = pk2(x[j][1].x, x[j][1].y); o.w = pk2(x[j][1].z, x[j][1].w); yo[64 * j] = o; }
            s2 += (x[j][0].x * x[j][0].x + x[j][0].y * x[j][0].y) + (x[j][0].z * x[j][0].z + x[j][0].w * x[j][0].w) + (x[j][1].x * x[j][1].x + x[j][1].y * x[j][1].y) + (x[j][1].z * x[j][1].z + x[j][1].w * x[j][1].w);
        }
        const float rs2 = 1.0f / sqrtf(wave_sum(s2) * (1.f / D) + EPS);
        v4u* o8 = (v4u*)(F.XN + (size_t)m * D) + lane;
#pragma unroll
        for (int j = 0; j < 4; ++j) { const f32x4 ga = g2[128 * j], gb = g2[128 * j + 1]; const f32x4 a = x[j][0] * rs2 * ga, b2 = x[j][1] * rs2 * gb;
            v4u o; o.x = pk2(a.x, a.y); o.y = pk2(a.z, a.w); o.z = pk2(b2.x, b2.y); o.w = pk2(b2.z, b2.w); o8[64 * j] = o; }
    }
}
__device__ __forceinline__ void p9_rows(Frame& F, float* dst) {
    const int lane = F.lane;
    for (int m = F.gw; m < M; m += F.NGW) {
        const v4u* fo = (const v4u*)(F.MOB + (size_t)m * D) + lane; const v4u* yi = (const v4u*)(F.X1B + (size_t)m * D) + lane; f32x4* yo = (f32x4*)(dst + (size_t)m * D) + 2 * lane;
        const f32x4* g1 = (const f32x4*)F.g_post_ffn + 2 * lane;
        v4u mv[4]; f32x4 x[4][2]; float v[4][8]; float s = 0.f;
#pragma unroll
        for (int j = 0; j < 4; ++j) { mv[j] = __builtin_nontemporal_load(fo + 64 * j); const v4u xb = __builtin_nontemporal_load(yi + 64 * j); x[j][0] = (f32x4){bflo(xb.x), bfhi(xb.x), bflo(xb.y), bfhi(xb.y)}; x[j][1] = (f32x4){bflo(xb.z), bfhi(xb.z), bflo(xb.w), bfhi(xb.w)}; }
#pragma unroll
        for (int j = 0; j < 4; ++j) { unpack8(mv[j], v[j]);
#pragma unroll
            for (int e = 0; e < 8; ++e) s += v[j][e] * v[j][e]; }
        const float rs = 1.0f / sqrtf(wave_sum(s) * (1.f / D) + EPS);
#pragma unroll
        for (int j = 0; j < 4; ++j) { const f32x4 ga = g1[128 * j], gb = g1[128 * j + 1];
            __builtin_nontemporal_store(x[j][0] + (f32x4){v[j][0], v[j][1], v[j][2], v[j][3]} * rs * ga, yo + 128 * j); __builtin_nontemporal_store(x[j][1] + (f32x4){v[j][4], v[j][5], v[j][6], v[j][7]} * rs * gb, yo + 128 * j + 1); }
    }
}

__device__ __forceinline__ float gelu_tanh(float g) {
    const float u = (g * g) * (1.5957691216057308f * 0.044715f * 1.4426950408889634f) + (1.5957691216057308f * 1.4426950408889634f);
    return g * __builtin_amdgcn_rcpf(1.0f + __builtin_amdgcn_exp2f(-(g * u)));
}
__device__ __forceinline__ void p7_conv(Frame& F) {
    constexpr int NCG = FF / 8, NRB = M / 8, NIT = NRB * NCG;
    const int gt = blockIdx.x * 512 + F.tid, NT = F.G * 512;
    v4u rawv[10], rawg[10];
#define P7_LOAD(dv, dg, it_) do { const int rb_ = (it_) / NCG, f0_ = 8 * ((it_) - rb_ * NCG), m0_ = rb_ * 8; const bool z_ = (m0_ >= MP) || ((m0_ & 2047) == 0); \
        _Pragma("unroll") for (int r = 0; r < 10; ++r) { const int rr = (r < 2 && z_) ? 2 : r; const bf16* ur = F.UP + (size_t)(m0_ + rr - 2) * FF2; dv[r] = *(const v4u*)(ur + f0_); dg[r] = *(const v4u*)(ur + FF + f0_); } } while (0)
#pragma unroll 1
    for (int it = gt; it < NIT; it += NT) {
        const int rb = it / NCG, cg = it - rb * NCG, f0 = 8 * cg, m0 = rb * 8;
        const bool is_p = m0 < MP; const int t0 = is_p ? (m0 & 2047) : 0; const int sb = is_p ? 0 : (m0 - MP) >> 3;
        P7_LOAD(rawv, rawg, it);
        float hv[3][8], hg[3][8];
#pragma unroll
        for (int r = 0; r < 2; ++r) {
            if (t0 == 0) {
                if (is_p) {
#pragma unroll
                    for (int e = 0; e < 8; ++e) { hv[r + 1][e] = 0.f; hg[r + 1][e] = 0.f; }
                } else { const float* sc = F.state_conv + ((size_t)sb * 2 + r) * FF2; ld8f(sc + f0, hv[r + 1]); ld8f(sc + FF + f0, hg[r + 1]); }
            } else { unpack8(rawv[r], hv[r + 1]); unpack8(rawg[r], hg[r + 1]); }
        }
        float wv[3][8], wg[3][8], bv[8], bg[8];
#pragma unroll
        for (int j = 0; j < 3; ++j) { ld8f(F.conv_w + (size_t)j * FF2 + f0, wv[j]); ld8f(F.conv_w + (size_t)j * FF2 + FF + f0, wg[j]); }
        ld8f(F.conv_b + f0, bv); ld8f(F.conv_b + FF + f0, bg);
#pragma unroll
        for (int r = 0; r < 8; ++r) {
#pragma unroll
            for (int e = 0; e < 8; ++e) { hv[0][e] = hv[1][e]; hv[1][e] = hv[2][e]; hg[0][e] = hg[1][e]; hg[1][e] = hg[2][e]; }
            unpack8(rawv[r + 2], hv[2]); unpack8(rawg[r + 2], hg[2]);
            float a[8];
#pragma unroll
            for (int e = 0; e < 8; ++e) { const float val = bv[e] + wv[0][e] * hv[0][e] + wv[1][e] * hv[1][e] + wv[2][e] * hv[2][e], gate = bg[e] + wg[0][e] * hg[0][e] + wg[1][e] * hg[1][e] + wg[2][e] * hg[2][e]; a[e] = gelu_tanh(gate) * val; }
            *(v4u*)(F.ACT + (size_t)(m0 + r) * FF + f0) = pack8(a);
            if (r >= 6) {
                float* o = nullptr;
                if (is_p) { if (t0 == 2040) o = F.out + O_CONVP + ((size_t)(m0 >> 11) * 2 + (r - 6)) * FF2; } else o = F.out + O_CONVS + ((size_t)sb * 2 + (r - 6)) * FF2;
                if (o) { *(f32x4*)(o + f0) = (f32x4){hv[2][0], hv[2][1], hv[2][2], hv[2][3]}; *(f32x4*)(o + f0 + 4) = (f32x4){hv[2][4], hv[2][5], hv[2][6], hv[2][7]};
                    *(f32x4*)(o + FF + f0) = (f32x4){hg[2][0], hg[2][1], hg[2][2], hg[2][3]}; *(f32x4*)(o + FF + f0 + 4) = (f32x4){hg[2][4], hg[2][5], hg[2][6], hg[2][7]}; }
            }
        }
    }
#undef P7_LOAD
}

struct Args { const float* in[18]; float* out; unsigned char* ws; int ph_lo, ph_hi, li, pad; };
template <int LO, int HI> __global__ void __launch_bounds__(NWAVES * 64, 2) skel_fwd(Args args) {
    extern __shared__ __attribute__((aligned(16))) unsigned char lds[];
    Frame F;
    F.lds = (LAS unsigned char*)lds;
    F.MISC = (volatile LAS unsigned*)(F.lds + LDSCTL_OFF);
    F.tid = threadIdx.x; F.lane = F.tid & 63; F.wave = __builtin_amdgcn_readfirstlane(F.tid >> 6);
    F.G = gridDim.x; F.gw = blockIdx.x * NWAVES + F.wave; F.NGW = F.G * NWAVES;
    unsigned char* ws = args.ws;
    F.ctl = (unsigned*)(ws + WS_CTL);
    F.xp = args.in[0]; F.xs = args.in[1]; F.state_pool = args.in[2]; F.state_ret = args.in[3]; F.state_conv = args.in[4]; F.g_pre_mix = args.in[5]; F.w_in = args.in[6]; F.w_pool = args.in[7];
    F.pool_scale = args.in[8]; F.gn_gain = args.in[9]; F.w_out = args.in[10]; F.g_post_mix = args.in[11]; F.g_pre_ffn = args.in[12]; F.w_up = args.in[13]; F.conv_w = args.in[14]; F.conv_b = args.in[15];
    F.w_down = args.in[16]; F.g_post_ffn = args.in[17]; F.out = args.out;
    F.WIN = (bf16*)(ws + WS_WIN); F.WUP = (bf16*)(ws + WS_WUP); F.WDN = (bf16*)(ws + WS_WDN); F.WOUT = (bf16*)(ws + WS_WOUT); F.WPOOL = (bf16*)(ws + WS_WPOOL);
    F.ROPE_C = (float*)(ws + WS_ROPE); F.ROPE_S = F.ROPE_C + 2056 * 64;
    F.XN = (bf16*)(ws + WS_XN); F.PROJ = (bf16*)(ws + WS_PROJ); F.UP = (bf16*)(ws + WS_PROJ); F.MOB = (bf16*)(ws + WS_PROJ);
    F.SP16 = (bf16*)(ws + WS_SP16); F.X1B = (bf16*)(ws + WS_X1);
    F.OB = (bf16*)(ws + WS_O); F.AP = (bf16*)(ws + WS_AP); F.MM = (bf16*)(ws + WS_MM); F.ACT = (bf16*)(ws + WS_O);
    for (int u = F.tid; u < (LDS_BYTES - LDSCTL_OFF) / 4; u += NWAVES * 64) ((LAS unsigned*)(F.lds + LDSCTL_OFF))[u] = 0u;
    __syncthreads();
    XcdBarrier bar; bar.bar = F.ctl + CW_BAR; bar.x = 0; bar.st = nullptr;
    if (N_LAUNCHES == 1) bar = xcd_barrier_post(F.ctl + CW_BAR, F.MISC + 8);
#define GRID_BAR() do { if (N_LAUNCHES == 1) xcd_barrier(bar); } while (0)
#define IN(k) (LO <= (k) && (k) < HI)
#define FRESH() do { int t_ = threadIdx.x; asm volatile("" : "+v"(t_)); F.tid = t_; F.lane = t_ & 63; } while (0)
#define SEAM(k) do { if constexpr (IN(k) && IN((k) + 1)) GRID_BAR(); } while (0)

#define REPS(k)
#define DUPBAR(k)
    const int rep = args.li;
    if constexpr (IN(0)) { FRESH(); REPS(0) { p0_prologue(F); DUPBAR(0); } SEAM(0); }
    if constexpr (IN(1)) {
      REPS(1) {
        pg8::Gemm g{F.XN, F.WIN, M, NIN, D}; pg8::HybridOrder S; S.init(M, NIN, D, F.G, (int)blockIdx.x, false);
        EpiProj E{F.PROJ, F.ROPE_C, F.ROPE_S}; pg8::SplitCtx X{(float*)(ws + WS_SLAB_A), F.ctl + CW_SPLIT};
        pg8::gemm_phase<EpiProj, pg8::HybridOrder, true, PG8_SP2, 5>(F.lds, g, S, E, X);
        if (rep == 0) { FRESH(); p0_deferred_weights(F, (LAS float*)(F.lds + F.wave * 16384)); }
        DUPBAR(1);
      }
        SEAM(1);
    }
    if constexpr (IN(2)) { FRESH(); REPS(2) { p2_mixers(F, rep); DUPBAR(2); } SEAM(2); }
    if constexpr (IN(3)) { FRESH(); REPS(3) { p3_merge(F); DUPBAR(3); } SEAM(3); }
    if constexpr (IN(4)) {
      REPS(4) {
        pg8::Gemm g{F.MM, F.WOUT, M, D, D}; pg8::HybridOrder S; S.init(M, D, D, F.G, (int)blockIdx.x);
        pg8::EpiBf16<0> E{F.MOB, D}; pg8::SplitCtx X{(float*)(ws + WS_SLAB_A), F.ctl + CW_SPLIT + 4096};
        pg8::gemm_phase<pg8::EpiBf16<0>, pg8::HybridOrder, true, PG8_SP2, 8>(F.lds, g, S, E, X);
        DUPBAR(4);
      }
        SEAM(4);
    }
    if constexpr (IN(5)) { FRESH(); REPS(5) { p5_rows(F); DUPBAR(5); } SEAM(5); }
    if constexpr (IN(6)) {
      REPS(6) {
        pg8::Gemm g{F.XN, F.WUP, M, FF2, D}; pg8::HybridOrder S; S.init(M, FF2, D, F.G, (int)blockIdx.x);
        pg8::EpiBf16<0> E{F.UP, FF2}; pg8::SplitCtx X{(float*)(ws + WS_SLAB_A), F.ctl + CW_SPLIT + 2 * 4096};
        pg8::gemm_phase<pg8::EpiBf16<0>, pg8::HybridOrder, true, PG8_SP2, 5>(F.lds, g, S, E, X);
        DUPBAR(6);
      }
        SEAM(6);
    }
    if constexpr (IN(7)) { FRESH(); REPS(7) { p7_conv(F); DUPBAR(7); } SEAM(7); }
    if constexpr (IN(8)) {
      REPS(8) {
        pg8::Gemm g{F.ACT, F.WDN, M, D, FF}; pg8::HybridOrder S; S.init(M, D, FF, F.G, (int)blockIdx.x);
        pg8::EpiBf16<0> E{F.MOB, D}; pg8::SplitCtx X{(float*)(ws + WS_SLAB_B), F.ctl + CW_SPLIT + 3 * 4096};
        pg8::gemm_phase<pg8::EpiBf16<0>, pg8::HybridOrder, true, PG8_SP2, 8>(F.lds, g, S, E, X);
        DUPBAR(8);
      }
        SEAM(8);
    }
    if constexpr (IN(9)) { FRESH(); p9_rows(F, (DUP_PHASE == 9 && rep == 1) ? (float*)(ws + WS_O) : F.out + O_Y); }
#undef IN
#undef SEAM
}


#if MK_N_LAUNCHES != 1
template <int P> static void launch_one(int grid, const Args& a, hipStream_t stream) { hipLaunchKernelGGL((skel_fwd<P, P + 1>), dim3(grid), dim3(NWAVES * 64), LDS_BYTES, stream, a); }
static void launch_phase(int li, int grid, const Args& a, hipStream_t stream) {
    switch (li) { case 0: launch_one<0>(grid, a, stream); break; case 1: launch_one<1>(grid, a, stream); break; case 2: launch_one<2>(grid, a, stream); break; case 3: launch_one<3>(grid, a, stream); break;
        case 4: launch_one<4>(grid, a, stream); break; case 5: launch_one<5>(grid, a, stream); break; case 6: launch_one<6>(grid, a, stream); break; case 7: launch_one<7>(grid, a, stream); break;
        case 8: launch_one<8>(grid, a, stream); break; default: launch_one<9>(grid, a, stream); break; }
}
#endif
static hipError_t set_lds_attr() {
    hipError_t e = hipSuccess;
#if MK_N_LAUNCHES == 1
    e = hipFuncSetAttribute((const void*)skel_fwd<0, N_PHASES>, hipFuncAttributeMaxDynamicSharedMemorySize, LDS_BYTES);
#else
#define SET1(P) if (e == hipSuccess) e = hipFuncSetAttribute((const void*)skel_fwd<P, P + 1>, hipFuncAttributeMaxDynamicSharedMemorySize, LDS_BYTES)
    SET1(0); SET1(1); SET1(2); SET1(3); SET1(4); SET1(5); SET1(6); SET1(7); SET1(8); SET1(9);
#undef SET1
#endif
    return e;
}
static hipError_t occ_query(int* per_cu) {
#if MK_N_LAUNCHES == 1
    return hipOccupancyMaxActiveBlocksPerMultiprocessor(per_cu, (const void*)skel_fwd<0, N_PHASES>, NWAVES * 64, LDS_BYTES);
#else
    return hipOccupancyMaxActiveBlocksPerMultiprocessor(per_cu, (const void*)skel_fwd<1, 2>, NWAVES * 64, LDS_BYTES);
#endif
}
extern "C" void kernel_launch(void* const* d_in, const int* in_sizes, int n_in, void* d_out, int out_size, void* d_ws, size_t ws_size, hipStream_t stream) {
    static int grid = 0;
    if (grid == 0) {
        if (n_in != 18 || (size_t)out_size != O_END || ws_size < WS_END) { fprintf(stderr, "kernel_launch: unexpected shapes: n_in %d out %d ws %zu (need %zu)\n", n_in, out_size, ws_size, (size_t)WS_END); grid = -1; return; }
        int dev = 0, cus = 0, per_cu = 0;
        if (hipGetDevice(&dev) != hipSuccess || hipDeviceGetAttribute(&cus, hipDeviceAttributeMultiprocessorCount, dev) != hipSuccess) { grid = -1; return; }
        if (set_lds_attr() != hipSuccess) { fprintf(stderr, "kernel_launch: hipFuncSetAttribute failed\n"); grid = -1; return; }
        if (occ_query(&per_cu) != hipSuccess || per_cu < 1) { fprintf(stderr, "kernel_launch: occupancy query says %d blocks per CU\n", per_cu); (void)hipGetLastError(); per_cu = 1; }
        grid = cus;
        fprintf(stderr, "kernel_launch: cus %d per_cu %d grid %d ws %zu\n", cus, per_cu, grid, ws_size);
    }
    if (grid < 0) return;
    (void)hipMemsetAsync((char*)d_ws + WS_CTL, 0, CTL_ZERO_BYTES, stream);
    Args a{};
    for (int i = 0; i < 18; ++i) a.in[i] = (const float*)d_in[i];
    a.out = (float*)d_out; a.ws = (unsigned char*)d_ws;
#if MK_N_LAUNCHES == 1
    {
        a.ph_lo = 0; a.ph_hi = N_PHASES; a.li = 0;
        void* kargs[] = {&a};
        hipError_t e = hipLaunchCooperativeKernel((const void*)skel_fwd<0, N_PHASES>, dim3(grid), dim3(NWAVES * 64), kargs, LDS_BYTES, stream);
        if (e != hipSuccess) fprintf(stderr, "kernel_launch: cooperative launch failed: %s (grid %d)\n", hipGetErrorString(e), grid);
    }
#else
    for (int li = 0; li < N_PHASES; ++li) { a.ph_lo = li; a.ph_hi = li + 1; a.li = 0; launch_phase(li, grid, a, stream); if (li == DUP_PHASE) { a.li = 1; launch_phase(li, grid, a, stream); if (li == 9) { a.li = 0; } } if (li == 2 && DUP_PHASE >= 20) { a.li = 1 + 16 * (DUP_PHASE - 20); launch_phase(li, grid, a, stream); } }
#endif
}
```

```cpp
#include <hip/hip_runtime.h>
#include <cstdio>
#include <cstdint>
namespace pg8 {
#define PG8_LAS __attribute__((address_space(3)))
typedef unsigned short bf16_t;
typedef short bf16x8 __attribute__((ext_vector_type(8)));
typedef float f32x4 __attribute__((ext_vector_type(4)));
typedef unsigned u32x4 __attribute__((ext_vector_type(4)));
constexpr int BM = 256, BK = 64, HALF = 128, HTB = HALF * BK * 2  , STAGE_BYTES = 8 * HTB, NXCD = 8, WGM = 2;

__host__ __device__ __forceinline__ int lds_byte(int r, int c) { const int st = (r >> 4) * 2 + (c >> 5), rr = r & 15, cc = c & 31, ob = rr * 64 + cc * 2; return st * 1024 + (ob ^ (((ob >> 9) & 1) << 5)); }
__host__ __device__ __forceinline__ void stage_rc(int b, int& R, int& C) { const int st = b / 1024, sb = b % 1024, swz = sb ^ (((sb >> 9) & 1) << 5); R = (st >> 1) * 16 + swz / 64; C = (st & 1) * 32 + (swz % 64) / 2; }
__host__ __device__ __forceinline__ int perm32(int rho) { const int n = rho >> 4, i = rho & 15; return 8 * (i >> 2) + 4 * n + (i & 3); }

struct Unit { int pm, pn, k0, nt, np, piece, slot; };
struct Gemm { const bf16_t* A; const bf16_t* Bt; int M, N, K; };

struct StaticOrder {
    int nM, nN, nwg, G, c;
    __host__ __device__ void init(int M, int N, int G_, int c_) { nM = M / BM; nN = N / BM; nwg = nM * nN; G = G_; c = c_; }
    __host__ __device__ bool next(int i, Unit& u) const {
        const long L = (long)i * G + c; if (L >= nwg) return false;
        int wgid = (int)L;
#ifndef ORDER_NOREMAP
        { const int q = nwg / NXCD, r = nwg % NXCD, xcd = wgid % NXCD, off = wgid / NXCD; wgid = (xcd < r ? xcd * (q + 1) : r * (q + 1) + (xcd - r) * q) + off; }
#endif
        const int nig = WGM * nN, gid = wgid / nig, fm = gid * WGM, gsz = (nM - fm) < WGM ? (nM - fm) : WGM;
        u.pm = fm + ((wgid % nig) % gsz); u.pn = (wgid % nig) / gsz; return true;
    }
    __device__ __forceinline__ void a_ready(const Unit&) const {}
    __device__ __forceinline__ void done(const Unit&) const {}
};


struct HybridOrder {
    int nM, nN, nwg, G, c, ntk, nfull, nrem, np;
    __host__ __device__ void init(int M, int N, int K, int G_, int c_, bool allow_split = true) {
        nM = M / BM; nN = N / BM; nwg = nM * nN; G = G_; c = c_; ntk = K / BK; nfull = nwg / G; nrem = nwg - nfull * G; np = 0;
        if (allow_split && nrem > 0 && (G % NXCD) == 0) { const int grp = (nrem + NXCD - 1) / NXCD; int p = (G / NXCD) / grp; const int maxp = ntk / 4; if (p > maxp) p = maxp; if (p > 8) p = 8; if (p >= 2) np = p; }
    }
    __host__ __device__ void map(long L, Unit& u) const {
        int wgid = (int)L;
#ifndef ORDER_NOREMAP
        { const int q = nwg / NXCD, r = nwg % NXCD, xcd = wgid % NXCD, off = wgid / NXCD; wgid = (xcd < r ? xcd * (q + 1) : r * (q + 1) + (xcd - r) * q) + off; }
#endif
        const int nig = WGM * nN, gid = wgid / nig, fm = gid * WGM, gsz = (nM - fm) < WGM ? (nM - fm) : WGM;
        u.pm = fm + ((wgid % nig) % gsz); u.pn = (wgid % nig) / gsz; u.k0 = 0; u.nt = ntk; u.np = 0; u.piece = 0; u.slot = 0;
    }
    __host__ __device__ bool next(int i, Unit& u) const {
        if (i < nfull) { map((long)i * G + c, u); return true; }
        if (i > nfull || nrem == 0) return false;
        if (np == 0) { if (c >= nrem) return false; map((long)nfull * G + c, u); return true; }
        const int x = c % NXCD, j = c / NXCD, grp = j / np, p = j - grp * np, r = grp * NXCD + x;
        if (r >= nrem) return false;
        map((long)nfull * G + r, u);
        const int pairs = ntk / 2, base = pairs / np, extra = pairs - base * np, first_big = np - extra;
        const int start = p * base + (p > first_big ? p - first_big : 0), len = base + (p >= first_big ? 1 : 0);
        u.k0 = 2 * start; u.nt = 2 * len; u.np = np; u.piece = p; u.slot = r; return true;
    }
    __device__ __forceinline__ void a_ready(const Unit&) const {}
    __device__ __forceinline__ void done(const Unit&) const {}
};
struct SplitCtx { float* slabs; unsigned* cnt; };

__device__ __forceinline__ unsigned cvt_pk_bf16(float lo, float hi) { unsigned r; asm volatile("v_cvt_pk_bf16_f32 %0, %1, %2" : "=v"(r) : "v"(lo), "v"(hi)); return r; }
typedef float f32x2 __attribute__((ext_vector_type(2)));
__device__ __forceinline__ f32x2 gelu_pk(f32x2 v) {
    const f32x2 av = __builtin_elementwise_abs(v), d = av * 0.2316418882f + 1.0f;
    f32x2 t; t.x = __builtin_amdgcn_rcpf(d.x); t.y = __builtin_amdgcn_rcpf(d.y);
    f32x2 q = t * 0.5307027145f + (-0.7265760135f); q = q * t + 0.7107068705f; q = q * t + (-0.142248368f); q = q * t + 0.127414796f; q = q * t;
    const f32x2 s = (v * v) * (-0.72134752044f);
    f32x2 e; e.x = __builtin_amdgcn_exp2f(s.x); e.y = __builtin_amdgcn_exp2f(s.y);
    const f32x2 m = v * (q * e), r = v - m;
    f32x2 o; o.x = v.x < 0.f ? m.x : r.x; o.y = v.y < 0.f ? m.y : r.y; return o;
}

template <int ACT> struct EpiBf16 {
    static constexpr bool PERM = true, AFTER_DRAIN = false;
    bf16_t* O; int ldc;
    __device__ __forceinline__ void tri(const f32x4 v0, const f32x4 v1, const Unit& u, int ai, int bj, int m, int wr, int wc, int fr, int fq) const {
        bf16_t* p = O + (size_t)(u.pm * BM + ai * HALF + wr * 64 + m * 16 + fr) * ldc + u.pn * BM + bj * HALF + wc * 32 + 8 * fq;
        u32x4 w; w.x = cvt_pk_bf16(v0[0], v0[1]); w.y = cvt_pk_bf16(v0[2], v0[3]); w.z = cvt_pk_bf16(v1[0], v1[1]); w.w = cvt_pk_bf16(v1[2], v1[3]);
        *(u32x4*)p = w;
    }
    __device__ __forceinline__ void operator()(const f32x4 (&acc)[2][2][4][2], const Unit& u, int wr, int wc, int fr, int fq) const {
#pragma unroll
        for (int ai = 0; ai < 2; ++ai)
#pragma unroll
            for (int m = 0; m < 4; ++m)
#pragma unroll
                for (int bj = 0; bj < 2; ++bj) tri(acc[ai][bj][m][0], acc[ai][bj][m][1], u, ai, bj, m, wr, wc, fr, fq);
    }
};
struct EpiF32 {
    static constexpr bool PERM = false, AFTER_DRAIN = false;
    float* C; int ldc;
    __device__ __forceinline__ void tri(const f32x4 v0, const f32x4 v1, const Unit& u, int ai, int bj, int m, int wr, int wc, int fr, int fq) const {
        float* p = C + (size_t)(u.pm * BM + ai * HALF + wr * 64 + m * 16 + fr) * ldc + u.pn * BM + bj * HALF + wc * 32 + 4 * fq;
        *(f32x4*)p = v0; *(f32x4*)(p + 16) = v1;
    }
    __device__ __forceinline__ void operator()(const f32x4 (&acc)[2][2][4][2], const Unit& u, int wr, int wc, int fr, int fq) const {
#pragma unroll
        for (int ai = 0; ai < 2; ++ai)
#pragma unroll
            for (int m = 0; m < 4; ++m)
#pragma unroll
                for (int bj = 0; bj < 2; ++bj) tri(acc[ai][bj][m][0], acc[ai][bj][m][1], u, ai, bj, m, wr, wc, fr, fq);
    }
};
typedef unsigned u32x2 __attribute__((ext_vector_type(2)));
__device__ __forceinline__ f32x4 bf4_to_f32(u32x2 x) { f32x4 o; o[0] = __builtin_bit_cast(float, x.x << 16); o[1] = __builtin_bit_cast(float, x.x & 0xffff0000u); o[2] = __builtin_bit_cast(float, x.y << 16); o[3] = __builtin_bit_cast(float, x.y & 0xffff0000u); return o; }
template <int NP, class Epi> __device__ __forceinline__ void split_epilogue(const f32x4 (&acc)[2][2][4][2], const Unit& u, const Epi& E, const SplitCtx& X, int tid, int wr, int wc, int fr, int fq) {
    constexpr int SLAB = 32 * 512 * 8;
    const __amdgpu_buffer_rsrc_t rs = __builtin_amdgcn_make_buffer_rsrc((void*)((char*)X.slabs + (size_t)(u.slot * u.np) * SLAB), 0, u.np * SLAB, 0x00020000);
    {
        const int so = u.piece * SLAB;
#pragma unroll
        for (int r = 0; r < 32; ++r) { const f32x4 v = acc[r >> 4][(r >> 3) & 1][(r >> 1) & 3][r & 1]; u32x2 w; w.x = cvt_pk_bf16(v[0], v[1]); w.y = cvt_pk_bf16(v[2], v[3]);
            __builtin_amdgcn_raw_buffer_store_b64(w, rs, (unsigned)(tid * 8), so + r * 4096, 16); }
    }
    asm volatile("s_waitcnt vmcnt(0)" ::: "memory");
    asm volatile("" ::: "memory"); __builtin_amdgcn_s_barrier(); asm volatile("" ::: "memory");
    if (tid == 0) {
        unsigned* cw = X.cnt + 64 * u.slot;
        (void)__hip_atomic_fetch_add(cw, 1u, __ATOMIC_RELAXED, __HIP_MEMORY_SCOPE_AGENT);
        unsigned sp = 0;
        while (__hip_atomic_load(cw, __ATOMIC_RELAXED, __HIP_MEMORY_SCOPE_AGENT) < (unsigned)u.np) { __builtin_amdgcn_s_sleep(1); if (++sp > (1u << 24)) break; }
        __builtin_amdgcn_fence(__ATOMIC_ACQUIRE, "agent");
        asm volatile("s_waitcnt vmcnt(0)" ::: "memory");
    }
    asm volatile("" ::: "memory"); __builtin_amdgcn_s_barrier(); asm volatile("" ::: "memory");
    const int q0 = (16 * u.piece) / u.np, q1 = (16 * (u.piece + 1)) / u.np;
#pragma unroll 1
    for (int q = q0; q < q1; ++q) {
        const unsigned vo = (unsigned)(tid * 8 + q * 8192);
        f32x4 v0 = (f32x4){0.f, 0.f, 0.f, 0.f}, v1 = v0;
        if (u.np == NP) {
            u32x2 t0[NP], t1[NP];
#pragma unroll
            for (int pp = 0; pp < NP; ++pp) { t0[pp] = __builtin_amdgcn_raw_buffer_load_b64(rs, vo, pp * SLAB, 0); t1[pp] = __builtin_amdgcn_raw_buffer_load_b64(rs, vo, pp * SLAB + 4096, 0); }
#pragma unroll
            for (int pp = 0; pp < NP; ++pp) { v0 += bf4_to_f32(t0[pp]); v1 += bf4_to_f32(t1[pp]); }
        } else {
            for (int pp = 0; pp < u.np; ++pp) { v0 += bf4_to_f32(__builtin_amdgcn_raw_buffer_load_b64(rs, vo, pp * SLAB, 0)); v1 += bf4_to_f32(__builtin_amdgcn_raw_buffer_load_b64(rs, vo, pp * SLAB + 4096, 0)); }
        }
        E.tri(v0, v1, u, q >> 3, (q >> 2) & 1, q & 3, wr, wc, fr, fq);
    }
}
template <class Epi, class Sched, bool ALIGN_EPI = false, bool SP2 = false, int NP = 8>
__device__ __forceinline__ void gemm_phase(PG8_LAS unsigned char* lds, const Gemm g, const Sched& S, const Epi& E, const SplitCtx& X) {
    int tid_ = threadIdx.x; asm volatile("" : "+v"(tid_));
    const int tid = tid_, wid = __builtin_amdgcn_readfirstlane(tid >> 6), lane = tid & 63, wr = wid >> 2, wc = wid & 3, fr = lane & 15, fq = lane >> 4;
    const int K = g.K;
    unsigned voffA[2], voffB[2];
#pragma unroll
    for (int i = 0; i < 2; ++i) { int R, C; stage_rc(tid * 16 + i * 8192, R, C); const int Rb = Epi::PERM ? ((R & ~31) + perm32(R & 31)) : R;
        voffA[i] = (unsigned)(R * K + C) * 2u; voffB[i] = (unsigned)(Rb * K + C) * 2u; }
    const size_t kstep = (size_t)(BK * 2);
    const size_t hstep = (size_t)HALF * K * 2;
    const size_t tstep = 2 * hstep;
    const unsigned ldsw = (unsigned)wid * 1024u;
    const int aoff = lds_byte(wr * 64 + fr, fq * 8), boff = lds_byte(wc * 32 + fr, fq * 8);
#define PG8_SA(b, h) (((b) * 2 + (h)) * HTB)
#define PG8_SB(b, h) ((4 + (b) * 2 + (h)) * HTB)
#define PG8_STAGE(bufoff, gbase, voff) do { _Pragma("unroll") for (int _i = 0; _i < 2; ++_i) \
        __builtin_amdgcn_global_load_lds((const unsigned*)((const char*)(gbase) + (voff)[_i]), (PG8_LAS unsigned*)(lds + (bufoff) + ldsw + _i * 8192), 16, 0, 0); } while (0)
#define PG8_LDA(dst, b, h) do { _Pragma("unroll") for (int m = 0; m < 4; ++m) _Pragma("unroll") for (int k = 0; k < 2; ++k) dst[m][k] = *(const PG8_LAS bf16x8*)(lds + PG8_SA(b, h) + aoff + m * 2048 + k * 1024); } while (0)
#define PG8_LDB(dst, b, h) do { _Pragma("unroll") for (int n = 0; n < 2; ++n) _Pragma("unroll") for (int k = 0; k < 2; ++k) dst[n][k] = *(const PG8_LAS bf16x8*)(lds + PG8_SB(b, h) + boff + n * 2048 + k * 1024); } while (0)
#define PG8_MMA(ai, bj, At, Bt) do { __builtin_amdgcn_s_setprio(1); _Pragma("unroll") for (int m = 0; m < 4; ++m) _Pragma("unroll") for (int n = 0; n < 2; ++n) _Pragma("unroll") for (int k = 0; k < 2; ++k) \
        acc[ai][bj][m][n] = __builtin_amdgcn_mfma_f32_16x16x32_bf16(Bt[n][k], At[m][k], acc[ai][bj][m][n], 0, 0, 0); __builtin_amdgcn_s_setprio(0); } while (0)
#define PG8_WAIT_V(n) asm volatile("s_waitcnt vmcnt(" #n ")" ::: "memory")
#define PG8_WAIT_L(n) asm volatile("s_waitcnt lgkmcnt(" #n ")" ::: "memory")
#define PG8_BAR __builtin_amdgcn_s_barrier()
#define PG8_SCHED __builtin_amdgcn_sched_barrier(0)
    Unit cur, nxt; int ui = 0;
    if (!S.next(0, cur)) return;
    f32x4 acc[2][2][4][2];
#pragma unroll
    for (int a = 0; a < 2; ++a)
#pragma unroll
        for (int b = 0; b < 2; ++b)
#pragma unroll
            for (int m = 0; m < 4; ++m)
#pragma unroll
                for (int n = 0; n < 2; ++n) acc[a][b][m][n] = (f32x4){0.f, 0.f, 0.f, 0.f};
    bf16x8 At[4][2], B0[2][2], B1[2][2];
    const char* cA = (const char*)g.A + (size_t)cur.pm * tstep + (size_t)cur.k0 * kstep; const char* cB = (const char*)g.Bt + (size_t)cur.pn * tstep + (size_t)cur.k0 * kstep;
    S.a_ready(cur);
    if constexpr (SP2) {
        PG8_STAGE(PG8_SB(0, 0), cB, voffB); PG8_STAGE(PG8_SB(0, 1), cB + hstep, voffB); PG8_STAGE(PG8_SA(0, 0), cA, voffA); PG8_STAGE(PG8_SA(0, 1), cA + hstep, voffA);
        if (wr == 1) PG8_BAR;
        PG8_WAIT_V(2); PG8_BAR;
        PG8_STAGE(PG8_SB(1, 0), cB + kstep, voffB); PG8_STAGE(PG8_SA(1, 0), cA + kstep, voffA); PG8_STAGE(PG8_SB(1, 1), cB + hstep + kstep, voffB);
        PG8_WAIT_V(6); PG8_BAR;
    } else {
        PG8_STAGE(PG8_SB(0, 0), cB, voffB); PG8_STAGE(PG8_SA(0, 0), cA, voffA); PG8_STAGE(PG8_SB(0, 1), cB + hstep, voffB); PG8_STAGE(PG8_SA(0, 1), cA + hstep, voffA);
        if (wr == 1) PG8_BAR;
        PG8_WAIT_V(4); PG8_BAR;
        PG8_STAGE(PG8_SB(1, 0), cB + kstep, voffB); PG8_STAGE(PG8_SA(1, 0), cA + kstep, voffA); PG8_STAGE(PG8_SB(1, 1), cB + hstep + kstep, voffB);
        PG8_WAIT_V(6); PG8_BAR;
    }
    for (;;) {
        const bool has_next = S.next(ui + 1, nxt);
        const char* nA = has_next ? (const char*)g.A + (size_t)nxt.pm * tstep + (size_t)nxt.k0 * kstep : cA; const char* nB = has_next ? (const char*)g.Bt + (size_t)nxt.pn * tstep + (size_t)nxt.k0 * kstep : cB;
        const int nt = cur.nt;
        for (int t = 0; t < nt; t += 2) {
            const bool last = (t == nt - 2);
            const char* a1 = cA + (size_t)(t + 1) * kstep;
            const char* a2 = last ? nA : cA + (size_t)(t + 2) * kstep; const char* b2 = last ? nB : cB + (size_t)(t + 2) * kstep;
            const char* a3 = a2 + kstep; const char* b3 = b2 + kstep;
            if (last && has_next) S.a_ready(nxt);
            if constexpr (SP2) {
            PG8_LDB(B0, 0, 0); PG8_LDB(B1, 0, 1); PG8_SCHED; PG8_LDA(At, 0, 0); PG8_STAGE(PG8_SA(1, 1), a1 + hstep, voffA);
            PG8_WAIT_V(8); PG8_WAIT_L(0); PG8_BAR; PG8_MMA(0, 0, At, B0); PG8_MMA(0, 1, At, B1); PG8_BAR; PG8_SCHED;
            PG8_LDA(At, 0, 1); PG8_STAGE(PG8_SB(0, 0), b2, voffB); PG8_STAGE(PG8_SB(0, 1), b2 + hstep, voffB); PG8_STAGE(PG8_SA(0, 0), a2, voffA);
            PG8_WAIT_V(8); PG8_WAIT_L(0); PG8_BAR; PG8_MMA(1, 0, At, B0); PG8_MMA(1, 1, At, B1); PG8_BAR; PG8_SCHED;
            PG8_LDB(B0, 1, 0); PG8_LDB(B1, 1, 1); PG8_SCHED; PG8_LDA(At, 1, 0); PG8_STAGE(PG8_SA(0, 1), a2 + hstep, voffA);
            PG8_WAIT_V(8); PG8_WAIT_L(0); PG8_BAR; PG8_MMA(0, 0, At, B0); PG8_MMA(0, 1, At, B1); PG8_BAR; PG8_SCHED;
            PG8_LDA(At, 1, 1); PG8_STAGE(PG8_SB(1, 0), b3, voffB); PG8_STAGE(PG8_SB(1, 1), b3 + hstep, voffB); PG8_STAGE(PG8_SA(1, 0), a3, voffA);
            PG8_WAIT_V(8); PG8_WAIT_L(0); PG8_BAR; PG8_MMA(1, 0, At, B0); PG8_MMA(1, 1, At, B1); PG8_BAR; PG8_SCHED;
            } else {
            PG8_LDB(B0, 0, 0); PG8_SCHED; PG8_LDA(At, 0, 0); PG8_STAGE(PG8_SA(1, 1), a1 + hstep, voffA);
            PG8_WAIT_L(8); PG8_BAR; PG8_WAIT_L(0); PG8_MMA(0, 0, At, B0); PG8_BAR; PG8_SCHED;
            PG8_LDB(B1, 0, 1); PG8_STAGE(PG8_SB(0, 0), b2, voffB);
            PG8_BAR; PG8_WAIT_L(0); PG8_MMA(0, 1, At, B1); PG8_BAR;
            PG8_LDA(At, 0, 1); PG8_STAGE(PG8_SA(0, 0), a2, voffA);
            PG8_BAR; PG8_WAIT_L(0); PG8_MMA(1, 0, At, B0); PG8_BAR; PG8_SCHED;
            PG8_STAGE(PG8_SB(0, 1), b2 + hstep, voffB);
            PG8_WAIT_V(6); PG8_BAR; PG8_MMA(1, 1, At, B1); PG8_BAR;
            PG8_LDB(B0, 1, 0); PG8_SCHED; PG8_LDA(At, 1, 0); PG8_STAGE(PG8_SA(0, 1), a2 + hstep, voffA);
            PG8_WAIT_L(8); PG8_BAR; PG8_WAIT_L(0); PG8_MMA(0, 0, At, B0); PG8_BAR; PG8_SCHED;
            PG8_LDB(B1, 1, 1); PG8_STAGE(PG8_SB(1, 0), b3, voffB);
            PG8_BAR; PG8_WAIT_L(0); PG8_MMA(0, 1, At, B1); PG8_BAR;
            PG8_LDA(At, 1, 1); PG8_STAGE(PG8_SA(1, 0), a3, voffA);
            PG8_BAR; PG8_WAIT_L(0); PG8_MMA(1, 0, At, B0); PG8_BAR; PG8_SCHED;
            PG8_STAGE(PG8_SB(1, 1), b3 + hstep, voffB);
            PG8_WAIT_V(6); PG8_BAR; PG8_MMA(1, 1, At, B1); PG8_BAR;
            }
        }
        if constexpr (ALIGN_EPI) { if (wr == 0) PG8_BAR; }
        if constexpr (!Epi::AFTER_DRAIN) { if (cur.np > 0) split_epilogue<NP>(acc, cur, E, X, tid, wr, wc, fr, fq); else E(acc, cur, wr, wc, fr, fq); S.done(cur); }
        if (!has_next) break;
#pragma unroll
        for (int a = 0; a < 2; ++a)
#pragma unroll
            for (int b = 0; b < 2; ++b)
#pragma unroll
                for (int m = 0; m < 4; ++m)
#pragma unroll
                    for (int n = 0; n < 2; ++n) acc[a][b][m][n] = (f32x4){0.f, 0.f, 0.f, 0.f};
        cur = nxt; cA = nA; cB = nB; ++ui;
        if constexpr (ALIGN_EPI) { if (wr == 1) PG8_BAR; }
    }
    PG8_WAIT_V(0);
    if constexpr (!ALIGN_EPI) { if (wr == 0) PG8_BAR; }
    PG8_BAR;
    if constexpr (Epi::AFTER_DRAIN) { E.fused(acc, cur, wr, wc, fr, fq, lds, wid, lane); S.done(cur); }
#undef PG8_SA
#undef PG8_SB
#undef PG8_STAGE
#undef PG8_LDA
#undef PG8_LDB
#undef PG8_MMA
#undef PG8_WAIT_V
#undef PG8_WAIT_L
#undef PG8_BAR
#undef PG8_SCHED
}
}

#ifndef PG8_SP2
#define PG8_SP2 true
#endif
#ifndef PG8_ALIGN
#define PG8_ALIGN true
#endif
#ifndef DUP_PHASE
#define DUP_PHASE -1
#endif
#ifndef MK_N_LAUNCHES
#define MK_N_LAUNCHES 1
#endif
constexpr int NWAVES = 8;
constexpr int N_PHASES = 10;
constexpr int N_LAUNCHES = MK_N_LAUNCHES;

constexpr int MP = 8192, MS = 1024, M = MP + MS;
constexpr int D = 2048, NIN = 11264, FF = 5632, FF2 = 11264;
constexpr int NH = 8, DK = 128, DVH = 256;
constexpr int C_POOL = 0, C_Q = 1024, C_K = 2048, C_V = 3072, C_GRET = 5120, C_GA = 7168, C_GR = 9216;
constexpr float EPS = 1e-6f;
constexpr int NS = 4, DVS = DVH / NS;
constexpr size_t O_Y = 0, O_POOLP = 18874368, O_RETP = 18935808, O_CONVP = 19984384, O_POOLS = 20074496, O_RETS = 22040576, O_CONVS = 55595008, O_END = 58478592;

constexpr size_t MiB = 1u << 20;
constexpr size_t WS_CTL = 0, CTL_ZERO_BYTES = 128 * 1024;
constexpr size_t WS_WIN = 1 * MiB, WS_WUP = 45 * MiB, WS_WDN = 89 * MiB, WS_WOUT = 111 * MiB, WS_WPOOL = 119 * MiB;
constexpr size_t WS_ROPE = 120 * MiB;
constexpr size_t WS_XN = 122 * MiB;
constexpr size_t WS_PROJ = 158 * MiB;
constexpr size_t WS_O = 356 * MiB, WS_AP = 392 * MiB, WS_MM = 428 * MiB;
constexpr size_t WS_SP16 = 464 * MiB;
constexpr size_t WS_X1 = 468 * MiB;
constexpr size_t WS_END = 504 * MiB;
constexpr int CW_TMO = 0, CW_CODE = 1, CW_Q2 = 64, CW_QW = 2048, CW_BAR = 4096, CW_SPLIT = 8192;
static_assert((CW_SPLIT + 4 * 4096) * 4 <= (int)CTL_ZERO_BYTES && CW_BAR + 3456 <= CW_SPLIT, "control words inside the per-call memset");
constexpr size_t WS_SLAB_A = 356 * MiB, WS_SLAB_B = 230 * MiB;

constexpr int LDS_BYTES = 147456, LDSCTL_OFF = 143360;

#define GAS __attribute__((address_space(1)))
#define LAS __attribute__((address_space(3)))
typedef unsigned short bf16;
typedef unsigned v4u __attribute__((ext_vector_type(4)));
typedef unsigned v2u __attribute__((ext_vector_type(2)));
typedef float f32x4 __attribute__((ext_vector_type(4)));
typedef short bf16x8 __attribute__((ext_vector_type(8)));
#define RLX_AGENT __ATOMIC_RELAXED, __HIP_MEMORY_SCOPE_AGENT
#define LDS_WAIT() asm volatile("s_waitcnt lgkmcnt(0)" ::: "memory")
#define VM_WAIT() asm volatile("s_waitcnt vmcnt(0)" ::: "memory")
__device__ __forceinline__ unsigned pk2(float lo, float hi) { return pg8::cvt_pk_bf16(lo, hi); }
__device__ __forceinline__ float bflo(unsigned u) { return __uint_as_float(u << 16); }
__device__ __forceinline__ float bfhi(unsigned u) { return __uint_as_float(u & 0xffff0000u); }
__device__ __forceinline__ void unpack8(v4u x, float (&f)[8]) { f[0] = bflo(x.x); f[1] = bfhi(x.x); f[2] = bflo(x.y); f[3] = bfhi(x.y); f[4] = bflo(x.z); f[5] = bfhi(x.z); f[6] = bflo(x.w); f[7] = bfhi(x.w); }
__device__ __forceinline__ v4u pack8(const float (&f)[8]) { v4u o; o.x = pk2(f[0], f[1]); o.y = pk2(f[2], f[3]); o.z = pk2(f[4], f[5]); o.w = pk2(f[6], f[7]); return o; }
__device__ __forceinline__ v2u pack4(f32x4 a) { v2u o; o.x = pk2(a[0], a[1]); o.y = pk2(a[2], a[3]); return o; }
__device__ __forceinline__ float sigmoidf_(float x) { return __builtin_amdgcn_rcpf(1.0f + __expf(-x)); }
__device__ __forceinline__ float wave_sum(float v) {
#pragma unroll
    for (int o = 1; o < 64; o <<= 1) v += __shfl_xor(v, o);
    return v;
}
__device__ __forceinline__ bf16x8 as_bf16x8(v4u x) { return __builtin_bit_cast(bf16x8, x); }
#define MFMA16(a, b, c) __builtin_amdgcn_mfma_f32_16x16x32_bf16((a), (b), (c), 0, 0, 0)

#define XB_TMO      128
#define XB_XCNT(j)  (256  + 64 * (j))
#define XB_XSUB(j)  (1280 + 64 * (j))
#define XB_XGEN(j)  (2304 + 64 * (j))
#define XB_TOP      3328
#define XB_TOPGEN   3392
#define XCD_BAR_WORDS 3456
#define XB_SPIN_CAP (1u << 22)
__device__ __forceinline__ unsigned xb_ld(unsigned* p)              { return __hip_atomic_load(p, __ATOMIC_RELAXED, __HIP_MEMORY_SCOPE_AGENT); }
__device__ __forceinline__ unsigned xb_add(unsigned* p, unsigned v) { return __hip_atomic_fetch_add(p, v, __ATOMIC_RELAXED, __HIP_MEMORY_SCOPE_AGENT); }
__device__ __forceinline__ unsigned xb_xcc_id() { return (unsigned)__builtin_amdgcn_s_getreg((3 << 11) | 20) & 0xFu; }
#define XB_SPIN(cond, bar) do { unsigned _sp = 0; while (cond) { __builtin_amdgcn_s_sleep(1); \
    if ((++_sp & 255u) == 0u) { if (xb_ld(&(bar)[XB_TMO])) break; if (_sp > XB_SPIN_CAP) { atomicAdd(&(bar)[XB_TMO], 1u); break; } } } } while (0)
struct XcdBarrier { unsigned* bar; unsigned x; volatile LAS unsigned* st; };
__device__ __forceinline__ XcdBarrier xcd_barrier_post(unsigned* bar, volatile LAS unsigned* st) {
    XcdBarrier b; b.bar = bar; b.x = xb_xcc_id(); b.st = st;
    if (threadIdx.x == 0) (void)xb_add(&bar[XB_XCNT(b.x)], 1u);
    return b;
}
__device__ __forceinline__ void xcd_barrier_complete(unsigned* bar, unsigned x, unsigned& nloc, unsigned& nx) {
    const unsigned G = gridDim.x * gridDim.y * gridDim.z;
    unsigned sum, cnt, mine, sp = 0u;
    for (;;) {
        sum = 0u; cnt = 0u; mine = 0u;
#pragma unroll
        for (unsigned j = 0; j < 16; ++j) { const unsigned c = xb_ld(&bar[XB_XCNT(j)]); sum += c; cnt += (c > 0u) ? 1u : 0u; mine = (j == x) ? c : mine; }
        if (sum == G) break;
        __builtin_amdgcn_s_sleep(1);
        if ((++sp & 255u) == 0u) { if (xb_ld(&bar[XB_TMO])) break; if (sp > XB_SPIN_CAP) { atomicAdd(&bar[XB_TMO], 1u); break; } }
    }
    nloc = mine > 0u ? mine : 1u; nx = cnt > 0u ? cnt : 1u;
}
__device__ __forceinline__ void xcd_barrier(const XcdBarrier& b) {
    asm volatile("s_waitcnt vmcnt(0)" ::: "memory");
    __syncthreads();
    if (threadIdx.x == 0) {
        unsigned* bar = b.bar;
        __builtin_amdgcn_s_waitcnt(0);
        unsigned nloc = b.st[0], nx = b.st[1];
        if (nloc == 0u) { xcd_barrier_complete(bar, b.x, nloc, nx); b.st[0] = nloc; b.st[1] = nx; }
        const unsigned old = xb_add(&bar[XB_XSUB(b.x)], 1u);
        const unsigned gen = old / nloc;
        if (old + 1u == (gen + 1u) * nloc) {
            __builtin_amdgcn_fence(__ATOMIC_RELEASE, "agent");
            asm volatile("s_waitcnt vmcnt(0)" ::: "memory");
            const unsigned og = xb_add(&bar[XB_TOP], 1u);
            const unsigned tg = og / nx;
            if (og + 1u == (tg + 1u) * nx) xb_add(&bar[XB_TOPGEN], 1u);
            else XB_SPIN(xb_ld(&bar[XB_TOPGEN]) == tg, bar);
            __builtin_amdgcn_fence(__ATOMIC_ACQUIRE, "agent");
            xb_add(&bar[XB_XGEN(b.x)], 1u);
            asm volatile("s_waitcnt vmcnt(0)" ::: "memory");
        } else {
            XB_SPIN(xb_ld(&bar[XB_XGEN(b.x)]) == gen, bar);
            __builtin_amdgcn_fence(__ATOMIC_ACQUIRE, "agent");
            asm volatile("s_waitcnt vmcnt(0)" ::: "memory");
        }
    }
    __syncthreads();
}

struct Frame {
    LAS unsigned char* lds;
    volatile LAS unsigned* MISC;
    unsigned* ctl;
    int tid, lane, wave, G, gw, NGW;
    const float *xp, *xs, *state_pool, *state_ret, *state_conv, *g_pre_mix, *w_in, *w_pool, *pool_scale, *gn_gain, *w_out, *g_post_mix, *g_pre_ffn, *w_up, *conv_w, *conv_b, *w_down, *g_post_ffn;
    float* out;
    bf16 *WIN, *WUP, *WDN, *WOUT, *WPOOL, *XN, *PROJ, *UP, *OB, *AP, *MM, *ACT;
    float *ROPE_C, *ROPE_S;
    bf16 *SP16, *MOB, *X1B;
};
__device__ __forceinline__ const float* xrow(const Frame& F, int m) { return m < MP ? F.xp + (size_t)m * D : F.xs + (size_t)(m - MP) * D; }

__host__ __device__ __forceinline__ int unperm_d(int p) { const int g8 = p >> 3, e = p & 7; return e < 4 ? 4 * g8 + e : 64 + 4 * g8 + (e - 4); }
__device__ __forceinline__ void p0_transpose_item(const float* W, int K, int N, bf16* WT, LAS float* scr, int item, int lane, bool permqk = false) {
    const int nblk = N / 32, kb = item / nblk, nb = item % nblk, k0 = 64 * kb, n0 = 32 * nb;
    int src = n0 + (lane & 31); if (permqk && src >= C_Q && src < C_V) src = (src & ~127) + unperm_d(src & 127);
#pragma unroll 8
    for (int i = 0; i < 32; ++i) { const int kk = 2 * i + (lane >> 5); scr[kk * 33 + (lane & 31)] = __builtin_nontemporal_load(W + (size_t)(k0 + kk) * N + src); }
    LDS_WAIT(); asm volatile("" ::: "memory");
    const int c = lane & 7;
#pragma unroll
    for (int j = 0; j < 4; ++j) { const int n = (lane >> 3) + 8 * j; const LAS float* s = scr + (8 * c) * 33 + n;
        v4u o; o.x = pk2(s[0 * 33], s[1 * 33]); o.y = pk2(s[2 * 33], s[3 * 33]); o.z = pk2(s[4 * 33], s[5 * 33]); o.w = pk2(s[6 * 33], s[7 * 33]);
        *(v4u*)(WT + (size_t)(n0 + n) * K + k0 + 8 * c) = o; }
    LDS_WAIT(); asm volatile("" ::: "memory");
}
__device__ __forceinline__ void rms_row_to_bf16(const float* xr_, const float* g, bf16* orow, int lane) {
    const f32x4* xr = (const f32x4*)xr_ + lane; const f32x4* gr = (const f32x4*)g + lane;
    f32x4 v[8]; float s = 0.f;
#pragma unroll
    for (int j = 0; j < 8; ++j) { v[j] = __builtin_nontemporal_load(xr + 64 * j); s += (v[j].x * v[j].x + v[j].y * v[j].y) + (v[j].z * v[j].z + v[j].w * v[j].w); }
    const float rs = 1.0f / sqrtf(wave_sum(s) * (1.f / D) + EPS);
    v2u* o8 = (v2u*)orow + lane;
#pragma unroll
    for (int j = 0; j < 8; ++j) { const f32x4 gg = gr[64 * j]; v2u o; o.x = pk2(v[j].x * rs * gg.x, v[j].y * rs * gg.y); o.y = pk2(v[j].z * rs * gg.z, v[j].w * rs * gg.w); o8[64 * j] = o; }
}
__device__ __forceinline__ void p0_deferred_weights(Frame& F, LAS float* scr) {
    constexpr int I_UP = (D / 64) * (FF2 / 32), I_DN = (FF / 64) * (D / 32), I_OUT = (D / 64) * (D / 32), I_PL = (256 / 64) * (512 / 32);
    constexpr int NITEMS = I_UP + I_DN + I_OUT + 4 * I_PL, CHUNK = 2, NQ = 16, PERQ = NITEMS / NQ;
    static_assert(NITEMS % NQ == 0 && PERQ % CHUNK == 0, "deferred-weight queue split");
    const int qi = blockIdx.x & (NQ - 1);
    for (;;) {
        int base = 0;
        if (F.lane == 0) base = (int)__hip_atomic_fetch_add(F.ctl + CW_QW + 64 * qi, (unsigned)CHUNK, RLX_AGENT);
        base = __builtin_amdgcn_readfirstlane(base);
        if (base >= PERQ) break;
        base += qi * PERQ;
        for (int it = base; it < base + CHUNK; ++it) {
            int r = it;
            if (r < I_UP) { p0_transpose_item(F.w_up, D, FF2, F.WUP, scr, r, F.lane); continue; } r -= I_UP;
            if (r < I_DN) { p0_transpose_item(F.w_down, FF, D, F.WDN, scr, r, F.lane); continue; } r -= I_DN;
            if (r < I_OUT) { p0_transpose_item(F.w_out, D, D, F.WOUT, scr, r, F.lane); continue; } r -= I_OUT;
            const int g = r / I_PL; r -= g * I_PL;
            p0_transpose_item(F.w_pool + (size_t)g * 256 * 512, 256, 512, F.WPOOL + (size_t)g * 512 * 256, scr, r, F.lane);
        }
    }
}
__device__ __forceinline__ void p0_prologue(Frame& F) {
    LAS float* scr = (LAS float*)(F.lds + F.wave * 16384);
    constexpr int I_IN = (D / 64) * (NIN / 32);
    for (int it = F.gw; it < I_IN; it += F.NGW) p0_transpose_item(F.w_in, D, NIN, F.WIN, scr, it, F.lane, true);
    for (int m = F.NGW - 1 - F.gw; m < M; m += F.NGW) rms_row_to_bf16(xrow(F, m), F.g_pre_mix, F.XN + (size_t)m * D, F.lane);
    for (int idx = blockIdx.x * 512 + F.tid; idx < 128 * 15 * 1024 / 4; idx += F.G * 512) { const f32x4 v = ((const f32x4*)F.state_pool)[idx]; ((v2u*)F.SP16)[idx] = pack4(v); }
    for (int idx = blockIdx.x * 512 + F.tid; idx < 2056 * 64; idx += F.G * 512) {
        const int row = idx >> 6, i = idx & 63; const int pos = row < 2048 ? row : 16384 + (row - 2048);
        double th = 1.0; for (int k = 0; k < i; ++k) th *= 0.8659643233600653;
        const double a = (double)pos * th;
        const double kd = rint(a * 0.6366197723675814);
        double y = fma(-kd, 1.57079632679489655800e+00, a); y = fma(-kd, 6.12323399573676603587e-17, y);
        const int k4 = ((int)kd) & 3; const double y2 = y * y;
        const double sp = y * (1.0 + y2 * (-1.0 / 6 + y2 * (1.0 / 120 + y2 * (-1.0 / 5040 + y2 * (1.0 / 362880 + y2 * (-1.0 / 39916800 + y2 * (1.0 / 6227020800.0)))))));
        const double cp = 1.0 + y2 * (-0.5 + y2 * (1.0 / 24 + y2 * (-1.0 / 720 + y2 * (1.0 / 40320 + y2 * (-1.0 / 3628800 + y2 * (1.0 / 479001600 + y2 * (-1.0 / 87178291200.0)))))));
        double sn, cs;
        if (k4 == 0) { sn = sp; cs = cp; } else if (k4 == 1) { sn = cp; cs = -sp; } else if (k4 == 2) { sn = -sp; cs = -cp; } else { sn = -cp; cs = sp; }
        F.ROPE_C[idx] = (float)cs; F.ROPE_S[idx] = (float)sn;
    }
}

constexpr float KSCALE = 0.08838834764831845f;
struct EpiProj {
    static constexpr bool PERM = true, AFTER_DRAIN = false;
    bf16* O; const float* rc; const float* rs;
    __device__ __forceinline__ void tri(f32x4 v0, f32x4 v1, const pg8::Unit& u, int ai, int bj, int m, int wr, int wc, int fr, int fq) const {
        const int row = u.pm * 256 + ai * 128 + wr * 64 + m * 16 + fr, col = u.pn * 256 + bj * 128 + wc * 32 + 8 * fq;
        if (u.pn >= 4 && u.pn < 12) {
            const int h = ((u.pn & 3) << 1) + bj;
            int prow, tl; if (row < MP) { const int t = row & 2047; prow = t; tl = t & 127; } else { tl = row & 7; prow = 2048 + tl; }
            const int g8 = 4 * wc + fq;
            const f32x4 c = *(const f32x4*)(rc + prow * 64 + 4 * g8), sn = *(const f32x4*)(rs + prow * 64 + 4 * g8);
            const float lg2 = __log2f(1.0f - __builtin_amdgcn_exp2f(-5.0f - (float)h));
            const float sc = u.pn >= 8 ? KSCALE * __builtin_amdgcn_exp2f(-lg2 * (float)tl) : __builtin_amdgcn_exp2f(lg2 * (float)tl);
            const f32x4 y1 = (v0 * c - v1 * sn) * sc, y2 = (v1 * c + v0 * sn) * sc;
            v0 = y1; v1 = y2;
        }
        v4u w4; w4.x = pk2(v0[0], v0[1]); w4.y = pk2(v0[2], v0[3]); w4.z = pk2(v1[0], v1[1]); w4.w = pk2(v1[2], v1[3]);
        *(v4u*)(O + (size_t)row * NIN + col) = w4;
    }
    __device__ __forceinline__ void operator()(const f32x4 (&acc)[2][2][4][2], const pg8::Unit& u, int wr, int wc, int fr, int fq) const {
#pragma unroll
        for (int ai = 0; ai < 2; ++ai)
#pragma unroll
            for (int m = 0; m < 4; ++m)
#pragma unroll
                for (int bj = 0; bj < 2; ++bj) tri(acc[ai][bj][m][0], acc[ai][bj][m][1], u, ai, bj, m, wr, wc, fr, fq);
    }
};

typedef short s16x4 __attribute__((ext_vector_type(4)));
__device__ __forceinline__ bf16x8 tr16x2(const LAS unsigned char* p0, const LAS unsigned char* p1) {
    const s16x4 a = __builtin_amdgcn_ds_read_tr16_b64_v4i16((LAS s16x4*)p0), b = __builtin_amdgcn_ds_read_tr16_b64_v4i16((LAS s16x4*)p1);
    return __builtin_shufflevector(a, b, 0, 1, 2, 3, 4, 5, 6, 7);
}
static_assert(DVS == 64, "chain staging below assumes 64-wide value slices");
constexpr int QI_LD = 136, VI_LD = DVS + 8;
constexpr int QI_OFF = 0, KI_OFF = 34816, VI_OFF = 69632, RT_OFF = VI_OFF + 128 * VI_LD * 2, CH_END = RT_OFF + DVS * QI_LD * 2;
static_assert(CH_END <= LDSCTL_OFF, "chain LDS");
__device__ __forceinline__ void chain_unit(Frame& F, int unit) {
    const int s = unit % NS, h = (unit / NS) & 7, b = unit / (NS * 8);
    int tid_ = F.tid; asm volatile("" : "+v"(tid_));
    const int tid = tid_, lane = tid & 63, w = F.wave, fr = lane & 15, fq = lane >> 4, tq = (lane & 15) >> 2, tp = lane & 3;
    LAS unsigned char* L = F.lds;
    const float lg2 = __log2f(1.0f - __builtin_amdgcn_exp2f(-5.0f - (float)h));
    const float gam = __builtin_amdgcn_exp2f(lg2), g127 = __builtin_amdgcn_exp2f(127.f * lg2);
    for (int i = tid; i < DVS * QI_LD * 2 / 16; i += 512) *(LAS v4u*)(L + RT_OFF + i * 16) = (v4u){0u, 0u, 0u, 0u};
    f32x4 Racc[4];
#pragma unroll
    for (int i = 0; i < 4; ++i) Racc[i] = (f32x4){0.f, 0.f, 0.f, 0.f};
    const int vt_r = w & 3, dg = w >> 2;
    const bf16* pbase = F.PROJ + ((size_t)b * 2048) * NIN;
    v4u sq[4], sk[4], sv[2];
#define CH_ISSUE(c) do { const bf16* pr_ = pbase + (size_t)((c) * 128) * NIN; \
        _Pragma("unroll") for (int i_ = 0; i_ < 4; ++i_) { const int ci = tid + 512 * i_, j = ci >> 4, ch = ci & 15; sq[i_] = *(const v4u*)(pr_ + (size_t)j * NIN + C_Q + h * 128 + 8 * ch); sk[i_] = *(const v4u*)(pr_ + (size_t)j * NIN + C_K + h * 128 + 8 * ch); } \
        _Pragma("unroll") for (int i_ = 0; i_ < 2; ++i_) { const int ci = tid + 512 * i_, j = ci >> 3, ch = ci & 7; sv[i_] = *(const v4u*)(pr_ + (size_t)j * NIN + C_V + h * DVH + s * DVS + 8 * ch); } } while (0)
#define CH_WRITE() do { \
        _Pragma("unroll") for (int i_ = 0; i_ < 4; ++i_) { const int ci = tid + 512 * i_, j = ci >> 4, ch = ci & 15; *(LAS v4u*)(L + QI_OFF + (j * QI_LD + 8 * ch) * 2) = sq[i_]; *(LAS v4u*)(L + KI_OFF + (j * QI_LD + 8 * ch) * 2) = sk[i_]; } \
        _Pragma("unroll") for (int i_ = 0; i_ < 2; ++i_) { const int ci = tid + 512 * i_, j = ci >> 3, ch = ci & 7; *(LAS v4u*)(L + VI_OFF + (j * VI_LD + 8 * ch) * 2) = sv[i_]; } } while (0)
    CH_ISSUE(0);
#pragma unroll 1
    for (int c = 0; c < 16; ++c) {
        const size_t mrow0 = (size_t)b * 2048 + c * 128;
        CH_WRITE();
        __syncthreads();
        if (c + 1 < 16) CH_ISSUE(c + 1);
        {
            bf16x8 afr[4];
#pragma unroll
            for (int kk = 0; kk < 4; ++kk) afr[kk] = *(const LAS bf16x8*)(L + QI_OFF + ((16 * w + fr) * QI_LD + 32 * kk + 8 * fq) * 2);
            f32x4 oacc[4];
#pragma unroll
            for (int vt = 0; vt < 4; ++vt) {
                f32x4 acc = (f32x4){0.f, 0.f, 0.f, 0.f};
#pragma unroll
                for (int kk = 0; kk < 4; ++kk) { const bf16x8 rf = *(const LAS bf16x8*)(L + RT_OFF + ((16 * vt + fr) * QI_LD + 32 * kk + 8 * fq) * 2); acc = MFMA16(rf, afr[kk], acc); }
                oacc[vt] = acc * gam;
            }
            const int i_ = 16 * w + fr, nkk = (w >> 1) + 1;
#pragma unroll 1
            for (int kk = 0; kk < nkk; ++kk) {
                f32x4 s0 = (f32x4){0.f, 0.f, 0.f, 0.f}, s1 = s0;
                const LAS unsigned char* kb = L + KI_OFF + ((32 * kk + fr) * QI_LD + 8 * fq) * 2;
#pragma unroll
                for (int k2 = 0; k2 < 4; ++k2) {
                    const bf16x8 kf0 = *(const LAS bf16x8*)(kb + 64 * k2), kf1 = *(const LAS bf16x8*)(kb + 16 * QI_LD * 2 + 64 * k2);
                    s0 = MFMA16(kf0, afr[k2], s0); s1 = MFMA16(kf1, afr[k2], s1);
                }
                float pv[8];
#pragma unroll
                for (int e = 0; e < 4; ++e) { const int dd0 = i_ - (32 * kk + 4 * fq + e); pv[e] = dd0 >= 0 ? s0[e] : 0.f; pv[4 + e] = dd0 >= 16 ? s1[e] : 0.f; }
                const bf16x8 pf = as_bf16x8(pack8(pv));
                const LAS unsigned char* vb = L + VI_OFF + ((32 * kk + 4 * fq + tq) * VI_LD + 4 * tp) * 2;
#pragma unroll
                for (int vt = 0; vt < 4; ++vt) oacc[vt] = MFMA16(tr16x2(vb + 32 * vt, vb + 16 * VI_LD * 2 + 32 * vt), pf, oacc[vt]);
            }
            bf16* orow = F.OB + (mrow0 + 16 * w + fr) * D + h * DVH + s * DVS + 4 * fq;
#pragma unroll
            for (int vt = 0; vt < 4; ++vt) *(v2u*)(orow + 16 * vt) = pack4(oacc[vt]);
        }
#pragma unroll
        for (int di = 0; di < 4; ++di) {
            const int dt = dg * 4 + di;
            f32x4 acc = Racc[di] * gam;
#pragma unroll
            for (int kk = 0; kk < 4; ++kk) {
                const LAS unsigned char* ka = L + KI_OFF + ((32 * kk + 8 * fq + tq) * QI_LD + 16 * dt + 4 * tp) * 2;
                const LAS unsigned char* va = L + VI_OFF + ((32 * kk + 8 * fq + tq) * VI_LD + 16 * vt_r + 4 * tp) * 2;
                acc = MFMA16(tr16x2(ka, ka + 4 * QI_LD * 2), tr16x2(va, va + 4 * VI_LD * 2), acc);
            }
            Racc[di] = acc * g127;
        }
        __syncthreads();
#pragma unroll
        for (int di = 0; di < 4; ++di) { const int dt = dg * 4 + di; *(LAS v2u*)(L + RT_OFF + ((16 * vt_r + fr) * QI_LD + 16 * dt + 4 * fq) * 2) = pack4(Racc[di]); }
    }
#undef CH_ISSUE
#undef CH_WRITE
    float* ro = F.out + O_RETP + ((size_t)(b * 8 + h) * 128) * DVH + s * DVS + 16 * vt_r + fr;
#pragma unroll
    for (int di = 0; di < 4; ++di) { const int dt = dg * 4 + di;
#pragma unroll
        for (int r = 0; r < 4; ++r) ro[(size_t)unperm_d(16 * dt + 4 * fq + r) * DVH] = Racc[di][r]; }
}

constexpr int SQ_OFF = 0, SKZ_OFF = 4096, SK_OFF = 8192, SV_OFF = 12288, SS_OFF = 20480, SRED_OFF = 24576;
__device__ __forceinline__ void sample_unit(Frame& F, int unit) {
    const int h = unit & 7, b = unit >> 3;
    int tid_ = F.tid; asm volatile("" : "+v"(tid_));
    const int tid = tid_, lane = tid & 63, w = F.wave;
    LAS unsigned char* L = F.lds;
    LAS float* qT = (LAS float*)(L + SQ_OFF); LAS float* kzT = (LAS float*)(L + SKZ_OFF); LAS float* kS = (LAS float*)(L + SK_OFF);
    LAS float* vs = (LAS float*)(L + SV_OFF); LAS float* ss = (LAS float*)(L + SS_OFF); LAS float* red = (LAS float*)(L + SRED_OFF);
    const float lg2 = __log2f(1.0f - __builtin_amdgcn_exp2f(-5.0f - (float)h));
    const float gam = __builtin_amdgcn_exp2f(lg2), g7 = __builtin_amdgcn_exp2f(7.f * lg2), g8c = __builtin_amdgcn_exp2f(8.f * lg2);
    const size_t mrow0 = (size_t)MP + (size_t)b * 8;
    const float* Rin = F.state_ret + ((size_t)(b * 8 + h) * 128) * DVH + 4 * lane;
    float* Rout = F.out + O_RETS + ((size_t)(b * 8 + h) * 128) * DVH + 4 * lane;
    f32x4 r0[16];
#pragma unroll
    for (int dd = 0; dd < 16; ++dd) r0[dd] = __builtin_nontemporal_load((const f32x4*)(Rin + (size_t)(16 * w + dd) * DVH));
    if (tid < 256) {
        const int qk = tid >> 7, it = tid & 127, i = it >> 4, ch = it & 15;
        float f[8]; unpack8(*(const v4u*)(F.PROJ + (mrow0 + i) * NIN + (qk ? C_K : C_Q) + h * 128 + 8 * ch), f);
#pragma unroll
        for (int e = 0; e < 8; ++e) { const int d = e < 4 ? 4 * ch + e : 64 + 4 * ch + (e - 4);
            if (qk == 0) qT[d * 8 + i] = f[e]; else { kS[i * 128 + d] = f[e]; kzT[d * 8 + i] = f[e] * g7; } }
    } else {
        const int it = tid - 256, j = it >> 5, g = it & 31;
        float f[8]; unpack8(*(const v4u*)(F.PROJ + (mrow0 + j) * NIN + C_V + h * DVH + 8 * g), f);
#pragma unroll
        for (int e = 0; e < 8; ++e) vs[j * 256 + 8 * g + e] = f[e];
    }
    __syncthreads();
    {
        const int pr = tid >> 3, part = tid & 7, i = pr >> 3, j = pr & 7; float dot = 0.f;
#pragma unroll
        for (int dd = 0; dd < 16; ++dd) { const int d = 16 * part + dd; dot += qT[d * 8 + i] * kS[j * 128 + d]; }
        dot += __shfl_xor(dot, 1); dot += __shfl_xor(dot, 2); dot += __shfl_xor(dot, 4);
        if (part == 0) ss[i * 8 + j] = (i >= j) ? dot : 0.f;
    }
    {
        f32x4 vreg[8], oacc[8];
#pragma unroll
        for (int j = 0; j < 8; ++j) { vreg[j] = *(const LAS f32x4*)(vs + j * 256 + 4 * lane); oacc[j] = (f32x4){0.f, 0.f, 0.f, 0.f}; }
#pragma unroll
        for (int dd = 0; dd < 16; ++dd) {
            const int d = 16 * w + dd;
            const f32x4 qa = *(const LAS f32x4*)(qT + d * 8), qb = *(const LAS f32x4*)(qT + d * 8 + 4), ka = *(const LAS f32x4*)(kzT + d * 8), kb = *(const LAS f32x4*)(kzT + d * 8 + 4);
            f32x4 rn = r0[dd] * g8c;
            rn += ka.x * vreg[0]; rn += ka.y * vreg[1]; rn += ka.z * vreg[2]; rn += ka.w * vreg[3]; rn += kb.x * vreg[4]; rn += kb.y * vreg[5]; rn += kb.z * vreg[6]; rn += kb.w * vreg[7];
            __builtin_nontemporal_store(rn, (f32x4*)(Rout + (size_t)d * DVH));
            oacc[0] += qa.x * r0[dd]; oacc[1] += qa.y * r0[dd]; oacc[2] += qa.z * r0[dd]; oacc[3] += qa.w * r0[dd];
            oacc[4] += qb.x * r0[dd]; oacc[5] += qb.y * r0[dd]; oacc[6] += qb.z * r0[dd]; oacc[7] += qb.w * r0[dd];
        }
#pragma unroll
        for (int i = 0; i < 8; ++i) *(LAS f32x4*)(red + (w * 8 + i) * 256 + 4 * lane) = oacc[i];
    }
    __syncthreads();
    {
        const int i = tid >> 6, l = tid & 63;
        f32x4 tot = (f32x4){0.f, 0.f, 0.f, 0.f};
#pragma unroll
        for (int ww = 0; ww < 8; ++ww) tot += *(const LAS f32x4*)(red + (ww * 8 + i) * 256 + 4 * l);
        tot = tot * gam;
#pragma unroll
        for (int j = 0; j < 8; ++j) tot += ss[i * 8 + j] * *(const LAS f32x4*)(vs + j * 256 + 4 * l);
        *(v2u*)(F.OB + (mrow0 + i) * D + h * DVH + 4 * l) = pack4(tot);
    }
}

constexpr int Z_LD = 264;
template <int W, int IB> __device__ __forceinline__ void pool_z(Frame& F, int g, int m0, int tid) {
    LAS unsigned char* L = F.lds;
#pragma unroll 1
    for (int it0 = tid; it0 < 4096; it0 += 512 * IB) {
        v4u raw[IB][W]; bool ok[IB][W];
#pragma unroll
        for (int ib = 0; ib < IB; ++ib) {
            const int it = it0 + 512 * ib, j = it >> 5, c8 = it & 31, m = m0 + j, col = C_POOL + 256 * g + 8 * c8;
#pragma unroll
            for (int k = 0; k < W; ++k) {
                const bf16* p;
                if (m < MP) { const int t = m & 2047; ok[ib][k] = t - k >= 0; p = F.PROJ + (size_t)(ok[ib][k] ? m - k : m) * NIN + col; }
                else { const int ms = m - MP, bb = ms >> 3, i = ms & 7, ee = 15 + i - k; ok[ib][k] = true;
                    const bf16* p1 = F.PROJ + (size_t)(MP + bb * 8 + (ee >= 15 ? ee - 15 : 0)) * NIN + col; const bf16* p2 = F.SP16 + ((size_t)bb * 15 + (ee < 15 ? ee : 0)) * 1024 + 256 * g + 8 * c8;
                    p = ee >= 15 ? p1 : p2; }
                raw[ib][k] = *(const v4u*)p;
            }
        }
#pragma unroll
        for (int ib = 0; ib < IB; ++ib) {
            const int it = it0 + 512 * ib, j = it >> 5, c8 = it & 31, m = m0 + j;
            float sum[8], cur[8], f[8];
            unpack8(raw[ib][0], cur);
#pragma unroll
            for (int e = 0; e < 8; ++e) sum[e] = cur[e];
#pragma unroll
            for (int k = 1; k < W; ++k) { unpack8(raw[ib][k], f);
#pragma unroll
                for (int e = 0; e < 8; ++e) sum[e] += ok[ib][k] ? f[e] : 0.f; }
            int cn = W; if (m < MP) { const int t = m & 2047; cn = W < t + 1 ? W : t + 1; }
            const float ic = 1.0f / (float)cn;
#pragma unroll
            for (int e = 0; e < 8; ++e) f[e] = sum[e] * ic - cur[e];
            *(LAS v4u*)(L + (j * Z_LD + 8 * c8) * 2) = pack8(f);
        }
    }
}
__device__ __forceinline__ void pool_unit(Frame& F, int unit) {
    const int g = unit & 3, tile = unit >> 2, m0 = tile * 128;
    int tid_ = F.tid; asm volatile("" : "+v"(tid_));
    const int tid = tid_, lane = tid & 63, w = F.wave, fr = lane & 15, fq = lane >> 4;
    LAS unsigned char* L = F.lds;
    bf16x8 bfr[4][8];
    {
        const bf16* wt = F.WPOOL + ((size_t)g * 512 + 64 * w + fr) * 256 + 8 * fq;
#pragma unroll
        for (int et = 0; et < 4; ++et)
#pragma unroll
            for (int kk = 0; kk < 8; ++kk) bfr[et][kk] = *(const bf16x8*)(wt + (size_t)(16 * et) * 256 + 32 * kk);
    }
    if (m0 >= MP) {
        if (g == 0) pool_z<2, 4>(F, g, m0, tid); else if (g == 1) pool_z<4, 4>(F, g, m0, tid); else if (g == 2) pool_z<8, 2>(F, g, m0, tid); else pool_z<16, 1>(F, g, m0, tid);
    } else {
        constexpr int UT_OFF = 128 * Z_LD * 2;
        static_assert(UT_OFF + 143 * Z_LD * 2 <= LDSCTL_OFF, "pool LDS");
        const bool seq0 = (m0 & 2047) == 0;
        const bf16* src = F.PROJ + (size_t)(m0 - 15) * NIN + C_POOL + 256 * g;
#pragma unroll
        for (int i = 0; i < 9; ++i) { const int ci = tid + 512 * i;
            if (ci < 143 * 32) { const int rw = ci >> 5, c8 = ci & 31; v4u v = (v4u){0u, 0u, 0u, 0u}; if (!(seq0 && rw < 15)) v = *(const v4u*)(src + (size_t)rw * NIN + 8 * c8);
                *(LAS v4u*)(L + UT_OFF + (rw * Z_LD + 8 * c8) * 2) = v; } }
        __syncthreads();
        const int W = 2 << g, c8 = tid & 31, j0 = (tid >> 5) * 8;
        const LAS unsigned char* up = L + UT_OFF + ((15 + j0) * Z_LD + 8 * c8) * 2;
        float sum[8], f[8], cur[8];
#pragma unroll
        for (int e = 0; e < 8; ++e) sum[e] = 0.f;
        for (int k = 1; k < W; ++k) { unpack8(*(const LAS v4u*)(up - k * Z_LD * 2), f);
#pragma unroll
            for (int e = 0; e < 8; ++e) sum[e] += f[e]; }
        const int t0 = (m0 & 2047) + j0;
#pragma unroll
        for (int j = 0; j < 8; ++j) {
            unpack8(*(const LAS v4u*)(up + j * Z_LD * 2), cur);
#pragma unroll
            for (int e = 0; e < 8; ++e) sum[e] += cur[e];
            const int t = t0 + j; const float ic = 1.0f / (float)(W < t + 1 ? W : t + 1);
#pragma unroll
            for (int e = 0; e < 8; ++e) f[e] = sum[e] * ic - cur[e];
            *(LAS v4u*)(L + ((j0 + j) * Z_LD + 8 * c8) * 2) = pack8(f);
            unpack8(*(const LAS v4u*)(up + (j + 1 - W) * Z_LD * 2), f);
#pragma unroll
            for (int e = 0; e < 8; ++e) sum[e] -= f[e];
        }
    }
    __syncthreads();
    f32x4 sc[4];
#pragma unroll
    for (int et = 0; et < 4; ++et) sc[et] = *(const f32x4*)(F.pool_scale + 512 * g + 64 * w + 16 * et + 4 * fq);
#pragma unroll 1
    for (int rt = 0; rt < 8; ++rt) {
        bf16x8 afr[8];
#pragma unroll
        for (int kk = 0; kk < 8; ++kk) afr[kk] = *(const LAS bf16x8*)(L + ((16 * rt + fr) * Z_LD + 32 * kk + 8 * fq) * 2);
        bf16* orow = F.AP + (size_t)(m0 + 16 * rt + fr) * D + 512 * g + 64 * w + 4 * fq;
#pragma unroll
        for (int et = 0; et < 4; ++et) {
            f32x4 acc = (f32x4){0.f, 0.f, 0.f, 0.f};
#pragma unroll
            for (int kk = 0; kk < 8; ++kk) acc = MFMA16(bfr[et][kk], afr[kk], acc);
            *(v2u*)(orow + 16 * et) = pack4(acc * sc[et]);
        }
    }
}
constexpr int N_CHAIN = 4 * 8 * NS, N_POOLU = (M / 128) * 4, N_SAMP = 128 * 8, N_P2 = N_CHAIN + N_POOLU + N_SAMP;
__device__ __forceinline__ void p2_mixers(Frame& F, int rep) {
    const int mode = rep >> 4, lo = mode == 2 ? N_CHAIN : (mode == 3 ? N_CHAIN + N_POOLU : 0), hi = mode == 1 ? N_CHAIN : (mode == 2 ? N_CHAIN + N_POOLU : N_P2);
    const bool static_chain = mode == 0 && (F.G % 8) == 0 && F.G >= N_CHAIN && NS == 4;
    if (static_chain && (int)blockIdx.x < N_CHAIN) { __syncthreads(); const int c = (int)blockIdx.x, slot = c >> 3, bh = (c & 7) + 8 * (slot >> 2); chain_unit(F, bh * NS + (slot & 3)); }
    unsigned nxt_ = 0;
    if (F.tid == 0) nxt_ = __hip_atomic_fetch_add(F.ctl + CW_Q2 + 64 * (rep & 15), 1u, RLX_AGENT);
    for (;;) {
        __syncthreads();
        if (F.tid == 0) F.MISC[0] = nxt_;
        __syncthreads();
        const int u = (int)F.MISC[0] + (static_chain ? N_CHAIN : lo);
        if (u >= hi) break;
        if (F.tid == 0) nxt_ = __hip_atomic_fetch_add(F.ctl + CW_Q2 + 64 * (rep & 15), 1u, RLX_AGENT);
        if (u < N_CHAIN) chain_unit(F, u);
        else if (u < N_CHAIN + N_POOLU) pool_unit(F, u - N_CHAIN);
        else sample_unit(F, u - N_CHAIN - N_POOLU);
    }
}

__device__ __forceinline__ void ld8f(const float* p, float (&o)[8]) { const f32x4 a = *(const f32x4*)p, b = *(const f32x4*)(p + 4); o[0] = a.x; o[1] = a.y; o[2] = a.z; o[3] = a.w; o[4] = b.x; o[5] = b.y; o[6] = b.z; o[7] = b.w; }
__device__ __forceinline__ float half_sum(float v) {
#pragma unroll
    for (int o = 1; o < 32; o <<= 1) v += __shfl_xor(v, o);
    return v;
}
__device__ __forceinline__ void p3_merge(Frame& F) {
    const int lane = F.lane, hl = lane >> 5, l32 = lane & 31;
    constexpr int NIT = M * 4;
    for (int it0 = 2 * F.gw; it0 < NIT; it0 += 2 * F.NGW) {
        v4u ov[2], gv[2], av[2], rv[2], pv[2]; int cc[2]; size_t mm[2];
#pragma unroll
        for (int u = 0; u < 2; ++u) {
            const int it = it0 + u, m = it >> 2, hp = it & 3, c = (2 * hp + hl) * DVH + 8 * l32; cc[u] = c; mm[u] = (size_t)m;
            const bf16* prow = F.PROJ + (size_t)m * NIN + c;
            ov[u] = __builtin_nontemporal_load((const v4u*)(F.OB + (size_t)m * D + c)); gv[u] = __builtin_nontemporal_load((const v4u*)(prow + C_GRET)); av[u] = __builtin_nontemporal_load((const v4u*)(prow + C_GA)); rv[u] = __builtin_nontemporal_load((const v4u*)(prow + C_GR)); pv[u] = __builtin_nontemporal_load((const v4u*)(F.AP + (size_t)m * D + c));
        }
#pragma unroll
        for (int u = 0; u < 2; ++u) {
            float o[8], g[8], ga[8], gr[8], ap[8], res[8];
            unpack8(ov[u], o); unpack8(gv[u], g); unpack8(av[u], ga); unpack8(rv[u], gr); unpack8(pv[u], ap);
            const f32x4 gn0 = *(const f32x4*)(F.gn_gain + cc[u]), gn1 = *(const f32x4*)(F.gn_gain + cc[u] + 4);
            const float gn[8] = {gn0.x, gn0.y, gn0.z, gn0.w, gn1.x, gn1.y, gn1.z, gn1.w};
            float sm = 0.f;
#pragma unroll
            for (int e = 0; e < 8; ++e) sm += o[e];
            const float mean = half_sum(sm) * (1.f / 256.f);
            float sq = 0.f;
#pragma unroll
            for (int e = 0; e < 8; ++e) { o[e] -= mean; sq += o[e] * o[e]; }
            const float rstd = 1.0f / sqrtf(half_sum(sq) * (1.f / 256.f) + EPS);
#pragma unroll
            for (int e = 0; e < 8; ++e) { const float r = g[e] * sigmoidf_(g[e]) * (o[e] * rstd * gn[e]); res[e] = sigmoidf_(ga[e]) * ap[e] + sigmoidf_(gr[e]) * r; }
            *(v4u*)(F.MM + mm[u] * D + cc[u]) = pack8(res);
        }
    }
    const int gt = blockIdx.x * 512 + F.tid, NT = F.G * 512;
    for (int gi = gt; gi < (4 + 128) * 15 * 128; gi += NT) {
        const int c8 = gi & 127, rr = gi >> 7, r = rr % 15, bb = rr / 15;
        float v8[8]; float* dst;
        if (bb < 4) { unpack8(*(const v4u*)(F.PROJ + (size_t)(bb * 2048 + 2033 + r) * NIN + C_POOL + 8 * c8), v8); dst = F.out + O_POOLP + ((size_t)bb * 15 + r) * 1024 + 8 * c8; }
        else { const int b = bb - 4, e = 8 + r; dst = F.out + O_POOLS + ((size_t)b * 15 + r) * 1024 + 8 * c8;
            if (e < 15) ld8f(F.state_pool + ((size_t)b * 15 + e) * 1024 + 8 * c8, v8); else unpack8(*(const v4u*)(F.PROJ + (size_t)(MP + b * 8 + e - 15) * NIN + C_POOL + 8 * c8), v8); }
        *(f32x4*)dst = (f32x4){v8[0], v8[1], v8[2], v8[3]}; *(f32x4*)(dst + 4) = (f32x4){v8[4], v8[5], v8[6], v8[7]};
    }
}

__device__ __forceinline__ float pair_sum(float s, LAS float* px, int w) {
    const float t = wave_sum(s);
    __syncthreads(); px[w] = t; __syncthreads();
    return t + px[w ^ 1];
}
template <bool HALF> __device__ __forceinline__ void p5_row(Frame& F, int m, int half) {
    constexpr int NJ = HALF ? 2 : 4; const int jb = HALF ? 2 * half : 0, lane = F.lane;
    LAS float* px = (LAS float*)F.lds;
    const v4u* mo = (const v4u*)(F.MOB + (size_t)m * D) + lane + 64 * jb; const f32x4* xr = (const f32x4*)xrow(F, m) + 2 * lane + 128 * jb;
    const f32x4* g1 = (const f32x4*)F.g_post_mix + 2 * lane + 128 * jb; const f32x4* g2 = (const f32x4*)F.g_pre_ffn + 2 * lane + 128 * jb;
    v4u mv[NJ]; f32x4 x[NJ][2]; float v[NJ][8]; float s = 0.f;
#pragma unroll
    for (int j = 0; j < NJ; ++j) { mv[j] = __builtin_nontemporal_load(mo + 64 * j); x[j][0] = __builtin_nontemporal_load(xr + 128 * j); x[j][1] = __builtin_nontemporal_load(xr + 128 * j + 1); }
#pragma unroll
    for (int j = 0; j < NJ; ++j) { unpack8(mv[j], v[j]);
#pragma unroll
        for (int e = 0; e < 8; ++e) s += v[j][e] * v[j][e]; }
    const float rs = 1.0f / sqrtf((HALF ? pair_sum(s, px, F.wave) : wave_sum(s)) * (1.f / D) + EPS);
    float s2 = 0.f; v4u* yo = (v4u*)(F.X1B + (size_t)m * D) + lane + 64 * jb;
#pragma unroll
    for (int j = 0; j < NJ; ++j) {
        const f32x4 ga = g1[128 * j], gb = g1[128 * j + 1];
        x[j][0] = x[j][0] + (f32x4){v[j][0], v[j][1], v[j][2], v[j][3]} * rs * ga; x[j][1] = x[j][1] + (f32x4){v[j][4], v[j][5], v[j][6], v[j][7]} * rs * gb;
        { v4u o; o.x = pk2(x[j][0].x, x[j][0].y); o.y = pk2(x[j][0].z, x[j][0].w); o.z = pk2(x[j][1].x, x[j][1].y); o.w = pk2(x[j][1].z, x[j][1].w); yo[64 * j] = o; }
        s2 += (x[j][0].x * x[j][0].x + x[j][0].y * x[j][0].y) + (x[j][0].z * x[j][0].z + x[j][0].w * x[j][0].w) + (x[j][1].x * x[j][1].x + x[j][1].y * x[j][1].y) + (x[j][1].z * x[j][1].z + x[j][1].w * x[j][1].w);
    }
    const float rs2 = 1.0f / sqrtf((HALF ? pair_sum(s2, px, F.wave) : wave_sum(s2)) * (1.f / D) + EPS);
    v4u* o8 = (v4u*)(F.XN + (size_t)m * D) + lane + 64 * jb;
#pragma unroll
    for (int j = 0; j < NJ; ++j) { const f32x4 ga = g2[128 * j], gb = g2[128 * j + 1]; const f32x4 a = x[j][0] * rs2 * ga, b2 = x[j][1] * rs2 * gb;
        v4u o; o.x = pk2(a.x, a.y); o.y = pk2(a.z, a.w); o.z = pk2(b2.x, b2.y); o.w = pk2(b2.z, b2.w); o8[64 * j] = o; }
}
__device__ __forceinline__ void p5_rows(Frame& F) {
    const int mfull = (M / F.NGW) * F.NGW;
    for (int m = F.gw; m < mfull; m += F.NGW) p5_row<false>(F, m, 0);
    for (int base = mfull + 4 * (int)blockIdx.x; base < M; base += 4 * F.G) { const int m = base + (F.wave >> 1); if (m < M) p5_row<true>(F, m, F.wave & 1); else { __syncthreads(); __syncthreads(); __syncthreads(); __syncthreads(); } }
}
template <bool HALF> __device__ __forceinline__ void p9_row(Frame& F, int m, int half, float* dst) {
    constexpr int NJ = HALF ? 2 : 4; const int jb = HALF ? 2 * half : 0, lane = F.lane;
    LAS float* px = (LAS float*)F.lds;
    const v4u* fo = (const v4u*)(F.MOB + (size_t)m * D) + lane + 64 * jb; const v4u* yi = (const v4u*)(F.X1B + (size_t)m * D) + lane + 64 * jb; f32x4* yo = (f32x4*)(dst + (size_t)m * D) + 2 * lane + 128 * jb;
    const f32x4* g1 = (const f32x4*)F.g_post_ffn + 2 * lane + 128 * jb;
    v4u mv[NJ]; f32x4 x[NJ][2]; float v[NJ][8]; float s = 0.f;
#pragma unroll
    for (int j = 0; j < NJ; ++j) { mv[j] = __builtin_nontemporal_load(fo + 64 * j); const v4u xb = __builtin_nontemporal_load(yi + 64 * j); x[j][0] = (f32x4){bflo(xb.x), bfhi(xb.x), bflo(xb.y), bfhi(xb.y)}; x[j][1] = (f32x4){bflo(xb.z), bfhi(xb.z), bflo(xb.w), bfhi(xb.w)}; }
#pragma unroll
    for (int j = 0; j < NJ; ++j) { unpack8(mv[j], v[j]);
#pragma unroll
        for (int e = 0; e < 8; ++e) s += v[j][e] * v[j][e]; }
    const float rs = 1.0f / sqrtf((HALF ? pair_sum(s, px, F.wave) : wave_sum(s)) * (1.f / D) + EPS);
#pragma unroll
    for (int j = 0; j < NJ; ++j) { const f32x4 ga = g1[128 * j], gb = g1[128 * j + 1];
        __builtin_nontemporal_store(x[j][0] + (f32x4){v[j][0], v[j][1], v[j][2], v[j][3]} * rs * ga, yo + 128 * j); __builtin_nontemporal_store(x[j][1] + (f32x4){v[j][4], v[j][5], v[j][6], v[j][7]} * rs * gb, yo + 128 * j + 1); }
}
__device__ __forceinline__ void p9_rows(Frame& F, float* dst) {
    const int mfull = (M / F.NGW) * F.NGW;
    for (int m = F.gw; m < mfull; m += F.NGW) p9_row<false>(F, m, 0, dst);
    for (int base = mfull + 4 * (int)blockIdx.x; base < M; base += 4 * F.G) { const int m = base + (F.wave >> 1); if (m < M) p9_row<true>(F, m, F.wave & 1, dst); else { __syncthreads(); __syncthreads(); } }
}

__device__ __forceinline__ float gelu_tanh(float g) {
    const float u = (g * g) * (1.5957691216057308f * 0.044715f * 1.4426950408889634f) + (1.5957691216057308f * 1.4426950408889634f);
    return g * __builtin_amdgcn_rcpf(1.0f + __builtin_amdgcn_exp2f(-(g * u)));
}
__device__ __forceinline__ void p7_conv(Frame& F) {
    constexpr int NCG = FF / 4, NRB = M / 8, NIT = NRB * NCG;
    const int gt = blockIdx.x * 512 + F.tid, NT = F.G * 512;
#pragma unroll 1
    for (int it = gt; it < NIT; it += NT) {
        const int rb = it / NCG, cg = it - rb * NCG, f0 = 4 * cg, m0 = rb * 8;
        const bool is_p = m0 < MP; const int t0 = is_p ? (m0 & 2047) : 0; const int sb = is_p ? 0 : (m0 - MP) >> 3;
        const bf16* ub = F.UP + (size_t)m0 * FF2 + f0;
        v2u av[10], ag[10];
#pragma unroll
        for (int r = 0; r < 10; ++r) { const int rr = (r < 2 && t0 == 0) ? 2 : r; av[r] = *(const v2u*)(ub + (size_t)(rr - 2) * FF2); ag[r] = *(const v2u*)(ub + (size_t)(rr - 2) * FF2 + FF); }
        f32x4 wv[3], wg[3];
#pragma unroll
        for (int j = 0; j < 3; ++j) { wv[j] = *(const f32x4*)(F.conv_w + (size_t)j * FF2 + f0); wg[j] = *(const f32x4*)(F.conv_w + (size_t)j * FF2 + FF + f0); }
        const f32x4 cbv = *(const f32x4*)(F.conv_b + f0), cbg = *(const f32x4*)(F.conv_b + FF + f0);
        f32x4 hv[3], hg[3];
#pragma unroll
        for (int r = 0; r < 2; ++r) {
            if (!is_p) { const float* sc = F.state_conv + ((size_t)sb * 2 + r) * FF2 + f0; hv[r + 1] = *(const f32x4*)sc; hg[r + 1] = *(const f32x4*)(sc + FF); }
            else if (t0 == 0) { hv[r + 1] = (f32x4){0.f, 0.f, 0.f, 0.f}; hg[r + 1] = hv[r + 1]; }
            else { hv[r + 1] = (f32x4){bflo(av[r].x), bfhi(av[r].x), bflo(av[r].y), bfhi(av[r].y)}; hg[r + 1] = (f32x4){bflo(ag[r].x), bfhi(ag[r].x), bflo(ag[r].y), bfhi(ag[r].y)}; }
        }
#pragma unroll
        for (int r = 0; r < 8; ++r) {
            const v2u rv = av[r + 2], rg = ag[r + 2];
            hv[0] = hv[1]; hv[1] = hv[2]; hg[0] = hg[1]; hg[1] = hg[2];
            hv[2] = (f32x4){bflo(rv.x), bfhi(rv.x), bflo(rv.y), bfhi(rv.y)}; hg[2] = (f32x4){bflo(rg.x), bfhi(rg.x), bflo(rg.y), bfhi(rg.y)};
            const f32x4 val = cbv + wv[0] * hv[0] + wv[1] * hv[1] + wv[2] * hv[2], gate = cbg + wg[0] * hg[0] + wg[1] * hg[1] + wg[2] * hg[2];
            f32x4 a; a.x = gelu_tanh(gate.x) * val.x; a.y = gelu_tanh(gate.y) * val.y; a.z = gelu_tanh(gate.z) * val.z; a.w = gelu_tanh(gate.w) * val.w;
            *(v2u*)(F.ACT + (size_t)(m0 + r) * FF + f0) = pack4(a);
            if (r >= 6) {
                float* o = nullptr;
                if (is_p) { if (t0 == 2040) o = F.out + O_CONVP + ((size_t)(m0 >> 11) * 2 + (r - 6)) * FF2; } else o = F.out + O_CONVS + ((size_t)sb * 2 + (r - 6)) * FF2;
                if (o) { *(f32x4*)(o + f0) = hv[2]; *(f32x4*)(o + FF + f0) = hg[2]; }
            }
        }
    }
}

struct Args { const float* in[18]; float* out; unsigned char* ws; int ph_lo, ph_hi, li, pad; };
template <int LO, int HI> __global__ void __launch_bounds__(NWAVES * 64, 2) skel_fwd(Args args) {
    extern __shared__ __attribute__((aligned(16))) unsigned char lds[];
    Frame F;
    F.lds = (LAS unsigned char*)lds;
    F.MISC = (volatile LAS unsigned*)(F.lds + LDSCTL_OFF);
    F.tid = threadIdx.x; F.lane = F.tid & 63; F.wave = __builtin_amdgcn_readfirstlane(F.tid >> 6);
    F.G = gridDim.x; F.gw = blockIdx.x * NWAVES + F.wave; F.NGW = F.G * NWAVES;
    unsigned char* ws = args.ws;
    F.ctl = (unsigned*)(ws + WS_CTL);
    F.xp = args.in[0]; F.xs = args.in[1]; F.state_pool = args.in[2]; F.state_ret = args.in[3]; F.state_conv = args.in[4]; F.g_pre_mix = args.in[5]; F.w_in = args.in[6]; F.w_pool = args.in[7];
    F.pool_scale = args.in[8]; F.gn_gain = args.in[9]; F.w_out = args.in[10]; F.g_post_mix = args.in[11]; F.g_pre_ffn = args.in[12]; F.w_up = args.in[13]; F.conv_w = args.in[14]; F.conv_b = args.in[15];
    F.w_down = args.in[16]; F.g_post_ffn = args.in[17]; F.out = args.out;
    F.WIN = (bf16*)(ws + WS_WIN); F.WUP = (bf16*)(ws + WS_WUP); F.WDN = (bf16*)(ws + WS_WDN); F.WOUT = (bf16*)(ws + WS_WOUT); F.WPOOL = (bf16*)(ws + WS_WPOOL);
    F.ROPE_C = (float*)(ws + WS_ROPE); F.ROPE_S = F.ROPE_C + 2056 * 64;
    F.XN = (bf16*)(ws + WS_XN); F.PROJ = (bf16*)(ws + WS_PROJ); F.UP = (bf16*)(ws + WS_PROJ); F.MOB = (bf16*)(ws + WS_PROJ);
    F.SP16 = (bf16*)(ws + WS_SP16); F.X1B = (bf16*)(ws + WS_X1);
    F.OB = (bf16*)(ws + WS_O); F.AP = (bf16*)(ws + WS_AP); F.MM = (bf16*)(ws + WS_MM); F.ACT = (bf16*)(ws + WS_O);
    for (int u = F.tid; u < (LDS_BYTES - LDSCTL_OFF) / 4; u += NWAVES * 64) ((LAS unsigned*)(F.lds + LDSCTL_OFF))[u] = 0u;
    __syncthreads();
    XcdBarrier bar; bar.bar = F.ctl + CW_BAR; bar.x = 0; bar.st = nullptr;
    if (N_LAUNCHES == 1) bar = xcd_barrier_post(F.ctl + CW_BAR, F.MISC + 8);
#define GRID_BAR() do { if (N_LAUNCHES == 1) xcd_barrier(bar); } while (0)
#define IN(k) (LO <= (k) && (k) < HI)
#define FRESH() do { int t_ = threadIdx.x; asm volatile("" : "+v"(t_)); F.tid = t_; F.lane = t_ & 63; } while (0)
#define SEAM(k) do { if constexpr (IN(k) && IN((k) + 1)) GRID_BAR(); } while (0)

#define REPS(k)
#define DUPBAR(k)
    const int rep = args.li;
    if constexpr (IN(0)) { FRESH(); REPS(0) { p0_prologue(F); DUPBAR(0); } SEAM(0); }
    if constexpr (IN(1)) {
      REPS(1) {
        pg8::Gemm g{F.XN, F.WIN, M, NIN, D}; pg8::HybridOrder S; S.init(M, NIN, D, F.G, (int)blockIdx.x, false);
        EpiProj E{F.PROJ, F.ROPE_C, F.ROPE_S}; pg8::SplitCtx X{(float*)(ws + WS_SLAB_A), F.ctl + CW_SPLIT};
        pg8::gemm_phase<EpiProj, pg8::HybridOrder, true, PG8_SP2, 5>(F.lds, g, S, E, X);
        if (rep == 0) { FRESH(); p0_deferred_weights(F, (LAS float*)(F.lds + F.wave * 16384)); }
        DUPBAR(1);
      }
        SEAM(1);
    }
    if constexpr (IN(2)) { FRESH(); REPS(2) { p2_mixers(F, rep); DUPBAR(2); } SEAM(2); }
    if constexpr (IN(3)) { FRESH(); REPS(3) { p3_merge(F); DUPBAR(3); } SEAM(3); }
    if constexpr (IN(4)) {
      REPS(4) {
        pg8::Gemm g{F.MM, F.WOUT, M, D, D}; pg8::HybridOrder S; S.init(M, D, D, F.G, (int)blockIdx.x);
        pg8::EpiBf16<0> E{F.MOB, D}; pg8::SplitCtx X{(float*)(ws + WS_SLAB_A), F.ctl + CW_SPLIT + 4096};
        pg8::gemm_phase<pg8::EpiBf16<0>, pg8::HybridOrder, true, PG8_SP2, 8>(F.lds, g, S, E, X);
        DUPBAR(4);
      }
        SEAM(4);
    }
    if constexpr (IN(5)) { FRESH(); REPS(5) { p5_rows(F); DUPBAR(5); } SEAM(5); }
    if constexpr (IN(6)) {
      REPS(6) {
        pg8::Gemm g{F.XN, F.WUP, M, FF2, D}; pg8::HybridOrder S; S.init(M, FF2, D, F.G, (int)blockIdx.x);
        pg8::EpiBf16<0> E{F.UP, FF2}; pg8::SplitCtx X{(float*)(ws + WS_SLAB_A), F.ctl + CW_SPLIT + 2 * 4096};
        pg8::gemm_phase<pg8::EpiBf16<0>, pg8::HybridOrder, true, PG8_SP2, 5>(F.lds, g, S, E, X);
        DUPBAR(6);
      }
        SEAM(6);
    }
    if constexpr (IN(7)) { FRESH(); REPS(7) { p7_conv(F); DUPBAR(7); } SEAM(7); }
    if constexpr (IN(8)) {
      REPS(8) {
        pg8::Gemm g{F.ACT, F.WDN, M, D, FF}; pg8::HybridOrder S; S.init(M, D, FF, F.G, (int)blockIdx.x);
        pg8::EpiBf16<0> E{F.MOB, D}; pg8::SplitCtx X{(float*)(ws + WS_SLAB_B), F.ctl + CW_SPLIT + 3 * 4096};
        pg8::gemm_phase<pg8::EpiBf16<0>, pg8::HybridOrder, true, PG8_SP2, 8>(F.lds, g, S, E, X);
        DUPBAR(8);
      }
        SEAM(8);
    }
    if constexpr (IN(9)) { FRESH(); p9_rows(F, (DUP_PHASE == 9 && rep == 1) ? (float*)(ws + WS_O) : F.out + O_Y); }
#undef IN
#undef SEAM
}


#if MK_N_LAUNCHES != 1
template <int P> static void launch_one(int grid, const Args& a, hipStream_t stream) { hipLaunchKernelGGL((skel_fwd<P, P + 1>), dim3(grid), dim3(NWAVES * 64), LDS_BYTES, stream, a); }
static void launch_phase(int li, int grid, const Args& a, hipStream_t stream) {
    switch (li) { case 0: launch_one<0>(grid, a, stream); break; case 1: launch_one<1>(grid, a, stream); break; case 2: launch_one<2>(grid, a, stream); break; case 3: launch_one<3>(grid, a, stream); break;
        case 4: launch_one<4>(grid, a, stream); break; case 5: launch_one<5>(grid, a, stream); break; case 6: launch_one<6>(grid, a, stream); break; case 7: launch_one<7>(grid, a, stream); break;
        case 8: launch_one<8>(grid, a, stream); break; default: launch_one<9>(grid, a, stream); break; }
}
#endif
static hipError_t set_lds_attr() {
    hipError_t e = hipSuccess;
#if MK_N_LAUNCHES == 1
    e = hipFuncSetAttribute((const void*)skel_fwd<0, N_PHASES>, hipFuncAttributeMaxDynamicSharedMemorySize, LDS_BYTES);
#else
#define SET1(P) if (e == hipSuccess) e = hipFuncSetAttribute((const void*)skel_fwd<P, P + 1>, hipFuncAttributeMaxDynamicSharedMemorySize, LDS_BYTES)
    SET1(0); SET1(1); SET1(2); SET1(3); SET1(4); SET1(5); SET1(6); SET1(7); SET1(8); SET1(9);
#undef SET1
#endif
    return e;
}
static hipError_t occ_query(int* per_cu) {
#if MK_N_LAUNCHES == 1
    return hipOccupancyMaxActiveBlocksPerMultiprocessor(per_cu, (const void*)skel_fwd<0, N_PHASES>, NWAVES * 64, LDS_BYTES);
#else
    return hipOccupancyMaxActiveBlocksPerMultiprocessor(per_cu, (const void*)skel_fwd<1, 2>, NWAVES * 64, LDS_BYTES);
#endif
}
extern "C" void kernel_launch(void* const* d_in, const int* in_sizes, int n_in, void* d_out, int out_size, void* d_ws, size_t ws_size, hipStream_t stream) {
    static int grid = 0;
    if (grid == 0) {
        if (n_in != 18 || (size_t)out_size != O_END || ws_size < WS_END) { fprintf(stderr, "kernel_launch: unexpected shapes: n_in %d out %d ws %zu (need %zu)\n", n_in, out_size, ws_size, (size_t)WS_END); grid = -1; return; }
        int dev = 0, cus = 0, per_cu = 0;
        if (hipGetDevice(&dev) != hipSuccess || hipDeviceGetAttribute(&cus, hipDeviceAttributeMultiprocessorCount, dev) != hipSuccess) { grid = -1; return; }
        if (set_lds_attr() != hipSuccess) { fprintf(stderr, "kernel_launch: hipFuncSetAttribute failed\n"); grid = -1; return; }
        if (occ_query(&per_cu) != hipSuccess || per_cu < 1) { fprintf(stderr, "kernel_launch: occupancy query says %d blocks per CU\n", per_cu); (void)hipGetLastError(); per_cu = 1; }
        grid = cus;
        fprintf(stderr, "kernel_launch: cus %d per_cu %d grid %d ws %zu\n", cus, per_cu, grid, ws_size);
    }
    if (grid < 0) return;
    (void)hipMemsetAsync((char*)d_ws + WS_CTL, 0, CTL_ZERO_BYTES, stream);
    Args a{};
    for (int i = 0; i < 18; ++i) a.in[i] = (const float*)d_in[i];
    a.out = (float*)d_out; a.ws = (unsigned char*)d_ws;
#if MK_N_LAUNCHES == 1
    {
        a.ph_lo = 0; a.ph_hi = N_PHASES; a.li = 0;
        void* kargs[] = {&a};
        hipError_t e = hipLaunchCooperativeKernel((const void*)skel_fwd<0, N_PHASES>, dim3(grid), dim3(NWAVES * 64), kargs, LDS_BYTES, stream);
        if (e != hipSuccess) fprintf(stderr, "kernel_launch: cooperative launch failed: %s (grid %d)\n", hipGetErrorString(e), grid);
    }
#else
    for (int li = 0; li < N_PHASES; ++li) { a.ph_lo = li; a.ph_hi = li + 1; a.li = 0; launch_phase(li, grid, a, stream); if (li == DUP_PHASE) { a.li = 1; launch_phase(li, grid, a, stream); if (li == 9) { a.li = 0; } } if (li == 2 && DUP_PHASE >= 20) { a.li = 1 + 16 * (DUP_PHASE - 20); launch_phase(li, grid, a, stream); } }
#endif
}
```

```cpp
#include <hip/hip_runtime.h>
#include <cstdio>
#include <cstdint>
namespace pg8 {
#define PG8_LAS __attribute__((address_space(3)))
typedef unsigned short bf16_t;
typedef short bf16x8 __attribute__((ext_vector_type(8)));
typedef float f32x4 __attribute__((ext_vector_type(4)));
typedef unsigned u32x4 __attribute__((ext_vector_type(4)));
constexpr int BM = 256, BK = 64, HALF = 128, HTB = HALF * BK * 2  , STAGE_BYTES = 8 * HTB, NXCD = 8, WGM = 4;

__host__ __device__ __forceinline__ int lds_byte(int r, int c) { const int st = (r >> 4) * 2 + (c >> 5), rr = r & 15, cc = c & 31, ob = rr * 64 + cc * 2; return st * 1024 + (ob ^ (((ob >> 9) & 1) << 5)); }
__host__ __device__ __forceinline__ void stage_rc(int b, int& R, int& C) { const int st = b / 1024, sb = b % 1024, swz = sb ^ (((sb >> 9) & 1) << 5); R = (st >> 1) * 16 + swz / 64; C = (st & 1) * 32 + (swz % 64) / 2; }
__host__ __device__ __forceinline__ int perm32(int rho) { const int n = rho >> 4, i = rho & 15; return 8 * (i >> 2) + 4 * n + (i & 3); }

struct Unit { int pm, pn, k0, nt, np, piece, slot; };
struct Gemm { const bf16_t* A; const bf16_t* Bt; int M, N, K; };

struct StaticOrder {
    int nM, nN, nwg, G, c;
    __host__ __device__ void init(int M, int N, int G_, int c_) { nM = M / BM; nN = N / BM; nwg = nM * nN; G = G_; c = c_; }
    __host__ __device__ bool next(int i, Unit& u) const {
        const long L = (long)i * G + c; if (L >= nwg) return false;
        int wgid = (int)L;
#ifndef ORDER_NOREMAP
        { const int q = nwg / NXCD, r = nwg % NXCD, xcd = wgid % NXCD, off = wgid / NXCD; wgid = (xcd < r ? xcd * (q + 1) : r * (q + 1) + (xcd - r) * q) + off; }
#endif
        const int nig = WGM * nN, gid = wgid / nig, fm = gid * WGM, gsz = (nM - fm) < WGM ? (nM - fm) : WGM;
        u.pm = fm + ((wgid % nig) % gsz); u.pn = (wgid % nig) / gsz; return true;
    }
    __device__ __forceinline__ void a_ready(const Unit&) const {}
    __device__ __forceinline__ void done(const Unit&) const {}
};


struct HybridOrder {
    int nM, nN, nwg, G, c, ntk, nfull, nrem, np;
    __host__ __device__ void init(int M, int N, int K, int G_, int c_, bool allow_split = true) {
        nM = M / BM; nN = N / BM; nwg = nM * nN; G = G_; c = c_; ntk = K / BK; nfull = nwg / G; nrem = nwg - nfull * G; np = 0;
        if (allow_split && nrem > 0 && (G % NXCD) == 0) { const int grp = (nrem + NXCD - 1) / NXCD; int p = (G / NXCD) / grp; const int maxp = ntk / 4; if (p > maxp) p = maxp; if (p > 8) p = 8; if (p >= 2) np = p; }
    }
    __host__ __device__ void map(long L, Unit& u) const {
        int wgid = (int)L;
#ifndef ORDER_NOREMAP
        { const int q = nwg / NXCD, r = nwg % NXCD, xcd = wgid % NXCD, off = wgid / NXCD; wgid = (xcd < r ? xcd * (q + 1) : r * (q + 1) + (xcd - r) * q) + off; }
#endif
        const int nig = WGM * nN, gid = wgid / nig, fm = gid * WGM, gsz = (nM - fm) < WGM ? (nM - fm) : WGM;
        u.pm = fm + ((wgid % nig) % gsz); u.pn = (wgid % nig) / gsz; u.k0 = 0; u.nt = ntk; u.np = 0; u.piece = 0; u.slot = 0;
    }
    __host__ __device__ bool next(int i, Unit& u) const {
        if (i < nfull) { map((long)i * G + c, u); return true; }
        if (i > nfull || nrem == 0) return false;
        if (np == 0) { if (c >= nrem) return false; map((long)nfull * G + c, u); return true; }
        const int x = c % NXCD, j = c / NXCD, grp = j / np, p = j - grp * np, r = grp * NXCD + x;
        if (r >= nrem) return false;
        map((long)nfull * G + r, u);
        const int pairs = ntk / 2, base = pairs / np, extra = pairs - base * np, first_big = np - extra;
        const int start = p * base + (p > first_big ? p - first_big : 0), len = base + (p >= first_big ? 1 : 0);
        u.k0 = 2 * start; u.nt = 2 * len; u.np = np; u.piece = p; u.slot = r; return true;
    }
    __device__ __forceinline__ void a_ready(const Unit&) const {}
    __device__ __forceinline__ void done(const Unit&) const {}
};
struct PartOrder {
    static constexpr int PWGM = 2;
    int nM, nN, nwg, ntk, ng, base, size, j, nhelp, hrank;
    __host__ __device__ void init(int M, int N, int K, int G, int c) {
        nM = M / BM; nN = N / BM; nwg = nM * nN; ntk = K / BK;
        const int R = (nwg + G - 1) / G, Gp = (nwg + R - 1) / R; nhelp = G - Gp;
        const int NX = (G % NXCD) == 0 ? NXCD : 1, per = G / NX, x = c % NX; j = c / NX;
        int b0 = 0; ng = 0;
        for (int y = 0; y <= x; ++y) { const int nh = nhelp / NX + (y < nhelp % NX ? 1 : 0), g = per - nh; if (y < x) b0 += g * R; else ng = g; }
        base = b0 < nwg ? b0 : nwg; const int e = b0 + ng * R; size = (e < nwg ? e : nwg) - base;
        hrank = j >= ng ? (j - ng) * NX + x : -1;
    }
    __host__ __device__ bool next(int i, Unit& u) const {
        const int local = i * ng + j; if (j >= ng || local >= size) return false;
        const int wgid = base + local, nig = PWGM * nN, gid = wgid / nig, fm = gid * PWGM, gsz = (nM - fm) < PWGM ? (nM - fm) : PWGM;
        u.pm = fm + ((wgid % nig) % gsz); u.pn = (wgid % nig) / gsz; u.k0 = 0; u.nt = ntk; u.np = 0; u.piece = 0; u.slot = 0; return true;
    }
    __device__ __forceinline__ void a_ready(const Unit&) const {}
    __device__ __forceinline__ void done(const Unit&) const {}
};
struct SplitCtx { float* slabs; unsigned* cnt; };

__device__ __forceinline__ unsigned cvt_pk_bf16(float lo, float hi) { unsigned r; asm volatile("v_cvt_pk_bf16_f32 %0, %1, %2" : "=v"(r) : "v"(lo), "v"(hi)); return r; }
typedef float f32x2 __attribute__((ext_vector_type(2)));
__device__ __forceinline__ f32x2 gelu_pk(f32x2 v) {
    const f32x2 av = __builtin_elementwise_abs(v), d = av * 0.2316418882f + 1.0f;
    f32x2 t; t.x = __builtin_amdgcn_rcpf(d.x); t.y = __builtin_amdgcn_rcpf(d.y);
    f32x2 q = t * 0.5307027145f + (-0.7265760135f); q = q * t + 0.7107068705f; q = q * t + (-0.142248368f); q = q * t + 0.127414796f; q = q * t;
    const f32x2 s = (v * v) * (-0.72134752044f);
    f32x2 e; e.x = __builtin_amdgcn_exp2f(s.x); e.y = __builtin_amdgcn_exp2f(s.y);
    const f32x2 m = v * (q * e), r = v - m;
    f32x2 o; o.x = v.x < 0.f ? m.x : r.x; o.y = v.y < 0.f ? m.y : r.y; return o;
}

template <int ACT> struct EpiBf16 {
    static constexpr bool PERM = true, AFTER_DRAIN = false;
    bf16_t* O; int ldc;
    __device__ __forceinline__ void tri(const f32x4 v0, const f32x4 v1, const Unit& u, int ai, int bj, int m, int wr, int wc, int fr, int fq) const {
        bf16_t* p = O + (size_t)(u.pm * BM + ai * HALF + wr * 64 + m * 16 + fr) * ldc + u.pn * BM + bj * HALF + wc * 32 + 8 * fq;
        u32x4 w; w.x = cvt_pk_bf16(v0[0], v0[1]); w.y = cvt_pk_bf16(v0[2], v0[3]); w.z = cvt_pk_bf16(v1[0], v1[1]); w.w = cvt_pk_bf16(v1[2], v1[3]);
        *(u32x4*)p = w;
    }
    __device__ __forceinline__ void operator()(const f32x4 (&acc)[2][2][4][2], const Unit& u, int wr, int wc, int fr, int fq) const {
#pragma unroll
        for (int ai = 0; ai < 2; ++ai)
#pragma unroll
            for (int m = 0; m < 4; ++m)
#pragma unroll
                for (int bj = 0; bj < 2; ++bj) tri(acc[ai][bj][m][0], acc[ai][bj][m][1], u, ai, bj, m, wr, wc, fr, fq);
    }
};
struct EpiF32 {
    static constexpr bool PERM = false, AFTER_DRAIN = false;
    float* C; int ldc;
    __device__ __forceinline__ void tri(const f32x4 v0, const f32x4 v1, const Unit& u, int ai, int bj, int m, int wr, int wc, int fr, int fq) const {
        float* p = C + (size_t)(u.pm * BM + ai * HALF + wr * 64 + m * 16 + fr) * ldc + u.pn * BM + bj * HALF + wc * 32 + 4 * fq;
        *(f32x4*)p = v0; *(f32x4*)(p + 16) = v1;
    }
    __device__ __forceinline__ void operator()(const f32x4 (&acc)[2][2][4][2], const Unit& u, int wr, int wc, int fr, int fq) const {
#pragma unroll
        for (int ai = 0; ai < 2; ++ai)
#pragma unroll
            for (int m = 0; m < 4; ++m)
#pragma unroll
                for (int bj = 0; bj < 2; ++bj) tri(acc[ai][bj][m][0], acc[ai][bj][m][1], u, ai, bj, m, wr, wc, fr, fq);
    }
};
typedef unsigned u32x2 __attribute__((ext_vector_type(2)));
__device__ __forceinline__ f32x4 bf4_to_f32(u32x2 x) { f32x4 o; o[0] = __builtin_bit_cast(float, x.x << 16); o[1] = __builtin_bit_cast(float, x.x & 0xffff0000u); o[2] = __builtin_bit_cast(float, x.y << 16); o[3] = __builtin_bit_cast(float, x.y & 0xffff0000u); return o; }
template <int NP, class Epi> __device__ __forceinline__ void split_epilogue(const f32x4 (&acc)[2][2][4][2], const Unit& u, const Epi& E, const SplitCtx& X, int tid, int wr, int wc, int fr, int fq) {
    constexpr int SLAB = 32 * 512 * 8;
    const __amdgpu_buffer_rsrc_t rs = __builtin_amdgcn_make_buffer_rsrc((void*)((char*)X.slabs + (size_t)(u.slot * u.np) * SLAB), 0, u.np * SLAB, 0x00020000);
    {
        const int so = u.piece * SLAB;
#pragma unroll
        for (int r = 0; r < 32; ++r) { const f32x4 v = acc[r >> 4][(r >> 3) & 1][(r >> 1) & 3][r & 1]; u32x2 w; w.x = cvt_pk_bf16(v[0], v[1]); w.y = cvt_pk_bf16(v[2], v[3]);
            __builtin_amdgcn_raw_buffer_store_b64(w, rs, (unsigned)(tid * 8), so + r * 4096, 16); }
    }
    asm volatile("s_waitcnt vmcnt(0)" ::: "memory");
    asm volatile("" ::: "memory"); __builtin_amdgcn_s_barrier(); asm volatile("" ::: "memory");
    if (tid == 0) {
        unsigned* cw = X.cnt + 64 * u.slot;
        (void)__hip_atomic_fetch_add(cw, 1u, __ATOMIC_RELAXED, __HIP_MEMORY_SCOPE_AGENT);
        unsigned sp = 0;
        while (__hip_atomic_load(cw, __ATOMIC_RELAXED, __HIP_MEMORY_SCOPE_AGENT) < (unsigned)u.np) { __builtin_amdgcn_s_sleep(1); if (++sp > (1u << 24)) break; }
    }
    asm volatile("" ::: "memory"); __builtin_amdgcn_s_barrier(); asm volatile("" ::: "memory");
    const int q0 = (16 * u.piece) / u.np, q1 = (16 * (u.piece + 1)) / u.np;
#pragma unroll 1
    for (int q = q0; q < q1; ++q) {
        const unsigned vo = (unsigned)(tid * 8 + q * 8192);
        f32x4 v0 = (f32x4){0.f, 0.f, 0.f, 0.f}, v1 = v0;
        if (u.np == NP) {
            u32x2 t0[NP], t1[NP];
#pragma unroll
            for (int pp = 0; pp < NP; ++pp) { t0[pp] = __builtin_amdgcn_raw_buffer_load_b64(rs, vo, pp * SLAB, 16); t1[pp] = __builtin_amdgcn_raw_buffer_load_b64(rs, vo, pp * SLAB + 4096, 16); }
#pragma unroll
            for (int pp = 0; pp < NP; ++pp) { v0 += bf4_to_f32(t0[pp]); v1 += bf4_to_f32(t1[pp]); }
        } else {
            for (int pp = 0; pp < u.np; ++pp) { v0 += bf4_to_f32(__builtin_amdgcn_raw_buffer_load_b64(rs, vo, pp * SLAB, 16)); v1 += bf4_to_f32(__builtin_amdgcn_raw_buffer_load_b64(rs, vo, pp * SLAB + 4096, 16)); }
        }
        E.tri(v0, v1, u, q >> 3, (q >> 2) & 1, q & 3, wr, wc, fr, fq);
    }
}
template <class Epi, class Sched, bool ALIGN_EPI = false, bool SP2 = false, int NP = 8>
__device__ __forceinline__ void gemm_phase(PG8_LAS unsigned char* lds, const Gemm g, const Sched& S, const Epi& E, const SplitCtx& X) {
    int tid_ = threadIdx.x; asm volatile("" : "+v"(tid_));
    const int tid = tid_, wid = __builtin_amdgcn_readfirstlane(tid >> 6), lane = tid & 63, wr = wid >> 2, wc = wid & 3, fr = lane & 15, fq = lane >> 4;
    const int K = g.K;
    unsigned voffA[2], voffB[2];
#pragma unroll
    for (int i = 0; i < 2; ++i) { int R, C; stage_rc(tid * 16 + i * 8192, R, C); const int Rb = Epi::PERM ? ((R & ~31) + perm32(R & 31)) : R;
        voffA[i] = (unsigned)(R * K + C) * 2u; voffB[i] = (unsigned)(Rb * K + C) * 2u; }
    const size_t kstep = (size_t)(BK * 2);
    const size_t hstep = (size_t)HALF * K * 2;
    const size_t tstep = 2 * hstep;
    const unsigned ldsw = (unsigned)wid * 1024u;
    const int aoff = lds_byte(wr * 64 + fr, fq * 8), boff = lds_byte(wc * 32 + fr, fq * 8);
#define PG8_SA(b, h) (((b) * 2 + (h)) * HTB)
#define PG8_SB(b, h) ((4 + (b) * 2 + (h)) * HTB)
#define PG8_STAGE(bufoff, gbase, voff) do { _Pragma("unroll") for (int _i = 0; _i < 2; ++_i) \
        __builtin_amdgcn_global_load_lds((const unsigned*)((const char*)(gbase) + (voff)[_i]), (PG8_LAS unsigned*)(lds + (bufoff) + ldsw + _i * 8192), 16, 0, 0); } while (0)
#define PG8_LDA(dst, b, h) do { _Pragma("unroll") for (int m = 0; m < 4; ++m) _Pragma("unroll") for (int k = 0; k < 2; ++k) dst[m][k] = *(const PG8_LAS bf16x8*)(lds + PG8_SA(b, h) + aoff + m * 2048 + k * 1024); } while (0)
#define PG8_LDB(dst, b, h) do { _Pragma("unroll") for (int n = 0; n < 2; ++n) _Pragma("unroll") for (int k = 0; k < 2; ++k) dst[n][k] = *(const PG8_LAS bf16x8*)(lds + PG8_SB(b, h) + boff + n * 2048 + k * 1024); } while (0)
#define PG8_MMA(ai, bj, At, Bt) do { __builtin_amdgcn_s_setprio(1); _Pragma("unroll") for (int m = 0; m < 4; ++m) _Pragma("unroll") for (int n = 0; n < 2; ++n) _Pragma("unroll") for (int k = 0; k < 2; ++k) \
        acc[ai][bj][m][n] = __builtin_amdgcn_mfma_f32_16x16x32_bf16(Bt[n][k], At[m][k], acc[ai][bj][m][n], 0, 0, 0); __builtin_amdgcn_s_setprio(0); } while (0)
#define PG8_WAIT_V(n) asm volatile("s_waitcnt vmcnt(" #n ")" ::: "memory")
#define PG8_WAIT_L(n) asm volatile("s_waitcnt lgkmcnt(" #n ")" ::: "memory")
#define PG8_BAR __builtin_amdgcn_s_barrier()
#define PG8_SCHED __builtin_amdgcn_sched_barrier(0)
    Unit cur, nxt; int ui = 0;
    if (!S.next(0, cur)) return;
    f32x4 acc[2][2][4][2];
#pragma unroll
    for (int a = 0; a < 2; ++a)
#pragma unroll
        for (int b = 0; b < 2; ++b)
#pragma unroll
            for (int m = 0; m < 4; ++m)
#pragma unroll
                for (int n = 0; n < 2; ++n) acc[a][b][m][n] = (f32x4){0.f, 0.f, 0.f, 0.f};
    bf16x8 At[4][2], B0[2][2], B1[2][2];
    const char* cA = (const char*)g.A + (size_t)cur.pm * tstep + (size_t)cur.k0 * kstep; const char* cB = (const char*)g.Bt + (size_t)cur.pn * tstep + (size_t)cur.k0 * kstep;
    S.a_ready(cur);
    if constexpr (SP2) {
        PG8_STAGE(PG8_SB(0, 0), cB, voffB); PG8_STAGE(PG8_SB(0, 1), cB + hstep, voffB); PG8_STAGE(PG8_SA(0, 0), cA, voffA); PG8_STAGE(PG8_SA(0, 1), cA + hstep, voffA);
        if (wr == 1) PG8_BAR;
        PG8_WAIT_V(2); PG8_BAR;
        PG8_STAGE(PG8_SB(1, 0), cB + kstep, voffB); PG8_STAGE(PG8_SA(1, 0), cA + kstep, voffA); PG8_STAGE(PG8_SB(1, 1), cB + hstep + kstep, voffB);
        PG8_WAIT_V(6); PG8_BAR;
    } else {
        PG8_STAGE(PG8_SB(0, 0), cB, voffB); PG8_STAGE(PG8_SA(0, 0), cA, voffA); PG8_STAGE(PG8_SB(0, 1), cB + hstep, voffB); PG8_STAGE(PG8_SA(0, 1), cA + hstep, voffA);
        if (wr == 1) PG8_BAR;
        PG8_WAIT_V(4); PG8_BAR;
        PG8_STAGE(PG8_SB(1, 0), cB + kstep, voffB); PG8_STAGE(PG8_SA(1, 0), cA + kstep, voffA); PG8_STAGE(PG8_SB(1, 1), cB + hstep + kstep, voffB);
        PG8_WAIT_V(6); PG8_BAR;
    }
    for (;;) {
        const bool has_next = S.next(ui + 1, nxt);
        const char* nA = has_next ? (const char*)g.A + (size_t)nxt.pm * tstep + (size_t)nxt.k0 * kstep : cA; const char* nB = has_next ? (const char*)g.Bt + (size_t)nxt.pn * tstep + (size_t)nxt.k0 * kstep : cB;
        const int nt = cur.nt;
        for (int t = 0; t < nt; t += 2) {
            const bool last = (t == nt - 2);
            const char* a1 = cA + (size_t)(t + 1) * kstep;
            const char* a2 = last ? nA : cA + (size_t)(t + 2) * kstep; const char* b2 = last ? nB : cB + (size_t)(t + 2) * kstep;
            const char* a3 = a2 + kstep; const char* b3 = b2 + kstep;
            if (last && has_next) S.a_ready(nxt);
            if constexpr (SP2) {
            PG8_LDB(B0, 0, 0); PG8_LDB(B1, 0, 1); PG8_SCHED; PG8_LDA(At, 0, 0); PG8_STAGE(PG8_SA(1, 1), a1 + hstep, voffA);
            PG8_WAIT_V(8); PG8_WAIT_L(0); PG8_BAR; PG8_MMA(0, 0, At, B0); PG8_MMA(0, 1, At, B1); PG8_BAR; PG8_SCHED;
            PG8_LDA(At, 0, 1); PG8_STAGE(PG8_SB(0, 0), b2, voffB); PG8_STAGE(PG8_SB(0, 1), b2 + hstep, voffB); PG8_STAGE(PG8_SA(0, 0), a2, voffA);
            PG8_WAIT_V(8); PG8_WAIT_L(0); PG8_BAR; PG8_MMA(1, 0, At, B0); PG8_MMA(1, 1, At, B1); PG8_BAR; PG8_SCHED;
            PG8_LDB(B0, 1, 0); PG8_LDB(B1, 1, 1); PG8_SCHED; PG8_LDA(At, 1, 0); PG8_STAGE(PG8_SA(0, 1), a2 + hstep, voffA);
            PG8_WAIT_V(8); PG8_WAIT_L(0); PG8_BAR; PG8_MMA(0, 0, At, B0); PG8_MMA(0, 1, At, B1); PG8_BAR; PG8_SCHED;
            PG8_LDA(At, 1, 1); PG8_STAGE(PG8_SB(1, 0), b3, voffB); PG8_STAGE(PG8_SB(1, 1), b3 + hstep, voffB); PG8_STAGE(PG8_SA(1, 0), a3, voffA);
            PG8_WAIT_V(8); PG8_WAIT_L(0); PG8_BAR; PG8_MMA(1, 0, At, B0); PG8_MMA(1, 1, At, B1); PG8_BAR; PG8_SCHED;
            } else {
            PG8_LDB(B0, 0, 0); PG8_SCHED; PG8_LDA(At, 0, 0); PG8_STAGE(PG8_SA(1, 1), a1 + hstep, voffA);
            PG8_WAIT_L(8); PG8_BAR; PG8_WAIT_L(0); PG8_MMA(0, 0, At, B0); PG8_BAR; PG8_SCHED;
            PG8_LDB(B1, 0, 1); PG8_STAGE(PG8_SB(0, 0), b2, voffB);
            PG8_BAR; PG8_WAIT_L(0); PG8_MMA(0, 1, At, B1); PG8_BAR;
            PG8_LDA(At, 0, 1); PG8_STAGE(PG8_SA(0, 0), a2, voffA);
            PG8_BAR; PG8_WAIT_L(0); PG8_MMA(1, 0, At, B0); PG8_BAR; PG8_SCHED;
            PG8_STAGE(PG8_SB(0, 1), b2 + hstep, voffB);
            PG8_WAIT_V(6); PG8_BAR; PG8_MMA(1, 1, At, B1); PG8_BAR;
            PG8_LDB(B0, 1, 0); PG8_SCHED; PG8_LDA(At, 1, 0); PG8_STAGE(PG8_SA(0, 1), a2 + hstep, voffA);
            PG8_WAIT_L(8); PG8_BAR; PG8_WAIT_L(0); PG8_MMA(0, 0, At, B0); PG8_BAR; PG8_SCHED;
            PG8_LDB(B1, 1, 1); PG8_STAGE(PG8_SB(1, 0), b3, voffB);
            PG8_BAR; PG8_WAIT_L(0); PG8_MMA(0, 1, At, B1); PG8_BAR;
            PG8_LDA(At, 1, 1); PG8_STAGE(PG8_SA(1, 0), a3, voffA);
            PG8_BAR; PG8_WAIT_L(0); PG8_MMA(1, 0, At, B0); PG8_BAR; PG8_SCHED;
            PG8_STAGE(PG8_SB(1, 1), b3 + hstep, voffB);
            PG8_WAIT_V(6); PG8_BAR; PG8_MMA(1, 1, At, B1); PG8_BAR;
            }
        }
        if constexpr (ALIGN_EPI) { if (wr == 0) PG8_BAR; }
        if constexpr (!Epi::AFTER_DRAIN) { if (cur.np > 0) split_epilogue<NP>(acc, cur, E, X, tid, wr, wc, fr, fq); else E(acc, cur, wr, wc, fr, fq); S.done(cur); }
        if (!has_next) break;
#pragma unroll
        for (int a = 0; a < 2; ++a)
#pragma unroll
            for (int b = 0; b < 2; ++b)
#pragma unroll
                for (int m = 0; m < 4; ++m)
#pragma unroll
                    for (int n = 0; n < 2; ++n) acc[a][b][m][n] = (f32x4){0.f, 0.f, 0.f, 0.f};
        cur = nxt; cA = nA; cB = nB; ++ui;
        if constexpr (ALIGN_EPI) { if (wr == 1) PG8_BAR; }
    }
    PG8_WAIT_V(0);
    if constexpr (!ALIGN_EPI) { if (wr == 0) PG8_BAR; }
    PG8_BAR;
    if constexpr (Epi::AFTER_DRAIN) { E.fused(acc, cur, wr, wc, fr, fq, lds, wid, lane); S.done(cur); }
#undef PG8_SA
#undef PG8_SB
#undef PG8_STAGE
#undef PG8_LDA
#undef PG8_LDB
#undef PG8_MMA
#undef PG8_WAIT_V
#undef PG8_WAIT_L
#undef PG8_BAR
#undef PG8_SCHED
}
}

#ifndef PG8_SP2
#define PG8_SP2 true
#endif
#ifndef PG8_ALIGN
#define PG8_ALIGN true
#endif
#ifndef DUP_PHASE
#define DUP_PHASE -1
#endif
#ifndef MK_N_LAUNCHES
#define MK_N_LAUNCHES 1
#endif
constexpr int NWAVES = 8;
constexpr int N_PHASES = 10;
constexpr int N_LAUNCHES = MK_N_LAUNCHES;

constexpr int MP = 8192, MS = 1024, M = MP + MS;
constexpr int D = 2048, NIN = 11264, FF = 5632, FF2 = 11264;
constexpr int NH = 8, DK = 128, DVH = 256;
constexpr int C_POOL = 0, C_Q = 1024, C_K = 2048, C_V = 3072, C_GRET = 5120, C_GA = 7168, C_GR = 9216;
constexpr float EPS = 1e-6f;
constexpr int NS = 4, DVS = DVH / NS;
constexpr size_t O_Y = 0, O_POOLP = 18874368, O_RETP = 18935808, O_CONVP = 19984384, O_POOLS = 20074496, O_RETS = 22040576, O_CONVS = 55595008, O_END = 58478592;

constexpr size_t MiB = 1u << 20;
constexpr size_t WS_CTL = 0, CTL_ZERO_BYTES = 128 * 1024;
constexpr size_t WS_WIN = 1 * MiB, WS_WUP = 45 * MiB, WS_WDN = 89 * MiB, WS_WOUT = 111 * MiB, WS_WPOOL = 119 * MiB;
constexpr size_t WS_ROPE = 120 * MiB;
constexpr size_t WS_XN = 122 * MiB;
constexpr size_t WS_PROJ = 158 * MiB;
constexpr size_t WS_O = 356 * MiB, WS_AP = 392 * MiB, WS_MM = 428 * MiB;
constexpr size_t WS_SP16 = 464 * MiB;
constexpr size_t WS_QH = 428 * MiB, WS_KH = 444 * MiB, WS_VH = 468 * MiB;
constexpr size_t WS_X1 = 468 * MiB;
constexpr size_t WS_END = 504 * MiB;
constexpr int CW_TMO = 0, CW_CODE = 1, CW_Q2 = 64, CW_QW = 2048, CW_BAR = 4096, CW_SPLIT = 8192;
static_assert((CW_SPLIT + 4 * 4096) * 4 <= (int)CTL_ZERO_BYTES && CW_BAR + 3456 <= CW_SPLIT, "control words inside the per-call memset");
constexpr size_t WS_SLAB_A = 356 * MiB, WS_SLAB_B = 230 * MiB;

constexpr int LDS_BYTES = 147456, LDSCTL_OFF = 143360;

#define GAS __attribute__((address_space(1)))
#define LAS __attribute__((address_space(3)))
typedef unsigned short bf16;
typedef unsigned v4u __attribute__((ext_vector_type(4)));
typedef unsigned v2u __attribute__((ext_vector_type(2)));
typedef float f32x4 __attribute__((ext_vector_type(4)));
typedef short bf16x8 __attribute__((ext_vector_type(8)));
#define RLX_AGENT __ATOMIC_RELAXED, __HIP_MEMORY_SCOPE_AGENT
#define LDS_WAIT() asm volatile("s_waitcnt lgkmcnt(0)" ::: "memory")
#define VM_WAIT() asm volatile("s_waitcnt vmcnt(0)" ::: "memory")
#define LDS_BARRIER() asm volatile("s_waitcnt lgkmcnt(0)\n\ts_barrier" ::: "memory")
__device__ __forceinline__ unsigned pk2(float lo, float hi) { return pg8::cvt_pk_bf16(lo, hi); }
__device__ __forceinline__ float bflo(unsigned u) { return __uint_as_float(u << 16); }
__device__ __forceinline__ float bfhi(unsigned u) { return __uint_as_float(u & 0xffff0000u); }
__device__ __forceinline__ void unpack8(v4u x, float (&f)[8]) { f[0] = bflo(x.x); f[1] = bfhi(x.x); f[2] = bflo(x.y); f[3] = bfhi(x.y); f[4] = bflo(x.z); f[5] = bfhi(x.z); f[6] = bflo(x.w); f[7] = bfhi(x.w); }
__device__ __forceinline__ v4u pack8(const float (&f)[8]) { v4u o; o.x = pk2(f[0], f[1]); o.y = pk2(f[2], f[3]); o.z = pk2(f[4], f[5]); o.w = pk2(f[6], f[7]); return o; }
__device__ __forceinline__ v2u pack4(f32x4 a) { v2u o; o.x = pk2(a[0], a[1]); o.y = pk2(a[2], a[3]); return o; }
__device__ __forceinline__ float sigmoidf_(float x) { return __builtin_amdgcn_rcpf(1.0f + __expf(-x)); }
template <int CTRL, int ROWMASK> __device__ __forceinline__ float dpp_f(float v) { return __builtin_bit_cast(float, __builtin_amdgcn_update_dpp(0, __builtin_bit_cast(int, v), CTRL, ROWMASK, 0xF, false)); }
__device__ __forceinline__ float row_sum16(float v) { v += dpp_f<0xB1, 0xF>(v); v += dpp_f<0x4E, 0xF>(v); v += dpp_f<0x141, 0xF>(v); v += dpp_f<0x140, 0xF>(v); return v; }
__device__ __forceinline__ float wave_sum(float v) {
    v = row_sum16(v); v += dpp_f<0x142, 0xA>(v); v += dpp_f<0x143, 0xC>(v);
    return __builtin_bit_cast(float, __builtin_amdgcn_readlane(__builtin_bit_cast(int, v), 63));
}
__device__ __forceinline__ bf16x8 as_bf16x8(v4u x) { return __builtin_bit_cast(bf16x8, x); }
#define MFMA16(a, b, c) __builtin_amdgcn_mfma_f32_16x16x32_bf16((a), (b), (c), 0, 0, 0)

#define XB_TMO      128
#define XB_XCNT(j)  (256  + 64 * (j))
#define XB_XSUB(j)  (1280 + 64 * (j))
#define XB_XGEN(j)  (2304 + 64 * (j))
#define XB_TOP      3328
#define XB_TOPGEN   3392
#define XCD_BAR_WORDS 3456
#define XB_SPIN_CAP (1u << 22)
__device__ __forceinline__ unsigned xb_ld(unsigned* p)              { return __hip_atomic_load(p, __ATOMIC_RELAXED, __HIP_MEMORY_SCOPE_AGENT); }
__device__ __forceinline__ unsigned xb_add(unsigned* p, unsigned v) { return __hip_atomic_fetch_add(p, v, __ATOMIC_RELAXED, __HIP_MEMORY_SCOPE_AGENT); }
__device__ __forceinline__ unsigned xb_xcc_id() { return (unsigned)__builtin_amdgcn_s_getreg((3 << 11) | 20) & 0xFu; }
#define XB_SPIN(cond, bar) do { unsigned _sp = 0; while (cond) { __builtin_amdgcn_s_sleep(1); \
    if ((++_sp & 255u) == 0u) { if (xb_ld(&(bar)[XB_TMO])) break; if (_sp > XB_SPIN_CAP) { atomicAdd(&(bar)[XB_TMO], 1u); break; } } } } while (0)
struct XcdBarrier { unsigned* bar; unsigned x; volatile LAS unsigned* st; };
__device__ __forceinline__ XcdBarrier xcd_barrier_post(unsigned* bar, volatile LAS unsigned* st) {
    XcdBarrier b; b.bar = bar; b.x = xb_xcc_id(); b.st = st;
    if (threadIdx.x == 0) (void)xb_add(&bar[XB_XCNT(b.x)], 1u);
    return b;
}
__device__ __forceinline__ void xcd_barrier_complete(unsigned* bar, unsigned x, unsigned& nloc, unsigned& nx) {
    const unsigned G = gridDim.x * gridDim.y * gridDim.z;
    unsigned sum, cnt, mine, sp = 0u;
    for (;;) {
        sum = 0u; cnt = 0u; mine = 0u;
#pragma unroll
        for (unsigned j = 0; j < 16; ++j) { const unsigned c = xb_ld(&bar[XB_XCNT(j)]); sum += c; cnt += (c > 0u) ? 1u : 0u; mine = (j == x) ? c : mine; }
        if (sum == G) break;
        __builtin_amdgcn_s_sleep(1);
        if ((++sp & 255u) == 0u) { if (xb_ld(&bar[XB_TMO])) break; if (sp > XB_SPIN_CAP) { atomicAdd(&bar[XB_TMO], 1u); break; } }
    }
    nloc = mine > 0u ? mine : 1u; nx = cnt > 0u ? cnt : 1u;
}
__device__ __forceinline__ void xcd_barrier(const XcdBarrier& b) {
    asm volatile("s_waitcnt vmcnt(0)" ::: "memory");
    __syncthreads();
    if (threadIdx.x == 64) asm volatile("buffer_inv sc1\n\ts_waitcnt vmcnt(0)" ::: "memory");
    if (threadIdx.x == 0) {
        unsigned* bar = b.bar;
        __builtin_amdgcn_s_waitcnt(0);
        unsigned nloc = b.st[0], nx = b.st[1];
        if (nloc == 0u) { xcd_barrier_complete(bar, b.x, nloc, nx); b.st[0] = nloc; b.st[1] = nx; }
        const unsigned old = xb_add(&bar[XB_XSUB(b.x)], 1u);
        const unsigned gen = old / nloc;
        if (old + 1u == (gen + 1u) * nloc) {
            __builtin_amdgcn_fence(__ATOMIC_RELEASE, "agent");
            asm volatile("s_waitcnt vmcnt(0)" ::: "memory");
            const unsigned og = xb_add(&bar[XB_TOP], 1u);
            const unsigned tg = og / nx;
            if (og + 1u == (tg + 1u) * nx) xb_add(&bar[XB_TOPGEN], 1u);
            else XB_SPIN(xb_ld(&bar[XB_TOPGEN]) == tg, bar);
            xb_add(&bar[XB_XGEN(b.x)], 1u);
            asm volatile("s_waitcnt vmcnt(0)" ::: "memory");
        } else {
            XB_SPIN(xb_ld(&bar[XB_XGEN(b.x)]) == gen, bar);
            asm volatile("s_waitcnt vmcnt(0)" ::: "memory");
        }
    }
    asm volatile("" ::: "memory");
    __syncthreads();
}

struct Frame {
    LAS unsigned char* lds;
    volatile LAS unsigned* MISC;
    unsigned* ctl;
    int tid, lane, wave, G, gw, NGW;
    const float *xp, *xs, *state_pool, *state_ret, *state_conv, *g_pre_mix, *w_in, *w_pool, *pool_scale, *gn_gain, *w_out, *g_post_mix, *g_pre_ffn, *w_up, *conv_w, *conv_b, *w_down, *g_post_ffn;
    float* out;
    bf16 *WIN, *WUP, *WDN, *WOUT, *WPOOL, *XN, *PROJ, *UP, *OB, *AP, *MM, *ACT;
    float *ROPE_C, *ROPE_S;
    bf16 *SP16, *MOB, *X1B;
};
__device__ __forceinline__ const float* xrow(const Frame& F, int m) { return m < MP ? F.xp + (size_t)m * D : F.xs + (size_t)(m - MP) * D; }

__host__ __device__ __forceinline__ int unperm_d(int p) { const int g8 = p >> 3, e = p & 7; return e < 4 ? 4 * g8 + e : 64 + 4 * g8 + (e - 4); }
constexpr int TSCR = 64 * 65 * 4;
__device__ __forceinline__ void p0_transpose_item(const float* W, int K, int N, bf16* WT, LAS float* scr, int item, int lane, bool permqk = false) {
    const int nblk = N / 64, kb = item / nblk, nb = item % nblk, k0 = 64 * kb, n0 = 64 * nb, r4 = lane >> 4, c4 = 4 * (lane & 15);
    int src = n0 + c4; if (permqk && src >= C_Q && src < C_V) src = (src & ~127) + unperm_d(src & 127);
    const float* wp = W + (size_t)(k0 + r4) * N + src;
    f32x4 v[16];
#pragma unroll
    for (int i = 0; i < 16; ++i) v[i] = __builtin_nontemporal_load((const f32x4*)(wp + (size_t)(4 * i) * N));
#pragma unroll
    for (int i = 0; i < 16; ++i) { LAS float* d = scr + (4 * i + r4) * 65 + c4; d[0] = v[i].x; d[1] = v[i].y; d[2] = v[i].z; d[3] = v[i].w; }
    LDS_WAIT(); asm volatile("" ::: "memory");
    const int c = lane & 7;
#pragma unroll
    for (int j = 0; j < 8; ++j) { const int n = (lane >> 3) + 8 * j; const LAS float* s = scr + (8 * c) * 65 + n;
        v4u o; o.x = pk2(s[0 * 65], s[1 * 65]); o.y = pk2(s[2 * 65], s[3 * 65]); o.z = pk2(s[4 * 65], s[5 * 65]); o.w = pk2(s[6 * 65], s[7 * 65]);
        *(v4u*)(WT + (size_t)(n0 + n) * K + k0 + 8 * c) = o; }
    LDS_WAIT(); asm volatile("" ::: "memory");
}
__device__ __forceinline__ void rms_row_to_bf16(const float* xr_, const f32x4 (&G)[8], bf16* orow, int lane) {
    const f32x4* xr = (const f32x4*)xr_ + lane;
    f32x4 v[8]; float s = 0.f;
#pragma unroll
    for (int j = 0; j < 8; ++j) { v[j] = __builtin_nontemporal_load(xr + 64 * j); s += (v[j].x * v[j].x + v[j].y * v[j].y) + (v[j].z * v[j].z + v[j].w * v[j].w); }
    const float rs = 1.0f / sqrtf(wave_sum(s) * (1.f / D) + EPS);
    v2u* o8 = (v2u*)orow + lane;
#pragma unroll
    for (int j = 0; j < 8; ++j) { const f32x4 gg = G[j]; v2u o; o.x = pk2(v[j].x * rs * gg.x, v[j].y * rs * gg.y); o.y = pk2(v[j].z * rs * gg.z, v[j].w * rs * gg.w); o8[64 * j] = o; }
}
__device__ __forceinline__ void p0_deferred_weights(Frame& F, LAS float* scr) {
    constexpr int I_UP = (D / 64) * (FF2 / 64), I_DN = (FF / 64) * (D / 64), I_OUT = (D / 64) * (D / 64), I_PL = (256 / 64) * (512 / 64);
    constexpr int NITEMS = I_UP + I_DN + I_OUT + 4 * I_PL, CHUNK = 1, NQ = 16, PERQ = NITEMS / NQ;
    static_assert(NITEMS % NQ == 0 && PERQ % CHUNK == 0, "deferred-weight queue split");
    const int qi = blockIdx.x & (NQ - 1);
    for (;;) {
        int base = 0;
        if (F.lane == 0) base = (int)__hip_atomic_fetch_add(F.ctl + CW_QW + 64 * qi, (unsigned)CHUNK, RLX_AGENT);
        base = __builtin_amdgcn_readfirstlane(base);
        if (base >= PERQ) break;
        base += qi * PERQ;
        for (int it = base; it < base + CHUNK; ++it) {
            int r = it;
            if (r < I_UP) { p0_transpose_item(F.w_up, D, FF2, F.WUP, scr, r, F.lane); continue; } r -= I_UP;
            if (r < I_DN) { p0_transpose_item(F.w_down, FF, D, F.WDN, scr, r, F.lane); continue; } r -= I_DN;
            if (r < I_OUT) { p0_transpose_item(F.w_out, D, D, F.WOUT, scr, r, F.lane); continue; } r -= I_OUT;
            const int g = r / I_PL; r -= g * I_PL;
            p0_transpose_item(F.w_pool + (size_t)g * 256 * 512, 256, 512, F.WPOOL + (size_t)g * 512 * 256, scr, r, F.lane);
        }
    }
}
__device__ __forceinline__ void p0_prologue(Frame& F) {
    LAS float* scr = (LAS float*)(F.lds + F.wave * TSCR);
    constexpr int I_IN = (D / 64) * (NIN / 64);
    for (int it = F.gw; it < I_IN; it += F.NGW) p0_transpose_item(F.w_in, D, NIN, F.WIN, scr, it, F.lane, true);
    {
        f32x4 GP[8];
#pragma unroll
        for (int j = 0; j < 8; ++j) GP[j] = *((const f32x4*)F.g_pre_mix + F.lane + 64 * j);
        const int mfull = (M / F.NGW) * F.NGW, rest = M - mfull, nhigh = I_IN % F.NGW, nlow = F.NGW - nhigh;
        for (int m = F.gw; m < mfull; m += F.NGW) rms_row_to_bf16(xrow(F, m), GP, F.XN + (size_t)m * D, F.lane);
        if (nhigh > 0 && rest % nlow == 0) { const int per = rest / nlow; if (F.gw >= nhigh) for (int q = 0; q < per; ++q) { const int m = mfull + (F.gw - nhigh) * per + q; rms_row_to_bf16(xrow(F, m), GP, F.XN + (size_t)m * D, F.lane); } }
        else for (int m = mfull + F.NGW - 1 - F.gw; m < M; m += F.NGW) rms_row_to_bf16(xrow(F, m), GP, F.XN + (size_t)m * D, F.lane);
    }
    for (int idx = blockIdx.x * 512 + F.tid; idx < 2056 * 64; idx += F.G * 512) {
        const int row = idx >> 6, i = idx & 63; const int pos = row < 2048 ? row : 16384 + (row - 2048);
        double th = 1.0; for (int k = 0; k < i; ++k) th *= 0.8659643233600653;
        const double a = (double)pos * th;
        const double kd = rint(a * 0.6366197723675814);
        double y = fma(-kd, 1.57079632679489655800e+00, a); y = fma(-kd, 6.12323399573676603587e-17, y);
        const int k4 = ((int)kd) & 3; const double y2 = y * y;
        const double sp = y * (1.0 + y2 * (-1.0 / 6 + y2 * (1.0 / 120 + y2 * (-1.0 / 5040 + y2 * (1.0 / 362880 + y2 * (-1.0 / 39916800 + y2 * (1.0 / 6227020800.0)))))));
        const double cp = 1.0 + y2 * (-0.5 + y2 * (1.0 / 24 + y2 * (-1.0 / 720 + y2 * (1.0 / 40320 + y2 * (-1.0 / 3628800 + y2 * (1.0 / 479001600 + y2 * (-1.0 / 87178291200.0)))))));
        double sn, cs;
        if (k4 == 0) { sn = sp; cs = cp; } else if (k4 == 1) { sn = cp; cs = -sp; } else if (k4 == 2) { sn = -sp; cs = -cp; } else { sn = -cp; cs = sp; }
        F.ROPE_C[idx] = (float)cs; F.ROPE_S[idx] = (float)sn;
    }
}

constexpr float KSCALE = 0.08838834764831845f;
struct EpiProj {
    static constexpr bool PERM = true, AFTER_DRAIN = false;
    bf16* O; const float* rc; const float* rs;
    __device__ __forceinline__ void tri(f32x4 v0, f32x4 v1, const pg8::Unit& u, int ai, int bj, int m, int wr, int wc, int fr, int fq) const {
        const int row = u.pm * 256 + ai * 128 + wr * 64 + m * 16 + fr, col = u.pn * 256 + bj * 128 + wc * 32 + 8 * fq;
        if (u.pn >= 4 && u.pn < 12) {
            const int h = ((u.pn & 3) << 1) + bj;
            int prow, tl; if (row < MP) { const int t = row & 2047; prow = t; tl = t & 127; } else { tl = row & 7; prow = 2048 + tl; }
            const int g8 = 4 * wc + fq;
            const f32x4 c = *(const f32x4*)(rc + prow * 64 + 4 * g8), sn = *(const f32x4*)(rs + prow * 64 + 4 * g8);
            const float lg2 = __log2f(1.0f - __builtin_amdgcn_exp2f(-5.0f - (float)h));
            const float sc = u.pn >= 8 ? KSCALE * __builtin_amdgcn_exp2f(-lg2 * (float)tl) : __builtin_amdgcn_exp2f(lg2 * (float)tl);
            const f32x4 y1 = (v0 * c - v1 * sn) * sc, y2 = (v1 * c + v0 * sn) * sc;
            v0 = y1; v1 = y2;
        }
        v4u w4; w4.x = pk2(v0[0], v0[1]); w4.y = pk2(v0[2], v0[3]); w4.z = pk2(v1[0], v1[1]); w4.w = pk2(v1[2], v1[3]);
        bf16* dst = O + (size_t)row * NIN + col;
        if (u.pm < MP / 256 && u.pn >= 4 && u.pn < 20) {
            const int bb = row >> 11, t = row & 2047;
            if (u.pn < 12) { const int hd = ((u.pn & 3) << 1) + bj; dst = (bf16*)((char*)O + ((u.pn < 8 ? WS_QH : WS_KH) - WS_PROJ)) + ((size_t)(bb * 8 + hd) * 2048 + t) * 128 + wc * 32 + 8 * fq; }
            else { const int hd = u.pn - 12, sl = bj * 2 + (wc >> 1); dst = (bf16*)((char*)O + (WS_VH - WS_PROJ)) + ((size_t)((bb * 8 + hd) * NS + sl) * 2048 + t) * DVS + (wc & 1) * 32 + 8 * fq; }
        }
        *(v4u*)dst = w4;
    }
    __device__ __forceinline__ void qk_tile(const f32x4 (&acc)[2][2][4][2], const pg8::Unit& u, int wr, int wc, int fr, int fq) const {
        const int g8 = 4 * wc + fq; const bool prompt = u.pm < MP / 256;
        auto pos = [&](int step, int& row, int& prow, int& tl) __attribute__((always_inline)) {
            row = u.pm * 256 + (step >> 2) * 128 + wr * 64 + (step & 3) * 16 + fr;
            if (prompt) { const int t = row & 2047; prow = t; tl = t & 127; } else { tl = row & 7; prow = 2048 + tl; } };
        f32x4 cc[2], ss[2];
        { int row, prow, tl; pos(0, row, prow, tl); cc[0] = *(const f32x4*)(rc + prow * 64 + 4 * g8); ss[0] = *(const f32x4*)(rs + prow * 64 + 4 * g8); }
        float lg2[2];
#pragma unroll
        for (int bj = 0; bj < 2; ++bj) lg2[bj] = __log2f(1.0f - __builtin_amdgcn_exp2f(-5.0f - (float)(((u.pn & 3) << 1) + bj)));
#pragma unroll
        for (int step = 0; step < 8; ++step) {
            if (step + 1 < 8) { int row, prow, tl; pos(step + 1, row, prow, tl); cc[(step + 1) & 1] = *(const f32x4*)(rc + prow * 64 + 4 * g8); ss[(step + 1) & 1] = *(const f32x4*)(rs + prow * 64 + 4 * g8); }
            int row, prow, tl; pos(step, row, prow, tl);
            const f32x4 c = cc[step & 1], sn = ss[step & 1];
#pragma unroll
            for (int bj = 0; bj < 2; ++bj) {
                const float sc = u.pn >= 8 ? KSCALE * __builtin_amdgcn_exp2f(-lg2[bj] * (float)tl) : __builtin_amdgcn_exp2f(lg2[bj] * (float)tl);
                const f32x4 v0 = acc[step >> 2][bj][step & 3][0], v1 = acc[step >> 2][bj][step & 3][1];
                const f32x4 y1 = (v0 * c - v1 * sn) * sc, y2 = (v1 * c + v0 * sn) * sc;
                v4u w4; w4.x = pk2(y1[0], y1[1]); w4.y = pk2(y1[2], y1[3]); w4.z = pk2(y2[0], y2[1]); w4.w = pk2(y2[2], y2[3]);
                bf16* dst = O + (size_t)row * NIN + u.pn * 256 + bj * 128 + wc * 32 + 8 * fq;
                if (prompt) { const int bb = row >> 11, t = row & 2047, hd = ((u.pn & 3) << 1) + bj; dst = (bf16*)((char*)O + ((u.pn < 8 ? WS_QH : WS_KH) - WS_PROJ)) + ((size_t)(bb * 8 + hd) * 2048 + t) * 128 + wc * 32 + 8 * fq; }
                *(v4u*)dst = w4;
            }
        }
    }
    __device__ __forceinline__ void operator()(const f32x4 (&acc)[2][2][4][2], const pg8::Unit& u, int wr, int wc, int fr, int fq) const {
        if (u.pn >= 4 && u.pn < 12) { qk_tile(acc, u, wr, wc, fr, fq); return; }
#pragma unroll
        for (int ai = 0; ai < 2; ++ai)
#pragma unroll
            for (int m = 0; m < 4; ++m)
#pragma unroll
                for (int bj = 0; bj < 2; ++bj) tri(acc[ai][bj][m][0], acc[ai][bj][m][1], u, ai, bj, m, wr, wc, fr, fq);
    }
};

typedef short s16x4 __attribute__((ext_vector_type(4)));
__device__ __forceinline__ bf16x8 tr16x2(const LAS unsigned char* p0, const LAS unsigned char* p1) {
    const s16x4 a = __builtin_amdgcn_ds_read_tr16_b64_v4i16((LAS s16x4*)p0), b = __builtin_amdgcn_ds_read_tr16_b64_v4i16((LAS s16x4*)p1);
    return __builtin_shufflevector(a, b, 0, 1, 2, 3, 4, 5, 6, 7);
}
static_assert(DVS == 64, "chain staging below assumes 64-wide value slices");
constexpr int QI_LD = 136, VI_LD = DVS + 8;
constexpr int QI_OFF = 0, KI_OFF = 34816, VI_OFF = 69632, RT_OFF = VI_OFF + 128 * VI_LD * 2, CH_END = RT_OFF + DVS * QI_LD * 2;
static_assert(CH_END <= LDSCTL_OFF, "chain LDS");
__device__ __forceinline__ void chain_unit(Frame& F, int unit) {
    const int s = unit % NS, h = (unit / NS) & 7, b = unit / (NS * 8);
    int tid_ = F.tid; asm volatile("" : "+v"(tid_));
    const int tid = tid_, lane = tid & 63, w = F.wave, fr = lane & 15, fq = lane >> 4, tq = (lane & 15) >> 2, tp = lane & 3;
    LAS unsigned char* L = F.lds;
    const float lg2 = __log2f(1.0f - __builtin_amdgcn_exp2f(-5.0f - (float)h));
    const float gam = __builtin_amdgcn_exp2f(lg2), g127 = __builtin_amdgcn_exp2f(127.f * lg2);
    for (int i = tid; i < DVS * QI_LD * 2 / 16; i += 512) *(LAS v4u*)(L + RT_OFF + i * 16) = (v4u){0u, 0u, 0u, 0u};
    f32x4 Racc[4];
#pragma unroll
    for (int i = 0; i < 4; ++i) Racc[i] = (f32x4){0.f, 0.f, 0.f, 0.f};
    const int vt_r = w & 3, dg = w >> 2;
    const bf16* qh = (const bf16*)((const char*)F.PROJ + (WS_QH - WS_PROJ)) + (size_t)(b * 8 + h) * 2048 * 128; const bf16* kh = (const bf16*)((const char*)F.PROJ + (WS_KH - WS_PROJ)) + (size_t)(b * 8 + h) * 2048 * 128;
    const bf16* vh = (const bf16*)((const char*)F.PROJ + (WS_VH - WS_PROJ)) + (size_t)((b * 8 + h) * NS + s) * 2048 * DVS;
    v4u sqA[4], skA[4], svA[2], sqB[4], skB[4], svB[2];
#define CH_ISSUE(c, sq, sk, sv) do { const int r0_ = (c) * 128; \
        _Pragma("unroll") for (int i_ = 0; i_ < 4; ++i_) { const int ci = tid + 512 * i_; sq[i_] = *(const v4u*)(qh + (size_t)r0_ * 128 + 8 * ci); sk[i_] = *(const v4u*)(kh + (size_t)r0_ * 128 + 8 * ci); } \
        _Pragma("unroll") for (int i_ = 0; i_ < 2; ++i_) { const int ci = tid + 512 * i_; sv[i_] = *(const v4u*)(vh + (size_t)r0_ * DVS + 8 * ci); } } while (0)
#define CH_WRITE(sq, sk, sv) do { \
        _Pragma("unroll") for (int i_ = 0; i_ < 4; ++i_) { const int ci = tid + 512 * i_, j = ci >> 4, ch = ci & 15; *(LAS v4u*)(L + QI_OFF + (j * QI_LD + 8 * ch) * 2) = sq[i_]; *(LAS v4u*)(L + KI_OFF + (j * QI_LD + 8 * ch) * 2) = sk[i_]; } \
        _Pragma("unroll") for (int i_ = 0; i_ < 2; ++i_) { const int ci = tid + 512 * i_, j = ci >> 3, ch = ci & 7; *(LAS v4u*)(L + VI_OFF + (j * VI_LD + 8 * ch) * 2) = sv[i_]; } } while (0)
    auto chunk = [&](const int c) __attribute__((always_inline)) {
        const size_t mrow0 = (size_t)b * 2048 + c * 128;
        {
            bf16x8 afr[4];
#pragma unroll
            for (int kk = 0; kk < 4; ++kk) afr[kk] = *(const LAS bf16x8*)(L + QI_OFF + ((16 * w + fr) * QI_LD + 32 * kk + 8 * fq) * 2);
            f32x4 oacc[4];
#pragma unroll
            for (int vt = 0; vt < 4; ++vt) {
                f32x4 acc = (f32x4){0.f, 0.f, 0.f, 0.f};
#pragma unroll
                for (int kk = 0; kk < 4; ++kk) { const bf16x8 rf = *(const LAS bf16x8*)(L + RT_OFF + ((16 * vt + fr) * QI_LD + 32 * kk + 8 * fq) * 2); acc = MFMA16(rf, afr[kk], acc); }
                oacc[vt] = acc * gam;
            }
            const int i_ = 16 * w + fr, nkk = (w >> 1) + 1;
#pragma unroll 1
            for (int kk = 0; kk < nkk; ++kk) {
                f32x4 s0 = (f32x4){0.f, 0.f, 0.f, 0.f}, s1 = s0;
                const LAS unsigned char* kb = L + KI_OFF + ((32 * kk + fr) * QI_LD + 8 * fq) * 2;
#pragma unroll
                for (int k2 = 0; k2 < 4; ++k2) {
                    const bf16x8 kf0 = *(const LAS bf16x8*)(kb + 64 * k2), kf1 = *(const LAS bf16x8*)(kb + 16 * QI_LD * 2 + 64 * k2);
                    s0 = MFMA16(kf0, afr[k2], s0); s1 = MFMA16(kf1, afr[k2], s1);
                }
                float pv[8];
#pragma unroll
                for (int e = 0; e < 4; ++e) { const int dd0 = i_ - (32 * kk + 4 * fq + e); pv[e] = dd0 >= 0 ? s0[e] : 0.f; pv[4 + e] = dd0 >= 16 ? s1[e] : 0.f; }
                const bf16x8 pf = as_bf16x8(pack8(pv));
                const LAS unsigned char* vb = L + VI_OFF + ((32 * kk + 4 * fq + tq) * VI_LD + 4 * tp) * 2;
#pragma unroll
                for (int vt = 0; vt < 4; ++vt) oacc[vt] = MFMA16(tr16x2(vb + 32 * vt, vb + 16 * VI_LD * 2 + 32 * vt), pf, oacc[vt]);
            }
            bf16* orow = F.OB + (mrow0 + 16 * w + fr) * D + h * DVH + s * DVS + 4 * fq;
#pragma unroll
            for (int vt = 0; vt < 4; ++vt) *(v2u*)(orow + 16 * vt) = pack4(oacc[vt]);
        }
#pragma unroll
        for (int di = 0; di < 4; ++di) {
            const int dt = dg * 4 + di;
            f32x4 acc = Racc[di] * gam;
#pragma unroll
            for (int kk = 0; kk < 4; ++kk) {
                const LAS unsigned char* ka = L + KI_OFF + ((32 * kk + 8 * fq + tq) * QI_LD + 16 * dt + 4 * tp) * 2;
                const LAS unsigned char* va = L + VI_OFF + ((32 * kk + 8 * fq + tq) * VI_LD + 16 * vt_r + 4 * tp) * 2;
                acc = MFMA16(tr16x2(ka, ka + 4 * QI_LD * 2), tr16x2(va, va + 4 * VI_LD * 2), acc);
            }
            Racc[di] = acc * g127;
        }
        LDS_BARRIER();
#pragma unroll
        for (int di = 0; di < 4; ++di) { const int dt = dg * 4 + di; *(LAS v2u*)(L + RT_OFF + ((16 * vt_r + fr) * QI_LD + 16 * dt + 4 * fq) * 2) = pack4(Racc[di]); }
    };
    CH_ISSUE(0, sqA, skA, svA); CH_ISSUE(1, sqB, skB, svB);
    LDS_BARRIER();
#pragma unroll 1
    for (int c = 0; c < 16; c += 2) {
        CH_WRITE(sqA, skA, svA); LDS_BARRIER(); CH_ISSUE((c + 2 < 16 ? c + 2 : 15), sqA, skA, svA); chunk(c);
        CH_WRITE(sqB, skB, svB); LDS_BARRIER(); CH_ISSUE((c + 3 < 16 ? c + 3 : 15), sqB, skB, svB); chunk(c + 1);
    }
#undef CH_ISSUE
#undef CH_WRITE
    float* ro = F.out + O_RETP + ((size_t)(b * 8 + h) * 128) * DVH + s * DVS + 16 * vt_r + fr;
#pragma unroll
    for (int di = 0; di < 4; ++di) { const int dt = dg * 4 + di;
#pragma unroll
        for (int r = 0; r < 4; ++r) ro[(size_t)unperm_d(16 * dt + 4 * fq + r) * DVH] = Racc[di][r]; }
}

constexpr int SQ_OFF = 0, SKZ_OFF = 4096, SK_OFF = 8192, SV_OFF = 12288, SS_OFF = 20480, SRED_OFF = 24576;
__device__ __forceinline__ void sample_unit(Frame& F, int unit, unsigned* qctr, unsigned& nxt_) {
    const int h = unit & 7, b = unit >> 3;
    int tid_ = F.tid; asm volatile("" : "+v"(tid_));
    const int tid = tid_, lane = tid & 63, w = F.wave;
    LAS unsigned char* L = F.lds;
    LAS float* qT = (LAS float*)(L + SQ_OFF); LAS float* kzT = (LAS float*)(L + SKZ_OFF); LAS float* kS = (LAS float*)(L + SK_OFF);
    LAS float* vs = (LAS float*)(L + SV_OFF); LAS float* ss = (LAS float*)(L + SS_OFF); LAS float* red = (LAS float*)(L + SRED_OFF);
    const float lg2 = __log2f(1.0f - __builtin_amdgcn_exp2f(-5.0f - (float)h));
    const float gam = __builtin_amdgcn_exp2f(lg2), g7 = __builtin_amdgcn_exp2f(7.f * lg2), g8c = __builtin_amdgcn_exp2f(8.f * lg2);
    const size_t mrow0 = (size_t)MP + (size_t)b * 8;
    const float* Rin = F.state_ret + ((size_t)(b * 8 + h) * 128) * DVH + 4 * lane;
    float* Rout = F.out + O_RETS + ((size_t)(b * 8 + h) * 128) * DVH + 4 * lane;
    f32x4 r0[16];
#pragma unroll
    for (int dd = 0; dd < 16; ++dd) r0[dd] = __builtin_nontemporal_load((const f32x4*)(Rin + (size_t)(16 * w + dd) * DVH));
    if (tid < 256) {
        const int qk = tid >> 7, it = tid & 127, i = it >> 4, ch = it & 15;
        float f[8]; unpack8(*(const v4u*)(F.PROJ + (mrow0 + i) * NIN + (qk ? C_K : C_Q) + h * 128 + 8 * ch), f);
#pragma unroll
        for (int e = 0; e < 8; ++e) { const int d = e < 4 ? 4 * ch + e : 64 + 4 * ch + (e - 4);
            if (qk == 0) qT[d * 8 + i] = f[e]; else { kS[i * 128 + d] = f[e]; kzT[d * 8 + i] = f[e] * g7; } }
    } else {
        const int it = tid - 256, j = it >> 5, g = it & 31;
        float f[8]; unpack8(*(const v4u*)(F.PROJ + (mrow0 + j) * NIN + C_V + h * DVH + 8 * g), f);
#pragma unroll
        for (int e = 0; e < 8; ++e) vs[j * 256 + 8 * g + e] = f[e];
    }
    if (tid == 0) nxt_ = __hip_atomic_fetch_add(qctr, 1u, RLX_AGENT);
    __syncthreads();
    {
        const int pr = tid >> 3, part = tid & 7, i = pr >> 3, j = pr & 7; float dot = 0.f;
#pragma unroll
        for (int dd = 0; dd < 16; ++dd) { const int d = 16 * part + dd; dot += qT[d * 8 + i] * kS[j * 128 + d]; }
        dot += __shfl_xor(dot, 1); dot += __shfl_xor(dot, 2); dot += __shfl_xor(dot, 4);
        if (part == 0) ss[i * 8 + j] = (i >= j) ? dot : 0.f;
    }
    {
        f32x4 vreg[8], oacc[8];
#pragma unroll
        for (int j = 0; j < 8; ++j) { vreg[j] = *(const LAS f32x4*)(vs + j * 256 + 4 * lane); oacc[j] = (f32x4){0.f, 0.f, 0.f, 0.f}; }
#pragma unroll
        for (int dd = 0; dd < 16; ++dd) {
            const int d = 16 * w + dd;
            const f32x4 qa = *(const LAS f32x4*)(qT + d * 8), qb = *(const LAS f32x4*)(qT + d * 8 + 4), ka = *(const LAS f32x4*)(kzT + d * 8), kb = *(const LAS f32x4*)(kzT + d * 8 + 4);
            f32x4 rn = r0[dd] * g8c;
            rn += ka.x * vreg[0]; rn += ka.y * vreg[1]; rn += ka.z * vreg[2]; rn += ka.w * vreg[3]; rn += kb.x * vreg[4]; rn += kb.y * vreg[5]; rn += kb.z * vreg[6]; rn += kb.w * vreg[7];
            __builtin_nontemporal_store(rn, (f32x4*)(Rout + (size_t)d * DVH));
            oacc[0] += qa.x * r0[dd]; oacc[1] += qa.y * r0[dd]; oacc[2] += qa.z * r0[dd]; oacc[3] += qa.w * r0[dd];
            oacc[4] += qb.x * r0[dd]; oacc[5] += qb.y * r0[dd]; oacc[6] += qb.z * r0[dd]; oacc[7] += qb.w * r0[dd];
        }
#pragma unroll
        for (int i = 0; i < 8; ++i) *(LAS f32x4*)(red + (w * 8 + i) * 256 + 4 * lane) = oacc[i];
    }
    __syncthreads();
    {
        const int i = tid >> 6, l = tid & 63;
        f32x4 tot = (f32x4){0.f, 0.f, 0.f, 0.f};
#pragma unroll
        for (int ww = 0; ww < 8; ++ww) tot += *(const LAS f32x4*)(red + (ww * 8 + i) * 256 + 4 * l);
        tot = tot * gam;
#pragma unroll
        for (int j = 0; j < 8; ++j) tot += ss[i * 8 + j] * *(const LAS f32x4*)(vs + j * 256 + 4 * l);
        *(v2u*)(F.OB + (mrow0 + i) * D + h * DVH + 4 * l) = pack4(tot);
    }
}

constexpr int Z_LD = 264;
template <int W, int IB> __device__ __forceinline__ void pool_z(Frame& F, int g, int m0, int tid) {
    LAS unsigned char* L = F.lds;
#pragma unroll 1
    for (int it0 = tid; it0 < 4096; it0 += 512 * IB) {
        v4u raw[IB][W]; bool ok[IB][W];
#pragma unroll
        for (int ib = 0; ib < IB; ++ib) {
            const int it = it0 + 512 * ib, j = it >> 5, c8 = it & 31, m = m0 + j, col = C_POOL + 256 * g + 8 * c8;
#pragma unroll
            for (int k = 0; k < W; ++k) {
                const bf16* p;
                if (m < MP) { const int t = m & 2047; ok[ib][k] = t - k >= 0; p = F.PROJ + (size_t)(ok[ib][k] ? m - k : m) * NIN + col; }
                else { const int ms = m - MP, bb = ms >> 3, i = ms & 7, ee = 15 + i - k; ok[ib][k] = true;
                    const bf16* p1 = F.PROJ + (size_t)(MP + bb * 8 + (ee >= 15 ? ee - 15 : 0)) * NIN + col; const bf16* p2 = F.SP16 + ((size_t)bb * 15 + (ee < 15 ? ee : 0)) * 1024 + 256 * g + 8 * c8;
                    p = ee >= 15 ? p1 : p2; }
                raw[ib][k] = *(const v4u*)p;
            }
        }
#pragma unroll
        for (int ib = 0; ib < IB; ++ib) {
            const int it = it0 + 512 * ib, j = it >> 5, c8 = it & 31, m = m0 + j;
            float sum[8], cur[8], f[8];
            unpack8(raw[ib][0], cur);
#pragma unroll
            for (int e = 0; e < 8; ++e) sum[e] = cur[e];
#pragma unroll
            for (int k = 1; k < W; ++k) { unpack8(raw[ib][k], f);
#pragma unroll
                for (int e = 0; e < 8; ++e) sum[e] += ok[ib][k] ? f[e] : 0.f; }
            int cn = W; if (m < MP) { const int t = m & 2047; cn = W < t + 1 ? W : t + 1; }
            const float ic = 1.0f / (float)cn;
#pragma unroll
            for (int e = 0; e < 8; ++e) f[e] = sum[e] * ic - cur[e];
            *(LAS v4u*)(L + (j * Z_LD + 8 * c8) * 2) = pack8(f);
        }
    }
}
__device__ __forceinline__ void pool_unit(Frame& F, int unit, unsigned* qctr, unsigned& nxt_) {
    const int g = unit & 3, tile = unit >> 2, m0 = tile * 128;
    int tid_ = F.tid; asm volatile("" : "+v"(tid_));
    const int tid = tid_, lane = tid & 63, w = F.wave, fr = lane & 15, fq = lane >> 4;
    LAS unsigned char* L = F.lds;
    f32x4 sc[4]; bf16x8 bfr[4][8];
#define POOL_WLOADS() do { _Pragma("unroll") for (int et = 0; et < 4; ++et) sc[et] = *(const f32x4*)(F.pool_scale + 512 * g + 64 * w + 16 * et + 4 * fq); \
        const bf16* wt = F.WPOOL + ((size_t)g * 512 + 64 * w + fr) * 256 + 8 * fq; \
        _Pragma("unroll") for (int et = 0; et < 4; ++et) _Pragma("unroll") for (int kk = 0; kk < 8; ++kk) bfr[et][kk] = *(const bf16x8*)(wt + (size_t)(16 * et) * 256 + 32 * kk); } while (0)
    if (m0 >= MP) {
        POOL_WLOADS();
        if (g == 0) pool_z<2, 4>(F, g, m0, tid); else if (g == 1) pool_z<4, 4>(F, g, m0, tid); else if (g == 2) pool_z<8, 2>(F, g, m0, tid); else pool_z<16, 1>(F, g, m0, tid);
    } else {
        constexpr int UT_OFF = 128 * Z_LD * 2;
        static_assert(UT_OFF + 143 * Z_LD * 2 <= LDSCTL_OFF, "pool LDS");
        const bool seq0 = (m0 & 2047) == 0;
        const bf16* src = F.PROJ + (size_t)(m0 - 15) * NIN + C_POOL + 256 * g;
#pragma unroll
        for (int i = 0; i < 9; ++i) { const int ci = tid + 512 * i;
            if (ci < 143 * 32) { const int rw = ci >> 5, c8 = ci & 31; v4u v = (v4u){0u, 0u, 0u, 0u}; if (!(seq0 && rw < 15)) v = *(const v4u*)(src + (size_t)rw * NIN + 8 * c8);
                *(LAS v4u*)(L + UT_OFF + (rw * Z_LD + 8 * c8) * 2) = v; } }
        POOL_WLOADS();
        LDS_BARRIER();
        const int W = 2 << g, c8 = tid & 31, j0 = (tid >> 5) * 8;
        const LAS unsigned char* up = L + UT_OFF + ((15 + j0) * Z_LD + 8 * c8) * 2;
        float sum[8], f[8], cur[8];
#pragma unroll
        for (int e = 0; e < 8; ++e) sum[e] = 0.f;
        for (int k = 1; k < W; ++k) { unpack8(*(const LAS v4u*)(up - k * Z_LD * 2), f);
#pragma unroll
            for (int e = 0; e < 8; ++e) sum[e] += f[e]; }
        const int t0 = (m0 & 2047) + j0;
#pragma unroll
        for (int j = 0; j < 8; ++j) {
            unpack8(*(const LAS v4u*)(up + j * Z_LD * 2), cur);
#pragma unroll
            for (int e = 0; e < 8; ++e) sum[e] += cur[e];
            const int t = t0 + j; const float ic = 1.0f / (float)(W < t + 1 ? W : t + 1);
#pragma unroll
            for (int e = 0; e < 8; ++e) f[e] = sum[e] * ic - cur[e];
            *(LAS v4u*)(L + ((j0 + j) * Z_LD + 8 * c8) * 2) = pack8(f);
            unpack8(*(const LAS v4u*)(up + (j + 1 - W) * Z_LD * 2), f);
#pragma unroll
            for (int e = 0; e < 8; ++e) sum[e] -= f[e];
        }
    }
    if (tid == 0) nxt_ = __hip_atomic_fetch_add(qctr, 1u, RLX_AGENT);
    LDS_BARRIER();
#pragma unroll 1
    for (int rt = 0; rt < 8; ++rt) {
        bf16x8 afr[8];
#pragma unroll
        for (int kk = 0; kk < 8; ++kk) afr[kk] = *(const LAS bf16x8*)(L + ((16 * rt + fr) * Z_LD + 32 * kk + 8 * fq) * 2);
        bf16* orow = F.AP + (size_t)(m0 + 16 * rt + fr) * D + 512 * g + 64 * w + 4 * fq;
#pragma unroll
        for (int et = 0; et < 4; ++et) {
            f32x4 acc = (f32x4){0.f, 0.f, 0.f, 0.f};
#pragma unroll
            for (int kk = 0; kk < 8; ++kk) acc = MFMA16(bfr[et][kk], afr[kk], acc);
            *(v2u*)(orow + 16 * et) = pack4(acc * sc[et]);
        }
    }
}
constexpr int N_CHAIN = 4 * 8 * NS, N_POOLU = (M / 128) * 4, N_SAMP = 128 * 8, N_P2 = N_CHAIN + N_POOLU + N_SAMP;
__device__ __forceinline__ void p2_mixers(Frame& F, int rep) {
    const int mode = rep >> 4, lo = mode == 2 ? N_CHAIN : (mode == 3 ? N_CHAIN + N_POOLU : 0), hi = mode == 1 ? N_CHAIN : (mode == 2 ? N_CHAIN + N_POOLU : N_P2);
    const bool static_chain = mode == 0 && (F.G % 8) == 0 && F.G >= N_CHAIN && NS == 4;
    if (static_chain && (int)blockIdx.x < N_CHAIN) { __syncthreads(); const int c = (int)blockIdx.x, slot = c >> 3, bh = (c & 7) + 8 * (slot >> 2); chain_unit(F, bh * NS + (slot & 3)); }
    unsigned nxt_ = 0;
    if (F.tid == 0) nxt_ = __hip_atomic_fetch_add(F.ctl + CW_Q2 + 64 * (rep & 15), 1u, RLX_AGENT);
    for (;;) {
        __syncthreads();
        if (F.tid == 0) F.MISC[0] = nxt_;
        __syncthreads();
        const int u = (int)F.MISC[0] + (static_chain ? N_CHAIN : lo);
        if (u >= hi) break;
        unsigned* qctr = F.ctl + CW_Q2 + 64 * (rep & 15);
        if (u < N_CHAIN) { if (F.tid == 0) nxt_ = __hip_atomic_fetch_add(qctr, 1u, RLX_AGENT); chain_unit(F, u); }
        else if (u < N_CHAIN + N_POOLU) pool_unit(F, u - N_CHAIN, qctr, nxt_);
        else sample_unit(F, u - N_CHAIN - N_POOLU, qctr, nxt_);
    }
}

__device__ __forceinline__ void ld8f(const float* p, float (&o)[8]) { const f32x4 a = *(const f32x4*)p, b = *(const f32x4*)(p + 4); o[0] = a.x; o[1] = a.y; o[2] = a.z; o[3] = a.w; o[4] = b.x; o[5] = b.y; o[6] = b.z; o[7] = b.w; }
__device__ __forceinline__ float half_sum(float v) {
    v = row_sum16(v); v += dpp_f<0x142, 0xA>(v);
    const float lo = __builtin_bit_cast(float, __builtin_amdgcn_readlane(__builtin_bit_cast(int, v), 31)), hi = __builtin_bit_cast(float, __builtin_amdgcn_readlane(__builtin_bit_cast(int, v), 63));
    return (threadIdx.x & 32) ? hi : lo;
}
__device__ __forceinline__ void p3_merge(Frame& F) {
    const int lane = F.lane, hl = lane >> 5, l32 = lane & 31;
    constexpr int NIT = M * 4;
    f32x4 GN[2][2]; const bool gn_fixed = ((2 * F.NGW) & 3) == 0;
#pragma unroll
    for (int u = 0; u < 2; ++u) { const int c0 = (2 * ((2 * F.gw + u) & 3) + hl) * DVH + 8 * l32; GN[u][0] = *(const f32x4*)(F.gn_gain + c0); GN[u][1] = *(const f32x4*)(F.gn_gain + c0 + 4); }
    for (int it0 = 2 * F.gw; it0 < NIT; it0 += 2 * F.NGW) {
        v4u ov[2], gv[2], av[2], rv[2], pv[2]; int cc[2]; size_t mm[2];
#pragma unroll
        for (int u = 0; u < 2; ++u) {
            const int it = it0 + u, m = it >> 2, hp = it & 3, c = (2 * hp + hl) * DVH + 8 * l32; cc[u] = c; mm[u] = (size_t)m;
            const bf16* prow = F.PROJ + (size_t)m * NIN + c;
            ov[u] = __builtin_nontemporal_load((const v4u*)(F.OB + (size_t)m * D + c)); gv[u] = __builtin_nontemporal_load((const v4u*)(prow + C_GRET)); av[u] = __builtin_nontemporal_load((const v4u*)(prow + C_GA)); rv[u] = __builtin_nontemporal_load((const v4u*)(prow + C_GR)); pv[u] = __builtin_nontemporal_load((const v4u*)(F.AP + (size_t)m * D + c));
        }
#pragma unroll
        for (int u = 0; u < 2; ++u) {
            float o[8], g[8], ga[8], gr[8], ap[8], res[8];
            unpack8(ov[u], o); unpack8(gv[u], g); unpack8(av[u], ga); unpack8(rv[u], gr); unpack8(pv[u], ap);
            f32x4 gn0 = GN[u][0], gn1 = GN[u][1]; if (!gn_fixed) { gn0 = *(const f32x4*)(F.gn_gain + cc[u]); gn1 = *(const f32x4*)(F.gn_gain + cc[u] + 4); }
            const float gn[8] = {gn0.x, gn0.y, gn0.z, gn0.w, gn1.x, gn1.y, gn1.z, gn1.w};
            float sm = 0.f;
#pragma unroll
            for (int e = 0; e < 8; ++e) sm += o[e];
            const float mean = half_sum(sm) * (1.f / 256.f);
            float sq = 0.f;
#pragma unroll
            for (int e = 0; e < 8; ++e) { o[e] -= mean; sq += o[e] * o[e]; }
            const float rstd = 1.0f / sqrtf(half_sum(sq) * (1.f / 256.f) + EPS);
#pragma unroll
            for (int e = 0; e < 8; ++e) { const float r = g[e] * sigmoidf_(g[e]) * (o[e] * rstd * gn[e]); res[e] = sigmoidf_(ga[e]) * ap[e] + sigmoidf_(gr[e]) * r; }
            *(v4u*)(F.MM + mm[u] * D + cc[u]) = pack8(res);
        }
    }
    const int gt = blockIdx.x * 512 + F.tid, NT = F.G * 512;
    for (int gi = gt; gi < (4 + 128) * 15 * 128; gi += NT) {
        const int c8 = gi & 127, rr = gi >> 7, r = rr % 15, bb = rr / 15;
        float v8[8]; float* dst;
        if (bb < 4) { unpack8(*(const v4u*)(F.PROJ + (size_t)(bb * 2048 + 2033 + r) * NIN + C_POOL + 8 * c8), v8); dst = F.out + O_POOLP + ((size_t)bb * 15 + r) * 1024 + 8 * c8; }
        else { const int b = bb - 4, e = 8 + r; dst = F.out + O_POOLS + ((size_t)b * 15 + r) * 1024 + 8 * c8;
            if (e < 15) ld8f(F.state_pool + ((size_t)b * 15 + e) * 1024 + 8 * c8, v8); else unpack8(*(const v4u*)(F.PROJ + (size_t)(MP + b * 8 + e - 15) * NIN + C_POOL + 8 * c8), v8); }
        *(f32x4*)dst = (f32x4){v8[0], v8[1], v8[2], v8[3]}; *(f32x4*)(dst + 4) = (f32x4){v8[4], v8[5], v8[6], v8[7]};
    }
}

__device__ __forceinline__ float pair_sum(float s, LAS float* px, int w) {
    const float t = wave_sum(s);
    __syncthreads(); px[w] = t; __syncthreads();
    return t + px[w ^ 1];
}
template <int NJ> __device__ __forceinline__ void load_gain(const float* g, int lane, int jb, f32x4 (&G)[NJ][2]) {
#pragma unroll
    for (int j = 0; j < NJ; ++j) { const f32x4* p = (const f32x4*)g + 2 * lane + 128 * (jb + j); G[j][0] = p[0]; G[j][1] = p[1]; }
}
template <bool HALF> __device__ __forceinline__ void p5_row(Frame& F, int m, int half, const f32x4 (&G1)[HALF ? 2 : 4][2], const f32x4 (&G2)[HALF ? 2 : 4][2]) {
    constexpr int NJ = HALF ? 2 : 4; const int jb = HALF ? 2 * half : 0, lane = F.lane;
    LAS float* px = (LAS float*)F.lds;
    const v4u* mo = (const v4u*)(F.MOB + (size_t)m * D) + lane + 64 * jb; const f32x4* xr = (const f32x4*)xrow(F, m) + 2 * lane + 128 * jb;
    v4u mv[NJ]; f32x4 x[NJ][2]; float v[NJ][8]; float s = 0.f;
#pragma unroll
    for (int j = 0; j < NJ; ++j) { mv[j] = __builtin_nontemporal_load(mo + 64 * j); x[j][0] = __builtin_nontemporal_load(xr + 128 * j); x[j][1] = __builtin_nontemporal_load(xr + 128 * j + 1); }
#pragma unroll
    for (int j = 0; j < NJ; ++j) { unpack8(mv[j], v[j]);
#pragma unroll
        for (int e = 0; e < 8; ++e) s += v[j][e] * v[j][e]; }
    const float rs = 1.0f / sqrtf((HALF ? pair_sum(s, px, F.wave) : wave_sum(s)) * (1.f / D) + EPS);
    float s2 = 0.f; v4u* yo = (v4u*)(F.X1B + (size_t)m * D) + lane + 64 * jb;
#pragma unroll
    for (int j = 0; j < NJ; ++j) {
        const f32x4 ga = G1[j][0], gb = G1[j][1];
        x[j][0] = x[j][0] + (f32x4){v[j][0], v[j][1], v[j][2], v[j][3]} * rs * ga; x[j][1] = x[j][1] + (f32x4){v[j][4], v[j][5], v[j][6], v[j][7]} * rs * gb;
        { v4u o; o.x = pk2(x[j][0].x, x[j][0].y); o.y = pk2(x[j][0].z, x[j][0].w); o.z = pk2(x[j][1].x, x[j][1].y); o.w = pk2(x[j][1].z, x[j][1].w); yo[64 * j] = o; }
        s2 += (x[j][0].x * x[j][0].x + x[j][0].y * x[j][0].y) + (x[j][0].z * x[j][0].z + x[j][0].w * x[j][0].w) + (x[j][1].x * x[j][1].x + x[j][1].y * x[j][1].y) + (x[j][1].z * x[j][1].z + x[j][1].w * x[j][1].w);
    }
    const float rs2 = 1.0f / sqrtf((HALF ? pair_sum(s2, px, F.wave) : wave_sum(s2)) * (1.f / D) + EPS);
    v4u* o8 = (v4u*)(F.XN + (size_t)m * D) + lane + 64 * jb;
#pragma unroll
    for (int j = 0; j < NJ; ++j) { const f32x4 ga = G2[j][0], gb = G2[j][1]; const f32x4 a = x[j][0] * rs2 * ga, b2 = x[j][1] * rs2 * gb;
        v4u o; o.x = pk2(a.x, a.y); o.y = pk2(a.z, a.w); o.z = pk2(b2.x, b2.y); o.w = pk2(b2.z, b2.w); o8[64 * j] = o; }
}
__device__ __forceinline__ void p5_rows(Frame& F) {
    const int mfull = (M / F.NGW) * F.NGW;
    { f32x4 G1[4][2], G2[4][2]; load_gain<4>(F.g_post_mix, F.lane, 0, G1); load_gain<4>(F.g_pre_ffn, F.lane, 0, G2);
      for (int m = F.gw; m < mfull; m += F.NGW) p5_row<false>(F, m, 0, G1, G2); }
    for (int base = mfull + 4 * (int)blockIdx.x; base < M; base += 4 * F.G) { const int m = base + (F.wave >> 1);
        if (m < M) { f32x4 G1[2][2], G2[2][2]; load_gain<2>(F.g_post_mix, F.lane, 2 * (F.wave & 1), G1); load_gain<2>(F.g_pre_ffn, F.lane, 2 * (F.wave & 1), G2); p5_row<true>(F, m, F.wave & 1, G1, G2); }
        else { __syncthreads(); __syncthreads(); __syncthreads(); __syncthreads(); } }
}
template <bool HALF> __device__ __forceinline__ void p9_row(Frame& F, int m, int half, float* dst, const f32x4 (&G1)[HALF ? 2 : 4][2]) {
    constexpr int NJ = HALF ? 2 : 4; const int jb = HALF ? 2 * half : 0, lane = F.lane;
    LAS float* px = (LAS float*)F.lds;
    const v4u* fo = (const v4u*)(F.MOB + (size_t)m * D) + lane + 64 * jb; const v4u* yi = (const v4u*)(F.X1B + (size_t)m * D) + lane + 64 * jb; f32x4* yo = (f32x4*)(dst + (size_t)m * D) + 2 * lane + 128 * jb;
    v4u mv[NJ]; f32x4 x[NJ][2]; float v[NJ][8]; float s = 0.f;
#pragma unroll
    for (int j = 0; j < NJ; ++j) { mv[j] = __builtin_nontemporal_load(fo + 64 * j); const v4u xb = __builtin_nontemporal_load(yi + 64 * j); x[j][0] = (f32x4){bflo(xb.x), bfhi(xb.x), bflo(xb.y), bfhi(xb.y)}; x[j][1] = (f32x4){bflo(xb.z), bfhi(xb.z), bflo(xb.w), bfhi(xb.w)}; }
#pragma unroll
    for (int j = 0; j < NJ; ++j) { unpack8(mv[j], v[j]);
#pragma unroll
        for (int e = 0; e < 8; ++e) s += v[j][e] * v[j][e]; }
    const float rs = 1.0f / sqrtf((HALF ? pair_sum(s, px, F.wave) : wave_sum(s)) * (1.f / D) + EPS);
#pragma unroll
    for (int j = 0; j < NJ; ++j) { const f32x4 ga = G1[j][0], gb = G1[j][1];
        __builtin_nontemporal_store(x[j][0] + (f32x4){v[j][0], v[j][1], v[j][2], v[j][3]} * rs * ga, yo + 128 * j); __builtin_nontemporal_store(x[j][1] + (f32x4){v[j][4], v[j][5], v[j][6], v[j][7]} * rs * gb, yo + 128 * j + 1); }
}
__device__ __forceinline__ void p9_rows(Frame& F, float* dst) {
    const int mfull = (M / F.NGW) * F.NGW;
    { f32x4 G1[4][2]; load_gain<4>(F.g_post_ffn, F.lane, 0, G1);
      for (int m = F.gw; m < mfull; m += F.NGW) p9_row<false>(F, m, 0, dst, G1); }
    for (int base = mfull + 4 * (int)blockIdx.x; base < M; base += 4 * F.G) { const int m = base + (F.wave >> 1);
        if (m < M) { f32x4 G1[2][2]; load_gain<2>(F.g_post_ffn, F.lane, 2 * (F.wave & 1), G1); p9_row<true>(F, m, F.wave & 1, dst, G1); } else { __syncthreads(); __syncthreads(); } }
}

__device__ __forceinline__ float gelu_tanh(float g) {
    const float u = (g * g) * (1.5957691216057308f * 0.044715f * 1.4426950408889634f) + (1.5957691216057308f * 1.4426950408889634f);
    return g * __builtin_amdgcn_rcpf(1.0f + __builtin_amdgcn_exp2f(-(g * u)));
}
__device__ __forceinline__ f32x4 gelu_tanh4(f32x4 g) {
    const f32x4 u = (g * g) * (1.5957691216057308f * 0.044715f * 1.4426950408889634f) + (1.5957691216057308f * 1.4426950408889634f);
    const f32x4 t = g * u;
    f32x4 e; e.x = __builtin_amdgcn_exp2f(-t.x); e.y = __builtin_amdgcn_exp2f(-t.y); e.z = __builtin_amdgcn_exp2f(-t.z); e.w = __builtin_amdgcn_exp2f(-t.w);
    const f32x4 d = e + 1.0f;
    f32x4 r; r.x = __builtin_amdgcn_rcpf(d.x); r.y = __builtin_amdgcn_rcpf(d.y); r.z = __builtin_amdgcn_rcpf(d.z); r.w = __builtin_amdgcn_rcpf(d.w);
    return g * r;
}
__device__ __forceinline__ void p7_load(const Frame& F, int rb, int f0, v2u (&av)[10], v2u (&ag)[10], f32x4 (&sv)[2], f32x4 (&sg)[2]) {
    const int m0 = rb * 8; const bool first = m0 < MP && (m0 & 2047) == 0;
    const bf16* ub = F.UP + (size_t)m0 * FF2 + f0;
#pragma unroll
    for (int r = 0; r < 10; ++r) { const int rr = (r < 2 && first) ? 2 : r; av[r] = *(const v2u*)(ub + (size_t)(rr - 2) * FF2); ag[r] = *(const v2u*)(ub + (size_t)(rr - 2) * FF2 + FF); }
    if (m0 >= MP) {
        const float* sc = F.state_conv + (size_t)((m0 - MP) >> 3) * 2 * FF2 + f0;
        sv[0] = *(const f32x4*)sc; sg[0] = *(const f32x4*)(sc + FF); sv[1] = *(const f32x4*)(sc + FF2); sg[1] = *(const f32x4*)(sc + FF2 + FF);
    }
}
__device__ __forceinline__ void p7_conv(Frame& F) {
    constexpr int NCG = FF / 4, NRB = M / 8;
    const int gt = blockIdx.x * 512 + F.tid, NT = F.G * 512, NJ = NT / NCG, j = gt / NCG, cg = gt - j * NCG, f0 = 4 * cg;
    if (j < NJ) {
        f32x4 wv[3], wg[3];
#pragma unroll
        for (int q = 0; q < 3; ++q) { wv[q] = *(const f32x4*)(F.conv_w + (size_t)q * FF2 + f0); wg[q] = *(const f32x4*)(F.conv_w + (size_t)q * FF2 + FF + f0); }
        const f32x4 cbv = *(const f32x4*)(F.conv_b + f0), cbg = *(const f32x4*)(F.conv_b + FF + f0);
        v2u av[10], ag[10]; f32x4 sv[2], sg[2];
        int rb = j;
        p7_load(F, rb, f0, av, ag, sv, sg);
#pragma unroll 1
        while (rb < NRB) {
            const int nrb = rb + NJ;
            v2u nav[10], nag[10]; f32x4 nsv[2], nsg[2];
            p7_load(F, nrb < NRB ? nrb : rb, f0, nav, nag, nsv, nsg);
            const int m0 = rb * 8;
            const bool is_p = m0 < MP; const int t0 = is_p ? (m0 & 2047) : 0; const int sb = is_p ? 0 : (m0 - MP) >> 3;
            const bool zero = is_p && t0 == 0;
            f32x4 hv[3], hg[3];
#pragma unroll
            for (int r = 0; r < 2; ++r) {
                const f32x4 pv = (f32x4){bflo(av[r].x), bfhi(av[r].x), bflo(av[r].y), bfhi(av[r].y)}, pg = (f32x4){bflo(ag[r].x), bfhi(ag[r].x), bflo(ag[r].y), bfhi(ag[r].y)};
#pragma unroll
                for (int e = 0; e < 4; ++e) { hv[r + 1][e] = zero ? 0.f : (is_p ? pv[e] : sv[r][e]); hg[r + 1][e] = zero ? 0.f : (is_p ? pg[e] : sg[r][e]); }
            }
#pragma unroll
            for (int r = 0; r < 8; ++r) {
                const v2u rv = av[r + 2], rg = ag[r + 2];
                hv[0] = hv[1]; hv[1] = hv[2]; hg[0] = hg[1]; hg[1] = hg[2];
                hv[2] = (f32x4){bflo(rv.x), bfhi(rv.x), bflo(rv.y), bfhi(rv.y)}; hg[2] = (f32x4){bflo(rg.x), bfhi(rg.x), bflo(rg.y), bfhi(rg.y)};
                const f32x4 val = cbv + wv[0] * hv[0] + wv[1] * hv[1] + wv[2] * hv[2], gate = cbg + wg[0] * hg[0] + wg[1] * hg[1] + wg[2] * hg[2];
                const f32x4 a = gelu_tanh4(gate) * val;
                *(v2u*)(F.ACT + (size_t)(m0 + r) * FF + f0) = pack4(a);
                if (r >= 6) {
                    float* o = nullptr;
                    if (is_p) { if (t0 == 2040) o = F.out + O_CONVP + ((size_t)(m0 >> 11) * 2 + (r - 6)) * FF2; } else o = F.out + O_CONVS + ((size_t)sb * 2 + (r - 6)) * FF2;
                    if (o) { *(f32x4*)(o + f0) = hv[2]; *(f32x4*)(o + FF + f0) = hg[2]; }
                }
            }
#pragma unroll
            for (int r = 0; r < 10; ++r) { av[r] = nav[r]; ag[r] = nag[r]; }
            sv[0] = nsv[0]; sv[1] = nsv[1]; sg[0] = nsg[0]; sg[1] = nsg[1];
            rb = nrb;
        }
    }
}

struct Args { const float* in[18]; float* out; unsigned char* ws; int ph_lo, ph_hi, li, pad; };
template <int LO, int HI> __global__ void __launch_bounds__(NWAVES * 64, 2) skel_fwd(Args args) {
    extern __shared__ __attribute__((aligned(16))) unsigned char lds[];
    Frame F;
    F.lds = (LAS unsigned char*)lds;
    F.MISC = (volatile LAS unsigned*)(F.lds + LDSCTL_OFF);
    F.tid = threadIdx.x; F.lane = F.tid & 63; F.wave = __builtin_amdgcn_readfirstlane(F.tid >> 6);
    F.G = gridDim.x; F.gw = blockIdx.x * NWAVES + F.wave; F.NGW = F.G * NWAVES;
    unsigned char* ws = args.ws;
    F.ctl = (unsigned*)(ws + WS_CTL);
    F.xp = args.in[0]; F.xs = args.in[1]; F.state_pool = args.in[2]; F.state_ret = args.in[3]; F.state_conv = args.in[4]; F.g_pre_mix = args.in[5]; F.w_in = args.in[6]; F.w_pool = args.in[7];
    F.pool_scale = args.in[8]; F.gn_gain = args.in[9]; F.w_out = args.in[10]; F.g_post_mix = args.in[11]; F.g_pre_ffn = args.in[12]; F.w_up = args.in[13]; F.conv_w = args.in[14]; F.conv_b = args.in[15];
    F.w_down = args.in[16]; F.g_post_ffn = args.in[17]; F.out = args.out;
    F.WIN = (bf16*)(ws + WS_WIN); F.WUP = (bf16*)(ws + WS_WUP); F.WDN = (bf16*)(ws + WS_WDN); F.WOUT = (bf16*)(ws + WS_WOUT); F.WPOOL = (bf16*)(ws + WS_WPOOL);
    F.ROPE_C = (float*)(ws + WS_ROPE); F.ROPE_S = F.ROPE_C + 2056 * 64;
    F.XN = (bf16*)(ws + WS_XN); F.PROJ = (bf16*)(ws + WS_PROJ); F.UP = (bf16*)(ws + WS_PROJ); F.MOB = (bf16*)(ws + WS_PROJ);
    F.SP16 = (bf16*)(ws + WS_SP16); F.X1B = (bf16*)(ws + WS_X1);
    F.OB = (bf16*)(ws + WS_O); F.AP = (bf16*)(ws + WS_AP); F.MM = (bf16*)(ws + WS_MM); F.ACT = (bf16*)(ws + WS_O);
    for (int u = F.tid; u < (LDS_BYTES - LDSCTL_OFF) / 4; u += NWAVES * 64) ((LAS unsigned*)(F.lds + LDSCTL_OFF))[u] = 0u;
    __syncthreads();
    XcdBarrier bar; bar.bar = F.ctl + CW_BAR; bar.x = 0; bar.st = nullptr;
    if (N_LAUNCHES == 1) bar = xcd_barrier_post(F.ctl + CW_BAR, F.MISC + 8);
#define GRID_BAR() do { if (N_LAUNCHES == 1) xcd_barrier(bar); } while (0)
#define IN(k) (LO <= (k) && (k) < HI)
#define FRESH() do { int t_ = threadIdx.x; asm volatile("" : "+v"(t_)); F.tid = t_; F.lane = t_ & 63; } while (0)
#define SEAM(k) do { if constexpr (IN(k) && IN((k) + 1)) GRID_BAR(); } while (0)

#define REPS(k)
#define DUPBAR(k)
    const int rep = args.li;
    if constexpr (IN(0)) { FRESH(); REPS(0) { p0_prologue(F); DUPBAR(0); } SEAM(0); }
    if constexpr (IN(1)) {
      REPS(1) {
        pg8::Gemm g{F.XN, F.WIN, M, NIN, D}; pg8::PartOrder S; S.init(M, NIN, D, F.G, (int)blockIdx.x);
        EpiProj E{F.PROJ, F.ROPE_C, F.ROPE_S}; pg8::SplitCtx X{(float*)(ws + WS_SLAB_A), F.ctl + CW_SPLIT};
        pg8::gemm_phase<EpiProj, pg8::PartOrder, true, PG8_SP2, 5>(F.lds, g, S, E, X);
        if (rep == 0) {
            FRESH();
            if (S.nhelp == 0 || S.hrank >= 0) { const int hb = S.nhelp == 0 ? (int)blockIdx.x : S.hrank, hn = S.nhelp == 0 ? F.G : S.nhelp;
                for (int idx = hb * 512 + F.tid; idx < 128 * 15 * 1024 / 4; idx += hn * 512) { const f32x4 v = __builtin_nontemporal_load((const f32x4*)F.state_pool + idx); ((v2u*)F.SP16)[idx] = pack4(v); } }
            p0_deferred_weights(F, (LAS float*)(F.lds + F.wave * TSCR));
        }
        DUPBAR(1);
      }
        SEAM(1);
    }
    if constexpr (IN(2)) { FRESH(); REPS(2) { p2_mixers(F, rep); DUPBAR(2); } SEAM(2); }
    if constexpr (IN(3)) { FRESH(); REPS(3) { p3_merge(F); DUPBAR(3); } SEAM(3); }
    if constexpr (IN(4)) {
      REPS(4) {
        pg8::Gemm g{F.MM, F.WOUT, M, D, D}; pg8::HybridOrder S; S.init(M, D, D, F.G, (int)blockIdx.x);
        pg8::EpiBf16<0> E{F.MOB, D}; pg8::SplitCtx X{(float*)(ws + WS_SLAB_A), F.ctl + CW_SPLIT + 4096};
        pg8::gemm_phase<pg8::EpiBf16<0>, pg8::HybridOrder, true, PG8_SP2, 8>(F.lds, g, S, E, X);
        DUPBAR(4);
      }
        SEAM(4);
    }
    if constexpr (IN(5)) { FRESH(); REPS(5) { p5_rows(F); DUPBAR(5); } SEAM(5); }
    if constexpr (IN(6)) {
      REPS(6) {
        pg8::Gemm g{F.XN, F.WUP, M, FF2, D}; pg8::HybridOrder S; S.init(M, FF2, D, F.G, (int)blockIdx.x);
        pg8::EpiBf16<0> E{F.UP, FF2}; pg8::SplitCtx X{(float*)(ws + WS_SLAB_A), F.ctl + CW_SPLIT + 2 * 4096};
        pg8::gemm_phase<pg8::EpiBf16<0>, pg8::HybridOrder, true, PG8_SP2, 5>(F.lds, g, S, E, X);
        DUPBAR(6);
      }
        SEAM(6);
    }
    if constexpr (IN(7)) { FRESH(); REPS(7) { p7_conv(F); DUPBAR(7); } SEAM(7); }
    if constexpr (IN(8)) {
      REPS(8) {
        pg8::Gemm g{F.ACT, F.WDN, M, D, FF}; pg8::HybridOrder S; S.init(M, D, FF, F.G, (int)blockIdx.x);
        pg8::EpiBf16<0> E{F.MOB, D}; pg8::SplitCtx X{(float*)(ws + WS_SLAB_B), F.ctl + CW_SPLIT + 3 * 4096};
        pg8::gemm_phase<pg8::EpiBf16<0>, pg8::HybridOrder, true, PG8_SP2, 8>(F.lds, g, S, E, X);
        DUPBAR(8);
      }
        SEAM(8);
    }
    if constexpr (IN(9)) { FRESH(); p9_rows(F, (DUP_PHASE == 9 && rep == 1) ? (float*)(ws + WS_O) : F.out + O_Y); }
#undef IN
#undef SEAM
}


#if MK_N_LAUNCHES != 1
template <int P> static void launch_one(int grid, const Args& a, hipStream_t stream) { hipLaunchKernelGGL((skel_fwd<P, P + 1>), dim3(grid), dim3(NWAVES * 64), LDS_BYTES, stream, a); }
static void launch_phase(int li, int grid, const Args& a, hipStream_t stream) {
    switch (li) { case 0: launch_one<0>(grid, a, stream); break; case 1: launch_one<1>(grid, a, stream); break; case 2: launch_one<2>(grid, a, stream); break; case 3: launch_one<3>(grid, a, stream); break;
        case 4: launch_one<4>(grid, a, stream); break; case 5: launch_one<5>(grid, a, stream); break; case 6: launch_one<6>(grid, a, stream); break; case 7: launch_one<7>(grid, a, stream); break;
        case 8: launch_one<8>(grid, a, stream); break; default: launch_one<9>(grid, a, stream); break; }
}
#endif
static hipError_t set_lds_attr() {
    hipError_t e = hipSuccess;
#if MK_N_LAUNCHES == 1
    e = hipFuncSetAttribute((const void*)skel_fwd<0, N_PHASES>, hipFuncAttributeMaxDynamicSharedMemorySize, LDS_BYTES);
#else
#define SET1(P) if (e == hipSuccess) e = hipFuncSetAttribute((const void*)skel_fwd<P, P + 1>, hipFuncAttributeMaxDynamicSharedMemorySize, LDS_BYTES)
    SET1(0); SET1(1); SET1(2); SET1(3); SET1(4); SET1(5); SET1(6); SET1(7); SET1(8); SET1(9);
#undef SET1
#endif
    return e;
}
static hipError_t occ_query(int* per_cu) {
#if MK_N_LAUNCHES == 1
    return hipOccupancyMaxActiveBlocksPerMultiprocessor(per_cu, (const void*)skel_fwd<0, N_PHASES>, NWAVES * 64, LDS_BYTES);
#else
    return hipOccupancyMaxActiveBlocksPerMultiprocessor(per_cu, (const void*)skel_fwd<1, 2>, NWAVES * 64, LDS_BYTES);
#endif
}
extern "C" void kernel_launch(void* const* d_in, const int* in_sizes, int n_in, void* d_out, int out_size, void* d_ws, size_t ws_size, hipStream_t stream) {
    static int grid = 0;
    if (grid == 0) {
        if (n_in != 18 || (size_t)out_size != O_END || ws_size < WS_END) { fprintf(stderr, "kernel_launch: unexpected shapes: n_in %d out %d ws %zu (need %zu)\n", n_in, out_size, ws_size, (size_t)WS_END); grid = -1; return; }
        int dev = 0, cus = 0, per_cu = 0;
        if (hipGetDevice(&dev) != hipSuccess || hipDeviceGetAttribute(&cus, hipDeviceAttributeMultiprocessorCount, dev) != hipSuccess) { grid = -1; return; }
        if (set_lds_attr() != hipSuccess) { fprintf(stderr, "kernel_launch: hipFuncSetAttribute failed\n"); grid = -1; return; }
        if (occ_query(&per_cu) != hipSuccess || per_cu < 1) { fprintf(stderr, "kernel_launch: occupancy query says %d blocks per CU\n", per_cu); (void)hipGetLastError(); per_cu = 1; }
        grid = cus;
        fprintf(stderr, "kernel_launch: cus %d per_cu %d grid %d ws %zu\n", cus, per_cu, grid, ws_size);
    }
    if (grid < 0) return;
    (void)hipMemsetAsync((char*)d_ws + WS_CTL, 0, CTL_ZERO_BYTES, stream);
    Args a{};
    for (int i = 0; i < 18; ++i) a.in[i] = (const float*)d_in[i];
    a.out = (float*)d_out; a.ws = (unsigned char*)d_ws;
#if MK_N_LAUNCHES == 1
    {
        a.ph_lo = 0; a.ph_hi = N_PHASES; a.li = 0;
        void* kargs[] = {&a};
        hipError_t e = hipLaunchCooperativeKernel((const void*)skel_fwd<0, N_PHASES>, dim3(grid), dim3(NWAVES * 64), kargs, LDS_BYTES, stream);
        if (e != hipSuccess) fprintf(stderr, "kernel_launch: cooperative launch failed: %s (grid %d)\n", hipGetErrorString(e), grid);
    }
#else
    for (int li = 0; li < N_PHASES; ++li) { a.ph_lo = li; a.ph_hi = li + 1; a.li = 0; launch_phase(li, grid, a, stream); if (li == DUP_PHASE) { a.li = 1; launch_phase(li, grid, a, stream); if (li == 9) { a.li = 0; } } if (li == 2 && DUP_PHASE >= 20) { a.li = 1 + 16 * (DUP_PHASE - 20); launch_phase(li, grid, a, stream); } }
#endif
}
```
